# Optimizing an MI355X kernel written in HIP

```python
import math
import jax, jax.numpy as jnp
from jax import lax
import numpy as np

D_MODEL = 1024
BATCH = 16
SEQ = 2048
DEPTH = 2

CHUNK = 64
Q_BLOCK = 128

SSD_HEADS = 16
SSD_HEAD_DIM = 64
SSD_INNER = SSD_HEADS * SSD_HEAD_DIM
SSD_GROUPS = 2
SSD_STATE = 128
SSD_CONV = 4
SSD_CONV_DIM = SSD_INNER + 2 * SSD_GROUPS * SSD_STATE

SB_HEADS = 8
SB_HEAD_DIM = 64
SB_WIDTH = SB_HEADS * SB_HEAD_DIM

MLA_HEADS = 8
MLA_Q_RANK = 256
MLA_KV_RANK = 128
MLA_NOPE = 64
MLA_ROPE = 32
MLA_V = 64
ROPE_THETA = 10000.0

FOX_HEADS = 8
FOX_HEAD_DIM = 64
FOX_WIDTH = FOX_HEADS * FOX_HEAD_DIM

EVEN_IN = SSD_INNER + SSD_CONV_DIM + SSD_HEADS + 3 * SB_WIDTH
EVEN_OUT = SSD_INNER + SB_WIDTH
ODD_IN = MLA_Q_RANK + MLA_KV_RANK + MLA_ROPE + 3 * FOX_WIDTH + FOX_HEADS
ODD_OUT = MLA_HEADS * MLA_V + FOX_WIDTH

MOE_GROUPS = 4
MOE_EXPERTS_PER_GROUP = 4
MOE_EXPERTS = MOE_GROUPS * MOE_EXPERTS_PER_GROUP
MOE_TOP_K = 2
MOE_FF = 256

DEEPNORM_ALPHA = (2.0 * DEPTH) ** 0.25
DEEPNORM_BETA = (8.0 * DEPTH) ** -0.25
LN_EPS = 1e-5
RMS_EPS = 1e-6

N_EVEN = (DEPTH + 1) // 2
N_ODD = DEPTH // 2

kernel_name = 'hybrid_ssd_stickbreak_mla_fox_hmoe'


def _layer_norm(x, g, b):
    x32 = x.astype(jnp.float32)
    mu = jnp.mean(x32, -1, keepdims=True)
    var = jnp.mean(jnp.square(x32 - mu), -1, keepdims=True)
    return ((x32 - mu) * lax.rsqrt(var + LN_EPS) * g + b).astype(x.dtype)


def _rms_norm(x, g):
    x32 = x.astype(jnp.float32)
    return (x32 * lax.rsqrt(jnp.mean(x32 * x32, -1, keepdims=True) + RMS_EPS) * g).astype(x.dtype)


def _split(h, sizes):
    idx = [int(i) for i in np.cumsum(sizes)[:-1]]
    return jnp.split(h, idx, axis=-1)


def _rope(x, cos, sin):
    x1, x2 = jnp.split(x, 2, axis=-1)
    return jnp.concatenate([x1 * cos - x2 * sin, x2 * cos + x1 * sin], axis=-1).astype(x.dtype)


def _causal_depthwise_conv(x, w, b):
    k, c = w.shape
    y = lax.conv_general_dilated(x, w[:, None, :], window_strides=(1,), padding=[(k - 1, 0)],
                                 dimension_numbers=('NWC', 'WIO', 'NWC'), feature_group_count=c)
    return y + b


def _ssd_scan(x, dt, a, b_in, c_in):
    f32 = jnp.float32
    bsz, s, h, p = x.shape
    g, n = b_in.shape[2], b_in.shape[3]
    r = h // g
    nc = s // CHUNK
    xs = (x.astype(f32) * dt[..., None]).reshape(bsz, nc, CHUNK, g, r, p)
    da = (dt * a).reshape(bsz, nc, CHUNK, g, r).transpose(0, 3, 4, 1, 2)
    a_cum = jnp.cumsum(da, axis=-1)
    bc = b_in.astype(f32).reshape(bsz, nc, CHUNK, g, n)
    cc = c_in.astype(f32).reshape(bsz, nc, CHUNK, g, n)
    causal = jnp.tril(jnp.ones((CHUNK, CHUNK), dtype=bool))
    seg = a_cum[..., :, None] - a_cum[..., None, :]
    decay_in = jnp.exp(jnp.where(causal, seg, -jnp.inf))
    cb = jnp.einsum('bclgn,bcsgn->bgcls', cc, bc)
    y_diag = jnp.einsum('bgcls,bgrcls,bcsgrp->bclgrp', cb, decay_in, xs)
    decay_to_end = jnp.exp(a_cum[..., -1:] - a_cum)
    states = jnp.einsum('bclgn,bgrcl,bclgrp->bcgrpn', bc, decay_to_end, xs)
    chunk_decay = jnp.exp(a_cum[..., -1])

    def step(hstate, inp):
        st, dec = inp
        return hstate * dec[..., None, None] + st, hstate

    h0 = jnp.zeros((bsz, g, r, p, n), f32)
    _, prev = lax.scan(step, h0, (jnp.moveaxis(states, 1, 0), jnp.moveaxis(chunk_decay, -1, 0)))
    y_off = jnp.einsum('bclgn,cbgrpn,bgrcl->bclgrp', cc, prev, jnp.exp(a_cum))
    return (y_diag + y_off).reshape(bsz, s, h, p)


def _stick_breaking_attention(q, k, v):
    s, d = q.shape[1], q.shape[3]
    scale = 1.0 / math.sqrt(d)
    outs = []
    for q0 in range(0, s, Q_BLOCK):
        end = q0 + Q_BLOCK
        z = jnp.einsum('bthd,bshd->bhts', q[:, q0:end], k[:, :end]).astype(jnp.float32) * scale
        t_pos = q0 + jnp.arange(Q_BLOCK)[:, None]
        s_pos = jnp.arange(end)[None, :]
        strict = s_pos < t_pos
        log_1m = jnp.where(strict, jax.nn.log_sigmoid(-z), 0.0)
        later = lax.cumsum(log_1m, axis=3, reverse=True) - log_1m
        w = jnp.where(strict, jnp.exp(jax.nn.log_sigmoid(z) + later), 0.0)
        outs.append(jnp.einsum('bhts,bshd->bthd', w.astype(v.dtype), v[:, :end]))
    return jnp.concatenate(outs, axis=1)


def _mla_attention(q_nope, q_pe, k_nope, k_pe, v):
    s = q_nope.shape[1]
    scale = 1.0 / math.sqrt(MLA_NOPE + MLA_ROPE)
    outs = []
    for q0 in range(0, s, Q_BLOCK):
        end = q0 + Q_BLOCK
        z = (jnp.einsum('bthd,bshd->bhts', q_nope[:, q0:end], k_nope[:, :end])
             + jnp.einsum('bthd,bsd->bhts', q_pe[:, q0:end], k_pe[:, :end])).astype(jnp.float32) * scale
        t_pos = q0 + jnp.arange(Q_BLOCK)[:, None]
        s_pos = jnp.arange(end)[None, :]
        allowed = (s_pos // CHUNK) <= (t_pos // CHUNK)
        prob = jax.nn.softmax(jnp.where(allowed, z, -jnp.inf), axis=-1)
        outs.append(jnp.einsum('bhts,bshd->bthd', prob.astype(v.dtype), v[:, :end]))
    return jnp.concatenate(outs, axis=1)


def _forgetting_attention(q, k, v, log_f):
    s, d = q.shape[1], q.shape[3]
    scale = 1.0 / math.sqrt(d)
    fh = jnp.cumsum(log_f, axis=1).transpose(0, 2, 1)
    outs = []
    for q0 in range(0, s, Q_BLOCK):
        end = q0 + Q_BLOCK
        z = jnp.einsum('bthd,bshd->bhts', q[:, q0:end], k[:, :end]).astype(jnp.float32) * scale
        z = z + fh[:, :, q0:end, None] - fh[:, :, None, :end]
        t_pos = q0 + jnp.arange(Q_BLOCK)[:, None]
        s_pos = jnp.arange(end)[None, :]
        prob = jax.nn.softmax(jnp.where(s_pos <= t_pos, z, -jnp.inf), axis=-1)
        outs.append(jnp.einsum('bhts,bshd->bthd', prob.astype(v.dtype), v[:, :end]))
    return jnp.concatenate(outs, axis=1)


def _even_mixer(x, w_in, conv_w, conv_b, dt_bias, a_log, d_skip, norm_g, w_out):
    f32 = jnp.float32
    bsz, s, _ = x.shape
    h = x @ w_in
    z, xbc, dt_raw, q, k, v = _split(h, [SSD_INNER, SSD_CONV_DIM, SSD_HEADS, SB_WIDTH, SB_WIDTH, SB_WIDTH])
    xbc = jax.nn.silu(_causal_depthwise_conv(xbc, conv_w, conv_b))
    xs, bs, cs = _split(xbc, [SSD_INNER, SSD_GROUPS * SSD_STATE, SSD_GROUPS * SSD_STATE])
    xs = xs.reshape(bsz, s, SSD_HEADS, SSD_HEAD_DIM)
    dt = jax.nn.softplus((dt_raw + dt_bias).astype(f32))
    a = -jnp.exp(a_log.astype(f32))
    y = _ssd_scan(xs, dt, a, bs.reshape(bsz, s, SSD_GROUPS, SSD_STATE), cs.reshape(bsz, s, SSD_GROUPS, SSD_STATE))
    y = (y + d_skip[:, None] * xs).reshape(bsz, s, SSD_INNER).astype(x.dtype)
    y = _rms_norm(y * jax.nn.silu(z), norm_g)
    sb = _stick_breaking_attention(q.reshape(bsz, s, SB_HEADS, SB_HEAD_DIM), k.reshape(bsz, s, SB_HEADS, SB_HEAD_DIM),
                                   v.reshape(bsz, s, SB_HEADS, SB_HEAD_DIM)).reshape(bsz, s, SB_WIDTH)
    return jnp.concatenate([y, sb], axis=-1) @ w_out


def _odd_mixer(x, w_in, q_norm_g, w_q_up, kv_norm_g, w_kv_up, f_bias, w_out, cos, sin):
    bsz, s, _ = x.shape
    h = x @ w_in
    c_q, c_kv, k_pe, q, k, v, f_raw = _split(h, [MLA_Q_RANK, MLA_KV_RANK, MLA_ROPE, FOX_WIDTH, FOX_WIDTH, FOX_WIDTH, FOX_HEADS])
    q_m = (_rms_norm(c_q, q_norm_g) @ w_q_up).reshape(bsz, s, MLA_HEADS, MLA_NOPE + MLA_ROPE)
    q_nope = q_m[..., :MLA_NOPE]
    q_pe = _rope(q_m[..., MLA_NOPE:], cos[:, None, :], sin[:, None, :])
    kv = (_rms_norm(c_kv, kv_norm_g) @ w_kv_up).reshape(bsz, s, MLA_HEADS, MLA_NOPE + MLA_V)
    k_nope, v_m = kv[..., :MLA_NOPE], kv[..., MLA_NOPE:]
    k_pe = _rope(k_pe, cos, sin)
    mla = _mla_attention(q_nope, q_pe, k_nope, k_pe, v_m).reshape(bsz, s, MLA_HEADS * MLA_V)
    log_f = jax.nn.log_sigmoid((f_raw + f_bias).astype(jnp.float32))
    fox = _forgetting_attention(q.reshape(bsz, s, FOX_HEADS, FOX_HEAD_DIM), k.reshape(bsz, s, FOX_HEADS, FOX_HEAD_DIM),
                                v.reshape(bsz, s, FOX_HEADS, FOX_HEAD_DIM), log_f).reshape(bsz, s, FOX_WIDTH)
    return jnp.concatenate([mla, fox], axis=-1) @ w_out


def _hier_moe(x, w_group, b_group, w_expert, b_expert, w_gate, w_up, w_down):
    f32 = jnp.float32
    bsz, s, d = x.shape
    t = x.reshape(bsz * s, d)
    n_tok = t.shape[0]
    g_prob = jax.nn.softmax((t @ w_group + b_group).astype(f32), axis=-1)
    g_p, g_sel = lax.top_k(g_prob, 1)
    e_logits = (t @ w_expert + b_expert).astype(f32).reshape(n_tok, MOE_GROUPS, MOE_EXPERTS_PER_GROUP)
    idx = jnp.broadcast_to(g_sel[:, :, None], (n_tok, 1, MOE_EXPERTS_PER_GROUP))
    e_prob = jax.nn.softmax(jnp.take_along_axis(e_logits, idx, axis=1)[:, 0], axis=-1)
    top_p, top_i = lax.top_k(e_prob, MOE_TOP_K)
    weights = g_p * top_p / jnp.sum(top_p, axis=-1, keepdims=True)
    expert_id = g_sel * MOE_EXPERTS_PER_GROUP + top_i
    gate = jnp.sum(jax.nn.one_hot(expert_id, MOE_EXPERTS, dtype=f32) * weights[..., None], axis=1)
    y = jnp.zeros((n_tok, d), f32)
    for e in range(MOE_EXPERTS):
        hid = jax.nn.silu(t @ w_gate[e]) * (t @ w_up[e])
        y = y + gate[:, e:e + 1] * (hid @ w_down[e])
    return y.astype(x.dtype).reshape(bsz, s, d)


def setup_inputs(seed: int = 0) -> dict:
    key = jax.random.key(seed)
    ks = iter(jax.random.split(key, 40))
    nrm = lambda shape, scale: jax.random.normal(next(ks), shape, jnp.float32) * scale
    gain = lambda shape: 1.0 + nrm(shape, 0.02)
    dt0 = jnp.exp(jax.random.uniform(next(ks), (N_EVEN, SSD_HEADS), jnp.float32, math.log(1e-3), math.log(1e-1)))
    return {
        'x': nrm((BATCH, SEQ, D_MODEL), 1.0),
        'ev_w_in': nrm((N_EVEN, D_MODEL, EVEN_IN), D_MODEL ** -0.5),
        'ev_conv_w': nrm((N_EVEN, SSD_CONV, SSD_CONV_DIM), SSD_CONV ** -0.5),
        'ev_conv_b': nrm((N_EVEN, SSD_CONV_DIM), 0.02),
        'ev_dt_bias': dt0 + jnp.log(-jnp.expm1(-dt0)),
        'ev_a_log': jnp.log(jax.random.uniform(next(ks), (N_EVEN, SSD_HEADS), jnp.float32, 1.0, 16.0)),
        'ev_d_skip': gain((N_EVEN, SSD_HEADS)),
        'ev_norm_g': gain((N_EVEN, SSD_INNER)),
        'ev_w_out': nrm((N_EVEN, EVEN_OUT, D_MODEL), EVEN_OUT ** -0.5 * DEEPNORM_BETA),
        'od_w_in': nrm((N_ODD, D_MODEL, ODD_IN), D_MODEL ** -0.5),
        'od_q_norm_g': gain((N_ODD, MLA_Q_RANK)),
        'od_w_q_up': nrm((N_ODD, MLA_Q_RANK, MLA_HEADS * (MLA_NOPE + MLA_ROPE)), MLA_Q_RANK ** -0.5),
        'od_kv_norm_g': gain((N_ODD, MLA_KV_RANK)),
        'od_w_kv_up': nrm((N_ODD, MLA_KV_RANK, MLA_HEADS * (MLA_NOPE + MLA_V)), MLA_KV_RANK ** -0.5),
        'od_f_bias': nrm((N_ODD, FOX_HEADS), 0.1),
        'od_w_out': nrm((N_ODD, ODD_OUT, D_MODEL), ODD_OUT ** -0.5 * DEEPNORM_BETA),
        'ln1_g': gain((DEPTH, D_MODEL)),
        'ln1_b': nrm((DEPTH, D_MODEL), 0.02),
        'ln2_g': gain((DEPTH, D_MODEL)),
        'ln2_b': nrm((DEPTH, D_MODEL), 0.02),
        'moe_w_group': nrm((DEPTH, D_MODEL, MOE_GROUPS), D_MODEL ** -0.5),
        'moe_b_group': nrm((DEPTH, MOE_GROUPS), 0.01),
        'moe_w_expert': nrm((DEPTH, D_MODEL, MOE_EXPERTS), D_MODEL ** -0.5),
        'moe_b_expert': nrm((DEPTH, MOE_EXPERTS), 0.01),
        'moe_w_gate': nrm((DEPTH, MOE_EXPERTS, D_MODEL, MOE_FF), D_MODEL ** -0.5),
        'moe_w_up': nrm((DEPTH, MOE_EXPERTS, D_MODEL, MOE_FF), D_MODEL ** -0.5 * DEEPNORM_BETA),
        'moe_w_down': nrm((DEPTH, MOE_EXPERTS, MOE_FF, D_MODEL), MOE_FF ** -0.5 * DEEPNORM_BETA),
    }


def reference(x, ev_w_in, ev_conv_w, ev_conv_b, ev_dt_bias, ev_a_log, ev_d_skip, ev_norm_g, ev_w_out,
              od_w_in, od_q_norm_g, od_w_q_up, od_kv_norm_g, od_w_kv_up, od_f_bias, od_w_out,
              ln1_g, ln1_b, ln2_g, ln2_b, moe_w_group, moe_b_group, moe_w_expert, moe_b_expert,
              moe_w_gate, moe_w_up, moe_w_down):
    s = x.shape[1]
    inv_freq = ROPE_THETA ** (-(jnp.arange(0, MLA_ROPE, 2, dtype=jnp.float32) / MLA_ROPE))
    ang = jnp.arange(s, dtype=jnp.float32)[:, None] * inv_freq[None, :]
    cos, sin = jnp.cos(ang), jnp.sin(ang)
    for i in range(DEPTH):
        j = i // 2
        if i % 2 == 0:
            mix = _even_mixer(x, ev_w_in[j], ev_conv_w[j], ev_conv_b[j], ev_dt_bias[j], ev_a_log[j],
                              ev_d_skip[j], ev_norm_g[j], ev_w_out[j])
        else:
            mix = _odd_mixer(x, od_w_in[j], od_q_norm_g[j], od_w_q_up[j], od_kv_norm_g[j], od_w_kv_up[j],
                             od_f_bias[j], od_w_out[j], cos, sin)
        x = _layer_norm(DEEPNORM_ALPHA * x + mix, ln1_g[i], ln1_b[i])
        ffn = _hier_moe(x, moe_w_group[i], moe_b_group[i], moe_w_expert[i], moe_b_expert[i],
                        moe_w_gate[i], moe_w_up[i], moe_w_down[i])
        x = _layer_norm(DEEPNORM_ALPHA * x + ffn, ln2_g[i], ln2_b[i])
    return x
```

```cpp
#include <hip/hip_runtime.h>
#include <stdint.h>
#include <stdio.h>

#ifndef MK_MULTI
#define MK_MULTI 1
#endif

typedef unsigned short bf16_t;
typedef float f32x4 __attribute__((ext_vector_type(4)));
typedef float f32x2 __attribute__((ext_vector_type(2)));
typedef unsigned u32x4 __attribute__((ext_vector_type(4)));
typedef unsigned u32x2 __attribute__((ext_vector_type(2)));

constexpr int NB = 16, S = 2048, T = NB * S, D = 1024;
constexpr int EVEN_IN = 4112, ODD_IN = 1960;
constexpr float ALPHA = 1.4142135623730951f;
constexpr float LOG2E = 1.4426950408889634f;
constexpr float C2_64 = 0.125f * LOG2E;
constexpr float C2_96 = 0.10206207261596577f * LOG2E;
constexpr int NTHR = 512;

constexpr size_t MiB = 1024 * 1024;
constexpr size_t OFF_BAR = 0;
constexpr size_t OFF_CTRL = 16 * 1024;
constexpr size_t CTRL_BYTES = 16 * 1024;
constexpr size_t OFF_TAB = 64 * 1024;
constexpr size_t OFF_DT = 1 * MiB;
constexpr size_t OFF_SSQ = 3 * MiB;
constexpr size_t OFF_ROUTE = 5 * MiB;
constexpr size_t OFF_W = 8 * MiB;
constexpr size_t W0M = OFF_W;
constexpr size_t W0V = W0M + (size_t)3584 * 1024 * 2;
constexpr size_t W0O = W0V + (size_t)512 * 1024 * 2;
constexpr size_t W1M = W0O + (size_t)1024 * 1536 * 2;
constexpr size_t W1V = W1M + (size_t)1536 * 1024 * 2;
constexpr size_t W1Q = W1V + (size_t)512 * 1024 * 2;
constexpr size_t W1K = W1Q + (size_t)768 * 256 * 2;
constexpr size_t W1VV = W1K + (size_t)512 * 128 * 2;
constexpr size_t W1O = W1VV + (size_t)512 * 128 * 2;
constexpr size_t WGU = W1O + (size_t)1024 * 1024 * 2;
constexpr size_t WDN = WGU + (size_t)2 * 16 * 512 * 1024 * 2;
constexpr size_t W_END = WDN + (size_t)2 * 16 * 1024 * 256 * 2;
static_assert(W_END <= 76 * MiB, "weights region");
constexpr size_t R_XBZ = 76 * MiB;
constexpr size_t R_XQ = 204 * MiB;
constexpr size_t R_A2 = 396 * MiB;
constexpr size_t WS_NEED = 512 * MiB;

struct P {
    const float* x; const float* ev_w_in; const float* ev_conv_w; const float* ev_conv_b; const float* ev_dt_bias; const float* ev_a_log;
    const float* ev_d_skip; const float* ev_norm_g; const float* ev_w_out; const float* od_w_in; const float* od_q_norm_g; const float* od_w_q_up;
    const float* od_kv_norm_g; const float* od_w_kv_up; const float* od_f_bias; const float* od_w_out; const float* ln1_g; const float* ln1_b;
    const float* ln2_g; const float* ln2_b; const float* moe_w_group; const float* moe_b_group; const float* moe_w_expert; const float* moe_b_expert;
    const float* moe_w_gate; const float* moe_w_up; const float* moe_w_down;
    float* out; unsigned char* ws;
};

__device__ __forceinline__ float bf2f(bf16_t v) { return __uint_as_float(((unsigned)v) << 16); }
__device__ __forceinline__ unsigned pk_bf16(float lo, float hi) {
    typedef __bf16 b2 __attribute__((ext_vector_type(2)));
    f32x2 v = {lo, hi}; b2 b = __builtin_convertvector(v, b2); return __builtin_bit_cast(unsigned, b);
}
__device__ __forceinline__ bf16_t f2bf(float f) { return (bf16_t)(pk_bf16(f, 0.f) & 0xffffu); }
__device__ __forceinline__ float bflo(unsigned w) { return __uint_as_float(w << 16); }
__device__ __forceinline__ float bfhi(unsigned w) { return __uint_as_float(w & 0xffff0000u); }
__device__ __forceinline__ float silu_f(float x) { return x / (1.0f + __expf(-x)); }
__device__ __forceinline__ float softplus_f(float x) { return x > 20.f ? x : log1pf(expf(x)); }
__device__ __forceinline__ float logsigmoid_f(float x) { return fminf(x, 0.f) - log1pf(expf(-fabsf(x))); }
__device__ __forceinline__ float wave_sum(float v) {
#pragma unroll
    for (int o = 32; o >= 1; o >>= 1) v += __shfl_xor(v, o);
    return v;
}
template <class T_> __device__ __forceinline__ T_* wsp(const P& p, size_t off) { return (T_*)(p.ws + off); }

#define XB_TMO      128
#define XB_XCNT(j)  (256  + 64 * (j))
#define XB_XSUB(j)  (1280 + 64 * (j))
#define XB_XGEN(j)  (2304 + 64 * (j))
#define XB_TOP      3328
#define XB_TOPGEN   3392
#define XCD_BAR_WORDS 3456
#define XB_SPIN_CAP (1u << 18)
#define LAS __attribute__((address_space(3)))

__device__ __forceinline__ unsigned xb_ld(unsigned* p)              { return __hip_atomic_load(p, __ATOMIC_RELAXED, __HIP_MEMORY_SCOPE_AGENT); }
__device__ __forceinline__ unsigned xb_add(unsigned* p, unsigned v) { return __hip_atomic_fetch_add(p, v, __ATOMIC_RELAXED, __HIP_MEMORY_SCOPE_AGENT); }
__device__ __forceinline__ unsigned xb_xcc_id() { return (unsigned)__builtin_amdgcn_s_getreg((3 << 11) | 20) & 0xFu; }
#define XB_SPIN(cond, bar) do { unsigned _sp = 0; while (cond) { __builtin_amdgcn_s_sleep(1); \
    if ((++_sp & 255u) == 0u) { if (xb_ld(&(bar)[XB_TMO])) break; if (_sp > XB_SPIN_CAP) { atomicAdd(&(bar)[XB_TMO], 1u); break; } } } } while (0)

struct XcdBarrier { unsigned* bar; unsigned x; volatile LAS unsigned* st; };

__device__ __forceinline__ XcdBarrier xcd_barrier_post(unsigned* bar, volatile LAS unsigned* st) {
    XcdBarrier b; b.bar = bar; b.x = xb_xcc_id(); b.st = st;
    if (threadIdx.x == 0) (void)xb_add(&bar[XB_XCNT(b.x)], 1u);
    return b;
}
__device__ __forceinline__ void xcd_barrier_complete(unsigned* bar, unsigned x, unsigned& nloc, unsigned& nx) {
    const unsigned G = gridDim.x * gridDim.y * gridDim.z;
    unsigned sum, cnt, mine, sp = 0u;
    for (;;) {
        sum = 0u; cnt = 0u; mine = 0u;
#pragma unroll
        for (unsigned j = 0; j < 16; ++j) { const unsigned c = xb_ld(&bar[XB_XCNT(j)]); sum += c; cnt += (c > 0u) ? 1u : 0u; mine = (j == x) ? c : mine; }
        if (sum == G) break;
        __builtin_amdgcn_s_sleep(1);
        if ((++sp & 255u) == 0u) { if (xb_ld(&bar[XB_TMO])) break; if (sp > XB_SPIN_CAP) { atomicAdd(&bar[XB_TMO], 1u); break; } }
    }
    nloc = mine > 0u ? mine : 1u; nx = cnt > 0u ? cnt : 1u;
}
__device__ __forceinline__ void xcd_barrier(const XcdBarrier& b) {
    asm volatile("s_waitcnt vmcnt(0)" ::: "memory");
    __syncthreads();
    if (threadIdx.x == 0) {
        unsigned* bar = b.bar;
        __builtin_amdgcn_s_waitcnt(0);
        unsigned nloc = b.st[0], nx = b.st[1];
        if (nloc == 0u) { xcd_barrier_complete(bar, b.x, nloc, nx); b.st[0] = nloc; b.st[1] = nx; }
        const unsigned old = xb_add(&bar[XB_XSUB(b.x)], 1u);
        const unsigned gen = old / nloc;
        if (old + 1u == (gen + 1u) * nloc) {
            __builtin_amdgcn_fence(__ATOMIC_RELEASE, "agent");
            asm volatile("s_waitcnt vmcnt(0)" ::: "memory");
            const unsigned og = xb_add(&bar[XB_TOP], 1u);
            const unsigned tg = og / nx;
            if (og + 1u == (tg + 1u) * nx) xb_add(&bar[XB_TOPGEN], 1u);
            else XB_SPIN(xb_ld(&bar[XB_TOPGEN]) == tg, bar);
            __builtin_amdgcn_fence(__ATOMIC_ACQUIRE, "agent");
            xb_add(&bar[XB_XGEN(b.x)], 1u);
            asm volatile("s_waitcnt vmcnt(0)" ::: "memory");
        } else {
            XB_SPIN(xb_ld(&bar[XB_XGEN(b.x)]) == gen, bar);
            __builtin_amdgcn_fence(__ATOMIC_ACQUIRE, "agent");
            asm volatile("s_waitcnt vmcnt(0)" ::: "memory");
        }
    }
    __syncthreads();
}

struct NoMid { static constexpr int ksplit = -1; __device__ __forceinline__ float scale(int) const { return 1.f; } };
template <bool DUAL, class Epi, class Mid>
__device__ void gemm_naive(const bf16_t* __restrict__ A, int lda, const int* __restrict__ gidx, const bf16_t* __restrict__ Bt, int ldb,
                           int M, int N, int K, const Epi& epi, const Mid& mid, float* lds, int bid, int nblk) {
    float* As = lds;
    float* Bs = lds + 32 * 132;
    float* Bs2 = Bs + 32 * 68;
    const int tid = threadIdx.x, ty = tid >> 4, tx = tid & 15;
    const int ntn = N / 64, ntiles = (M / 128) * ntn;
    for (int tile = bid; tile < ntiles; tile += nblk) {
        const int tm = tile / ntn, tn = tile % ntn;
        float acc[4][4], acc2[4][4];
#pragma unroll
        for (int i = 0; i < 4; ++i)
#pragma unroll
            for (int j = 0; j < 4; ++j) { acc[i][j] = 0.f; acc2[i][j] = 0.f; }
        const int lrow = tid >> 2, kc = (tid & 3) * 8;
        long arow = tm * 128 + lrow;
        if (gidx) { const int e = gidx[arow]; arow = e < 0 ? -1 : (e >> 1); }
        int brow = tn * 64 + (lrow & 63);
        if (DUAL) brow = (tn >> 1) * 256 + (tn & 1) * 64 + (lrow & 63);
        for (int k0 = 0; k0 < K; k0 += 32) {
            if (k0 == Mid::ksplit) {
#pragma unroll
                for (int i = 0; i < 4; ++i) { const float s = mid.scale(tm * 128 + ty * 4 + i);
#pragma unroll
                    for (int j = 0; j < 4; ++j) acc[i][j] *= s; }
            }
            u32x4 va = {0u, 0u, 0u, 0u};
            if (arow >= 0) va = *(const u32x4*)(A + (size_t)arow * lda + k0 + kc);
#pragma unroll
            for (int j = 0; j < 4; ++j) { As[(kc + 2 * j) * 132 + lrow] = bflo(va[j]); As[(kc + 2 * j + 1) * 132 + lrow] = bfhi(va[j]); }
            if (tid < 256) {
                const u32x4 vb = *(const u32x4*)(Bt + (size_t)brow * ldb + k0 + kc);
#pragma unroll
                for (int j = 0; j < 4; ++j) { Bs[(kc + 2 * j) * 68 + lrow] = bflo(vb[j]); Bs[(kc + 2 * j + 1) * 68 + lrow] = bfhi(vb[j]); }
            } else if (DUAL) {
                const u32x4 vb = *(const u32x4*)(Bt + (size_t)(brow + 128) * ldb + k0 + kc);
#pragma unroll
                for (int j = 0; j < 4; ++j) { Bs2[(kc + 2 * j) * 68 + (lrow & 63)] = bflo(vb[j]); Bs2[(kc + 2 * j + 1) * 68 + (lrow & 63)] = bfhi(vb[j]); }
            }
            __syncthreads();
#pragma unroll 8
            for (int k = 0; k < 32; ++k) {
                const f32x4 a = *(const f32x4*)(As + k * 132 + ty * 4);
                const f32x4 b = *(const f32x4*)(Bs + k * 68 + tx * 4);
#pragma unroll
                for (int i = 0; i < 4; ++i)
#pragma unroll
                    for (int j = 0; j < 4; ++j) acc[i][j] += a[i] * b[j];
                if (DUAL) {
                    const f32x4 b2 = *(const f32x4*)(Bs2 + k * 68 + tx * 4);
#pragma unroll
                    for (int i = 0; i < 4; ++i)
#pragma unroll
                        for (int j = 0; j < 4; ++j) acc2[i][j] += a[i] * b2[j];
                }
            }
            __syncthreads();
        }
#pragma unroll
        for (int i = 0; i < 4; ++i) {
            f32x4 v = {acc[i][0], acc[i][1], acc[i][2], acc[i][3]};
            if (DUAL) {
#pragma unroll
                for (int j = 0; j < 4; ++j) v[j] = silu_f(acc[i][j]) * acc2[i][j];
            }
            epi(tm * 128 + ty * 4 + i, tn * 64 + tx * 4, v);
        }
    }
}

__device__ __forceinline__ void st_bf16x4(bf16_t* p, f32x4 v) { u32x2 w; w.x = pk_bf16(v[0], v[1]); w.y = pk_bf16(v[2], v[3]); *(u32x2*)p = w; }

template <class F> __device__ __forceinline__ void conv_rows(bf16_t* dst, int nrows, int K, F f, size_t gtid, size_t gstride) {
    const size_t n_el = (size_t)nrows * K;
    for (size_t i = gtid; i < n_el; i += gstride) { const int n = (int)(i / K), k = (int)(i % K); dst[i] = f2bf(f(n, k)); }
}
__device__ void ph_prologue(const P& p, int bid, int nblk) {
    const size_t gtid = (size_t)bid * NTHR + threadIdx.x, gstride = (size_t)nblk * NTHR;
    { const f32x4* src = (const f32x4*)p.x; u32x2* dst = wsp<u32x2>(p, R_XBZ);
      for (size_t i = gtid; i < (size_t)T * D / 4; i += gstride) { const f32x4 v = src[i]; u32x2 o; o.x = pk_bf16(v[0], v[1]); o.y = pk_bf16(v[2], v[3]); dst[i] = o; } }
    { float* DT = wsp<float>(p, OFF_DT);
      for (size_t i = gtid; i < (size_t)T * 16; i += gstride) { const int t = (int)(i >> 4), h = (int)(i & 15); const float* xr = p.x + (size_t)t * D; const float* w = p.ev_w_in + 2560 + h;
        float a = 0.f; for (int k = 0; k < D; ++k) a += xr[k] * w[(size_t)k * EVEN_IN]; DT[i] = softplus_f(a + p.ev_dt_bias[h]); } }
    { const float* w = p.ev_w_in;
      conv_rows(wsp<bf16_t>(p, W0M), 3584, 1024, [=](int n, int k) { const int c = n < 2560 ? n : (n < 3072 ? 2576 + (n - 2560) : 3088 + (n - 3072)); return w[(size_t)k * EVEN_IN + c]; }, gtid, gstride);
      conv_rows(wsp<bf16_t>(p, W0V), 512, 1024, [=](int n, int k) { return w[(size_t)k * EVEN_IN + 3600 + n]; }, gtid, gstride); }
    { const float* w = p.ev_w_out; const float* g = p.ev_norm_g;
      conv_rows(wsp<bf16_t>(p, W0O), 1024, 1536, [=](int n, int k) { return w[(size_t)k * 1024 + n] * (k < 1024 ? g[k] : 1.f); }, gtid, gstride); }
    { const float* w = p.od_w_in;
      conv_rows(wsp<bf16_t>(p, W1M), 1536, 1024, [=](int n, int k) {
          int c;
          if (n < 384) c = n;
          else if (n < 416) { const int j = n - 384, i = j >> 1; c = 384 + ((j & 1) ? i + 16 : i); }
          else if (n < 512) return 0.f;
          else if (n < 1024) c = 416 + (n - 512);
          else c = 928 + (n - 1024);
          return w[(size_t)k * ODD_IN + c]; }, gtid, gstride);
      conv_rows(wsp<bf16_t>(p, W1V), 512, 1024, [=](int n, int k) { return w[(size_t)k * ODD_IN + 1440 + n]; }, gtid, gstride); }
    { const float* w = p.od_w_q_up; const float* g = p.od_q_norm_g;
      conv_rows(wsp<bf16_t>(p, W1Q), 768, 256, [=](int n, int k) { const int h = n / 96, j = n % 96; int c = n;
          if (j >= 64) { const int jj = j - 64, i = jj >> 1; c = 96 * h + 64 + ((jj & 1) ? i + 16 : i); }
          return w[(size_t)k * 768 + c] * g[k]; }, gtid, gstride); }
    { const float* w = p.od_w_kv_up; const float* g = p.od_kv_norm_g;
      conv_rows(wsp<bf16_t>(p, W1K), 512, 128, [=](int n, int k) { const int h = n >> 6, d = n & 63; return w[(size_t)k * 1024 + 128 * h + d] * g[k]; }, gtid, gstride);
      conv_rows(wsp<bf16_t>(p, W1VV), 512, 128, [=](int n, int k) { const int h = n >> 6, d = n & 63; return w[(size_t)k * 1024 + 128 * h + 64 + d] * g[k]; }, gtid, gstride); }
    { const float* w = p.od_w_out;
      conv_rows(wsp<bf16_t>(p, W1O), 1024, 1024, [=](int n, int k) { return w[(size_t)k * 1024 + n]; }, gtid, gstride); }
    { const float* wg = p.moe_w_gate; const float* wu = p.moe_w_up; const float* wd = p.moe_w_down;
      conv_rows(wsp<bf16_t>(p, WGU), 32 * 512, 1024, [=](int n, int k) { const int le = n >> 9, r = n & 511, j = r >> 8, rr = r & 255; const int c = 128 * j + (rr & 127);
          const float* src = (rr < 128) ? wg : wu; return src[((size_t)le * 1024 + k) * 256 + c]; }, gtid, gstride);
      conv_rows(wsp<bf16_t>(p, WDN), 32 * 1024, 256, [=](int n, int k) { const int le = n >> 10, c = n & 1023; return wd[((size_t)le * 256 + k) * 1024 + c]; }, gtid, gstride); }
    { float* tab = wsp<float>(p, OFF_TAB);
      for (size_t i = gtid; i < (size_t)S * 16; i += gstride) { const int s = (int)(i >> 4), f = (int)(i & 15);
        const double inv = pow(10000.0, -(double)f / 16.0); const double ang = (double)s * inv; tab[i] = (float)cos(ang); tab[S * 16 + i] = (float)sin(ang); } }
}

struct EpiIn0 {
    bf16_t* Z; bf16_t* XBCR; bf16_t* Q; bf16_t* K;
    __device__ __forceinline__ void operator()(int row, int col, f32x4 v) const {
        if (col < 1024) st_bf16x4(Z + (size_t)row * 1024 + col, v);
        else if (col < 2560) st_bf16x4(XBCR + (size_t)row * 1536 + (col - 1024), v);
        else if (col < 3072) st_bf16x4(Q + (size_t)row * 512 + (col - 2560), v * C2_64);
        else st_bf16x4(K + (size_t)row * 512 + (col - 3072), v);
    }
};
struct EpiVt { bf16_t* Vt; __device__ __forceinline__ void operator()(int row, int col, f32x4 v) const { st_bf16x4(Vt + (size_t)row * T + col, v); } };

__device__ void ph_inproj0(const P& p, float* lds, int bid, int nblk) {
    const bf16_t* XB = wsp<bf16_t>(p, R_XBZ);
    EpiIn0 e{wsp<bf16_t>(p, R_XBZ + 64 * MiB), wsp<bf16_t>(p, R_A2), wsp<bf16_t>(p, R_XQ + 96 * MiB), wsp<bf16_t>(p, R_XQ + 128 * MiB)};
    gemm_naive<false>(XB, 1024, nullptr, wsp<bf16_t>(p, W0M), 1024, T, 3584, 1024, e, NoMid{}, lds, bid, nblk);
    EpiVt ev{wsp<bf16_t>(p, R_XQ + 160 * MiB)};
    gemm_naive<false>(wsp<bf16_t>(p, W0V), 1024, nullptr, XB, 1024, 512, T, 1024, ev, NoMid{}, lds, bid, nblk);
}
__device__ void ph_conv(const P& p, int bid, int nblk) {
    const bf16_t* XR = wsp<bf16_t>(p, R_A2); bf16_t* XC = wsp<bf16_t>(p, R_XQ);
    const size_t gtid = (size_t)bid * NTHR + threadIdx.x, gstride = (size_t)nblk * NTHR;
    for (size_t i = gtid; i < (size_t)T * 1536; i += gstride) {
        const int t = (int)(i / 1536), c = (int)(i % 1536), s = t & (S - 1);
        float a = p.ev_conv_b[c];
#pragma unroll
        for (int k = 0; k < 4; ++k) { const int ss = s - 3 + k; if (ss >= 0) a += p.ev_conv_w[k * 1536 + c] * bf2f(XR[(size_t)(t - 3 + k) * 1536 + c]); }
        XC[i] = f2bf(silu_f(a));
    }
}
__device__ void ph_ssd_naive(const P& p, float* lds, int bid, int nblk) {
    const bf16_t* XC = wsp<bf16_t>(p, R_XQ); const bf16_t* Z = wsp<bf16_t>(p, R_XBZ + 64 * MiB); const float* DT = wsp<float>(p, OFF_DT);
    bf16_t* A2 = wsp<bf16_t>(p, R_A2); float* SSQ = wsp<float>(p, OFF_SSQ);
    float* Bs = lds; float* Cs = Bs + 16 * 128; float* xs = Cs + 16 * 128; float* dts = xs + 16 * 64; float* yp = dts + 16;
    const int tid = threadIdx.x, pp = tid & 63, nq = tid >> 6, lane = tid & 63;
    for (int u = bid; u < NB * 16; u += nblk) {
        const int b = u >> 4, h = u & 15, g = h >> 3;
        const float a = -expf(p.ev_a_log[h]), dsk = p.ev_d_skip[h];
        float st[16];
#pragma unroll
        for (int n = 0; n < 16; ++n) st[n] = 0.f;
        for (int c0 = 0; c0 < S; c0 += 16) {
            const size_t r0 = (size_t)b * S + c0;
            for (int idx = tid; idx < 16 * 128; idx += NTHR) { const int i = idx >> 7, n = idx & 127; const bf16_t* r = XC + (r0 + i) * 1536;
                Bs[idx] = bf2f(r[1024 + g * 128 + n]); Cs[idx] = bf2f(r[1280 + g * 128 + n]); }
            for (int idx = tid; idx < 16 * 64; idx += NTHR) { const int i = idx >> 6, q = idx & 63; xs[idx] = bf2f(XC[(r0 + i) * 1536 + h * 64 + q]); }
            if (tid < 16) dts[tid] = DT[(r0 + tid) * 16 + h];
            __syncthreads();
            for (int i = 0; i < 16; ++i) {
                const float dt = dts[i], dA = expf(dt * a), dtx = dt * xs[i * 64 + pp];
                float y = 0.f;
#pragma unroll
                for (int n = 0; n < 16; ++n) { st[n] = st[n] * dA + dtx * Bs[i * 128 + nq * 16 + n]; y += Cs[i * 128 + nq * 16 + n] * st[n]; }
                yp[(nq * 16 + i) * 64 + pp] = y;
            }
            __syncthreads();
            for (int idx = tid; idx < 16 * 64; idx += NTHR) {
                const int i = idx >> 6, q = idx & 63; float y = 0.f;
#pragma unroll
                for (int w = 0; w < 8; ++w) y += yp[(w * 16 + i) * 64 + q];
                y += dsk * xs[idx];
                const float z = bf2f(Z[(r0 + i) * 1024 + h * 64 + q]);
                const float uu = y * silu_f(z);
                A2[(r0 + i) * 1536 + h * 64 + q] = f2bf(uu);
                const float ss = wave_sum(uu * uu);
                if (lane == 0) SSQ[(r0 + i) * 16 + h] = ss;
            }
            __syncthreads();
        }
    }
}
__device__ void ph_sb_naive(const P& p, int bid, int nblk) {
    const bf16_t* Q = wsp<bf16_t>(p, R_XQ + 96 * MiB); const bf16_t* K = wsp<bf16_t>(p, R_XQ + 128 * MiB); const bf16_t* Vt = wsp<bf16_t>(p, R_XQ + 160 * MiB);
    bf16_t* A2 = wsp<bf16_t>(p, R_A2);
    const int lane = threadIdx.x & 63, wid = threadIdx.x >> 6;
    const int nunits = NB * 8 * (S / 64);
    for (int u = bid * 8 + wid; u < nunits; u += nblk * 8) {
        const int tb = (S / 64 - 1) - (u % (S / 64)), bh = u / (S / 64), b = bh >> 3, h = bh & 7;
        const int t0 = tb * 64, t = t0 + lane; const size_t row = (size_t)b * S + t;
        float q[64], o[64];
#pragma unroll
        for (int d = 0; d < 64; d += 8) { const u32x4 v = *(const u32x4*)(Q + row * 512 + h * 64 + d);
#pragma unroll
            for (int j = 0; j < 4; ++j) { q[d + 2 * j] = bflo(v[j]); q[d + 2 * j + 1] = bfhi(v[j]); } }
#pragma unroll
        for (int d = 0; d < 64; ++d) o[d] = 0.f;
        float csum = 0.f;
        for (int s = t0 + 62; s >= 0; --s) {
            const bf16_t* kr = K + ((size_t)b * S + s) * 512 + h * 64;
            float z = 0.f;
#pragma unroll
            for (int d = 0; d < 64; d += 8) { const u32x4 v = *(const u32x4*)(kr + d);
#pragma unroll
                for (int j = 0; j < 4; ++j) { z += q[d + 2 * j] * bflo(v[j]); z += q[d + 2 * j + 1] * bfhi(v[j]); } }
            float w = 0.f;
            if (s < t) { const float l = fmaxf(z, 0.f) + log2f(1.f + exp2f(-fabsf(z))); csum += l; w = exp2f(z - csum); }
            const bf16_t* vc = Vt + (size_t)(h * 64) * T + (size_t)b * S + s;
#pragma unroll
            for (int d = 0; d < 64; ++d) o[d] += w * bf2f(vc[(size_t)d * T]);
        }
#pragma unroll
        for (int d = 0; d < 64; d += 4) st_bf16x4(A2 + row * 1536 + 1024 + h * 64 + d, (f32x4){o[d], o[d + 1], o[d + 2], o[d + 3]});
    }
}
struct MidRms0 { static constexpr int ksplit = 1024; const float* SSQ;
    __device__ __forceinline__ float scale(int row) const { float s = 0.f;
#pragma unroll
        for (int h = 0; h < 16; ++h) s += SSQ[(size_t)row * 16 + h];
        return rsqrtf(s * (1.0f / 1024.0f) + 1e-6f); } };
struct EpiRes { const float* X; float* PRE; __device__ __forceinline__ void operator()(int row, int col, f32x4 v) const {
        const f32x4 xr = *(const f32x4*)(X + (size_t)row * 1024 + col); *(f32x4*)(PRE + (size_t)row * 1024 + col) = xr * ALPHA + v; } };
__device__ void ph_outproj0(const P& p, float* lds, int bid, int nblk) {
    MidRms0 mid{wsp<float>(p, OFF_SSQ)}; EpiRes e{p.x, wsp<float>(p, R_XBZ)};
    gemm_naive<false>(wsp<bf16_t>(p, R_A2), 1536, nullptr, wsp<bf16_t>(p, W0O), 1536, T, 1024, 1536, e, mid, lds, bid, nblk);
}

__device__ __forceinline__ void ln_row(f32x4 (&v)[4], const float* g, const float* bta, int lane) {
    float s = 0.f;
#pragma unroll
    for (int j = 0; j < 4; ++j) s += (v[j][0] + v[j][1]) + (v[j][2] + v[j][3]);
    const float mu = wave_sum(s) * (1.0f / 1024.0f);
    float q = 0.f;
#pragma unroll
    for (int j = 0; j < 4; ++j) { const f32x4 d = v[j] - mu; q += (d[0] * d[0] + d[1] * d[1]) + (d[2] * d[2] + d[3] * d[3]); }
    const float rstd = rsqrtf(wave_sum(q) * (1.0f / 1024.0f) + 1e-5f);
#pragma unroll
    for (int j = 0; j < 4; ++j) { const f32x4 gg = *(const f32x4*)(g + j * 256 + lane * 4), bb = *(const f32x4*)(bta + j * 256 + lane * 4); v[j] = (v[j] - mu) * rstd * gg + bb; }
}
__device__ void ph_ln1_router(const P& p, int l, int bid, int nblk) {
    const float* PRE = wsp<float>(p, R_XBZ); float* X1F = wsp<float>(p, R_XQ); bf16_t* X1B = wsp<bf16_t>(p, R_XQ + 128 * MiB);
    int* TOKE = wsp<int>(p, OFF_ROUTE); float* TOKW = wsp<float>(p, OFF_ROUTE + 256 * 1024); int* LIST = wsp<int>(p, OFF_ROUTE + 512 * 1024);
    unsigned* CNT = wsp<unsigned>(p, OFF_CTRL) + 64 * l;
    const float* g = p.ln1_g + l * 1024; const float* bta = p.ln1_b + l * 1024;
    const float* wgp = p.moe_w_group + (size_t)l * 1024 * 4; const float* wep = p.moe_w_expert + (size_t)l * 1024 * 16;
    const int lane = threadIdx.x & 63, wid = threadIdx.x >> 6;
    for (int t = bid * 8 + wid; t < T; t += nblk * 8) {
        f32x4 v[4];
#pragma unroll
        for (int j = 0; j < 4; ++j) v[j] = *(const f32x4*)(PRE + (size_t)t * 1024 + j * 256 + lane * 4);
        ln_row(v, g, bta, lane);
#pragma unroll
        for (int j = 0; j < 4; ++j) { *(f32x4*)(X1F + (size_t)t * 1024 + j * 256 + lane * 4) = v[j]; st_bf16x4(X1B + (size_t)t * 1024 + j * 256 + lane * 4, v[j]); }
        float lg[20];
#pragma unroll
        for (int e = 0; e < 20; ++e) lg[e] = 0.f;
#pragma unroll
        for (int j = 0; j < 4; ++j)
#pragma unroll
            for (int i = 0; i < 4; ++i) { const int k = j * 256 + lane * 4 + i; const float xv = v[j][i];
                const f32x4 wg4 = *(const f32x4*)(wgp + (size_t)k * 4);
#pragma unroll
                for (int e = 0; e < 4; ++e) lg[e] += xv * wg4[e];
#pragma unroll
                for (int e4 = 0; e4 < 4; ++e4) { const f32x4 we4 = *(const f32x4*)(wep + (size_t)k * 16 + e4 * 4);
#pragma unroll
                    for (int e = 0; e < 4; ++e) lg[4 + e4 * 4 + e] += xv * we4[e]; } }
#pragma unroll
        for (int e = 0; e < 20; ++e) lg[e] = wave_sum(lg[e]);
        if (lane == 0) {
            float gl[4]; float gm = -INFINITY; int gs = 0;
#pragma unroll
            for (int e = 0; e < 4; ++e) { gl[e] = lg[e] + p.moe_b_group[l * 4 + e]; if (gl[e] > gm) { gm = gl[e]; gs = e; } }
            float gsum = 0.f;
#pragma unroll
            for (int e = 0; e < 4; ++e) gsum += expf(gl[e] - gm);
            const float gp = 1.0f / gsum;
            float el[4]; float em = -INFINITY;
#pragma unroll
            for (int e = 0; e < 4; ++e) { float vv = 0.f;
#pragma unroll
                for (int gg = 0; gg < 4; ++gg) vv = (gg == gs) ? lg[4 + gg * 4 + e] : vv;
                el[e] = vv + p.moe_b_expert[l * 16 + gs * 4 + e]; em = fmaxf(em, el[e]); }
            int i0 = 0;
#pragma unroll
            for (int e = 1; e < 4; ++e) if (el[e] > el[i0]) i0 = e;
            int i1 = -1;
#pragma unroll
            for (int e = 0; e < 4; ++e) if (e != i0 && (i1 < 0 || el[e] > el[i1])) i1 = e;
            const float p0 = expf(el[i0] - em), p1 = expf(el[i1] - em);
            const float w0 = gp * p0 / (p0 + p1), w1 = gp * p1 / (p0 + p1);
            const int e0 = gs * 4 + i0, e1 = gs * 4 + i1;
            TOKE[t * 2] = e0; TOKE[t * 2 + 1] = e1; TOKW[t * 2] = w0; TOKW[t * 2 + 1] = w1;
            const unsigned s0 = atomicAdd(&CNT[e0], 1u); LIST[(size_t)e0 * T + s0] = t * 2;
            const unsigned s1 = atomicAdd(&CNT[e1], 1u); LIST[(size_t)e1 * T + s1] = t * 2 + 1;
        }
    }
}
struct EpiHid { bf16_t* HID; __device__ __forceinline__ void operator()(int row, int col, f32x4 v) const { st_bf16x4(HID + (size_t)row * 256 + col, v); } };
struct EpiDown { bf16_t* Y; const int* gidx; const float* TOKW;
    __device__ __forceinline__ void operator()(int row, int col, f32x4 v) const { const int e = gidx[row]; if (e < 0) return; const float w = TOKW[e];
        st_bf16x4(Y + ((size_t)(e & 1) * T + (e >> 1)) * 1024 + col, v * w); } };
__device__ __forceinline__ void moe_offsets(const unsigned* CNT, int (&n)[16], int (&off)[17]) {
    off[0] = 0;
#pragma unroll
    for (int e = 0; e < 16; ++e) { n[e] = (int)CNT[e]; off[e + 1] = off[e] + ((n[e] + 255) & ~255); }
}
__device__ void ph_moe_index(const P& p, int l, int bid, int nblk) {
    const unsigned* CNT = wsp<unsigned>(p, OFF_CTRL) + 64 * l; const int* LIST = wsp<int>(p, OFF_ROUTE + 512 * 1024); int* GIDX = wsp<int>(p, OFF_ROUTE + 512 * 1024 + 2 * MiB);
    int n[16], off[17]; moe_offsets(CNT, n, off);
    const size_t gtid = (size_t)bid * NTHR + threadIdx.x, gstride = (size_t)nblk * NTHR;
    for (size_t i = gtid; i < (size_t)off[16]; i += gstride) {
        int e = 0;
#pragma unroll
        for (int k = 1; k < 16; ++k) e += ((int)i >= off[k]) ? 1 : 0;
        const int r = (int)i - off[e]; GIDX[i] = r < n[e] ? LIST[(size_t)e * T + r] : -1;
    }
}
__device__ void ph_moe1(const P& p, int l, float* lds, int bid, int nblk) {
    const unsigned* CNT = wsp<unsigned>(p, OFF_CTRL) + 64 * l; const int* GIDX = wsp<int>(p, OFF_ROUTE + 512 * 1024 + 2 * MiB);
    int n[16], off[17]; moe_offsets(CNT, n, off);
    const bf16_t* X1B = wsp<bf16_t>(p, R_XQ + 128 * MiB);
    for (int e = 0; e < 16; ++e) {
        const int rows = off[e + 1] - off[e]; if (rows == 0) continue;
        EpiHid ep{wsp<bf16_t>(p, R_A2) + (size_t)off[e] * 256};
        gemm_naive<true>(X1B, 1024, GIDX + off[e], wsp<bf16_t>(p, WGU) + (size_t)(l * 16 + e) * 512 * 1024, 1024, rows, 256, 1024, ep, NoMid{}, lds, bid, nblk);
    }
}
__device__ void ph_moe2(const P& p, int l, float* lds, int bid, int nblk) {
    const unsigned* CNT = wsp<unsigned>(p, OFF_CTRL) + 64 * l; const int* GIDX = wsp<int>(p, OFF_ROUTE + 512 * 1024 + 2 * MiB);
    int n[16], off[17]; moe_offsets(CNT, n, off);
    for (int e = 0; e < 16; ++e) {
        const int rows = off[e + 1] - off[e]; if (rows == 0) continue;
        EpiDown ep{wsp<bf16_t>(p, R_XBZ), GIDX + off[e], wsp<float>(p, OFF_ROUTE + 256 * 1024)};
        gemm_naive<false>(wsp<bf16_t>(p, R_A2) + (size_t)off[e] * 256, 256, nullptr, wsp<bf16_t>(p, WDN) + (size_t)(l * 16 + e) * 1024 * 256, 256, rows, 1024, 256, ep, NoMid{}, lds, bid, nblk);
    }
}
__device__ void ph_ln2(const P& p, int l, int bid, int nblk) {
    float* X1F = wsp<float>(p, R_XQ); bf16_t* X1B = wsp<bf16_t>(p, R_XQ + 128 * MiB); const bf16_t* Y = wsp<bf16_t>(p, R_XBZ);
    float* LOGF = wsp<float>(p, OFF_DT);
    const float* g = p.ln2_g + l * 1024; const float* bta = p.ln2_b + l * 1024;
    const int lane = threadIdx.x & 63, wid = threadIdx.x >> 6;
    for (int t = bid * 8 + wid; t < T; t += nblk * 8) {
        f32x4 v[4];
#pragma unroll
        for (int j = 0; j < 4; ++j) { const size_t o = (size_t)t * 1024 + j * 256 + lane * 4; const f32x4 xv = *(const f32x4*)(X1F + o);
            const u32x2 a = *(const u32x2*)(Y + o), b = *(const u32x2*)(Y + (size_t)T * 1024 + o);
            v[j] = xv * ALPHA + (f32x4){bflo(a.x) + bflo(b.x), bfhi(a.x) + bfhi(b.x), bflo(a.y) + bflo(b.y), bfhi(a.y) + bfhi(b.y)}; }
        ln_row(v, g, bta, lane);
        if (l == 1) {
#pragma unroll
            for (int j = 0; j < 4; ++j) *(f32x4*)(p.out + (size_t)t * 1024 + j * 256 + lane * 4) = v[j];
        } else {
#pragma unroll
            for (int j = 0; j < 4; ++j) { *(f32x4*)(X1F + (size_t)t * 1024 + j * 256 + lane * 4) = v[j]; st_bf16x4(X1B + (size_t)t * 1024 + j * 256 + lane * 4, v[j]); }
            float f[8];
#pragma unroll
            for (int e = 0; e < 8; ++e) f[e] = 0.f;
#pragma unroll
            for (int j = 0; j < 4; ++j)
#pragma unroll
                for (int i = 0; i < 4; ++i) { const int k = j * 256 + lane * 4 + i; const float* w = p.od_w_in + (size_t)k * ODD_IN + 1952;
#pragma unroll
                    for (int e = 0; e < 8; ++e) f[e] += v[j][i] * w[e]; }
#pragma unroll
            for (int e = 0; e < 8; ++e) f[e] = wave_sum(f[e]);
            if (lane < 8) { float fv = 0.f;
#pragma unroll
                for (int e = 0; e < 8; ++e) fv = (e == lane) ? f[e] : fv;
                LOGF[(size_t)t * 8 + lane] = logsigmoid_f(fv + p.od_f_bias[lane]); }
        }
    }
}

struct EpiIn1 {
    bf16_t* CQ; bf16_t* CKV; bf16_t* Q; bf16_t* K; float* SSQQ; float* SSQK; const float* tab;
    __device__ __forceinline__ void operator()(int row, int col, f32x4 v) const {
        const int tx = threadIdx.x & 15;
        if (col < 512) {
            const bool isq = col < 256; const bool iskv = (col >= 256 && col < 384);
            float s = (isq || iskv) ? (v[0] * v[0] + v[1] * v[1]) + (v[2] * v[2] + v[3] * v[3]) : 0.f;
            s += __shfl_xor(s, 1); s += __shfl_xor(s, 2); s += __shfl_xor(s, 4); s += __shfl_xor(s, 8);
            if (tx == 0) { if (isq) SSQQ[(size_t)row * 4 + (col >> 6)] = s; else SSQK[(size_t)row * 4 + ((col - 256) >> 6)] = s; }
            if (isq) st_bf16x4(CQ + (size_t)row * 256 + col, v);
            else {
                if (col >= 384 && col < 416) { const int sp = row & (S - 1), i0 = (col - 384) >> 1;
                    const float c0 = tab[sp * 16 + i0], s0 = tab[S * 16 + sp * 16 + i0], c1 = tab[sp * 16 + i0 + 1], s1 = tab[S * 16 + sp * 16 + i0 + 1];
                    v = (f32x4){v[0] * c0 - v[1] * s0, v[1] * c0 + v[0] * s0, v[2] * c1 - v[3] * s1, v[3] * c1 + v[2] * s1}; }
                st_bf16x4(CKV + (size_t)row * 256 + (col - 256), v);
            }
        } else if (col < 1024) st_bf16x4(Q + (size_t)row * 512 + (col - 512), v * C2_64);
        else st_bf16x4(K + (size_t)row * 512 + (col - 1024), v);
    }
};
__device__ void ph_inproj1(const P& p, float* lds, int bid, int nblk) {
    const bf16_t* XB = wsp<bf16_t>(p, R_XQ + 128 * MiB);
    EpiIn1 e{wsp<bf16_t>(p, R_XBZ), wsp<bf16_t>(p, R_XBZ + 16 * MiB), wsp<bf16_t>(p, R_XBZ + 32 * MiB), wsp<bf16_t>(p, R_XBZ + 64 * MiB),
             wsp<float>(p, OFF_SSQ), wsp<float>(p, OFF_SSQ + 512 * 1024), wsp<float>(p, OFF_TAB)};
    gemm_naive<false>(XB, 1024, nullptr, wsp<bf16_t>(p, W1M), 1024, T, 1536, 1024, e, NoMid{}, lds, bid, nblk);
    EpiVt ev{wsp<bf16_t>(p, R_XBZ + 96 * MiB)};
    gemm_naive<false>(wsp<bf16_t>(p, W1V), 1024, nullptr, XB, 1024, 512, T, 1024, ev, NoMid{}, lds, bid, nblk);
}
__device__ __forceinline__ float rs4(const float* s, int row, float inv_n) { const f32x4 v = *(const f32x4*)(s + (size_t)row * 4); return rsqrtf(((v[0] + v[1]) + (v[2] + v[3])) * inv_n + 1e-6f); }
struct EpiQup { bf16_t* QM; const float* SSQQ; const float* tab;
    __device__ __forceinline__ void operator()(int row, int col, f32x4 v) const {
        v = v * rs4(SSQQ, row, 1.0f / 256.0f);
        const int j = col % 96;
        if (j >= 64) { const int sp = row & (S - 1), i0 = (j - 64) >> 1;
            const float c0 = tab[sp * 16 + i0], s0 = tab[S * 16 + sp * 16 + i0], c1 = tab[sp * 16 + i0 + 1], s1 = tab[S * 16 + sp * 16 + i0 + 1];
            v = (f32x4){v[0] * c0 - v[1] * s0, v[1] * c0 + v[0] * s0, v[2] * c1 - v[3] * s1, v[3] * c1 + v[2] * s1}; }
        st_bf16x4(QM + (size_t)row * 768 + col, v * C2_96);
    } };
struct EpiKup { bf16_t* KN; const float* SSQK; __device__ __forceinline__ void operator()(int row, int col, f32x4 v) const { st_bf16x4(KN + (size_t)row * 512 + col, v * rs4(SSQK, row, 1.0f / 128.0f)); } };
struct EpiVup { bf16_t* VtM; const float* SSQK; __device__ __forceinline__ void operator()(int row, int col, f32x4 v) const {
        v = (f32x4){v[0] * rs4(SSQK, col, 1.0f / 128.0f), v[1] * rs4(SSQK, col + 1, 1.0f / 128.0f), v[2] * rs4(SSQK, col + 2, 1.0f / 128.0f), v[3] * rs4(SSQK, col + 3, 1.0f / 128.0f)};
        st_bf16x4(VtM + (size_t)row * T + col, v); } };
__device__ void ph_upproj(const P& p, float* lds, int bid, int nblk) {
    const bf16_t* CQ = wsp<bf16_t>(p, R_XBZ); const bf16_t* CKV = wsp<bf16_t>(p, R_XBZ + 16 * MiB);
    const float* SSQQ = wsp<float>(p, OFF_SSQ); const float* SSQK = wsp<float>(p, OFF_SSQ + 512 * 1024);
    EpiQup eq{wsp<bf16_t>(p, R_A2), SSQQ, wsp<float>(p, OFF_TAB)};
    gemm_naive<false>(CQ, 256, nullptr, wsp<bf16_t>(p, W1Q), 256, T, 768, 256, eq, NoMid{}, lds, bid, nblk);
    EpiKup ek{wsp<bf16_t>(p, R_A2 + 48 * MiB), SSQK};
    gemm_naive<false>(CKV, 256, nullptr, wsp<bf16_t>(p, W1K), 128, T, 512, 128, ek, NoMid{}, lds, bid, nblk);
    EpiVup ev{wsp<bf16_t>(p, R_A2 + 80 * MiB), SSQK};
    gemm_naive<false>(wsp<bf16_t>(p, W1VV), 128, nullptr, CKV, 256, 512, T, 128, ev, NoMid{}, lds, bid, nblk);
    const float* LOGF = wsp<float>(p, OFF_DT); float* FH2 = wsp<float>(p, OFF_DT + 1 * MiB);
    const int lane = threadIdx.x & 63, wid = threadIdx.x >> 6;
    for (int u = bid * 8 + wid; u < NB * 8; u += nblk * 8) {
        const int b = u >> 3, h = u & 7;
        float loc[32]; float run = 0.f;
#pragma unroll
        for (int i = 0; i < 32; ++i) { run += LOGF[((size_t)b * S + lane * 32 + i) * 8 + h]; loc[i] = run; }
        float incl = run;
#pragma unroll
        for (int o = 1; o < 64; o <<= 1) { const float nb = __shfl_up(incl, o); if (lane >= o) incl += nb; }
        const float excl = incl - run;
#pragma unroll
        for (int i = 0; i < 32; ++i) FH2[(size_t)u * S + lane * 32 + i] = (excl + loc[i]) * LOG2E;
    }
}
__device__ void ph_attn1_naive(const P& p, int bid, int nblk) {
    const bf16_t* QM = wsp<bf16_t>(p, R_A2); const bf16_t* KN = wsp<bf16_t>(p, R_A2 + 48 * MiB); const bf16_t* VtM = wsp<bf16_t>(p, R_A2 + 80 * MiB);
    const bf16_t* CKV = wsp<bf16_t>(p, R_XBZ + 16 * MiB);
    const bf16_t* Qf = wsp<bf16_t>(p, R_XBZ + 32 * MiB); const bf16_t* Kf = wsp<bf16_t>(p, R_XBZ + 64 * MiB); const bf16_t* Vtf = wsp<bf16_t>(p, R_XBZ + 96 * MiB);
    const float* FH2 = wsp<float>(p, OFF_DT + 1 * MiB);
    bf16_t* A2 = wsp<bf16_t>(p, R_XQ + 128 * MiB);
    const int lane = threadIdx.x & 63, wid = threadIdx.x >> 6;
    const int nper = NB * 8 * (S / 64);
    for (int u = bid * 8 + wid; u < 2 * nper; u += nblk * 8) {
        const bool fox = u >= nper; const int uu = fox ? u - nper : u;
        const int tb = (S / 64 - 1) - (uu % (S / 64)), bh = uu / (S / 64), b = bh >> 3, h = bh & 7;
        const int t0 = tb * 64, t = t0 + lane; const size_t row = (size_t)b * S + t;
        float o[64];
#pragma unroll
        for (int d = 0; d < 64; ++d) o[d] = 0.f;
        float m = -INFINITY, lsum = 0.f;
        if (!fox) {
            float q[96];
#pragma unroll
            for (int d = 0; d < 96; d += 8) { const u32x4 v = *(const u32x4*)(QM + row * 768 + h * 96 + d);
#pragma unroll
                for (int j = 0; j < 4; ++j) { q[d + 2 * j] = bflo(v[j]); q[d + 2 * j + 1] = bfhi(v[j]); } }
            for (int s = 0; s < t0 + 64; ++s) {
                const size_t kr = (size_t)b * S + s; float z = 0.f;
#pragma unroll
                for (int d = 0; d < 64; d += 8) { const u32x4 v = *(const u32x4*)(KN + kr * 512 + h * 64 + d);
#pragma unroll
                    for (int j = 0; j < 4; ++j) { z += q[d + 2 * j] * bflo(v[j]); z += q[d + 2 * j + 1] * bfhi(v[j]); } }
#pragma unroll
                for (int d = 0; d < 32; d += 8) { const u32x4 v = *(const u32x4*)(CKV + kr * 256 + 128 + d);
#pragma unroll
                    for (int j = 0; j < 4; ++j) { z += q[64 + d + 2 * j] * bflo(v[j]); z += q[64 + d + 2 * j + 1] * bfhi(v[j]); } }
                const float mn = fmaxf(m, z), corr = exp2f(m - mn), pw = exp2f(z - mn); m = mn; lsum = lsum * corr + pw;
                const bf16_t* vc = VtM + (size_t)(h * 64) * T + kr;
#pragma unroll
                for (int d = 0; d < 64; ++d) o[d] = o[d] * corr + pw * bf2f(vc[(size_t)d * T]);
            }
        } else {
            float q[64];
#pragma unroll
            for (int d = 0; d < 64; d += 8) { const u32x4 v = *(const u32x4*)(Qf + row * 512 + h * 64 + d);
#pragma unroll
                for (int j = 0; j < 4; ++j) { q[d + 2 * j] = bflo(v[j]); q[d + 2 * j + 1] = bfhi(v[j]); } }
            const float fht = FH2[(size_t)bh * S + t];
            for (int s = 0; s < t0 + 64; ++s) {
                const size_t kr = (size_t)b * S + s; float z = 0.f;
#pragma unroll
                for (int d = 0; d < 64; d += 8) { const u32x4 v = *(const u32x4*)(Kf + kr * 512 + h * 64 + d);
#pragma unroll
                    for (int j = 0; j < 4; ++j) { z += q[d + 2 * j] * bflo(v[j]); z += q[d + 2 * j + 1] * bfhi(v[j]); } }
                z += fht - FH2[(size_t)bh * S + s];
                if (s <= t) {
                    const float mn = fmaxf(m, z), corr = exp2f(m - mn), pw = exp2f(z - mn); m = mn; lsum = lsum * corr + pw;
                    const bf16_t* vc = Vtf + (size_t)(h * 64) * T + kr;
#pragma unroll
                    for (int d = 0; d < 64; ++d) o[d] = o[d] * corr + pw * bf2f(vc[(size_t)d * T]);
                }
            }
        }
        const float inv = 1.0f / lsum;
#pragma unroll
        for (int d = 0; d < 64; d += 4) st_bf16x4(A2 + row * 1024 + (fox ? 512 : 0) + h * 64 + d, (f32x4){o[d] * inv, o[d + 1] * inv, o[d + 2] * inv, o[d + 3] * inv});
    }
}
__device__ void ph_outproj1(const P& p, float* lds, int bid, int nblk) {
    EpiRes e{wsp<float>(p, R_XQ), wsp<float>(p, R_XBZ)};
    gemm_naive<false>(wsp<bf16_t>(p, R_XQ + 128 * MiB), 1024, nullptr, wsp<bf16_t>(p, W1O), 1024, T, 1024, 1024, e, NoMid{}, lds, bid, nblk);
}

constexpr int NPHASE = 20;
constexpr int LDS_BYTES = 56 * 1024;
template <int PH> __device__ __forceinline__ void run_phase(const P& p, float* lds, int bid, int nblk) {
    if constexpr (PH == 0) ph_prologue(p, bid, nblk);
    if constexpr (PH == 1) ph_inproj0(p, lds, bid, nblk);
    if constexpr (PH == 2) ph_conv(p, bid, nblk);
    if constexpr (PH == 3) { ph_ssd_naive(p, lds, bid, nblk); ph_sb_naive(p, bid, nblk); }
    if constexpr (PH == 4) ph_outproj0(p, lds, bid, nblk);
    if constexpr (PH == 5) ph_ln1_router(p, 0, bid, nblk);
    if constexpr (PH == 6) ph_moe_index(p, 0, bid, nblk);
    if constexpr (PH == 7) ph_moe1(p, 0, lds, bid, nblk);
    if constexpr (PH == 8) ph_moe2(p, 0, lds, bid, nblk);
    if constexpr (PH == 9) ph_ln2(p, 0, bid, nblk);
    if constexpr (PH == 10) ph_inproj1(p, lds, bid, nblk);
    if constexpr (PH == 11) ph_upproj(p, lds, bid, nblk);
    if constexpr (PH == 12) ph_attn1_naive(p, bid, nblk);
    if constexpr (PH == 13) ph_outproj1(p, lds, bid, nblk);
    if constexpr (PH == 14) ph_ln1_router(p, 1, bid, nblk);
    if constexpr (PH == 15) ph_moe_index(p, 1, bid, nblk);
    if constexpr (PH == 16) ph_moe1(p, 1, lds, bid, nblk);
    if constexpr (PH == 17) ph_moe2(p, 1, lds, bid, nblk);
    if constexpr (PH == 18) ph_ln2(p, 1, bid, nblk);
}

#if MK_MULTI
template <int PH> __global__ void __launch_bounds__(NTHR, 2) k_phase(P p) {
    extern __shared__ __attribute__((aligned(16))) unsigned char smem[];
    run_phase<PH>(p, (float*)smem, blockIdx.x, gridDim.x);
}
template <int PH> static void launch_phases(const P& p, int grid, hipStream_t stream) {
    if constexpr (PH < 19) {
        hipLaunchKernelGGL(k_phase<PH>, dim3(grid), dim3(NTHR), LDS_BYTES, stream, p);
        launch_phases<PH + 1>(p, grid, stream);
    }
}
#else
template <int PH> __device__ __forceinline__ void run_all(const P& p, float* lds, const XcdBarrier& bar) {
    if constexpr (PH < 19) {
        run_phase<PH>(p, lds, blockIdx.x, gridDim.x);
        if constexpr (PH < 18) xcd_barrier(bar);
        run_all<PH + 1>(p, lds, bar);
    }
}
__global__ void __launch_bounds__(NTHR, 2) k_all(P p) {
    extern __shared__ __attribute__((aligned(16))) unsigned char smem[];
    volatile LAS unsigned* st = (volatile LAS unsigned*)(smem + LDS_BYTES);
    if (threadIdx.x == 0) { st[0] = 0u; st[1] = 0u; st[2] = 0u; st[3] = 0u; }
    __syncthreads();
    XcdBarrier bar = xcd_barrier_post((unsigned*)(p.ws + OFF_BAR), st);
    run_all<0>(p, (float*)smem, bar);
}
#endif

extern "C" void kernel_launch(void* const* d_in, const int* in_sizes, int n_in, void* d_out, int out_size, void* d_ws, size_t ws_size, hipStream_t stream) {
    (void)in_sizes; (void)n_in; (void)out_size;
    if (ws_size < WS_NEED) { fprintf(stderr, "workspace too small: %zu < %zu\n", ws_size, WS_NEED); return; }
    P p{};
    const float** f = (const float**)&p;
    for (int i = 0; i < 27; ++i) f[i] = (const float*)d_in[i];
    p.out = (float*)d_out; p.ws = (unsigned char*)d_ws;
    hipMemsetAsync(d_ws, 0, OFF_CTRL + CTRL_BYTES, stream);
#if MK_MULTI
    launch_phases<0>(p, 1024, stream);
#else
    static int grid = 0;
    if (!grid) {
        int dev = 0, cus = 0, per_cu = 0;
        hipGetDevice(&dev);
        hipDeviceGetAttribute(&cus, hipDeviceAttributeMultiprocessorCount, dev);
        hipFuncSetAttribute((const void*)k_all, hipFuncAttributeMaxDynamicSharedMemorySize, LDS_BYTES + 16);
        hipOccupancyMaxActiveBlocksPerMultiprocessor(&per_cu, k_all, NTHR, LDS_BYTES + 16);
        grid = cus * (per_cu < 1 ? per_cu : 1);
    }
    hipLaunchKernelGGL(k_all, dim3(grid), dim3(NTHR), LDS_BYTES + 16, stream, p);
#endif
}
```

```cpp
#include <hip/hip_runtime.h>
#include <stdint.h>
#include <stdio.h>

#ifndef MK_MULTI
#define MK_MULTI 0
#endif

#ifndef USE_SSD
#define USE_SSD 1
#endif
typedef unsigned short bf16_t;
typedef float f32x4 __attribute__((ext_vector_type(4)));
typedef float f32x2 __attribute__((ext_vector_type(2)));
typedef unsigned u32x4 __attribute__((ext_vector_type(4)));
typedef unsigned u32x2 __attribute__((ext_vector_type(2)));

constexpr int NB = 16, S = 2048, T = NB * S, D = 1024;
constexpr int EVEN_IN = 4112, ODD_IN = 1960;
constexpr float ALPHA = 1.4142135623730951f;
constexpr float LOG2E = 1.4426950408889634f;
constexpr float C2_64 = 0.125f * LOG2E;
constexpr float C2_96 = 0.10206207261596577f * LOG2E;
constexpr int NTHR = 512;

constexpr size_t MiB = 1024 * 1024;
constexpr size_t OFF_BAR = 0;
constexpr size_t OFF_CTRL = 16 * 1024;
constexpr size_t CTRL_BYTES = 16 * 1024;
constexpr size_t OFF_TAB = 64 * 1024;
constexpr size_t OFF_DT = 1 * MiB;
constexpr size_t OFF_SSQ = 3 * MiB;
constexpr size_t OFF_ROUTE = 5 * MiB;
constexpr size_t OFF_W = 8 * MiB;
constexpr size_t W0M = OFF_W;
constexpr size_t W0V = W0M + (size_t)3584 * 1024 * 2;
constexpr size_t W0O = W0V + (size_t)512 * 1024 * 2;
constexpr size_t W1M = W0O + (size_t)1024 * 1536 * 2;
constexpr size_t W1V = W1M + (size_t)1536 * 1024 * 2;
constexpr size_t W1Q = W1V + (size_t)512 * 1024 * 2;
constexpr size_t W1K = W1Q + (size_t)768 * 256 * 2;
constexpr size_t W1VV = W1K + (size_t)512 * 128 * 2;
constexpr size_t W1O = W1VV + (size_t)512 * 128 * 2;
constexpr size_t WGU = W1O + (size_t)1024 * 1024 * 2;
constexpr size_t WDN = WGU + (size_t)2 * 16 * 512 * 1024 * 2;
constexpr size_t W_END = WDN + (size_t)2 * 16 * 1024 * 256 * 2;
static_assert(W_END <= 76 * MiB, "weights region");
constexpr size_t R_XBZ = 76 * MiB;
constexpr size_t R_XQ = 204 * MiB;
constexpr size_t R_A2 = 396 * MiB;
constexpr size_t WS_NEED = 512 * MiB;

struct P {
    const float* x; const float* ev_w_in; const float* ev_conv_w; const float* ev_conv_b; const float* ev_dt_bias; const float* ev_a_log;
    const float* ev_d_skip; const float* ev_norm_g; const float* ev_w_out; const float* od_w_in; const float* od_q_norm_g; const float* od_w_q_up;
    const float* od_kv_norm_g; const float* od_w_kv_up; const float* od_f_bias; const float* od_w_out; const float* ln1_g; const float* ln1_b;
    const float* ln2_g; const float* ln2_b; const float* moe_w_group; const float* moe_b_group; const float* moe_w_expert; const float* moe_b_expert;
    const float* moe_w_gate; const float* moe_w_up; const float* moe_w_down;
    float* out; unsigned char* ws;
};

__device__ __forceinline__ float bf2f(bf16_t v) { return __uint_as_float(((unsigned)v) << 16); }
__device__ __forceinline__ unsigned pk_bf16(float lo, float hi) {
    typedef __bf16 b2 __attribute__((ext_vector_type(2)));
    f32x2 v = {lo, hi}; b2 b = __builtin_convertvector(v, b2); return __builtin_bit_cast(unsigned, b);
}
__device__ __forceinline__ bf16_t f2bf(float f) { return (bf16_t)(pk_bf16(f, 0.f) & 0xffffu); }
__device__ __forceinline__ float bflo(unsigned w) { return __uint_as_float(w << 16); }
__device__ __forceinline__ float bfhi(unsigned w) { return __uint_as_float(w & 0xffff0000u); }
__device__ __forceinline__ float silu_f(float x) { return x * __builtin_amdgcn_rcpf(1.0f + __builtin_amdgcn_exp2f(-1.4426950408889634f * x)); }
__device__ __forceinline__ float softplus_f(float x) { return x > 20.f ? x : log1pf(expf(x)); }
__device__ __forceinline__ float logsigmoid_f(float x) { return fminf(x, 0.f) - log1pf(expf(-fabsf(x))); }
template <int CTRL> __device__ __forceinline__ float dpp_f(float x) { return __int_as_float(__builtin_amdgcn_update_dpp(0, __float_as_int(x), CTRL, 0xF, 0xF, true)); }
template <int G> __device__ __forceinline__ float group_sum(float r) {
    if constexpr (G >= 16) r += dpp_f<0x140>(r);
    if constexpr (G >= 8) r += dpp_f<0x141>(r);
    r += dpp_f<0x4E>(r);
    r += dpp_f<0xB1>(r);
    return r;
}
__device__ __forceinline__ float other16(float x, bool odd) { auto rr = __builtin_amdgcn_permlane16_swap(__float_as_uint(x), __float_as_uint(x), false, false); return __uint_as_float(odd ? rr[0] : rr[1]); }
__device__ __forceinline__ float other32(float x, bool hi) { auto rr = __builtin_amdgcn_permlane32_swap(__float_as_uint(x), __float_as_uint(x), false, false); return __uint_as_float(hi ? rr[0] : rr[1]); }
__device__ __forceinline__ float wave_sum(float v) {
    v = group_sum<16>(v);
    { auto rr = __builtin_amdgcn_permlane16_swap(__float_as_uint(v), __float_as_uint(v), false, false); v = __uint_as_float(rr[0]) + __uint_as_float(rr[1]); }
    { auto rr = __builtin_amdgcn_permlane32_swap(__float_as_uint(v), __float_as_uint(v), false, false); v = __uint_as_float(rr[0]) + __uint_as_float(rr[1]); }
    return v;
}
__device__ __forceinline__ int lane_id() { unsigned z = 0u; asm volatile("" : "+v"(z)); return (int)__builtin_amdgcn_mbcnt_hi(~0u, __builtin_amdgcn_mbcnt_lo(~0u, z)); }
#define LDS_BARRIER() do { asm volatile("s_waitcnt lgkmcnt(0)" ::: "memory"); __builtin_amdgcn_s_barrier(); asm volatile("" ::: "memory"); } while (0)
template <class T_> __device__ __forceinline__ T_* wsp(const P& p, size_t off) { return (T_*)(p.ws + off); }

#define XB_TMO      128
#define XB_XCNT(j)  (256  + 64 * (j))
#define XB_XSUB(j)  (1280 + 64 * (j))
#define XB_XGEN(j)  (2304 + 64 * (j))
#define XB_TOP      3328
#define XB_TOPGEN   3392
#define XCD_BAR_WORDS 3456
#define XB_SPIN_CAP (1u << 18)
#define LAS __attribute__((address_space(3)))

__device__ __forceinline__ unsigned xb_ld(unsigned* p)              { return __hip_atomic_load(p, __ATOMIC_RELAXED, __HIP_MEMORY_SCOPE_AGENT); }
__device__ __forceinline__ unsigned xb_add(unsigned* p, unsigned v) { return __hip_atomic_fetch_add(p, v, __ATOMIC_RELAXED, __HIP_MEMORY_SCOPE_AGENT); }
__device__ __forceinline__ unsigned xb_xcc_id() { return (unsigned)__builtin_amdgcn_s_getreg((3 << 11) | 20) & 0xFu; }
#define XB_SPIN(cond, bar) do { unsigned _sp = 0; while (cond) { __builtin_amdgcn_s_sleep(1); \
    if ((++_sp & 255u) == 0u) { if (xb_ld(&(bar)[XB_TMO])) break; if (_sp > XB_SPIN_CAP) { atomicAdd(&(bar)[XB_TMO], 1u); break; } } } } while (0)

struct XcdBarrier { unsigned* bar; unsigned x; volatile LAS unsigned* st; };

__device__ __forceinline__ XcdBarrier xcd_barrier_post(unsigned* bar, volatile LAS unsigned* st) {
    XcdBarrier b; b.bar = bar; b.x = xb_xcc_id(); b.st = st;
    if (threadIdx.x == 0) (void)xb_add(&bar[XB_XCNT(b.x)], 1u);
    return b;
}
__device__ __forceinline__ void xcd_barrier_complete(unsigned* bar, unsigned x, unsigned& nloc, unsigned& nx) {
    const unsigned G = gridDim.x * gridDim.y * gridDim.z;
    unsigned sum, cnt, mine, sp = 0u;
    for (;;) {
        sum = 0u; cnt = 0u; mine = 0u;
#pragma unroll
        for (unsigned j = 0; j < 16; ++j) { const unsigned c = xb_ld(&bar[XB_XCNT(j)]); sum += c; cnt += (c > 0u) ? 1u : 0u; mine = (j == x) ? c : mine; }
        if (sum == G) break;
        __builtin_amdgcn_s_sleep(1);
        if ((++sp & 255u) == 0u) { if (xb_ld(&bar[XB_TMO])) break; if (sp > XB_SPIN_CAP) { atomicAdd(&bar[XB_TMO], 1u); break; } }
    }
    nloc = mine > 0u ? mine : 1u; nx = cnt > 0u ? cnt : 1u;
}
__device__ __forceinline__ void xcd_barrier(const XcdBarrier& b) {
    asm volatile("s_waitcnt vmcnt(0)" ::: "memory");
    __syncthreads();
    if (threadIdx.x == 0) {
        unsigned* bar = b.bar;
        __builtin_amdgcn_s_waitcnt(0);
        unsigned nloc = b.st[0], nx = b.st[1];
        if (nloc == 0u) { xcd_barrier_complete(bar, b.x, nloc, nx); b.st[0] = nloc; b.st[1] = nx; }
        const unsigned old = xb_add(&bar[XB_XSUB(b.x)], 1u);
        const unsigned gen = old / nloc;
        if (old + 1u == (gen + 1u) * nloc) {
            __builtin_amdgcn_fence(__ATOMIC_RELEASE, "agent");
            asm volatile("s_waitcnt vmcnt(0)" ::: "memory");
            const unsigned og = xb_add(&bar[XB_TOP], 1u);
            const unsigned tg = og / nx;
            if (og + 1u == (tg + 1u) * nx) xb_add(&bar[XB_TOPGEN], 1u);
            else XB_SPIN(xb_ld(&bar[XB_TOPGEN]) == tg, bar);
            __builtin_amdgcn_fence(__ATOMIC_ACQUIRE, "agent");
            xb_add(&bar[XB_XGEN(b.x)], 1u);
            asm volatile("s_waitcnt vmcnt(0)" ::: "memory");
        } else {
            XB_SPIN(xb_ld(&bar[XB_XGEN(b.x)]) == gen, bar);
            __builtin_amdgcn_fence(__ATOMIC_ACQUIRE, "agent");
            asm volatile("s_waitcnt vmcnt(0)" ::: "memory");
        }
    }
    __syncthreads();
}

struct NoMid { static constexpr int ksplit = -1; __device__ __forceinline__ float scale(int) const { return 1.f; } };
template <bool DUAL, class Epi, class Mid> __attribute__((always_inline))
__device__ void gemm_naive(const bf16_t* __restrict__ A, int lda, const int* __restrict__ gidx, const bf16_t* __restrict__ Bt, int ldb,
                           int M, int N, int K, const Epi& epi, const Mid& mid, float* lds, int bid, int nblk, int tid_) {
    float* As = lds;
    float* Bs = lds + 32 * 132;
    float* Bs2 = Bs + 32 * 68;
    const int tid = tid_, ty = tid >> 4, tx = tid & 15;
    const int ntn = N / 64, ntiles = (M / 128) * ntn;
    for (int tile = bid; tile < ntiles; tile += nblk) {
        const int tm = tile / ntn, tn = tile % ntn;
        float acc[4][4], acc2[4][4];
#pragma unroll
        for (int i = 0; i < 4; ++i)
#pragma unroll
            for (int j = 0; j < 4; ++j) { acc[i][j] = 0.f; acc2[i][j] = 0.f; }
        const int lrow = tid >> 2, kc = (tid & 3) * 8;
        long arow = tm * 128 + lrow;
        if (gidx) { const int e = gidx[arow]; arow = e < 0 ? -1 : (e >> 1); }
        int brow = tn * 64 + (lrow & 63);
        if (DUAL) brow = (tn >> 1) * 256 + (tn & 1) * 64 + (lrow & 63);
        for (int k0 = 0; k0 < K; k0 += 32) {
            if (k0 == Mid::ksplit) {
#pragma unroll
                for (int i = 0; i < 4; ++i) { const float s = mid.scale(tm * 128 + ty * 4 + i);
#pragma unroll
                    for (int j = 0; j < 4; ++j) acc[i][j] *= s; }
            }
            u32x4 va = {0u, 0u, 0u, 0u};
            if (arow >= 0) va = *(const u32x4*)(A + (size_t)arow * lda + k0 + kc);
#pragma unroll
            for (int j = 0; j < 4; ++j) { As[(kc + 2 * j) * 132 + lrow] = bflo(va[j]); As[(kc + 2 * j + 1) * 132 + lrow] = bfhi(va[j]); }
            if (tid < 256) {
                const u32x4 vb = *(const u32x4*)(Bt + (size_t)brow * ldb + k0 + kc);
#pragma unroll
                for (int j = 0; j < 4; ++j) { Bs[(kc + 2 * j) * 68 + lrow] = bflo(vb[j]); Bs[(kc + 2 * j + 1) * 68 + lrow] = bfhi(vb[j]); }
            } else if (DUAL) {
                const u32x4 vb = *(const u32x4*)(Bt + (size_t)(brow + 128) * ldb + k0 + kc);
#pragma unroll
                for (int j = 0; j < 4; ++j) { Bs2[(kc + 2 * j) * 68 + (lrow & 63)] = bflo(vb[j]); Bs2[(kc + 2 * j + 1) * 68 + (lrow & 63)] = bfhi(vb[j]); }
            }
            __syncthreads();
#pragma unroll 8
            for (int k = 0; k < 32; ++k) {
                const f32x4 a = *(const f32x4*)(As + k * 132 + ty * 4);
                const f32x4 b = *(const f32x4*)(Bs + k * 68 + tx * 4);
#pragma unroll
                for (int i = 0; i < 4; ++i)
#pragma unroll
                    for (int j = 0; j < 4; ++j) acc[i][j] += a[i] * b[j];
                if (DUAL) {
                    const f32x4 b2 = *(const f32x4*)(Bs2 + k * 68 + tx * 4);
#pragma unroll
                    for (int i = 0; i < 4; ++i)
#pragma unroll
                        for (int j = 0; j < 4; ++j) acc2[i][j] += a[i] * b2[j];
                }
            }
            __syncthreads();
        }
#pragma unroll
        for (int i = 0; i < 4; ++i) {
            f32x4 v = {acc[i][0], acc[i][1], acc[i][2], acc[i][3]};
            if (DUAL) {
#pragma unroll
                for (int j = 0; j < 4; ++j) v[j] = silu_f(acc[i][j]) * acc2[i][j];
            }
            epi(tm * 128 + ty * 4 + i, tn * 64 + tx * 4, v);
        }
    }
}

__device__ __forceinline__ void st_bf16x4(bf16_t* p, f32x4 v) { u32x2 w; w.x = pk_bf16(v[0], v[1]); w.y = pk_bf16(v[2], v[3]); *(u32x2*)p = w; }

namespace pg8 {
#define PG8_LAS __attribute__((address_space(3)))
typedef short bf16x8 __attribute__((ext_vector_type(8)));
constexpr int BM = 256, BK = 64, HALF = 128, HTB = HALF * BK * 2, STAGE_BYTES = 8 * HTB, NXCD = 8, WGM = 4;
__host__ __device__ __forceinline__ int lds_byte(int r, int c) { const int st = (r >> 4) * 2 + (c >> 5), rr = r & 15, cc = c & 31, ob = rr * 64 + cc * 2; return st * 1024 + (ob ^ (((ob >> 9) & 1) << 5)); }
__host__ __device__ __forceinline__ void stage_rc(int b, int& R, int& C) { const int st = b / 1024, sb = b % 1024, swz = sb ^ (((sb >> 9) & 1) << 5); R = (st >> 1) * 16 + swz / 64; C = (st & 1) * 32 + (swz % 64) / 2; }

struct Unit { int pm, pn, e, g0; size_t aoff, boff, boff2; };
struct Gemm { const bf16_t* A; const bf16_t* Bt; int lda, ldb, K; const PG8_LAS int* gl; };

struct DenseOrder {
    static constexpr bool HOOK = false; static constexpr int BSEAM = 0;
    int nM, nN, nwg, G, c, lda, ldb;
    __device__ __forceinline__ void init(int M, int N, int lda_, int ldb_, int G_, int c_) { nM = M / BM; nN = N / BM; nwg = nM * nN; G = G_; c = c_; lda = lda_; ldb = ldb_; }
    __device__ __forceinline__ bool next(int i, Unit& u) const {
        const long L = (long)i * G + c; if (L >= nwg) return false;
        int wgid = (int)L; { const int q = nwg / NXCD, r = nwg % NXCD, xcd = wgid % NXCD, off = wgid / NXCD; wgid = (xcd < r ? xcd * (q + 1) : r * (q + 1) + (xcd - r) * q) + off; }
        const int nig = WGM * nN, gid = wgid / nig, fm = gid * WGM, gsz = (nM - fm) < WGM ? (nM - fm) : WGM;
        u.pm = fm + ((wgid % nig) % gsz); u.pn = (wgid % nig) / gsz; u.e = 0; u.g0 = 0;
        u.aoff = (size_t)u.pm * BM * lda * 2; u.boff = (size_t)u.pn * BM * ldb * 2; u.boff2 = u.boff; return true;
    }
};
struct NoMidK { static constexpr int ktile = -1; __device__ __forceinline__ void apply(f32x4 (&)[2][2][4][2], int, int, int) const {} };

__host__ __device__ __forceinline__ int perm32(int rho) { const int n = rho >> 4, i = rho & 15; return 8 * (i >> 2) + 4 * n + (i & 3); }
template <class Epi, class Sched, class MidK, bool GATHER, bool PERM = false>
__device__ __forceinline__ void gemm_phase(PG8_LAS unsigned char* lds, const Gemm g, const Sched& S, const Epi& E, const MidK& mid, int tid_) {
    int tid = tid_; asm volatile("" : "+v"(tid));
    const int wid = __builtin_amdgcn_readfirstlane(tid >> 6), lane = tid & 63, wr = wid >> 2, wc = wid & 3, fr = lane & 15, fq = lane >> 4;
    const int K = g.K, nt = K / BK;
    int R_[2], C_[2];
#pragma unroll
    for (int i = 0; i < 2; ++i) stage_rc(tid * 16 + i * 8192, R_[i], C_[i]);
    unsigned vB[2], vAd[2], vAc[2][2], vAn[2][2];
#pragma unroll
    for (int i = 0; i < 2; ++i) { const int Rb = PERM ? ((R_[i] & ~31) + perm32(R_[i] & 31)) : R_[i]; vB[i] = (unsigned)(Rb * g.ldb + C_[i]) * 2u; vAd[i] = (unsigned)(R_[i] * g.lda + C_[i]) * 2u; }
#pragma unroll
    for (int h = 0; h < 2; ++h)
#pragma unroll
        for (int i = 0; i < 2; ++i) { vAc[h][i] = 0u; vAn[h][i] = 0u; }
    const size_t hstepA = GATHER ? (size_t)0 : (size_t)HALF * g.lda * 2, hstepB = (size_t)HALF * g.ldb * 2;
#define PG8_GATHER_SET(v, ui_) do { if constexpr (GATHER) { _Pragma("unroll") for (int h_ = 0; h_ < 2; ++h_) _Pragma("unroll") for (int i_ = 0; i_ < 2; ++i_) \
        v[h_][i_] = (unsigned)(g.gl[(ui_) * 256 + h_ * HALF + R_[i_]] * g.lda + C_[i_]) * 2u; } } while (0)
    const size_t kstep = (size_t)(BK * 2);
    const unsigned ldsw = (unsigned)wid * 1024u;
    const int aoff = lds_byte(wr * 64 + fr, fq * 8), boff = lds_byte(wc * 32 + fr, fq * 8);
#define PG8_SA(b, h) (((b) * 2 + (h)) * HTB)
#define PG8_SB(b, h) ((4 + (b) * 2 + (h)) * HTB)
#define PG8_STAGE(bufoff, gbase, voff) do { _Pragma("unroll") for (int _i = 0; _i < 2; ++_i) \
        __builtin_amdgcn_global_load_lds((const unsigned*)((const char*)(gbase) + (voff)[_i]), (PG8_LAS unsigned*)(lds + (bufoff) + ldsw + _i * 8192), 16, 0, 0); } while (0)
#define PG8_STB(bufoff, gbase, h) PG8_STAGE(bufoff, (gbase) + (h) * hstepB, vB)
#define PG8_STA(bufoff, gbase, h, VG) do { if constexpr (GATHER) { PG8_STAGE(bufoff, gbase, VG[h]); } else { PG8_STAGE(bufoff, (gbase) + (h) * hstepA, vAd); } } while (0)
#define PG8_LDA(dst, b, h) do { _Pragma("unroll") for (int m = 0; m < 4; ++m) _Pragma("unroll") for (int k = 0; k < 2; ++k) dst[m][k] = *(const PG8_LAS bf16x8*)(lds + PG8_SA(b, h) + aoff + m * 2048 + k * 1024); } while (0)
#define PG8_LDB(dst, b, h) do { _Pragma("unroll") for (int n = 0; n < 2; ++n) _Pragma("unroll") for (int k = 0; k < 2; ++k) dst[n][k] = *(const PG8_LAS bf16x8*)(lds + PG8_SB(b, h) + boff + n * 2048 + k * 1024); } while (0)
#define PG8_MMA(ai, bj, At, Bt) do { __builtin_amdgcn_s_setprio(1); _Pragma("unroll") for (int m = 0; m < 4; ++m) _Pragma("unroll") for (int n = 0; n < 2; ++n) _Pragma("unroll") for (int k = 0; k < 2; ++k) \
        acc[ai][bj][m][n] = __builtin_amdgcn_mfma_f32_16x16x32_bf16(Bt[n][k], At[m][k], acc[ai][bj][m][n], 0, 0, 0); __builtin_amdgcn_s_setprio(0); } while (0)
#define PG8_WAIT_V(n) asm volatile("s_waitcnt vmcnt(" #n ")" ::: "memory")
#define PG8_WAIT_L(n) asm volatile("s_waitcnt lgkmcnt(" #n ")" ::: "memory")
#define PG8_BAR __builtin_amdgcn_s_barrier()
#define PG8_SCHED __builtin_amdgcn_sched_barrier(0)
    Unit cur, nxt; int ui = 0;
    if (!S.next(0, cur)) return;
    f32x4 acc[2][2][4][2];
#pragma unroll
    for (int a = 0; a < 2; ++a)
#pragma unroll
        for (int b = 0; b < 2; ++b)
#pragma unroll
            for (int m = 0; m < 4; ++m)
#pragma unroll
                for (int n = 0; n < 2; ++n) acc[a][b][m][n] = (f32x4){0.f, 0.f, 0.f, 0.f};
    bf16x8 At[4][2], B0[2][2], B1[2][2];
    const char* cA = (const char*)g.A + cur.aoff; const char* cB = (const char*)g.Bt + cur.boff; const char* cB2 = (const char*)g.Bt + cur.boff2;
    if constexpr (Sched::HOOK) S.a_ready(cur, wid);
    PG8_GATHER_SET(vAc, 0);
    if constexpr (GATHER) PG8_WAIT_L(0);
    PG8_STB(PG8_SB(0, 0), cB, 0); PG8_STB(PG8_SB(0, 1), cB, 1); PG8_STA(PG8_SA(0, 0), cA, 0, vAc); PG8_STA(PG8_SA(0, 1), cA, 1, vAc);
    if (wr == 1) PG8_BAR;
    PG8_WAIT_V(2); PG8_BAR;
    PG8_STB(PG8_SB(1, 0), cB + kstep, 0); PG8_STA(PG8_SA(1, 0), cA + kstep, 0, vAc); PG8_STB(PG8_SB(1, 1), cB + kstep, 1);
    PG8_WAIT_V(6); PG8_BAR;
    for (;;) {
        const bool has_next = S.next(ui + 1, nxt);
        const char* nA = has_next ? (const char*)g.A + nxt.aoff : cA; const char* nB = has_next ? (const char*)g.Bt + nxt.boff : cB; const char* nB2 = has_next ? (const char*)g.Bt + nxt.boff2 : cB2;
        if constexpr (GATHER) { if (has_next) { PG8_GATHER_SET(vAn, ui + 1); } else {
#pragma unroll
            for (int h = 0; h < 2; ++h)
#pragma unroll
                for (int i = 0; i < 2; ++i) vAn[h][i] = vAc[h][i]; } }
#pragma unroll 1
        for (int t = 0; t < nt; t += 2) {
            const bool last = (t == nt - 2);
            if constexpr (Sched::HOOK) { if (last && has_next) S.a_ready(nxt, wid); }
            if constexpr (MidK::ktile >= 0) { if (t == MidK::ktile) mid.apply(acc, ui, wr, fr); }
            const char* a1 = cA + (size_t)(t + 1) * kstep;
            const char* cBs = (Sched::BSEAM > 0 && t + 2 >= Sched::BSEAM) ? cB2 : cB;
            const char* a2 = last ? nA : cA + (size_t)(t + 2) * kstep; const char* b2 = last ? nB : cBs + (size_t)(t + 2) * kstep;
            const char* a3 = a2 + kstep; const char* b3 = b2 + kstep;
            unsigned vA2[2][2];
#pragma unroll
            for (int h = 0; h < 2; ++h)
#pragma unroll
                for (int i = 0; i < 2; ++i) vA2[h][i] = (GATHER && last) ? vAn[h][i] : vAc[h][i];
            PG8_LDB(B0, 0, 0); PG8_LDB(B1, 0, 1); PG8_SCHED; PG8_LDA(At, 0, 0); PG8_STA(PG8_SA(1, 1), a1, 1, vAc);
            PG8_WAIT_V(8); PG8_WAIT_L(0); PG8_BAR; PG8_MMA(0, 0, At, B0); PG8_MMA(0, 1, At, B1); PG8_BAR; PG8_SCHED;
            PG8_LDA(At, 0, 1); PG8_STB(PG8_SB(0, 0), b2, 0); PG8_STB(PG8_SB(0, 1), b2, 1); PG8_STA(PG8_SA(0, 0), a2, 0, vA2);
            PG8_WAIT_V(8); PG8_WAIT_L(0); PG8_BAR; PG8_MMA(1, 0, At, B0); PG8_MMA(1, 1, At, B1); PG8_BAR; PG8_SCHED;
            PG8_LDB(B0, 1, 0); PG8_LDB(B1, 1, 1); PG8_SCHED; PG8_LDA(At, 1, 0); PG8_STA(PG8_SA(0, 1), a2, 1, vA2);
            PG8_WAIT_V(8); PG8_WAIT_L(0); PG8_BAR; PG8_MMA(0, 0, At, B0); PG8_MMA(0, 1, At, B1); PG8_BAR; PG8_SCHED;
            PG8_LDA(At, 1, 1); PG8_STB(PG8_SB(1, 0), b3, 0); PG8_STB(PG8_SB(1, 1), b3, 1); PG8_STA(PG8_SA(1, 0), a3, 0, vA2);
            PG8_WAIT_V(8); PG8_WAIT_L(0); PG8_BAR; PG8_MMA(1, 0, At, B0); PG8_MMA(1, 1, At, B1); PG8_BAR; PG8_SCHED;
        }
        if (wr == 0) PG8_BAR;
        { int le = lane_id(); asm volatile("" : "+v"(le)); E(acc, cur, ui, wr, wc, le & 15, le >> 4); }
        if (!has_next) break;
#pragma unroll
        for (int a = 0; a < 2; ++a)
#pragma unroll
            for (int b = 0; b < 2; ++b)
#pragma unroll
                for (int m = 0; m < 4; ++m)
#pragma unroll
                    for (int n = 0; n < 2; ++n) acc[a][b][m][n] = (f32x4){0.f, 0.f, 0.f, 0.f};
        cur = nxt; cA = nA; cB = nB; cB2 = nB2; ++ui;
        if constexpr (GATHER) {
#pragma unroll
            for (int h = 0; h < 2; ++h)
#pragma unroll
                for (int i = 0; i < 2; ++i) vAc[h][i] = vAn[h][i]; }
        if (wr == 1) PG8_BAR;
    }
    PG8_WAIT_V(0);
    PG8_BAR;
#undef PG8_GATHER_SET
#undef PG8_SA
#undef PG8_SB
#undef PG8_STAGE
#undef PG8_STA
#undef PG8_STB
#undef PG8_LDA
#undef PG8_LDB
#undef PG8_MMA
#undef PG8_WAIT_V
#undef PG8_WAIT_L
#undef PG8_BAR
#undef PG8_SCHED
}
template <class F> __device__ __forceinline__ void epi_each(const f32x4 (&acc)[2][2][4][2], const Unit& u, int wr, int wc, int fr, int fq, const F& f) {
#pragma unroll
    for (int ai = 0; ai < 2; ++ai)
#pragma unroll
        for (int m = 0; m < 4; ++m) { const int row = u.pm * BM + ai * HALF + wr * 64 + m * 16 + fr;
#pragma unroll
            for (int bj = 0; bj < 2; ++bj)
#pragma unroll
                for (int n = 0; n < 2; ++n) f(row, u.pn * BM + bj * HALF + wc * 32 + n * 16 + fq * 4, acc[ai][bj][m][n]); }
}
template <class F> struct EpiWrap { F f; __device__ __forceinline__ void operator()(const f32x4 (&acc)[2][2][4][2], const Unit& u, int, int wr, int wc, int fr, int fq) const { epi_each(acc, u, wr, wc, fr, fq, f); } };
}

template <class F> __device__ __forceinline__ void conv_rows(bf16_t* dst, int nrows, int K, F f, size_t gtid, size_t gstride) {
    const size_t n_el = (size_t)nrows * K;
    for (size_t i = gtid; i < n_el; i += gstride) { const int n = (int)(i / K), k = (int)(i % K); dst[i] = f2bf(f(n, k)); }
}
__device__ __forceinline__ void ph_prologue(const P& p, int bid, int nblk, int tid_) {
    const size_t gtid = (size_t)bid * NTHR + tid_, gstride = (size_t)nblk * NTHR;
    { const f32x4* src = (const f32x4*)p.x; u32x2* dst = wsp<u32x2>(p, R_XBZ);
      for (size_t i = gtid; i < (size_t)T * D / 4; i += gstride) { const f32x4 v = src[i]; u32x2 o; o.x = pk_bf16(v[0], v[1]); o.y = pk_bf16(v[2], v[3]); dst[i] = o; } }
    { float* DT = wsp<float>(p, OFF_DT);
      for (size_t i = gtid; i < (size_t)T * 16; i += gstride) { const int t = (int)(i >> 4), h = (int)(i & 15); const float* xr = p.x + (size_t)t * D; const float* w = p.ev_w_in + 2560 + h;
        float a = 0.f; for (int k = 0; k < D; ++k) a += xr[k] * w[(size_t)k * EVEN_IN]; DT[i] = softplus_f(a + p.ev_dt_bias[h]); } }
    { const float* w = p.ev_w_in;
      conv_rows(wsp<bf16_t>(p, W0M), 3584, 1024, [=](int n, int k) { const int c = n < 2560 ? n : (n < 3072 ? 2576 + (n - 2560) : 3088 + (n - 3072)); return w[(size_t)k * EVEN_IN + c]; }, gtid, gstride);
      conv_rows(wsp<bf16_t>(p, W0V), 512, 1024, [=](int n, int k) { return w[(size_t)k * EVEN_IN + 3600 + n]; }, gtid, gstride); }
    { const float* w = p.ev_w_out; const float* g = p.ev_norm_g;
      conv_rows(wsp<bf16_t>(p, W0O), 1024, 1536, [=](int n, int k) { return w[(size_t)k * 1024 + n] * (k < 1024 ? g[k] : 1.f); }, gtid, gstride); }
    { const float* w = p.od_w_in;
      conv_rows(wsp<bf16_t>(p, W1M), 1536, 1024, [=](int n, int k) {
          int c;
          if (n < 384) c = n;
          else if (n < 416) { const int j = n - 384, i = j >> 1; c = 384 + ((j & 1) ? i + 16 : i); }
          else if (n < 512) return 0.f;
          else if (n < 1024) c = 416 + (n - 512);
          else c = 928 + (n - 1024);
          return w[(size_t)k * ODD_IN + c]; }, gtid, gstride);
      conv_rows(wsp<bf16_t>(p, W1V), 512, 1024, [=](int n, int k) { return w[(size_t)k * ODD_IN + 1440 + n]; }, gtid, gstride); }
    { const float* w = p.od_w_q_up; const float* g = p.od_q_norm_g;
      conv_rows(wsp<bf16_t>(p, W1Q), 768, 256, [=](int n, int k) { const int h = n / 96, j = n % 96; int c = n;
          if (j >= 64) { const int jj = j - 64, i = jj >> 1; c = 96 * h + 64 + ((jj & 1) ? i + 16 : i); }
          return w[(size_t)k * 768 + c] * g[k]; }, gtid, gstride); }
    { const float* w = p.od_w_kv_up; const float* g = p.od_kv_norm_g;
      conv_rows(wsp<bf16_t>(p, W1K), 512, 128, [=](int n, int k) { const int h = n >> 6, d = n & 63; return w[(size_t)k * 1024 + 128 * h + d] * g[k]; }, gtid, gstride);
      conv_rows(wsp<bf16_t>(p, W1VV), 512, 128, [=](int n, int k) { const int h = n >> 6, d = n & 63; return w[(size_t)k * 1024 + 128 * h + 64 + d] * g[k]; }, gtid, gstride); }
    { const float* w = p.od_w_out;
      conv_rows(wsp<bf16_t>(p, W1O), 1024, 1024, [=](int n, int k) { return w[(size_t)k * 1024 + n]; }, gtid, gstride); }
    { const float* wg = p.moe_w_gate; const float* wu = p.moe_w_up; const float* wd = p.moe_w_down;
      { bf16_t* dst = wsp<bf16_t>(p, WGU);
        for (size_t i = gtid; i < (size_t)32 * 256 * 1024; i += gstride) { const int k = (int)(i & 1023), n = (int)(i >> 10), le = n >> 8, c = n & 255, j = c >> 7, r = c & 127;
          const size_t row = (size_t)le * 512 + j * 256 + r, si = ((size_t)le * 1024 + k) * 256 + c;
          dst[row * 1024 + k] = f2bf(wg[si]); dst[(row + 128) * 1024 + k] = f2bf(wu[si]); } }
      conv_rows(wsp<bf16_t>(p, WDN), 32 * 1024, 256, [=](int n, int k) { const int le = n >> 10, c = n & 1023; return wd[((size_t)le * 256 + k) * 1024 + c]; }, gtid, gstride); }
    { float* tab = wsp<float>(p, OFF_TAB);
      for (size_t i = gtid; i < (size_t)S * 16; i += gstride) { const int s = (int)(i >> 4), f = (int)(i & 15);
        double inv = 1.0; for (int k = 0; k < f; ++k) inv *= 0.56234132519034908;
        const double rev = (double)s * inv * 0.15915494309189535; const double fr = rev - floor(rev);
        const double x = fr * 4.0; const double qd = floor(x + 0.5); const int qi = (int)qd & 3;
        const double y = (x - qd) * 1.5707963267948966, y2 = y * y;
        const double sy = y * (1.0 + y2 * (-1.0 / 6 + y2 * (1.0 / 120 + y2 * (-1.0 / 5040 + y2 * (1.0 / 362880 + y2 * (-1.0 / 39916800 + y2 * (1.0 / 6227020800.0)))))));
        const double cy = 1.0 + y2 * (-0.5 + y2 * (1.0 / 24 + y2 * (-1.0 / 720 + y2 * (1.0 / 40320 + y2 * (-1.0 / 3628800 + y2 * (1.0 / 479001600.0 + y2 * (-1.0 / 87178291200.0)))))));
        const double cv = (qi == 0) ? cy : (qi == 1) ? -sy : (qi == 2) ? -cy : sy;
        const double sv = (qi == 0) ? sy : (qi == 1) ? cy : (qi == 2) ? -sy : -cy;
        tab[i] = (float)cv; tab[S * 16 + i] = (float)sv; } }
}

struct EpiIn0 {
    bf16_t* Z; bf16_t* XBCR; bf16_t* Q; bf16_t* K;
    __device__ __forceinline__ void operator()(int row, int col, f32x4 v) const {
        if (col < 1024) st_bf16x4(Z + (size_t)row * 1024 + col, v);
        else if (col < 2560) st_bf16x4(XBCR + (size_t)row * 1536 + (col - 1024), v);
        else if (col < 3072) st_bf16x4(Q + (size_t)row * 512 + (col - 2560), v * C2_64);
        else st_bf16x4(K + (size_t)row * 512 + (col - 3072), v);
    }
};
struct EpiVt { bf16_t* Vt; __device__ __forceinline__ void operator()(int row, int col, f32x4 v) const { st_bf16x4(Vt + (size_t)row * T + col, v); } };

__device__ __forceinline__ void ph_inproj0(const P& p, float* lds, int bid, int nblk, int tid_) {
    const bf16_t* XB = wsp<bf16_t>(p, R_XBZ);
    EpiIn0 e{wsp<bf16_t>(p, R_XBZ + 64 * MiB), wsp<bf16_t>(p, R_A2), wsp<bf16_t>(p, R_XQ + 96 * MiB), wsp<bf16_t>(p, R_XQ + 128 * MiB)};
    gemm_naive<false>(XB, 1024, nullptr, wsp<bf16_t>(p, W0M), 1024, T, 3584, 1024, e, NoMid{}, lds, bid, nblk, tid_);
    EpiVt ev{wsp<bf16_t>(p, R_XQ + 160 * MiB)};
    gemm_naive<false>(wsp<bf16_t>(p, W0V), 1024, nullptr, XB, 1024, 512, T, 1024, ev, NoMid{}, lds, bid, nblk, tid_);
}
__device__ __forceinline__ void ph_conv(const P& p, int bid, int nblk, int tid_) {
    const bf16_t* XR = wsp<bf16_t>(p, R_A2); bf16_t* XC = wsp<bf16_t>(p, R_XQ);
    const size_t gtid = (size_t)bid * NTHR + tid_, gstride = (size_t)nblk * NTHR;
    for (size_t i = gtid; i < (size_t)T * 1536; i += gstride) {
        const int t = (int)(i / 1536), c = (int)(i % 1536), s = t & (S - 1);
        float a = p.ev_conv_b[c];
#pragma unroll
        for (int k = 0; k < 4; ++k) { const int ss = s - 3 + k; if (ss >= 0) a += p.ev_conv_w[k * 1536 + c] * bf2f(XR[(size_t)(t - 3 + k) * 1536 + c]); }
        XC[i] = f2bf(silu_f(a));
    }
}
__device__ __forceinline__ void ph_ssd_naive(const P& p, float* lds, int bid, int nblk, int tid_) {
    const bf16_t* XC = wsp<bf16_t>(p, R_XQ); const bf16_t* Z = wsp<bf16_t>(p, R_XBZ + 64 * MiB); const float* DT = wsp<float>(p, OFF_DT);
    bf16_t* A2 = wsp<bf16_t>(p, R_A2); float* SSQ = wsp<float>(p, OFF_SSQ);
    float* Bs = lds; float* Cs = Bs + 16 * 128; float* xs = Cs + 16 * 128; float* dts = xs + 16 * 64; float* yp = dts + 16;
    const int tid = tid_, pp = tid & 63, nq = tid >> 6, lane = tid & 63;
    for (int u = bid; u < NB * 16; u += nblk) {
        const int b = u >> 4, h = u & 15, g = h >> 3;
        const float a = -expf(p.ev_a_log[h]), dsk = p.ev_d_skip[h];
        float st[16];
#pragma unroll
        for (int n = 0; n < 16; ++n) st[n] = 0.f;
        for (int c0 = 0; c0 < S; c0 += 16) {
            const size_t r0 = (size_t)b * S + c0;
            for (int idx = tid; idx < 16 * 128; idx += NTHR) { const int i = idx >> 7, n = idx & 127; const bf16_t* r = XC + (r0 + i) * 1536;
                Bs[idx] = bf2f(r[1024 + g * 128 + n]); Cs[idx] = bf2f(r[1280 + g * 128 + n]); }
            for (int idx = tid; idx < 16 * 64; idx += NTHR) { const int i = idx >> 6, q = idx & 63; xs[idx] = bf2f(XC[(r0 + i) * 1536 + h * 64 + q]); }
            if (tid < 16) dts[tid] = DT[(r0 + tid) * 16 + h];
            __syncthreads();
            for (int i = 0; i < 16; ++i) {
                const float dt = dts[i], dA = expf(dt * a), dtx = dt * xs[i * 64 + pp];
                float y = 0.f;
#pragma unroll
                for (int n = 0; n < 16; ++n) { st[n] = st[n] * dA + dtx * Bs[i * 128 + nq * 16 + n]; y += Cs[i * 128 + nq * 16 + n] * st[n]; }
                yp[(nq * 16 + i) * 64 + pp] = y;
            }
            __syncthreads();
            for (int idx = tid; idx < 16 * 64; idx += NTHR) {
                const int i = idx >> 6, q = idx & 63; float y = 0.f;
#pragma unroll
                for (int w = 0; w < 8; ++w) y += yp[(w * 16 + i) * 64 + q];
                y += dsk * xs[idx];
                const float z = bf2f(Z[(r0 + i) * 1024 + h * 64 + q]);
                const float uu = y * silu_f(z);
                A2[(r0 + i) * 1536 + h * 64 + q] = f2bf(uu);
                const float ss = wave_sum(uu * uu);
                if (lane == 0) SSQ[(r0 + i) * 16 + h] = ss;
            }
            __syncthreads();
        }
    }
}
__device__ __forceinline__ void ph_sb_naive(const P& p, int bid, int nblk, int tid_) {
    const bf16_t* Q = wsp<bf16_t>(p, R_XQ + 96 * MiB); const bf16_t* K = wsp<bf16_t>(p, R_XQ + 128 * MiB); const bf16_t* Vt = wsp<bf16_t>(p, R_XQ + 160 * MiB);
    bf16_t* A2 = wsp<bf16_t>(p, R_A2);
    const int lane = tid_ & 63, wid = tid_ >> 6;
    const int nunits = NB * 8 * (S / 64);
    for (int u = bid * 8 + wid; u < nunits; u += nblk * 8) {
        const int tb = (S / 64 - 1) - (u % (S / 64)), bh = u / (S / 64), b = bh >> 3, h = bh & 7;
        const int t0 = tb * 64, t = t0 + lane; const size_t row = (size_t)b * S + t;
        unsigned qp[32]; float o[64];
#pragma unroll
        for (int d = 0; d < 64; d += 8) { const u32x4 v = *(const u32x4*)(Q + row * 512 + h * 64 + d);
#pragma unroll
            for (int j = 0; j < 4; ++j) qp[d / 2 + j] = v[j]; }
#pragma unroll
        for (int d = 0; d < 64; ++d) o[d] = 0.f;
        float csum = 0.f;
        for (int s = t0 + 62; s >= 0; --s) {
            const bf16_t* kr = K + ((size_t)b * S + s) * 512 + h * 64;
            float z = 0.f;
#pragma unroll
            for (int d = 0; d < 64; d += 8) { const u32x4 v = *(const u32x4*)(kr + d);
#pragma unroll
                for (int j = 0; j < 4; ++j) { z += bflo(qp[d / 2 + j]) * bflo(v[j]); z += bfhi(qp[d / 2 + j]) * bfhi(v[j]); } }
            float w = 0.f;
            if (s < t) { const float l = fmaxf(z, 0.f) + log2f(1.f + exp2f(-fabsf(z))); csum += l; w = exp2f(z - csum); }
            const bf16_t* vc = Vt + (size_t)(h * 64) * T + (size_t)b * S + s;
#pragma unroll
            for (int d = 0; d < 64; ++d) o[d] += w * bf2f(vc[(size_t)d * T]);
        }
#pragma unroll
        for (int d = 0; d < 64; d += 4) st_bf16x4(A2 + row * 1536 + 1024 + h * 64 + d, (f32x4){o[d], o[d + 1], o[d + 2], o[d + 3]});
    }
}
struct MidRms0 { static constexpr int ksplit = 1024; const float* SSQ;
    __device__ __forceinline__ float scale(int row) const { float s = 0.f;
#pragma unroll
        for (int h = 0; h < 16; ++h) s += SSQ[(size_t)row * 16 + h];
        return rsqrtf(s * (1.0f / 1024.0f) + 1e-6f); } };
struct EpiRes { const float* X; float* PRE; __device__ __forceinline__ void operator()(int row, int col, f32x4 v) const {
        const f32x4 xr = *(const f32x4*)(X + (size_t)row * 1024 + col); *(f32x4*)(PRE + (size_t)row * 1024 + col) = xr * ALPHA + v; } };
struct EpiMixMf { bf16_t* MIX; __device__ __forceinline__ void operator()(const f32x4 (&acc)[2][2][4][2], const pg8::Unit& u, int, int wr, int wc, int fr, int fq) const; };
__device__ __forceinline__ void ph_outproj0(const P& p, float* lds, int bid, int nblk, int tid_) {
    MidRms0 mid{wsp<float>(p, OFF_SSQ)}; EpiRes e{p.x, wsp<float>(p, R_XBZ)};
    gemm_naive<false>(wsp<bf16_t>(p, R_A2), 1536, nullptr, wsp<bf16_t>(p, W0O), 1536, T, 1024, 1536, e, mid, lds, bid, nblk, tid_);
}

__device__ __forceinline__ void ln_row(f32x4 (&v)[4], const float* g, const float* bta, int lane) {
    float s = 0.f;
#pragma unroll
    for (int j = 0; j < 4; ++j) s += (v[j][0] + v[j][1]) + (v[j][2] + v[j][3]);
    const float mu = wave_sum(s) * (1.0f / 1024.0f);
    float q = 0.f;
#pragma unroll
    for (int j = 0; j < 4; ++j) { const f32x4 d = v[j] - mu; q += (d[0] * d[0] + d[1] * d[1]) + (d[2] * d[2] + d[3] * d[3]); }
    const float rstd = rsqrtf(wave_sum(q) * (1.0f / 1024.0f) + 1e-5f);
#pragma unroll
    for (int j = 0; j < 4; ++j) { const f32x4 gg = *(const f32x4*)(g + j * 256 + lane * 4), bb = *(const f32x4*)(bta + j * 256 + lane * 4); v[j] = (v[j] - mu) * rstd * gg + bb; }
}
__device__ __forceinline__ void ph_ln1_router(const P& p, int l, int bid, int nblk, int tid_) {
    const float* PRE = wsp<float>(p, R_XBZ); float* X1F = wsp<float>(p, R_XQ); bf16_t* X1B = wsp<bf16_t>(p, R_XQ + 128 * MiB);
    int* TOKE = wsp<int>(p, OFF_ROUTE); float* TOKW = wsp<float>(p, OFF_ROUTE + 256 * 1024); int* LIST = wsp<int>(p, OFF_ROUTE + 512 * 1024);
    unsigned* CNT = wsp<unsigned>(p, OFF_CTRL) + 64 * l;
    const float* g = p.ln1_g + l * 1024; const float* bta = p.ln1_b + l * 1024;
    const float* wgp = p.moe_w_group + (size_t)l * 1024 * 4; const float* wep = p.moe_w_expert + (size_t)l * 1024 * 16;
    const int lane = tid_ & 63, wid = tid_ >> 6;
    for (int t = bid * 8 + wid; t < T; t += nblk * 8) {
        f32x4 v[4];
#pragma unroll
        for (int j = 0; j < 4; ++j) v[j] = *(const f32x4*)(PRE + (size_t)t * 1024 + j * 256 + lane * 4);
        ln_row(v, g, bta, lane);
#pragma unroll
        for (int j = 0; j < 4; ++j) { *(f32x4*)(X1F + (size_t)t * 1024 + j * 256 + lane * 4) = v[j]; st_bf16x4(X1B + (size_t)t * 1024 + j * 256 + lane * 4, v[j]); }
        float lg[20];
#pragma unroll
        for (int e = 0; e < 20; ++e) lg[e] = 0.f;
#pragma unroll
        for (int j = 0; j < 4; ++j)
#pragma unroll
            for (int i = 0; i < 4; ++i) { const int k = j * 256 + lane * 4 + i; const float xv = v[j][i];
                const f32x4 wg4 = *(const f32x4*)(wgp + (size_t)k * 4);
#pragma unroll
                for (int e = 0; e < 4; ++e) lg[e] += xv * wg4[e];
#pragma unroll
                for (int e4 = 0; e4 < 4; ++e4) { const f32x4 we4 = *(const f32x4*)(wep + (size_t)k * 16 + e4 * 4);
#pragma unroll
                    for (int e = 0; e < 4; ++e) lg[4 + e4 * 4 + e] += xv * we4[e]; } }
#pragma unroll
        for (int e = 0; e < 20; ++e) lg[e] = wave_sum(lg[e]);
        if (lane == 0) {
            float gl[4]; float gm = -INFINITY; int gs = 0;
#pragma unroll
            for (int e = 0; e < 4; ++e) { gl[e] = lg[e] + p.moe_b_group[l * 4 + e]; if (gl[e] > gm) { gm = gl[e]; gs = e; } }
            float gsum = 0.f;
#pragma unroll
            for (int e = 0; e < 4; ++e) gsum += expf(gl[e] - gm);
            const float gp = 1.0f / gsum;
            float el[4]; float em = -INFINITY;
#pragma unroll
            for (int e = 0; e < 4; ++e) { float vv = 0.f;
#pragma unroll
                for (int gg = 0; gg < 4; ++gg) vv = (gg == gs) ? lg[4 + gg * 4 + e] : vv;
                el[e] = vv + p.moe_b_expert[l * 16 + gs * 4 + e]; em = fmaxf(em, el[e]); }
            int i0 = 0; float b0 = el[0];
#pragma unroll
            for (int e = 1; e < 4; ++e) if (el[e] > b0) { b0 = el[e]; i0 = e; }
            int i1 = 0; float b1 = -INFINITY;
#pragma unroll
            for (int e = 0; e < 4; ++e) if (e != i0 && el[e] > b1) { b1 = el[e]; i1 = e; }
            const float p0 = expf(b0 - em), p1 = expf(b1 - em);
            const float w0 = gp * p0 / (p0 + p1), w1 = gp * p1 / (p0 + p1);
            const int e0 = gs * 4 + i0, e1 = gs * 4 + i1;
            TOKE[t * 2] = e0; TOKE[t * 2 + 1] = e1; TOKW[t * 2] = w0; TOKW[t * 2 + 1] = w1;
            const unsigned s0 = atomicAdd(&CNT[e0], 1u); LIST[(size_t)e0 * T + s0] = t * 2;
            const unsigned s1 = atomicAdd(&CNT[e1], 1u); LIST[(size_t)e1 * T + s1] = t * 2 + 1;
        }
    }
}
struct EpiHid { bf16_t* HID; __device__ __forceinline__ void operator()(int row, int col, f32x4 v) const { st_bf16x4(HID + (size_t)row * 256 + col, v); } };
struct EpiDown { bf16_t* Y; const int* gidx; const float* TOKW;
    __device__ __forceinline__ void operator()(int row, int col, f32x4 v) const { const int e = gidx[row]; if (e < 0) return; const float w = TOKW[e];
        st_bf16x4(Y + ((size_t)(e & 1) * T + (e >> 1)) * 1024 + col, v * w); } };
__device__ __forceinline__ void moe_range(const unsigned* CNT, int e, int& off_e, int& rows) {
    int o = 0; off_e = 0; rows = 0;
#pragma unroll
    for (int k = 0; k < 16; ++k) { const int r = ((int)CNT[k] + 255) & ~255; if (k == e) { off_e = o; rows = r; } o += r; }
}
__device__ __forceinline__ void ph_moe_index(const P& p, int l, int bid, int nblk, int tid_) {
    const unsigned* CNT = wsp<unsigned>(p, OFF_CTRL) + 64 * l; const int* LIST = wsp<int>(p, OFF_ROUTE + 512 * 1024); int* GIDX = wsp<int>(p, OFF_ROUTE + 512 * 1024 + 2 * MiB);
    int total = 0;
#pragma unroll
    for (int k = 0; k < 16; ++k) total += ((int)CNT[k] + 255) & ~255;
    const size_t gtid = (size_t)bid * NTHR + tid_, gstride = (size_t)nblk * NTHR;
    for (size_t i = gtid; i < (size_t)total; i += gstride) {
        int o = 0, e_off = 0, e_n = 0, e_id = 0;
#pragma unroll
        for (int k = 0; k < 16; ++k) { const int nk = (int)CNT[k], r = (nk + 255) & ~255; if ((int)i >= o && (int)i < o + r) { e_off = o; e_n = nk; e_id = k; } o += r; }
        const int r = (int)i - e_off; GIDX[i] = r < e_n ? LIST[(size_t)e_id * T + r] : -1;
    }
}
__device__ __forceinline__ void ph_moe1(const P& p, int l, float* lds, int bid, int nblk, int tid_) {
    const unsigned* CNT = wsp<unsigned>(p, OFF_CTRL) + 64 * l; const int* GIDX = wsp<int>(p, OFF_ROUTE + 512 * 1024 + 2 * MiB);
    const bf16_t* X1B = wsp<bf16_t>(p, R_XQ + 128 * MiB);
    for (int e = 0; e < 16; ++e) {
        int off_e, rows; moe_range(CNT, e, off_e, rows); if (rows == 0) continue;
        EpiHid ep{wsp<bf16_t>(p, R_A2) + (size_t)off_e * 256};
        gemm_naive<true>(X1B, 1024, GIDX + off_e, wsp<bf16_t>(p, WGU) + (size_t)(l * 16 + e) * 512 * 1024, 1024, rows, 256, 1024, ep, NoMid{}, lds, bid, nblk, tid_);
    }
}
__device__ __forceinline__ void ph_moe2(const P& p, int l, float* lds, int bid, int nblk, int tid_) {
    const unsigned* CNT = wsp<unsigned>(p, OFF_CTRL) + 64 * l; const int* GIDX = wsp<int>(p, OFF_ROUTE + 512 * 1024 + 2 * MiB);
    for (int e = 0; e < 16; ++e) {
        int off_e, rows; moe_range(CNT, e, off_e, rows); if (rows == 0) continue;
        EpiDown ep{wsp<bf16_t>(p, R_XBZ), GIDX + off_e, wsp<float>(p, OFF_ROUTE + 256 * 1024)};
        gemm_naive<false>(wsp<bf16_t>(p, R_A2) + (size_t)off_e * 256, 256, nullptr, wsp<bf16_t>(p, WDN) + (size_t)(l * 16 + e) * 1024 * 256, 256, rows, 1024, 256, ep, NoMid{}, lds, bid, nblk, tid_);
    }
}
__device__ __forceinline__ void ph_ln2(const P& p, int l, int bid, int nblk, int tid_) {
    float* X1F = wsp<float>(p, R_XQ); bf16_t* X1B = wsp<bf16_t>(p, R_XQ + 128 * MiB); const bf16_t* Y = wsp<bf16_t>(p, R_XBZ);
    float* LOGF = wsp<float>(p, OFF_DT);
    const float* g = p.ln2_g + l * 1024; const float* bta = p.ln2_b + l * 1024;
    const int lane = tid_ & 63, wid = tid_ >> 6;
    for (int t = bid * 8 + wid; t < T; t += nblk * 8) {
        f32x4 v[4];
#pragma unroll
        for (int j = 0; j < 4; ++j) { const size_t o = (size_t)t * 1024 + j * 256 + lane * 4; const f32x4 xv = *(const f32x4*)(X1F + o);
            const u32x2 a = *(const u32x2*)(Y + o), b = *(const u32x2*)(Y + (size_t)T * 1024 + o);
            v[j] = xv * ALPHA + (f32x4){bflo(a.x) + bflo(b.x), bfhi(a.x) + bfhi(b.x), bflo(a.y) + bflo(b.y), bfhi(a.y) + bfhi(b.y)}; }
        ln_row(v, g, bta, lane);
        if (l == 1) {
#pragma unroll
            for (int j = 0; j < 4; ++j) *(f32x4*)(p.out + (size_t)t * 1024 + j * 256 + lane * 4) = v[j];
        } else {
#pragma unroll
            for (int j = 0; j < 4; ++j) { *(f32x4*)(X1F + (size_t)t * 1024 + j * 256 + lane * 4) = v[j]; st_bf16x4(X1B + (size_t)t * 1024 + j * 256 + lane * 4, v[j]); }
            float f[8];
#pragma unroll
            for (int e = 0; e < 8; ++e) f[e] = 0.f;
#pragma unroll
            for (int j = 0; j < 4; ++j)
#pragma unroll
                for (int i = 0; i < 4; ++i) { const int k = j * 256 + lane * 4 + i; const float* w = p.od_w_in + (size_t)k * ODD_IN + 1952;
#pragma unroll
                    for (int e = 0; e < 8; ++e) f[e] += v[j][i] * w[e]; }
#pragma unroll
            for (int e = 0; e < 8; ++e) f[e] = wave_sum(f[e]);
            if (lane < 8) { float fv = 0.f;
#pragma unroll
                for (int e = 0; e < 8; ++e) fv = (e == lane) ? f[e] : fv;
                LOGF[(size_t)t * 8 + lane] = logsigmoid_f(fv + p.od_f_bias[lane]); }
        }
    }
}

struct EpiIn1 {
    bf16_t* CQ; bf16_t* CKV; bf16_t* Q; bf16_t* K; float* SSQQ; float* SSQK; const float* tab;
    __device__ __forceinline__ void operator()(int row, int col, f32x4 v) const {
        const int tx = lane_id() & 15;
        if (col < 512) {
            const bool isq = col < 256; const bool iskv = (col >= 256 && col < 384);
            float s = (isq || iskv) ? (v[0] * v[0] + v[1] * v[1]) + (v[2] * v[2] + v[3] * v[3]) : 0.f;
            s += __shfl_xor(s, 1); s += __shfl_xor(s, 2); s += __shfl_xor(s, 4); s += __shfl_xor(s, 8);
            if (tx == 0) { if (isq) SSQQ[(size_t)row * 4 + (col >> 6)] = s; else SSQK[(size_t)row * 4 + ((col - 256) >> 6)] = s; }
            if (isq) st_bf16x4(CQ + (size_t)row * 256 + col, v);
            else {
                if (col >= 384 && col < 416) { const int sp = row & (S - 1), i0 = (col - 384) >> 1;
                    const float c0 = tab[sp * 16 + i0], s0 = tab[S * 16 + sp * 16 + i0], c1 = tab[sp * 16 + i0 + 1], s1 = tab[S * 16 + sp * 16 + i0 + 1];
                    v = (f32x4){v[0] * c0 - v[1] * s0, v[1] * c0 + v[0] * s0, v[2] * c1 - v[3] * s1, v[3] * c1 + v[2] * s1}; }
                st_bf16x4(CKV + (size_t)row * 256 + (col - 256), v);
            }
        } else if (col < 1024) st_bf16x4(Q + (size_t)row * 512 + (col - 512), v * C2_64);
        else st_bf16x4(K + (size_t)row * 512 + (col - 1024), v);
    }
};
__device__ __forceinline__ void ph_inproj1(const P& p, float* lds, int bid, int nblk, int tid_) {
    const bf16_t* XB = wsp<bf16_t>(p, R_XQ + 128 * MiB);
    EpiIn1 e{wsp<bf16_t>(p, R_XBZ), wsp<bf16_t>(p, R_XBZ + 16 * MiB), wsp<bf16_t>(p, R_XBZ + 32 * MiB), wsp<bf16_t>(p, R_XBZ + 64 * MiB),
             wsp<float>(p, OFF_SSQ), wsp<float>(p, OFF_SSQ + 512 * 1024), wsp<float>(p, OFF_TAB)};
    gemm_naive<false>(XB, 1024, nullptr, wsp<bf16_t>(p, W1M), 1024, T, 1536, 1024, e, NoMid{}, lds, bid, nblk, tid_);
    EpiVt ev{wsp<bf16_t>(p, R_XBZ + 96 * MiB)};
    gemm_naive<false>(wsp<bf16_t>(p, W1V), 1024, nullptr, XB, 1024, 512, T, 1024, ev, NoMid{}, lds, bid, nblk, tid_);
}
__device__ __forceinline__ float rs4(const float* s, int row, float inv_n) { const f32x4 v = *(const f32x4*)(s + (size_t)row * 4); return rsqrtf(((v[0] + v[1]) + (v[2] + v[3])) * inv_n + 1e-6f); }
struct EpiQup { bf16_t* QM; const float* SSQQ; const float* tab;
    __device__ __forceinline__ void operator()(int row, int col, f32x4 v) const {
        v = v * rs4(SSQQ, row, 1.0f / 256.0f);
        const int j = col % 96;
        if (j >= 64) { const int sp = row & (S - 1), i0 = (j - 64) >> 1;
            const float c0 = tab[sp * 16 + i0], s0 = tab[S * 16 + sp * 16 + i0], c1 = tab[sp * 16 + i0 + 1], s1 = tab[S * 16 + sp * 16 + i0 + 1];
            v = (f32x4){v[0] * c0 - v[1] * s0, v[1] * c0 + v[0] * s0, v[2] * c1 - v[3] * s1, v[3] * c1 + v[2] * s1}; }
        st_bf16x4(QM + (size_t)row * 768 + col, v * C2_96);
    } };
struct EpiKup { bf16_t* KN; const float* SSQK; __device__ __forceinline__ void operator()(int row, int col, f32x4 v) const { st_bf16x4(KN + (size_t)row * 512 + col, v * rs4(SSQK, row, 1.0f / 128.0f)); } };
struct EpiVup { bf16_t* VtM; const float* SSQK; __device__ __forceinline__ void operator()(int row, int col, f32x4 v) const {
        v = (f32x4){v[0] * rs4(SSQK, col, 1.0f / 128.0f), v[1] * rs4(SSQK, col + 1, 1.0f / 128.0f), v[2] * rs4(SSQK, col + 2, 1.0f / 128.0f), v[3] * rs4(SSQK, col + 3, 1.0f / 128.0f)};
        st_bf16x4(VtM + (size_t)row * T + col, v); } };
__device__ __forceinline__ void ph_upproj(const P& p, float* lds, int bid, int nblk, int tid_) {
    const bf16_t* CQ = wsp<bf16_t>(p, R_XBZ); const bf16_t* CKV = wsp<bf16_t>(p, R_XBZ + 16 * MiB);
    const float* SSQQ = wsp<float>(p, OFF_SSQ); const float* SSQK = wsp<float>(p, OFF_SSQ + 512 * 1024);
    EpiQup eq{wsp<bf16_t>(p, R_A2), SSQQ, wsp<float>(p, OFF_TAB)};
    gemm_naive<false>(CQ, 256, nullptr, wsp<bf16_t>(p, W1Q), 256, T, 768, 256, eq, NoMid{}, lds, bid, nblk, tid_);
    EpiKup ek{wsp<bf16_t>(p, R_A2 + 48 * MiB), SSQK};
    gemm_naive<false>(CKV, 256, nullptr, wsp<bf16_t>(p, W1K), 128, T, 512, 128, ek, NoMid{}, lds, bid, nblk, tid_);
    EpiVup ev{wsp<bf16_t>(p, R_A2 + 80 * MiB), SSQK};
    gemm_naive<false>(wsp<bf16_t>(p, W1VV), 128, nullptr, CKV, 256, 512, T, 128, ev, NoMid{}, lds, bid, nblk, tid_);
    const float* LOGF = wsp<float>(p, OFF_DT); float* FH2 = wsp<float>(p, OFF_DT + 1 * MiB);
    const int lane = tid_ & 63, wid = tid_ >> 6;
    for (int u = bid * 8 + wid; u < NB * 8; u += nblk * 8) {
        const int b = u >> 3, h = u & 7;
        float loc[32]; float run = 0.f;
#pragma unroll
        for (int i = 0; i < 32; ++i) { run += LOGF[((size_t)b * S + lane * 32 + i) * 8 + h]; loc[i] = run; }
        float incl = run;
#pragma unroll
        for (int o = 1; o < 64; o <<= 1) { const float nb = __shfl_up(incl, o); if (lane >= o) incl += nb; }
        const float excl = incl - run;
#pragma unroll
        for (int i = 0; i < 32; ++i) FH2[(size_t)u * S + lane * 32 + i] = (excl + loc[i]) * LOG2E;
    }
}
__device__ __forceinline__ void ph_attn1_naive(const P& p, int bid, int nblk, int tid_) {
    const bf16_t* QM = wsp<bf16_t>(p, R_A2); const bf16_t* KN = wsp<bf16_t>(p, R_A2 + 48 * MiB); const bf16_t* VtM = wsp<bf16_t>(p, R_A2 + 80 * MiB);
    const bf16_t* CKV = wsp<bf16_t>(p, R_XBZ + 16 * MiB);
    const bf16_t* Qf = wsp<bf16_t>(p, R_XBZ + 32 * MiB); const bf16_t* Kf = wsp<bf16_t>(p, R_XBZ + 64 * MiB); const bf16_t* Vtf = wsp<bf16_t>(p, R_XBZ + 96 * MiB);
    const float* FH2 = wsp<float>(p, OFF_DT + 1 * MiB);
    bf16_t* A2 = wsp<bf16_t>(p, R_XQ + 128 * MiB);
    const int lane = tid_ & 63, wid = tid_ >> 6;
    const int nper = NB * 8 * (S / 64);
    for (int u = bid * 8 + wid; u < 2 * nper; u += nblk * 8) {
        const bool fox = u >= nper; const int uu = fox ? u - nper : u;
        const int tb = (S / 64 - 1) - (uu % (S / 64)), bh = uu / (S / 64), b = bh >> 3, h = bh & 7;
        const int t0 = tb * 64, t = t0 + lane; const size_t row = (size_t)b * S + t;
        float o[64];
#pragma unroll
        for (int d = 0; d < 64; ++d) o[d] = 0.f;
        float m = -INFINITY, lsum = 0.f;
        if (!fox) {
            unsigned qp[48];
#pragma unroll
            for (int d = 0; d < 96; d += 8) { const u32x4 v = *(const u32x4*)(QM + row * 768 + h * 96 + d);
#pragma unroll
                for (int j = 0; j < 4; ++j) qp[d / 2 + j] = v[j]; }
            for (int s = 0; s < t0 + 64; ++s) {
                const size_t kr = (size_t)b * S + s; float z = 0.f;
#pragma unroll
                for (int d = 0; d < 64; d += 8) { const u32x4 v = *(const u32x4*)(KN + kr * 512 + h * 64 + d);
#pragma unroll
                    for (int j = 0; j < 4; ++j) { z += bflo(qp[d / 2 + j]) * bflo(v[j]); z += bfhi(qp[d / 2 + j]) * bfhi(v[j]); } }
#pragma unroll
                for (int d = 0; d < 32; d += 8) { const u32x4 v = *(const u32x4*)(CKV + kr * 256 + 128 + d);
#pragma unroll
                    for (int j = 0; j < 4; ++j) { z += bflo(qp[32 + d / 2 + j]) * bflo(v[j]); z += bfhi(qp[32 + d / 2 + j]) * bfhi(v[j]); } }
                const float mn = fmaxf(m, z), corr = exp2f(m - mn), pw = exp2f(z - mn); m = mn; lsum = lsum * corr + pw;
                const bf16_t* vc = VtM + (size_t)(h * 64) * T + kr;
#pragma unroll
                for (int d = 0; d < 64; ++d) o[d] = o[d] * corr + pw * bf2f(vc[(size_t)d * T]);
            }
        } else {
            unsigned qp[32];
#pragma unroll
            for (int d = 0; d < 64; d += 8) { const u32x4 v = *(const u32x4*)(Qf + row * 512 + h * 64 + d);
#pragma unroll
                for (int j = 0; j < 4; ++j) qp[d / 2 + j] = v[j]; }
            const float fht = FH2[(size_t)bh * S + t];
            for (int s = 0; s < t0 + 64; ++s) {
                const size_t kr = (size_t)b * S + s; float z = 0.f;
#pragma unroll
                for (int d = 0; d < 64; d += 8) { const u32x4 v = *(const u32x4*)(Kf + kr * 512 + h * 64 + d);
#pragma unroll
                    for (int j = 0; j < 4; ++j) { z += bflo(qp[d / 2 + j]) * bflo(v[j]); z += bfhi(qp[d / 2 + j]) * bfhi(v[j]); } }
                z += fht - FH2[(size_t)bh * S + s];
                if (s <= t) {
                    const float mn = fmaxf(m, z), corr = exp2f(m - mn), pw = exp2f(z - mn); m = mn; lsum = lsum * corr + pw;
                    const bf16_t* vc = Vtf + (size_t)(h * 64) * T + kr;
#pragma unroll
                    for (int d = 0; d < 64; ++d) o[d] = o[d] * corr + pw * bf2f(vc[(size_t)d * T]);
                }
            }
        }
        const float inv = 1.0f / lsum;
#pragma unroll
        for (int d = 0; d < 64; d += 4) st_bf16x4(A2 + row * 1024 + (fox ? 512 : 0) + h * 64 + d, (f32x4){o[d] * inv, o[d + 1] * inv, o[d + 2] * inv, o[d + 3] * inv});
    }
}
__device__ __forceinline__ void ph_outproj1(const P& p, float* lds, int bid, int nblk, int tid_) {
    EpiRes e{wsp<float>(p, R_XQ), wsp<float>(p, R_XBZ)};
    gemm_naive<false>(wsp<bf16_t>(p, R_XQ + 128 * MiB), 1024, nullptr, wsp<bf16_t>(p, W1O), 1024, T, 1024, 1024, e, NoMid{}, lds, bid, nblk, tid_);
}

constexpr int LDS_STAGE = pg8::STAGE_BYTES;
constexpr int LDS_TAB_OFF = LDS_STAGE;
constexpr int LDS_TAB_BYTES = 16 * 1024;
#define LDSP(smem) ((PG8_LAS unsigned char*)(smem))

__device__ __forceinline__ void st_bf16x8(bf16_t* p, f32x4 a, f32x4 b) { u32x4 w; w[0] = pk_bf16(a[0], a[1]); w[1] = pk_bf16(a[2], a[3]); w[2] = pk_bf16(b[0], b[1]); w[3] = pk_bf16(b[2], b[3]); *(u32x4*)p = w; }
__device__ __forceinline__ void epi_store_bf16p(const f32x4 (&acc)[2][2][4][2], const pg8::Unit& u, int wr, int wc, int fr, int fq, bf16_t* base, int ld, int c0, float sc) {
#pragma unroll
    for (int ai = 0; ai < 2; ++ai)
#pragma unroll
        for (int m = 0; m < 4; ++m) { bf16_t* rp = base + (size_t)(u.pm * 256 + ai * 128 + wr * 64 + m * 16 + fr) * ld + c0 + wc * 32 + fq * 8;
#pragma unroll
            for (int bj = 0; bj < 2; ++bj) st_bf16x8(rp + bj * 128, acc[ai][bj][m][0] * sc, acc[ai][bj][m][1] * sc); }
}
__device__ __forceinline__ void epi_store_bf16(const f32x4 (&acc)[2][2][4][2], const pg8::Unit& u, int wr, int wc, int fr, int fq, bf16_t* base, int ld, int c0, float sc) {
#pragma unroll
    for (int ai = 0; ai < 2; ++ai)
#pragma unroll
        for (int m = 0; m < 4; ++m) { bf16_t* rp = base + (size_t)(u.pm * 256 + ai * 128 + wr * 64 + m * 16 + fr) * ld + c0 + wc * 32 + fq * 4;
#pragma unroll
            for (int bj = 0; bj < 2; ++bj)
#pragma unroll
                for (int n = 0; n < 2; ++n) st_bf16x4(rp + bj * 128 + n * 16, acc[ai][bj][m][n] * sc); }
}
__device__ __forceinline__ void EpiMixMf::operator()(const f32x4 (&acc)[2][2][4][2], const pg8::Unit& u, int, int wr, int wc, int fr, int fq) const { epi_store_bf16p(acc, u, wr, wc, fr, fq, MIX, 1024, u.pn * 256, 1.f); }
struct EpiIn0Mf { bf16_t* Z; bf16_t* XBCR; bf16_t* Q; bf16_t* K;
    __device__ __forceinline__ void operator()(const f32x4 (&acc)[2][2][4][2], const pg8::Unit& u, int, int wr, int wc, int fr, int fq) const {
        bf16_t* base; int ld, c0; float sc = 1.f;
        if (u.pn < 4) { base = Z; ld = 1024; c0 = u.pn * 256; }
        else if (u.pn < 10) { base = XBCR; ld = 1536; c0 = (u.pn - 4) * 256; }
        else if (u.pn < 12) { base = Q; ld = 512; c0 = (u.pn - 10) * 256; sc = C2_64; }
        else { base = K; ld = 512; c0 = (u.pn - 12) * 256; }
        epi_store_bf16p(acc, u, wr, wc, fr, fq, base, ld, c0, sc); } };
struct EpiVtMf { bf16_t* Vt; __device__ __forceinline__ void operator()(const f32x4 (&acc)[2][2][4][2], const pg8::Unit& u, int, int wr, int wc, int fr, int fq) const {
        epi_store_bf16p(acc, u, wr, wc, fr, fq, Vt, T, u.pn * 256, 1.f); } };
template <class F> __device__ __forceinline__ void mf_dense(unsigned char* smem, const bf16_t* A, int lda, const bf16_t* Bt, int ldb, int M, int N, int K, const F& f, int bid, int nblk, int tid_) {
    pg8::Gemm g{A, Bt, lda, ldb, K, nullptr}; pg8::DenseOrder S; S.init(M, N, lda, ldb, nblk, bid);
    pg8::EpiWrap<F> E{f};
    pg8::gemm_phase<pg8::EpiWrap<F>, pg8::DenseOrder, pg8::NoMidK, false>(LDSP(smem), g, S, E, pg8::NoMidK{}, tid_);
}
template <bool PERM, class E_> __device__ __forceinline__ void mf_dense_e(unsigned char* smem, const bf16_t* A, int lda, const bf16_t* Bt, int ldb, int M, int N, int K, const E_& E, int bid, int nblk, int tid_) {
    pg8::Gemm g{A, Bt, lda, ldb, K, nullptr}; pg8::DenseOrder S; S.init(M, N, lda, ldb, nblk, bid);
    pg8::gemm_phase<E_, pg8::DenseOrder, pg8::NoMidK, false, PERM>(LDSP(smem), g, S, E, pg8::NoMidK{}, tid_);
}
__device__ __forceinline__ void ph_inproj0_mf(const P& p, unsigned char* smem, int bid, int nblk, int tid_) {
    const bf16_t* XB = wsp<bf16_t>(p, R_XBZ);
    EpiIn0Mf e{wsp<bf16_t>(p, R_XBZ + 64 * MiB), wsp<bf16_t>(p, R_A2), wsp<bf16_t>(p, R_XQ + 96 * MiB), wsp<bf16_t>(p, R_XQ + 128 * MiB)};
    mf_dense_e<true>(smem, XB, 1024, wsp<bf16_t>(p, W0M), 1024, T, 3584, 1024, e, bid, nblk, tid_);
    EpiVtMf ev{wsp<bf16_t>(p, R_XQ + 160 * MiB)};
    mf_dense_e<true>(smem, wsp<bf16_t>(p, W0V), 1024, XB, 1024, 512, T, 1024, ev, bid, nblk, tid_);
}
struct MidRmsK { static constexpr int ktile = 16; const PG8_LAS float* rs;
    __device__ __forceinline__ void apply(f32x4 (&acc)[2][2][4][2], int ui, int wr, int fr) const {
#pragma unroll
        for (int ai = 0; ai < 2; ++ai)
#pragma unroll
            for (int m = 0; m < 4; ++m) { const float s = rs[ui * 256 + ai * 128 + wr * 64 + m * 16 + fr];
#pragma unroll
                for (int bj = 0; bj < 2; ++bj)
#pragma unroll
                    for (int n = 0; n < 2; ++n) acc[ai][bj][m][n] *= s; } } };
constexpr int NSSQ = USE_SSD ? 32 : 16;
__device__ __forceinline__ void ph_outproj0_mf(const P& p, unsigned char* smem, int bid, int nblk, int tid_) {
    const float* SSQ = wsp<float>(p, OFF_SSQ);
    PG8_LAS float* rs = (PG8_LAS float*)(LDSP(smem) + LDS_TAB_OFF);
    pg8::Gemm g{wsp<bf16_t>(p, R_A2), wsp<bf16_t>(p, W0O), 1536, 1536, 1536, nullptr}; pg8::DenseOrder S; S.init(T, 1024, 1536, 1536, nblk, bid);
    for (int idx = tid_; idx < 8 * 256; idx += NTHR) { pg8::Unit u; const int ui = idx >> 8, r = idx & 255;
        if (S.next(ui, u)) { const int row = u.pm * 256 + r; float s = 0.f;
#pragma unroll
            for (int h = 0; h < NSSQ; h += 4) { const f32x4 v = *(const f32x4*)(SSQ + (size_t)row * NSSQ + h); s += (v[0] + v[1]) + (v[2] + v[3]); }
            rs[idx] = rsqrtf(s * (1.0f / 1024.0f) + 1e-6f); } }
    __syncthreads();
    EpiMixMf E{wsp<bf16_t>(p, R_XBZ)}; MidRmsK mid{rs};
    pg8::gemm_phase<EpiMixMf, pg8::DenseOrder, MidRmsK, false, true>(LDSP(smem), g, S, E, mid, tid_);
}
constexpr size_t OFF_DONE = OFF_CTRL + 4096;
constexpr size_t OFF_LIST = R_A2 + 100 * MiB;
constexpr int NLIST = 24;
__device__ __forceinline__ void pair_experts(int lid, int& elo, int& ehi) { const int gs = lid / 6, pid = lid % 6;
    const int lo = pid < 3 ? 0 : (pid < 5 ? 1 : 2), hi = pid < 3 ? pid + 1 : (pid < 5 ? pid - 1 : 3); elo = gs * 4 + lo; ehi = gs * 4 + hi; }
template <int PHASE> struct MoeOrder {
    static constexpr int NPN = 4;
    static constexpr bool HOOK = PHASE == 2;
    static constexpr int BSEAM = PHASE == 2 ? 4 : 0;
    int cnt[NLIST]; int G, c; unsigned* done; int nA, nB, qlo, NBtot, N2;
    __device__ __forceinline__ void init(const unsigned* CNT, unsigned* done_, int G_, int c_) {
        int tiles = 0;
#pragma unroll
        for (int k = 0; k < NLIST; ++k) { cnt[k] = (int)CNT[k]; tiles += (cnt[k] + 255) >> 8; }
        G = G_; c = c_; done = done_;
        const int n1 = tiles * 4; N2 = tiles * 4; nA = n1 % G; nB = G - nA;
        int q = (N2 + G - 1) / G;
        while (nB * q + nA * (q > 2 ? q - 2 : 0) < N2) ++q;
        qlo = q > 2 ? q - 2 : 0; NBtot = N2 - nA * qlo; if (NBtot < 0) NBtot = 0; }
    __device__ __forceinline__ bool next(int i, pg8::Unit& u) const {
        int L;
        if (PHASE == 1) L = i * G + c;
        else if (c >= nA) { L = i * nB + (c - nA); if (L >= NBtot) L = 1 << 30; }
        else { L = NBtot + i * nA + c; if (i >= qlo) L = 1 << 30; }
        int base = 0, off = 0; bool found = false;
        u.pm = 0; u.pn = 0; u.e = 0; u.g0 = 0;
#pragma unroll
        for (int k = 0; k < NLIST; ++k) { const int te = (cnt[k] + 255) >> 8, nu = te * NPN;
            if (!found && L < base + nu) { const int loc = L - base; u.e = k; u.pm = loc / NPN; u.pn = loc % NPN; u.g0 = off + u.pm * 256; found = true; }
            base += nu; off += te * 256; }
        int elo, ehi; pair_experts(u.e, elo, ehi);
        if (PHASE == 1) { u.aoff = 0; u.boff = ((size_t)((u.pn >> 1) ? ehi : elo) * 512 + (u.pn & 1) * 256) * 1024 * 2; u.boff2 = u.boff; }
        else { u.aoff = (size_t)u.g0 * 512 * 2; u.boff = ((size_t)elo * 1024 + u.pn * 256) * 256 * 2; u.boff2 = ((size_t)ehi * 1024 + u.pn * 256) * 256 * 2 - (size_t)BSEAM * 128; }
        return found; }
    __device__ __forceinline__ int count(int e) const { int r = 0;
#pragma unroll
        for (int k = 0; k < NLIST; ++k) r = (k == e) ? cnt[k] : r;
        return r; }
    __device__ __forceinline__ void a_ready(const pg8::Unit& u, int wid) const {
        if (wid == 0) { unsigned* w = done + (u.g0 >> 8); unsigned sp = 0;
            while (__hip_atomic_load(w, __ATOMIC_RELAXED, __HIP_MEMORY_SCOPE_AGENT) < 32u) { __builtin_amdgcn_s_sleep(2); if (++sp > (1u << 22)) break; }
            __builtin_amdgcn_fence(__ATOMIC_ACQUIRE, "agent"); asm volatile("s_waitcnt vmcnt(0)" ::: "memory"); }
        __builtin_amdgcn_s_barrier(); asm volatile("" ::: "memory"); }
};
__device__ __forceinline__ void st16_sc1(void* p, u32x4 v) { asm volatile("global_store_dwordx4 %0, %1, off sc1" :: "v"(p), "v"(v) : "memory"); }
struct EpiHidMf { bf16_t* HID; unsigned* done; const PG8_LAS int* gl; const float* TOKW;
    __device__ __forceinline__ void operator()(const f32x4 (&acc)[2][2][4][2], const pg8::Unit& u, int ui, int wr, int wc, int fr, int fq) const {
        const int hi = u.pn >> 1;
#pragma unroll
        for (int ai = 0; ai < 2; ++ai)
#pragma unroll
            for (int m = 0; m < 4; ++m) { const int rl = ai * 128 + wr * 64 + m * 16 + fr; const size_t hrow = (size_t)u.g0 + rl; u32x4 w;
                const float tw = TOKW[gl[ui * 256 + rl] * 2 + hi];
#pragma unroll
                for (int n = 0; n < 2; ++n) { const f32x4 gt = acc[ai][0][m][n], up = acc[ai][1][m][n] * tw;
                    w[2 * n] = pk_bf16(silu_f(gt[0]) * up[0], silu_f(gt[1]) * up[1]); w[2 * n + 1] = pk_bf16(silu_f(gt[2]) * up[2], silu_f(gt[3]) * up[3]); }
                st16_sc1(HID + hrow * 512 + hi * 256 + (u.pn & 1) * 128 + wc * 32 + fq * 8, w); }
        asm volatile("s_waitcnt vmcnt(0)" ::: "memory");
        if (fr == 0 && fq == 0) __hip_atomic_fetch_add(done + (u.g0 >> 8), 1u, __ATOMIC_RELAXED, __HIP_MEMORY_SCOPE_AGENT); } };
__device__ __forceinline__ void ph_moe1_mf(const P& p, int l, unsigned char* smem, int bid, int nblk, int tid_) {
    const unsigned* CNT = wsp<unsigned>(p, OFF_CTRL) + 64 * l; const int* LIST = wsp<int>(p, OFF_LIST);
    PG8_LAS int* gl = (PG8_LAS int*)(LDSP(smem) + LDS_TAB_OFF);
    unsigned* done = wsp<unsigned>(p, OFF_DONE) + 512 * l;
    MoeOrder<1> S; S.init(CNT, done, nblk, bid);
    for (int idx = tid_; idx < 8 * 256; idx += NTHR) { pg8::Unit u; const int ui = idx >> 8, r = idx & 255;
        if (S.next(ui, u)) { const int li = u.pm * 256 + r; gl[idx] = (li < S.count(u.e)) ? LIST[(size_t)u.e * T + li] : 0; } }
    __syncthreads();
    pg8::Gemm g{wsp<bf16_t>(p, R_XQ + 128 * MiB), wsp<bf16_t>(p, WGU) + (size_t)l * 16 * 512 * 1024, 1024, 1024, 1024, gl};
    EpiHidMf E{wsp<bf16_t>(p, R_A2), done, gl, wsp<float>(p, OFF_ROUTE + 256 * 1024)};
    pg8::gemm_phase<EpiHidMf, MoeOrder<1>, pg8::NoMidK, true, true>(LDSP(smem), g, S, E, pg8::NoMidK{}, tid_);
}
struct EpiDownMf { bf16_t* Y; const PG8_LAS int* ent;
    __device__ __forceinline__ void operator()(const f32x4 (&acc)[2][2][4][2], const pg8::Unit& u, int ui, int wr, int wc, int fr, int fq) const {
#pragma unroll
        for (int ai = 0; ai < 2; ++ai)
#pragma unroll
            for (int m = 0; m < 4; ++m) { const int r = ui * 256 + ai * 128 + wr * 64 + m * 16 + fr; const int en = ent[r];
                if (en >= 0) { bf16_t* yr = Y + (size_t)en * 1024 + u.pn * 256 + wc * 32 + fq * 8;
#pragma unroll
                    for (int bj = 0; bj < 2; ++bj) st_bf16x8(yr + bj * 128, acc[ai][bj][m][0], acc[ai][bj][m][1]); } } } };
__device__ __forceinline__ void ph_moe2_mf(const P& p, int l, unsigned char* smem, int bid, int nblk, int tid_) {
    const unsigned* CNT = wsp<unsigned>(p, OFF_CTRL) + 64 * l; const int* LIST = wsp<int>(p, OFF_LIST);
    PG8_LAS int* ent = (PG8_LAS int*)(LDSP(smem) + LDS_TAB_OFF);
    MoeOrder<2> S; S.init(CNT, wsp<unsigned>(p, OFF_DONE) + 512 * l, nblk, bid);
    for (int idx = tid_; idx < 8 * 256; idx += NTHR) { pg8::Unit u; const int ui = idx >> 8, r = idx & 255;
        if (S.next(ui, u)) { const int li = u.pm * 256 + r; ent[idx] = (li < S.count(u.e)) ? LIST[(size_t)u.e * T + li] : -1; } }
    __syncthreads();
    pg8::Gemm g{wsp<bf16_t>(p, R_A2), wsp<bf16_t>(p, WDN) + (size_t)l * 16 * 1024 * 256, 512, 256, 512, nullptr};
    EpiDownMf E{wsp<bf16_t>(p, R_XBZ), ent};
    pg8::gemm_phase<EpiDownMf, MoeOrder<2>, pg8::NoMidK, false, true>(LDSP(smem), g, S, E, pg8::NoMidK{}, tid_);
}
struct EpiIn1Mf { bf16_t* CQ; bf16_t* CKV; bf16_t* Q; bf16_t* K; float* SSQQ; float* SSQK; const float* tab;
    __device__ __forceinline__ void operator()(const f32x4 (&acc)[2][2][4][2], const pg8::Unit& u, int, int wr, int wc, int fr, int fq) const {
        if (u.pn == 0) {
#pragma unroll
            for (int ai = 0; ai < 2; ++ai)
#pragma unroll
                for (int m = 0; m < 4; ++m) { const size_t row = (size_t)u.pm * 256 + ai * 128 + wr * 64 + m * 16 + fr; float s = 0.f;
#pragma unroll
                    for (int bj = 0; bj < 2; ++bj) {
#pragma unroll
                        for (int n = 0; n < 2; ++n) { const f32x4 v = acc[ai][bj][m][n]; s += (v[0] * v[0] + v[1] * v[1]) + (v[2] * v[2] + v[3] * v[3]); }
                        st_bf16x8(CQ + row * 256 + bj * 128 + wc * 32 + fq * 8, acc[ai][bj][m][0], acc[ai][bj][m][1]); }
                    s += __shfl_xor(s, 16); s += __shfl_xor(s, 32);
                    if (fq == 0) SSQQ[row * 4 + wc] = s; }
        } else if (u.pn == 1) {
#pragma unroll
            for (int ai = 0; ai < 2; ++ai)
#pragma unroll
                for (int m = 0; m < 4; ++m) { const size_t row = (size_t)u.pm * 256 + ai * 128 + wr * 64 + m * 16 + fr; float s = 0.f;
#pragma unroll
                    for (int n = 0; n < 2; ++n) { const f32x4 v = acc[ai][0][m][n]; s += (v[0] * v[0] + v[1] * v[1]) + (v[2] * v[2] + v[3] * v[3]); }
                    st_bf16x8(CKV + row * 256 + wc * 32 + fq * 8, acc[ai][0][m][0], acc[ai][0][m][1]);
                    s += __shfl_xor(s, 16); s += __shfl_xor(s, 32);
                    if (fq == 0) SSQK[row * 4 + wc] = s;
                    if (wc == 0) { const int sp = (int)(row & (S - 1)); f32x4 vv[2];
#pragma unroll
                        for (int n = 0; n < 2; ++n) { f32x4 v = acc[ai][1][m][n]; const int cp = fq * 8 + n * 4, i0 = cp >> 1;
                            const float c0 = tab[sp * 16 + i0], s0 = tab[S * 16 + sp * 16 + i0], c1 = tab[sp * 16 + i0 + 1], s1 = tab[S * 16 + sp * 16 + i0 + 1];
                            vv[n] = (f32x4){v[0] * c0 - v[1] * s0, v[1] * c0 + v[0] * s0, v[2] * c1 - v[3] * s1, v[3] * c1 + v[2] * s1}; }
                        st_bf16x8(CKV + row * 256 + 128 + fq * 8, vv[0], vv[1]); } }
        } else {
            const bool isq = u.pn < 4;
            epi_store_bf16p(acc, u, wr, wc, fr, fq, isq ? Q : K, 512, (isq ? u.pn - 2 : u.pn - 4) * 256, isq ? C2_64 : 1.f);
        } } };
__device__ __forceinline__ void ph_inproj1_mf(const P& p, unsigned char* smem, int bid, int nblk, int tid_) {
    const bf16_t* XB = wsp<bf16_t>(p, R_XQ + 128 * MiB);
    EpiIn1Mf E{wsp<bf16_t>(p, R_XBZ), wsp<bf16_t>(p, R_XBZ + 16 * MiB), wsp<bf16_t>(p, R_XBZ + 32 * MiB), wsp<bf16_t>(p, R_XBZ + 64 * MiB),
               wsp<float>(p, OFF_SSQ), wsp<float>(p, OFF_SSQ + 512 * 1024), wsp<float>(p, OFF_TAB)};
    { pg8::Gemm g{XB, wsp<bf16_t>(p, W1M), 1024, 1024, 1024, nullptr}; pg8::DenseOrder S; S.init(T, 1536, 1024, 1024, nblk, bid);
      pg8::gemm_phase<EpiIn1Mf, pg8::DenseOrder, pg8::NoMidK, false, true>(LDSP(smem), g, S, E, pg8::NoMidK{}, tid_); }
    EpiVtMf ev{wsp<bf16_t>(p, R_XBZ + 96 * MiB)};
    mf_dense_e<true>(smem, wsp<bf16_t>(p, W1V), 1024, XB, 1024, 512, T, 1024, ev, bid, nblk, tid_);
}
__device__ __forceinline__ void ph_fh_cumsum(const P& p, int bid, int nblk, int tid_) {
    const float* LOGF = wsp<float>(p, OFF_DT); float* FH2 = wsp<float>(p, OFF_DT + 1 * MiB);
    const int lane = tid_ & 63, wid = tid_ >> 6;
    for (int u = bid * 8 + wid; u < NB * 8; u += nblk * 8) {
        const int b = u >> 3, h = u & 7;
        float loc[32]; float run = 0.f;
#pragma unroll
        for (int i = 0; i < 32; ++i) { run += LOGF[((size_t)b * S + lane * 32 + i) * 8 + h]; loc[i] = run; }
        float incl = run;
#pragma unroll
        for (int o = 1; o < 64; o <<= 1) { const float nb = __shfl_up(incl, o); if (lane >= o) incl += nb; }
        const float excl = incl - run;
#pragma unroll
        for (int i = 0; i < 32; ++i) FH2[(size_t)u * S + lane * 32 + i] = (excl + loc[i]) * LOG2E;
    }
}
template <bool BYCOL> __device__ __forceinline__ void fill_scale(const pg8::DenseOrder& S, PG8_LAS float* tab, const float* SSQ, float inv_n, int tid_) {
    for (int idx = tid_; idx < 8 * 256; idx += NTHR) { pg8::Unit u; const int ui = idx >> 8, r = idx & 255;
        if (S.next(ui, u)) tab[idx] = rs4(SSQ, (BYCOL ? u.pn : u.pm) * 256 + r, inv_n); }
    __syncthreads();
}
struct EpiQupMf { bf16_t* QM; const PG8_LAS float* rs; const float* tab;
    __device__ __forceinline__ void operator()(const f32x4 (&acc)[2][2][4][2], const pg8::Unit& u, int ui, int wr, int wc, int fr, int fq) const {
#pragma unroll
        for (int ai = 0; ai < 2; ++ai)
#pragma unroll
            for (int m = 0; m < 4; ++m) { const int r = ai * 128 + wr * 64 + m * 16 + fr; const size_t row = (size_t)u.pm * 256 + r; const float sc = rs[ui * 256 + r] * C2_96; const int sp = (int)(row & (S - 1));
#pragma unroll
                for (int bj = 0; bj < 2; ++bj) { f32x4 vv[2]; const int col8 = u.pn * 256 + bj * 128 + wc * 32 + fq * 8;
#pragma unroll
                    for (int n = 0; n < 2; ++n) { const int col = col8 + 4 * n; f32x4 v = acc[ai][bj][m][n] * sc; const int j = col % 96;
                        if (j >= 64) { const int i0 = (j - 64) >> 1;
                            const float c0 = tab[sp * 16 + i0], s0 = tab[S * 16 + sp * 16 + i0], c1 = tab[sp * 16 + i0 + 1], s1 = tab[S * 16 + sp * 16 + i0 + 1];
                            v = (f32x4){v[0] * c0 - v[1] * s0, v[1] * c0 + v[0] * s0, v[2] * c1 - v[3] * s1, v[3] * c1 + v[2] * s1}; }
                        vv[n] = v; }
                    st_bf16x8(QM + row * 768 + col8, vv[0], vv[1]); }
                asm volatile("" ::: "memory"); } } };
struct EpiKupMf { bf16_t* KN; const PG8_LAS float* rs;
    __device__ __forceinline__ void operator()(const f32x4 (&acc)[2][2][4][2], const pg8::Unit& u, int ui, int wr, int wc, int fr, int fq) const {
#pragma unroll
        for (int ai = 0; ai < 2; ++ai)
#pragma unroll
            for (int m = 0; m < 4; ++m) { const int r = ai * 128 + wr * 64 + m * 16 + fr; const size_t row = (size_t)u.pm * 256 + r; const float sc = rs[ui * 256 + r];
#pragma unroll
                for (int bj = 0; bj < 2; ++bj) st_bf16x8(KN + row * 512 + u.pn * 256 + bj * 128 + wc * 32 + fq * 8, acc[ai][bj][m][0] * sc, acc[ai][bj][m][1] * sc); } } };
struct EpiVupMf { bf16_t* VtM; const PG8_LAS float* cs;
    __device__ __forceinline__ void operator()(const f32x4 (&acc)[2][2][4][2], const pg8::Unit& u, int ui, int wr, int wc, int fr, int fq) const {
        f32x4 sc[2][2];
#pragma unroll
        for (int bj = 0; bj < 2; ++bj)
#pragma unroll
            for (int n = 0; n < 2; ++n) sc[bj][n] = *(const PG8_LAS f32x4*)(cs + ui * 256 + bj * 128 + wc * 32 + fq * 8 + n * 4);
#pragma unroll
        for (int ai = 0; ai < 2; ++ai)
#pragma unroll
            for (int m = 0; m < 4; ++m) { const size_t row = (size_t)u.pm * 256 + ai * 128 + wr * 64 + m * 16 + fr;
#pragma unroll
                for (int bj = 0; bj < 2; ++bj) st_bf16x8(VtM + row * T + u.pn * 256 + bj * 128 + wc * 32 + fq * 8, acc[ai][bj][m][0] * sc[bj][0], acc[ai][bj][m][1] * sc[bj][1]); } } };
__device__ __forceinline__ void ph_knorm(const P& p, int bid, int nblk, int tid_) {
    const bf16_t* Kf = wsp<bf16_t>(p, R_XBZ + 64 * MiB); float* KMAXT = wsp<float>(p, OFF_SSQ + 1 * MiB);
    const int lane = tid_ & 63, wid = tid_ >> 6;
    for (int it = bid * 8 + wid; it < 128 * 32; it += nblk * 8) {
        const int bh = it >> 5, tile = it & 31, b = bh >> 3, h = bh & 7;
        const bf16_t* kr = Kf + ((size_t)b * S + tile * 64 + lane) * 512 + h * 64; float s2 = 0.f;
#pragma unroll
        for (int c = 0; c < 8; ++c) { const u32x4 v = *(const u32x4*)(kr + c * 8);
#pragma unroll
            for (int j = 0; j < 4; ++j) { const float lo = bflo(v[j]), hi_ = bfhi(v[j]); s2 += lo * lo + hi_ * hi_; } }
        float m = sqrtf(s2);
#pragma unroll
        for (int o = 32; o >= 1; o >>= 1) m = fmaxf(m, __shfl_xor(m, o));
        if (lane == 0) KMAXT[it] = m;
    }
}
__device__ __forceinline__ void ph_upproj_mf(const P& p, unsigned char* smem, int bid, int nblk, int tid_) {
    const bf16_t* CQ = wsp<bf16_t>(p, R_XBZ); const bf16_t* CKV = wsp<bf16_t>(p, R_XBZ + 16 * MiB);
    const float* SSQQ = wsp<float>(p, OFF_SSQ); const float* SSQK = wsp<float>(p, OFF_SSQ + 512 * 1024);
    PG8_LAS float* tabl = (PG8_LAS float*)(LDSP(smem) + LDS_TAB_OFF);
    { pg8::Gemm g{CQ, wsp<bf16_t>(p, W1Q), 256, 256, 256, nullptr}; pg8::DenseOrder S; S.init(T, 768, 256, 256, nblk, bid);
      fill_scale<false>(S, tabl, SSQQ, 1.0f / 256.0f, tid_);
      EpiQupMf E{wsp<bf16_t>(p, R_A2), tabl, wsp<float>(p, OFF_TAB)};
      pg8::gemm_phase<EpiQupMf, pg8::DenseOrder, pg8::NoMidK, false, true>(LDSP(smem), g, S, E, pg8::NoMidK{}, tid_); }
    { pg8::Gemm g{CKV, wsp<bf16_t>(p, W1K), 256, 128, 128, nullptr}; pg8::DenseOrder S; S.init(T, 512, 256, 128, nblk, bid);
      fill_scale<false>(S, tabl, SSQK, 1.0f / 128.0f, tid_);
      EpiKupMf E{wsp<bf16_t>(p, R_A2 + 48 * MiB), tabl};
      pg8::gemm_phase<EpiKupMf, pg8::DenseOrder, pg8::NoMidK, false, true>(LDSP(smem), g, S, E, pg8::NoMidK{}, tid_); }
    { pg8::Gemm g{wsp<bf16_t>(p, W1VV), CKV, 128, 256, 128, nullptr}; pg8::DenseOrder S; S.init(512, T, 128, 256, nblk, bid);
      fill_scale<true>(S, tabl, SSQK, 1.0f / 128.0f, tid_);
      EpiVupMf E{wsp<bf16_t>(p, R_A2 + 80 * MiB), tabl};
      pg8::gemm_phase<EpiVupMf, pg8::DenseOrder, pg8::NoMidK, false, true>(LDSP(smem), g, S, E, pg8::NoMidK{}, tid_); }
    { const int half = nblk / 2; if (bid >= half) { ph_fh_cumsum(p, bid - half, nblk - half, tid_); ph_knorm(p, bid - half, nblk - half, tid_); } }
}
__device__ __forceinline__ void ph_outproj1_mf(const P& p, unsigned char* smem, int bid, int nblk, int tid_) {
    EpiMixMf E{wsp<bf16_t>(p, R_XBZ)};
    mf_dense_e<true>(smem, wsp<bf16_t>(p, R_XQ), 1024, wsp<bf16_t>(p, W1O), 1024, T, 1024, 1024, E, bid, nblk, tid_);
}

namespace att {
typedef short bf16x8 __attribute__((ext_vector_type(8)));
typedef float f32x16 __attribute__((ext_vector_type(16)));
struct Args { const bf16_t* Q; int ldq; const bf16_t* K; int ldk; const bf16_t* K2; const bf16_t* Vt; bf16_t* O; int ldo; const float* FH2; const float* KMAXT; };
template <int MODE> struct Cfg { static constexpr int DK = MODE == 2 ? 96 : 64, DKX = DK + (MODE == 1 ? 16 : 0), KROW = DKX * 2 + 16, VROW = 144, K_BYTES = 64 * KROW, V_BYTES = 64 * VROW, TILE = K_BYTES + V_BYTES + 256; };
__device__ __forceinline__ float swap_sum(float x) { auto rr = __builtin_amdgcn_permlane32_swap(__float_as_uint(x), __float_as_uint(x), false, false); return __uint_as_float(rr[0]) + __uint_as_float(rr[1]); }
__device__ __forceinline__ float swap_max(float x) { auto rr = __builtin_amdgcn_permlane32_swap(__float_as_uint(x), __float_as_uint(x), false, false); return fmaxf(__uint_as_float(rr[0]), __uint_as_float(rr[1])); }
__device__ __forceinline__ float swap_other(float x, int hi) { auto rr = __builtin_amdgcn_permlane32_swap(__float_as_uint(x), __float_as_uint(x), false, false); return __uint_as_float(hi ? rr[0] : rr[1]); }

template <int MODE, int HP = 1>
__device__ __forceinline__ void attn_unit(const Args& a, int b, int h0, int qb, unsigned char* smem, int tid_) {
    typedef Cfg<MODE> C;
    constexpr int BUF = HP * C::TILE, QROWS = 256 / HP;
    constexpr int NKS = C::DK / 16, NKX = C::DKX / 16;
    int tid = tid_; asm volatile("" : "+v"(tid));
    const int lane = tid & 63, wid = __builtin_amdgcn_readfirstlane(tid >> 6), r32 = lane & 31, hi = lane >> 5;
    PG8_LAS unsigned char* lds = (PG8_LAS unsigned char*)smem;
    const int hsw = (HP == 2) ? (wid >> 2) : 0, h = h0 + hsw, wq = (HP == 2) ? (wid & 3) : wid;
    const int q0 = qb * QROWS, qw = q0 + wq * 32;
    const size_t rowb = (size_t)b * S;
    const int jmax = q0 / 64 + QROWS / 64 - 1;
    const int hoff = hsw * C::TILE;
    const int jw = (MODE == 2) ? (qw >> 6) : ((qw + 31) >> 6);
    bf16x8 qf[NKX];
    { const bf16_t* qp = a.Q + (rowb + qw + r32) * a.ldq + h * C::DK + hi * 8;
#pragma unroll
      for (int ks = 0; ks < NKS; ++ks) qf[ks] = *(const bf16x8*)(qp + ks * 16);
      if (MODE == 1) { const u32x4 m1 = {hi ? 0u : 0xBF80BF80u, hi ? 0u : 0x0000BF80u, 0u, 0u}; qf[NKX - 1] = __builtin_bit_cast(bf16x8, m1); } }
    const u32x4 ones_u = {0x3F803F80u, 0x3F803F80u, 0x3F803F80u, 0x3F803F80u}; const bf16x8 ones8 = __builtin_bit_cast(bf16x8, ones_u);
    float qn = 0.f;
    if (MODE == 1) {
#pragma unroll
        for (int ks = 0; ks < NKS; ++ks)
#pragma unroll
            for (int e = 0; e < 8; ++e) { const float qv = __uint_as_float(((unsigned)(unsigned short)qf[ks][e]) << 16); qn += qv * qv; }
        qn = sqrtf(swap_sum(qn)) * 1.001f; }
    const int kkey = tid >> 3, kch = tid & 7;
    const bf16_t* kg = a.K + (rowb + kkey) * a.ldk + h0 * 64 + kch * 8;
    const bf16_t* k2g = a.K2 + (rowb + (tid >> 2)) * 256 + 128 + (tid & 3) * 8;
    const bf16_t* vg = a.Vt + (size_t)(h0 * 64 + kkey) * T + rowb + kch * 8;
    const float* fg0 = a.FH2 + (size_t)(b * 8 + h0) * S;
    const float* fg = fg0 + (size_t)hsw * S;
    const int k_l = kkey * C::KROW + kch * 16, k2_l = (tid >> 2) * C::KROW + 128 + (tid & 3) * 16, v_l = C::K_BYTES + kkey * C::VROW + (kch >> 1) * 32 + (kch & 1) * 8, f_l = C::K_BYTES + C::V_BYTES + tid * 4;
    u32x4 sk[HP], sv[HP], sk2; float sf[HP];
#pragma unroll
    for (int hs = 0; hs < HP; ++hs) sf[hs] = 0.f;
#define ATT_LOAD(j) do { _Pragma("unroll") for (int hs_ = 0; hs_ < HP; ++hs_) { sk[hs_] = *(const u32x4*)(kg + (size_t)(j) * 64 * a.ldk + hs_ * 64); sv[hs_] = *(const u32x4*)(vg + (size_t)hs_ * 64 * T + (j) * 64); \
            if (MODE == 1) { if (tid < 64) sf[hs_] = fg0[(size_t)hs_ * S + (j) * 64 + tid]; } } \
        if (MODE == 2) { if (tid < 256) sk2 = *(const u32x4*)(k2g + (size_t)(j) * 64 * 256); } } while (0)
#define ATT_STORE(bufo) do { _Pragma("unroll") for (int hs_ = 0; hs_ < HP; ++hs_) { const int bo_ = (bufo) + hs_ * C::TILE; *(PG8_LAS u32x4*)(lds + bo_ + k_l) = sk[hs_]; \
            *(PG8_LAS u32x2*)(lds + bo_ + v_l) = (u32x2){sv[hs_][0], sv[hs_][1]}; *(PG8_LAS u32x2*)(lds + bo_ + v_l + 16) = (u32x2){sv[hs_][2], sv[hs_][3]}; \
            if (MODE == 1) { if (tid < 64) { const float f_ = sf[hs_]; const unsigned h1_ = pk_bf16(f_, 0.f) & 0xffffu; const float r1_ = f_ - bflo(h1_); const unsigned h2_ = pk_bf16(r1_, 0.f) & 0xffffu; const float r2_ = r1_ - bflo(h2_); const unsigned h3_ = pk_bf16(r2_, 0.f) & 0xffffu; \
                *(PG8_LAS u32x4*)(lds + bo_ + tid * C::KROW + 128) = (u32x4){h1_ | (h2_ << 16), h3_, 0u, 0u}; *(PG8_LAS u32x4*)(lds + bo_ + tid * C::KROW + 144) = (u32x4){0u, 0u, 0u, 0u}; } } } \
        if (MODE == 2) { if (tid < 256) *(PG8_LAS u32x4*)(lds + (bufo) + k2_l) = sk2; } } while (0)
    f32x16 o[2];
#pragma unroll
    for (int i = 0; i < 16; ++i) { o[0][i] = 0.f; o[1][i] = 0.f; }
    float R = 0.f; bool first = true;
    f32x16 lacc;
#pragma unroll
    for (int i = 0; i < 16; ++i) lacc[i] = 0.f;
    float fht = 0.f; if (MODE == 1) fht = fg[qw + r32];
    f32x16 negm;
#pragma unroll
    for (int i = 0; i < 16; ++i) negm[i] = (MODE == 0) ? 0.f : fht;
    const int qi = qw + r32;
    const int nt = jmax + 1;
    PG8_LAS int* dflag = (PG8_LAS int*)(lds + 2 * BUF);
    PG8_LAS float* kpm0 = (PG8_LAS float*)(lds + 2 * BUF + 64);
    PG8_LAS float* kpm = kpm0 + hsw * 64;
    PG8_LAS float* fedge = kpm + 32;
    if (MODE != 2) { if (tid < 8) dflag[tid] = 0; }
    if (MODE == 1) { if (tid < 32 * HP) { const int hs = tid >> 5, ti = tid & 31; float v = a.KMAXT[(b * 8 + h0 + hs) * 32 + ti];
#pragma unroll
            for (int o = 1; o < 32; o <<= 1) { const float u_ = __shfl_up(v, o, 32); if (ti >= o) v = fmaxf(v, u_); }
            kpm0[hs * 64 + ti] = v; kpm0[hs * 64 + 32 + ti] = fg0[(size_t)hs * S + 64 * (ti + 1) - 1]; } }
    { const int j0 = (MODE != 2) ? jmax : 0; ATT_LOAD(j0); ATT_STORE(0); }
    __syncthreads();
    for (int it = 0; it < nt; ++it) {
        const int j = (MODE != 2) ? (jmax - it) : it;
        const int bufo = (it & 1) * BUF, nbufo = ((it + 1) & 1) * BUF;
        const bool more = (it + 1 < nt);
        if (more) { const int jn = (MODE != 2) ? (j - 1) : (j + 1); ATT_LOAD(jn); }
        if (j <= jw) {
            f32x16 p0 = negm, p1 = negm;
            { const PG8_LAS unsigned char* kb = lds + bufo + hoff + r32 * C::KROW + hi * 16;
              __builtin_amdgcn_s_setprio(1);
#pragma unroll
              for (int ks = 0; ks < NKX; ++ks) {
                  const bf16x8 a0 = *(const PG8_LAS bf16x8*)(kb + ks * 32), a1 = *(const PG8_LAS bf16x8*)(kb + 32 * C::KROW + ks * 32);
                  p0 = __builtin_amdgcn_mfma_f32_32x32x16_bf16(a0, qf[ks], p0, 0, 0, 0);
                  p1 = __builtin_amdgcn_mfma_f32_32x32x16_bf16(a1, qf[ks], p1, 0, 0, 0); }
              __builtin_amdgcn_s_setprio(0); }
            const int kbase = j * 64 + 4 * hi;
            if (MODE != 0) {
                if (MODE == 1 && j == jw) {
#pragma unroll
                    for (int i = 0; i < 16; ++i) { const int kp = kbase + 8 * (i >> 2) + (i & 3); if (kp > qi) p0[i] = -INFINITY; if (kp + 32 > qi) p1[i] = -INFINITY; }
                }
                float mx = __builtin_fmaxf(__builtin_fmaxf(p0[0], p0[1]), p1[0]), mx2 = __builtin_fmaxf(__builtin_fmaxf(p0[2], p0[3]), p1[1]);
                mx = __builtin_fmaxf(__builtin_fmaxf(mx, p1[2]), p1[3]);
#pragma unroll
                for (int i = 4; i < 16; i += 4) { mx = __builtin_fmaxf(__builtin_fmaxf(mx, p0[i]), p0[i + 1]); mx2 = __builtin_fmaxf(__builtin_fmaxf(mx2, p0[i + 2]), p0[i + 3]);
                    mx = __builtin_fmaxf(__builtin_fmaxf(mx, p1[i]), p1[i + 1]); mx2 = __builtin_fmaxf(__builtin_fmaxf(mx2, p1[i + 2]), p1[i + 3]); }
                mx = swap_max(__builtin_fmaxf(mx, mx2));
                if (first || __any(mx > 8.0f)) {
                    const float dl = first ? mx : __builtin_fmaxf(mx, 0.f);
                    const float alpha = first ? 0.f : __builtin_amdgcn_exp2f(-dl);
#pragma unroll
                    for (int i = 0; i < 16; ++i) { p0[i] -= dl; p1[i] -= dl; negm[i] -= dl; o[0][i] *= alpha; o[1][i] *= alpha; lacc[i] *= alpha; }
                    first = false;
                }
#pragma unroll
                for (int i = 0; i < 16; ++i) { p0[i] = __builtin_amdgcn_exp2f(p0[i]); p1[i] = __builtin_amdgcn_exp2f(p1[i]); }
            } else {
                const bool diag = (j == jw);
#pragma unroll
                for (int blk = 1; blk >= 0; --blk) {
                    f32x16& pz = blk ? p1 : p0;
                    float L[16];
#pragma unroll
                    for (int i = 0; i < 16; ++i) { const float z = pz[i]; float l = fmaxf(z, 0.f) + __builtin_amdgcn_logf(1.f + __builtin_amdgcn_exp2f(-fabsf(z)));
                        if (diag) { const int kp = kbase + 32 * blk + 8 * (i >> 2) + (i & 3); if (kp >= qi) l = 0.f; }
                        L[i] = l; }
                    float tail = R;
#pragma unroll
                    for (int g = 3; g >= 0; --g) {
                        const float s3 = L[4 * g + 3], s2 = s3 + L[4 * g + 2], s1 = s2 + L[4 * g + 1], s0 = s1 + L[4 * g];
                        const float gp = swap_other(s0, hi);
                        const float base = tail + (hi ? 0.f : gp);
                        tail += s0 + gp;
                        const float c0 = base + s0, c1 = base + s1, c2 = base + s2, c3 = base + s3;
                        pz[4 * g] = __builtin_amdgcn_exp2f(pz[4 * g] - c0); pz[4 * g + 1] = __builtin_amdgcn_exp2f(pz[4 * g + 1] - c1);
                        pz[4 * g + 2] = __builtin_amdgcn_exp2f(pz[4 * g + 2] - c2); pz[4 * g + 3] = __builtin_amdgcn_exp2f(pz[4 * g + 3] - c3);
                    }
                    R = tail;
                    if (diag) {
#pragma unroll
                        for (int i = 0; i < 16; ++i) { const int kp = kbase + 32 * blk + 8 * (i >> 2) + (i & 3); if (kp >= qi) pz[i] = 0.f; }
                    }
                }
            }
            bf16x8 pf[4];
#pragma unroll
            for (int s = 0; s < 4; ++s) { const f32x16& pp = (s < 2) ? p0 : p1; const int o8 = (s & 1) * 8; u32x4 w;
                w[0] = pk_bf16(pp[o8], pp[o8 + 1]); w[1] = pk_bf16(pp[o8 + 2], pp[o8 + 3]); w[2] = pk_bf16(pp[o8 + 4], pp[o8 + 5]); w[3] = pk_bf16(pp[o8 + 6], pp[o8 + 7]);
                pf[s] = __builtin_bit_cast(bf16x8, w); }
            __builtin_amdgcn_s_setprio(1);
            if (MODE != 0) {
#pragma unroll
                for (int s = 0; s < 4; ++s) lacc = __builtin_amdgcn_mfma_f32_32x32x16_bf16(ones8, pf[s], lacc, 0, 0, 0); }
            { const PG8_LAS unsigned char* vb = lds + bufo + hoff + C::K_BYTES + r32 * C::VROW + hi * 16;
#pragma unroll
              for (int db = 0; db < 2; ++db)
#pragma unroll
                  for (int s = 0; s < 4; ++s) o[db] = __builtin_amdgcn_mfma_f32_32x32x16_bf16(*(const PG8_LAS bf16x8*)(vb + db * 32 * C::VROW + s * 32), pf[s], o[db], 0, 0, 0); }
            __builtin_amdgcn_s_setprio(0);
        }
        if (more) ATT_STORE(nbufo);
        if (MODE == 0) {
            if (j <= jw) { const bool dn = __all(R >= 150.f) != 0; if (lane == 0) dflag[wid] = dn ? 1 : 0; }
        }
        if (MODE == 1) {
            if (j <= jw) { bool dn = true; if (j > 0) { const float bnd = qn * kpm[j - 1] + negm[0] - fedge[j - 1]; dn = __all(bnd < -150.f) != 0; } if (lane == 0) dflag[wid] = dn ? 1 : 0; }
        }
        LDS_BARRIER();
        if (MODE != 2) { const u32x4 f0 = *(const PG8_LAS u32x4*)dflag, f1 = *(const PG8_LAS u32x4*)(dflag + 4);
            if ((f0[0] & f0[1] & f0[2] & f0[3] & f1[0] & f1[1] & f1[2] & f1[3]) != 0u) break; }
    }
    if (MODE != 2) __syncthreads();
    float inv = 1.f;
    if (MODE != 0) inv = 1.0f / lacc[0];
    { bf16_t* op = a.O + (rowb + qw + r32) * a.ldo + h * 64 + 4 * hi;
#pragma unroll
      for (int db = 0; db < 2; ++db)
#pragma unroll
          for (int g = 0; g < 4; ++g) st_bf16x4(op + db * 32 + g * 8, (f32x4){o[db][4 * g] * inv, o[db][4 * g + 1] * inv, o[db][4 * g + 2] * inv, o[db][4 * g + 3] * inv}); }
#undef ATT_LOAD
#undef ATT_STORE
}
}

constexpr size_t O_XT = R_XQ, O_BN = R_XQ + 64 * MiB, O_CN = R_XQ + 80 * MiB, O_BT = R_A2 + 96 * MiB;
__device__ __forceinline__ void ph_conv2(const P& p, unsigned char* smem, int bid, int nblk, int tid_) {
    int tid = tid_; asm volatile("" : "+v"(tid));
    const bf16_t* XR = wsp<bf16_t>(p, R_A2);
    bf16_t* tile = (bf16_t*)smem;
    const int l = tid >> 3, cg = tid & 7;
    constexpr int NH = 4;
    for (int it = bid; it < 24 * 16 * (32 / NH); it += nblk) {
        const int cb = it / (16 * (32 / NH)), bc = it % (16 * (32 / NH)), b = bc / (32 / NH), c0 = (bc % (32 / NH)) * NH;
        const int ch0 = cb * 64 + cg * 8;
        u32x4 tap[NH][4];
#pragma unroll
        for (int hf = 0; hf < NH; ++hf) { const int s = (c0 + hf) * 64 + l; const size_t t = (size_t)b * S + s;
#pragma unroll
            for (int k = 0; k < 4; ++k) { tap[hf][k] = (u32x4){0u, 0u, 0u, 0u}; if (s - 3 + k >= 0) tap[hf][k] = *(const u32x4*)(XR + (t - 3 + k) * 1536 + ch0); } }
        f32x4 wv[4][2]; f32x4 bv[2];
        bv[0] = *(const f32x4*)(p.ev_conv_b + ch0); bv[1] = *(const f32x4*)(p.ev_conv_b + ch0 + 4);
#pragma unroll
        for (int k = 0; k < 4; ++k) { wv[k][0] = *(const f32x4*)(p.ev_conv_w + k * 1536 + ch0); wv[k][1] = *(const f32x4*)(p.ev_conv_w + k * 1536 + ch0 + 4); }
        u32x4 ov[NH];
#pragma unroll
        for (int hf = 0; hf < NH; ++hf) {
            f32x2 acc2[4] = {{bv[0][0], bv[0][1]}, {bv[0][2], bv[0][3]}, {bv[1][0], bv[1][1]}, {bv[1][2], bv[1][3]}};
#pragma unroll
            for (int k = 0; k < 4; ++k) { const u32x4 v = tap[hf][k];
#pragma unroll
                for (int j = 0; j < 4; ++j) acc2[j] = __builtin_elementwise_fma((f32x2){wv[k][j >> 1][(j & 1) * 2], wv[k][j >> 1][(j & 1) * 2 + 1]}, (f32x2){bflo(v[j]), bfhi(v[j])}, acc2[j]); }
#pragma unroll
            for (int j = 0; j < 4; ++j) ov[hf][j] = pk_bf16(silu_f(acc2[j][0]), silu_f(acc2[j][1]));
        }
        if (cb >= 16) { bf16_t* nat = wsp<bf16_t>(p, O_BN + (cb >= 20 ? 16 * MiB : 0));
#pragma unroll
            for (int hf = 0; hf < NH; ++hf) *(u32x4*)(nat + ((size_t)b * S + (c0 + hf) * 64 + l) * 256 + ((cb - 16) & 3) * 64 + cg * 8) = ov[hf]; }
        if (cb < 20) {
#pragma unroll
            for (int hf = 0; hf < NH; ++hf) *(u32x4*)(tile + hf * 64 * 72 + l * 72 + cg * 8) = ov[hf];
            LDS_BARRIER();
            const int r = tid >> 3, lg = tid & 7;
#pragma unroll
            for (int hf = 0; hf < NH; ++hf) { u32x4 tv; const int c = c0 + hf;
#pragma unroll
                for (int j = 0; j < 4; ++j) tv[j] = (unsigned)tile[hf * 64 * 72 + (lg * 8 + 2 * j) * 72 + r] | ((unsigned)tile[hf * 64 * 72 + (lg * 8 + 2 * j + 1) * 72 + r] << 16);
                bf16_t* dst;
                if (cb < 16) dst = wsp<bf16_t>(p, O_XT) + ((((size_t)(b * 16 + cb)) * 32 + c) * 64 + r) * 64 + lg * 8;
                else { const int g = (cb - 16) >> 1, n = ((cb - 16) & 1) * 64 + r; dst = wsp<bf16_t>(p, O_BT) + ((((size_t)(b * 2 + g)) * 32 + c) * 128 + n) * 64 + lg * 8; }
                *(u32x4*)dst = tv; }
            LDS_BARRIER();
        }
    }
}
namespace ssd {
typedef short bf16x8 __attribute__((ext_vector_type(8)));
typedef float f32x16 __attribute__((ext_vector_type(16)));
constexpr int RC = 272, RS = 144;
constexpr int O_CM = 0, O_BM = O_CM + 64 * RC, O_BMT = O_BM + 64 * RC, O_XST = O_BMT + 128 * RS, O_XDT = O_XST + 2 * 64 * RS, O_M = O_XDT + 64 * RS, O_HB = O_M + 64 * RS, O_TAB = O_HB + 64 * RC, LDS_END = O_TAB + 2 * 1024;
static_assert(LDS_END <= 128 * 1024, "ssd lds");
#define SSD_FRAG(off) (*(const PG8_LAS bf16x8*)(lds + (off)))
__device__ __forceinline__ void ssd_unit(const P& p, int b, int h, unsigned char* smem, int tid_) {
    int tid = tid_; asm volatile("" : "+v"(tid));
    const int lane = tid & 63, wid = __builtin_amdgcn_readfirstlane(tid >> 6), r32 = lane & 31, hi = lane >> 5;
    PG8_LAS unsigned char* lds = (PG8_LAS unsigned char*)smem;
    const int g = h >> 3;
    const float a = -expf(p.ev_a_log[h]), dsk = p.ev_d_skip[h];
    const bf16_t* XTu = wsp<bf16_t>(p, O_XT) + ((size_t)(b * 16 + h) * 32) * 4096 + tid * 8;
    const bf16_t* BTu = wsp<bf16_t>(p, O_BT) + ((size_t)(b * 2 + g) * 32) * 8192 + tid * 8;
    const bf16_t* BNu = wsp<bf16_t>(p, O_BN) + ((size_t)b * S + (tid >> 4)) * 256 + g * 128 + (tid & 15) * 8;
    const bf16_t* CNu = wsp<bf16_t>(p, O_CN) + ((size_t)b * S + (tid >> 4)) * 256 + g * 128 + (tid & 15) * 8;
    const float* DTu = wsp<float>(p, OFF_DT) + ((size_t)b * S + lane) * 16 + h;
    const bf16_t* Zu = wsp<bf16_t>(p, R_XBZ + 64 * MiB) + ((size_t)b * S) * 1024 + h * 64;
    bf16_t* A2u = wsp<bf16_t>(p, R_A2) + ((size_t)b * S) * 1536 + h * 64;
    float* SSQu = wsp<float>(p, OFF_SSQ) + ((size_t)b * S) * 32 + h * 2;
    u32x4 rxA, rbA[2], rbtA[2], rcA[2], rxB, rbB[2], rbtB[2], rcB[2]; float rdtA = 0.f, rdtB = 0.f;
#define SSD_LOAD(c, P) do { rx##P = *(const u32x4*)(XTu + (size_t)(c) * 4096); \
        rbt##P[0] = *(const u32x4*)(BTu + (size_t)(c) * 8192); rbt##P[1] = *(const u32x4*)(BTu + (size_t)(c) * 8192 + 4096); \
        rb##P[0] = *(const u32x4*)(BNu + (size_t)(c) * 64 * 256); rb##P[1] = *(const u32x4*)(BNu + ((size_t)(c) * 64 + 32) * 256); \
        rc##P[0] = *(const u32x4*)(CNu + (size_t)(c) * 64 * 256); rc##P[1] = *(const u32x4*)(CNu + ((size_t)(c) * 64 + 32) * 256); \
        if (wid == 2) rdt##P = DTu[(size_t)(c) * 64 * 16]; } while (0)
#define SSD_TABLES(par, P) do { PG8_LAS float* tb_ = (PG8_LAS float*)(lds + O_TAB + (par) * 1024); float x_ = rdt##P * a; \
        _Pragma("unroll") for (int o_ = 1; o_ < 64; o_ <<= 1) { const float y_ = __shfl_up(x_, o_); if (lane >= o_) x_ += y_; } \
        const float a63_ = __shfl(x_, 63); tb_[lane] = x_; tb_[64 + lane] = rdt##P; tb_[128 + lane] = rdt##P * __expf(a63_ - x_); tb_[192 + lane] = __expf(x_); } while (0)
#define SSD_FILL(c, P) do { const int par_ = (c) & 1; const PG8_LAS float* tw = (const PG8_LAS float*)(lds + O_TAB + par_ * 1024 + 512) + (tid & 7) * 8; \
        *(PG8_LAS u32x4*)(lds + O_XST + par_ * 64 * RS + (tid >> 3) * RS + (tid & 7) * 16) = rx##P; \
        { const f32x4 w0_ = *(const PG8_LAS f32x4*)tw, w1_ = *(const PG8_LAS f32x4*)(tw + 4); u32x4 xd_; \
          xd_[0] = pk_bf16(bflo(rx##P[0]) * w0_[0], bfhi(rx##P[0]) * w0_[1]); xd_[1] = pk_bf16(bflo(rx##P[1]) * w0_[2], bfhi(rx##P[1]) * w0_[3]); \
          xd_[2] = pk_bf16(bflo(rx##P[2]) * w1_[0], bfhi(rx##P[2]) * w1_[1]); xd_[3] = pk_bf16(bflo(rx##P[3]) * w1_[2], bfhi(rx##P[3]) * w1_[3]); \
          *(PG8_LAS u32x4*)(lds + O_XDT + (tid >> 3) * RS + (tid & 7) * 16) = xd_; } \
        *(PG8_LAS u32x4*)(lds + O_BMT + (tid >> 3) * RS + (tid & 7) * 16) = rbt##P[0]; *(PG8_LAS u32x4*)(lds + O_BMT + (64 + (tid >> 3)) * RS + (tid & 7) * 16) = rbt##P[1]; \
        *(PG8_LAS u32x4*)(lds + O_BM + (tid >> 4) * RC + (tid & 15) * 16) = rb##P[0]; *(PG8_LAS u32x4*)(lds + O_BM + (32 + (tid >> 4)) * RC + (tid & 15) * 16) = rb##P[1]; \
        *(PG8_LAS u32x4*)(lds + O_CM + (tid >> 4) * RC + (tid & 15) * 16) = rc##P[0]; *(PG8_LAS u32x4*)(lds + O_CM + (32 + (tid >> 4)) * RC + (tid & 15) * 16) = rc##P[1]; } while (0)
    for (int i = tid; i < 64 * RC / 16; i += NTHR) *(PG8_LAS u32x4*)(lds + O_HB + i * 16) = (u32x4){0u, 0u, 0u, 0u};
    f32x16 acch, accy;
#pragma unroll
    for (int i = 0; i < 16; ++i) { acch[i] = 0.f; accy[i] = 0.f; }
    const int nb = wid >> 1, pbh = wid & 1;
    const int w4 = wid & 3, t_a = w4 >> 1, t_b = w4 & 1;
#define SSD_BODY(c, P, Q) do { \
        const int par = (c) & 1; \
        if ((c) + 2 < 32) SSD_LOAD((c) + 2, P); \
        u32x2 zz[4] = {}; \
        if (wid >= 4) { \
_Pragma("unroll") \
            for (int g_ = 0; g_ < 4; ++g_) zz[g_] = *(const u32x2*)(Zu + ((size_t)(c) * 64 + 32 * t_b + r32) * 1024 + 32 * t_a + 8 * g_ + 4 * hi); } \
        LDS_BARRIER(); \
        const PG8_LAS float* tb = (const PG8_LAS float*)(lds + O_TAB + par * 1024); \
        { const float d63 = tb[192 + 63]; \
_Pragma("unroll") \
          for (int i = 0; i < 16; ++i) acch[i] *= d63; } \
        if (wid < 4) { \
            f32x16 cbt; \
_Pragma("unroll") \
            for (int i = 0; i < 16; ++i) cbt[i] = 0.f; \
            if (t_a <= t_b) { \
_Pragma("unroll") \
                for (int ks = 0; ks < 8; ++ks) { cbt = __builtin_amdgcn_mfma_f32_32x32x16_bf16(SSD_FRAG(O_BM + (32 * t_a + r32) * RC + ks * 32 + hi * 16), SSD_FRAG(O_CM + (32 * t_b + r32) * RC + ks * 32 + hi * 16), cbt, 0, 0, 0); \
                    if (ks < 4) { acch = __builtin_amdgcn_mfma_f32_32x32x16_bf16(SSD_FRAG(O_BMT + (32 * nb + r32) * RS + ks * 32 + hi * 16), SSD_FRAG(O_XDT + (32 * pbh + r32) * RS + ks * 32 + hi * 16), acch, 0, 0, 0); } } \
            } else { \
_Pragma("unroll") \
                for (int ks = 0; ks < 4; ++ks) { acch = __builtin_amdgcn_mfma_f32_32x32x16_bf16(SSD_FRAG(O_BMT + (32 * nb + r32) * RS + ks * 32 + hi * 16), SSD_FRAG(O_XDT + (32 * pbh + r32) * RS + ks * 32 + hi * 16), acch, 0, 0, 0); } \
            } \
            const int l = 32 * t_b + r32; const float Al = tb[l]; \
_Pragma("unroll") \
            for (int g_ = 0; g_ < 4; ++g_) { const int s0 = 32 * t_a + 8 * g_ + 4 * hi; \
                const f32x4 As = *(const PG8_LAS f32x4*)(tb + s0), ds = *(const PG8_LAS f32x4*)(tb + 64 + s0); \
                float m[4]; \
_Pragma("unroll") \
                for (int j = 0; j < 4; ++j) m[j] = (s0 + j <= l) ? cbt[4 * g_ + j] * __expf(Al - As[j]) * ds[j] : 0.f; \
                *(PG8_LAS u32x2*)(lds + O_M + l * RS + s0 * 2) = (u32x2){pk_bf16(m[0], m[1]), pk_bf16(m[2], m[3])}; } \
            if (wid == 2 && (c) + 1 < 32) SSD_TABLES(((c) + 1) & 1, Q); \
        } else { \
_Pragma("unroll") \
            for (int i = 0; i < 16; ++i) accy[i] = 0.f; \
_Pragma("unroll") \
            for (int ks = 0; ks < 8; ++ks) { accy = __builtin_amdgcn_mfma_f32_32x32x16_bf16(SSD_FRAG(O_HB + (32 * t_a + r32) * RC + ks * 32 + hi * 16), SSD_FRAG(O_CM + (32 * t_b + r32) * RC + ks * 32 + hi * 16), accy, 0, 0, 0); \
                if (ks < 4) { acch = __builtin_amdgcn_mfma_f32_32x32x16_bf16(SSD_FRAG(O_BMT + (32 * nb + r32) * RS + ks * 32 + hi * 16), SSD_FRAG(O_XDT + (32 * pbh + r32) * RS + ks * 32 + hi * 16), acch, 0, 0, 0); } } \
            const float eAl = tb[192 + 32 * t_b + r32]; \
_Pragma("unroll") \
            for (int i = 0; i < 16; ++i) accy[i] *= eAl; \
        } \
        LDS_BARRIER(); \
_Pragma("unroll") \
        for (int g_ = 0; g_ < 4; ++g_) *(PG8_LAS u32x2*)(lds + O_HB + (32 * pbh + r32) * RC + (32 * nb + 8 * g_ + 4 * hi) * 2) = (u32x2){pk_bf16(acch[4 * g_], acch[4 * g_ + 1]), pk_bf16(acch[4 * g_ + 2], acch[4 * g_ + 3])}; \
        if (wid >= 4) { \
            const int l = 32 * t_b + r32; const size_t trow = (size_t)(c) * 64 + l; \
_Pragma("unroll") \
            for (int ks = 0; ks < 4; ++ks) accy = __builtin_amdgcn_mfma_f32_32x32x16_bf16(SSD_FRAG(O_XST + par * 64 * RS + (32 * t_a + r32) * RS + ks * 32 + hi * 16), SSD_FRAG(O_M + (32 * t_b + r32) * RS + ks * 32 + hi * 16), accy, 0, 0, 0); \
            float ss = 0.f; \
_Pragma("unroll") \
            for (int g_ = 0; g_ < 4; ++g_) { const int p0 = 32 * t_a + 8 * g_ + 4 * hi; float u[4]; \
                const float z4[4] = {bflo(zz[g_][0]), bfhi(zz[g_][0]), bflo(zz[g_][1]), bfhi(zz[g_][1])}; \
_Pragma("unroll") \
                for (int j = 0; j < 4; ++j) { const float xs = bf2f(*(const PG8_LAS bf16_t*)(lds + O_XST + par * 64 * RS + (p0 + j) * RS + l * 2)); \
                    u[j] = (accy[4 * g_ + j] + dsk * xs) * silu_f(z4[j]); ss += u[j] * u[j]; } \
                st_bf16x4(A2u + trow * 1536 + p0, (f32x4){u[0], u[1], u[2], u[3]}); } \
            ss = att::swap_sum(ss); \
            if (hi == 0) SSQu[trow * 32 + t_a] = ss; \
        } \
        if ((c) + 1 < 32) SSD_FILL((c) + 1, Q); \
    } while (0)
    SSD_LOAD(0, A); SSD_LOAD(1, B);
    if (wid == 2) SSD_TABLES(0, A);
    __syncthreads();
    SSD_FILL(0, A);
    for (int c2 = 0; c2 < 32; c2 += 2) { SSD_BODY(c2, A, B); SSD_BODY(c2 + 1, B, A); }
    __syncthreads();
#undef SSD_LOAD
#undef SSD_BODY
#undef SSD_TABLES
#undef SSD_FILL
}
#undef SSD_FRAG
}
__device__ __forceinline__ void ph_ssd_mf(const P& p, unsigned char* smem, int bid, int nblk, int tid_) {
    for (int u = bid; u < NB * 16; u += nblk) ssd::ssd_unit(p, u >> 4, u & 15, smem, tid_);
}

__device__ __forceinline__ void hp_unit(int bid, int nblk, int i, int& b, int& h0, int& blk) {
    int pairidx;
    if (nblk == 256) { pairidx = (bid >> 4) + 16 * i; blk = ((bid & 15) + 4 * i) & 15; } else { const int u = bid + nblk * i; pairidx = u >> 4; blk = u & 15; }
    b = pairidx >> 2; h0 = (pairidx & 3) * 2;
}
__device__ __forceinline__ void ph_sb_mf(const P& p, unsigned char* smem, int bid, int nblk, int tid_) {
    att::Args a{wsp<bf16_t>(p, R_XQ + 96 * MiB), 512, wsp<bf16_t>(p, R_XQ + 128 * MiB), 512, nullptr, wsp<bf16_t>(p, R_XQ + 160 * MiB), wsp<bf16_t>(p, R_A2) + 1024, 1536, nullptr, nullptr};
    for (int i = 0; bid + nblk * i < 1024; ++i) { int b, h0, blk; hp_unit(bid, nblk, i, b, h0, blk); att::attn_unit<0, 2>(a, b, h0, blk, smem, tid_); }
}
__device__ __forceinline__ void ph_attn1_mf(const P& p, unsigned char* smem, int bid, int nblk, int tid_) {
    att::Args am{wsp<bf16_t>(p, R_A2), 768, wsp<bf16_t>(p, R_A2 + 48 * MiB), 512, wsp<bf16_t>(p, R_XBZ + 16 * MiB), wsp<bf16_t>(p, R_A2 + 80 * MiB), wsp<bf16_t>(p, R_XQ), 1024, nullptr, nullptr};
    att::Args af{wsp<bf16_t>(p, R_XBZ + 32 * MiB), 512, wsp<bf16_t>(p, R_XBZ + 64 * MiB), 512, nullptr, wsp<bf16_t>(p, R_XBZ + 96 * MiB), wsp<bf16_t>(p, R_XQ) + 512, 1024, wsp<float>(p, OFF_DT + 1 * MiB), wsp<float>(p, OFF_SSQ + 1 * MiB)};
    for (int pi = bid; pi < 512; pi += nblk) { const int bh = pi >> 2, pr = pi & 3;
        att::attn_unit<2>(am, bh >> 3, bh & 7, 7 - pr, smem, tid_); att::attn_unit<2>(am, bh >> 3, bh & 7, pr, smem, tid_); }
    for (int i = 0; bid + nblk * i < 1024; ++i) { int b, h0, blk; hp_unit(bid, nblk, i, b, h0, blk); att::attn_unit<1, 2>(af, b, h0, blk, smem, tid_); }
}
template <int N, int OFF, int NTOT> __device__ __forceinline__ void tred_rec(float (&v)[NTOT], int lane) {
    if constexpr (N > 1) {
        const bool up = (lane & OFF) != 0;
#pragma unroll
        for (int i = 0; i < N / 2; ++i) { const float keep = up ? v[i + N / 2] : v[i], send = up ? v[i] : v[i + N / 2];
            float got;
            if constexpr (OFF == 32) got = other32(send, up); else if constexpr (OFF == 16) got = other16(send, up); else if constexpr (OFF == 8) got = dpp_f<0x128>(send); else got = __shfl_xor(send, OFF);
            v[i] = keep + got; }
        tred_rec<N / 2, OFF / 2, NTOT>(v, lane);
    }
}
template <int N> __device__ __forceinline__ float tred(float (&v)[N], int lane) {
    tred_rec<N, 32, N>(v, lane);
    return group_sum<64 / N>(v[0]);
}
template <int N> __device__ __forceinline__ int tred_idx(int lane) { return lane / (64 / N); }
__device__ __forceinline__ int kpos(int k) { return (k & 1) * 512 + (k >> 1); }

struct TBuf { float v[4][8]; float g[8]; bf16_t* d; int ro[4]; int zm, gf; };
__device__ __forceinline__ void tconv_finish(const TBuf& pd, float* tile, int tid) {
    const int cq = tid & 63, rk = tid >> 6;
    const int wr_ = tid >> 3, wk = (tid & 7) * 8;
#pragma unroll
    for (int c = 0; c < 4; ++c)
#pragma unroll
        for (int i = 0; i < 8; ++i) { const float gv = pd.gf ? pd.g[i] : 1.f; tile[(rk + 8 * i) * 257 + cq + 64 * c] = ((pd.zm >> c) & 1) ? 0.f : pd.v[c][i] * gv; }
    LDS_BARRIER();
#pragma unroll
    for (int c = 0; c < 4; ++c) { u32x4 w;
#pragma unroll
      for (int j = 0; j < 4; ++j) w[j] = pk_bf16(tile[(wk + 2 * j) * 257 + wr_ + 64 * c], tile[(wk + 2 * j + 1) * 257 + wr_ + 64 * c]);
      *(u32x4*)(pd.d + pd.ro[c]) = w; }
    LDS_BARRIER();
}
template <bool GAIN, class Map> __device__ __forceinline__ void tconv(bf16_t* dst, const float* src, int src_ld, int K, const Map& map, const float* gain, int gain_n,
                                                          int nbatch, size_t dst_bstride, size_t src_bstride, float* tile, int bid, int nblk, int tid, int& toff, TBuf& A, TBuf& B, int& pp) {
    const int nkt = K / 64, nqt = map.nq / 256, per = nkt * nqt, total = per * nbatch;
    const int first = (bid - toff % nblk + nblk) % nblk;
    toff += total;
    const int cq = tid & 63, rk = tid >> 6;
    const int wr_ = tid >> 3, wk = (tid & 7) * 8;
#define TCONV_LOAD(X) do { \
        X.zm = 0; \
        _Pragma("unroll") for (int c = 0; c < 4; ++c) { const int sc = map.scol(q0 + cq + 64 * c); const int scc = sc < 0 ? 0 : sc; X.zm |= (sc < 0 ? 1 : 0) << c; \
            _Pragma("unroll") for (int i = 0; i < 8; ++i) X.v[c][i] = s[(size_t)(k0 + rk + 8 * i) * src_ld + scc]; } \
        if constexpr (GAIN) { X.gf = k0 < gain_n;             \
            _Pragma("unroll") for (int i = 0; i < 8; ++i) { const int k = k0 + rk + 8 * i; X.g[i] = gain[k < gain_n ? k : 0]; } } \
        else { X.gf = 0; _Pragma("unroll") for (int i = 0; i < 8; ++i) X.g[i] = 1.f; } \
        _Pragma("unroll") for (int c = 0; c < 4; ++c) X.ro[c] = map.drow(q0 + wr_ + 64 * c) * K + k0 + wk; \
        X.d = dst + (size_t)bt * dst_bstride; } while (0)
    for (int tI = first; tI < total; tI += nblk) {
        const int bt = tI / per, rem = tI % per, kt = rem / nqt, qt = rem % nqt, k0 = kt * 64, q0 = qt * 256;
        const float* s = src + (size_t)bt * src_bstride;
        if (pp == 1) { TCONV_LOAD(B); tconv_finish(A, tile, tid); pp = 2; }
        else { TCONV_LOAD(A); if (pp == 2) tconv_finish(B, tile, tid); pp = 1; }
    }
#undef TCONV_LOAD
}
struct MapIn0 { static constexpr int nq = 3584; __device__ __forceinline__ int drow(int q) const { return q; } __device__ __forceinline__ int scol(int q) const { return q < 2560 ? q : (q < 3072 ? 2576 + (q - 2560) : 3088 + (q - 3072)); } };
struct MapOff { int nq, off; __device__ __forceinline__ int drow(int q) const { return q; } __device__ __forceinline__ int scol(int q) const { return off + q; } };
struct MapIn1 { static constexpr int nq = 1536; __device__ __forceinline__ int drow(int q) const { return q; }
    __device__ __forceinline__ int scol(int q) const { if (q < 384) return q; if (q < 416) { const int j = q - 384, i = j >> 1; return 384 + ((j & 1) ? i + 16 : i); } if (q < 512) return -1; if (q < 1024) return 416 + (q - 512); return 928 + (q - 1024); } };
struct MapQup { static constexpr int nq = 768; __device__ __forceinline__ int drow(int q) const { return q; }
    __device__ __forceinline__ int scol(int q) const { const int h = q / 96, j = q % 96; if (j < 64) return q; const int jj = j - 64, i = jj >> 1; return 96 * h + 64 + ((jj & 1) ? i + 16 : i); } };
struct MapKV { static constexpr int nq = 512; int off; __device__ __forceinline__ int drow(int q) const { return q; } __device__ __forceinline__ int scol(int q) const { return 128 * (q >> 6) + off + (q & 63); } };
struct MapGU { static constexpr int nq = 256; int up; __device__ __forceinline__ int drow(int q) const { return 256 * (q >> 7) + 128 * up + (q & 127); } __device__ __forceinline__ int scol(int q) const { return q; } };

__device__ __forceinline__ void ph_prologue2(const P& p, unsigned char* smem, int bid, int nblk, int tid_) {
    int tid = tid_; asm volatile("" : "+v"(tid));
    const int lane = tid & 63, wid = tid >> 6;
    float* wl = (float*)smem;
    { f32x4 w4[8];
#pragma unroll
      for (int j = 0; j < 8; ++j) { const int q = tid + NTHR * j; w4[j] = *(const f32x4*)(p.ev_w_in + (size_t)(q >> 2) * EVEN_IN + 2560 + 4 * (q & 3)); }
#pragma unroll
      for (int j = 0; j < 8; ++j) { const int q = tid + NTHR * j; *(f32x4*)(wl + kpos(q >> 2) * 20 + 4 * (q & 3)) = w4[j]; } }
    __syncthreads();
    { float* DT = wsp<float>(p, OFF_DT); unsigned* XB = wsp<unsigned>(p, R_XBZ);
      const int hsel = tred_idx<16>(lane); const float dtb = p.ev_dt_bias[hsel];
      f32x2 xnx[8];
      { const int t0 = bid * 8 + wid; if (t0 < T) {
#pragma unroll
          for (int i = 0; i < 8; ++i) xnx[i] = ((const f32x2*)(p.x + (size_t)t0 * D))[lane + 64 * i]; } }
      for (int t = bid * 8 + wid; t < T; t += nblk * 8) {
          asm volatile("" ::: "memory");
          f32x2 xv[8];
#pragma unroll
          for (int i = 0; i < 8; ++i) xv[i] = xnx[i];
          { const int tn = t + nblk * 8; if (tn < T) {
#pragma unroll
              for (int i = 0; i < 8; ++i) xnx[i] = ((const f32x2*)(p.x + (size_t)tn * D))[lane + 64 * i]; } }
#pragma unroll
          for (int i = 0; i < 8; ++i) XB[(size_t)t * 512 + lane + 64 * i] = pk_bf16(xv[i][0], xv[i][1]);
          f32x2 accv[8];
#pragma unroll
          for (int h = 0; h < 8; ++h) accv[h] = (f32x2){0.f, 0.f};
#pragma unroll
          for (int i = 0; i < 8; ++i)
#pragma unroll
              for (int c = 0; c < 2; ++c) { const float* wrow = wl + (c * 512 + 64 * i + lane) * 20; const f32x2 xx = {xv[i][c], xv[i][c]};
#pragma unroll
                  for (int h4 = 0; h4 < 4; ++h4) { const f32x4 w4 = *(const f32x4*)(wrow + 4 * h4);
                      accv[2 * h4] = __builtin_elementwise_fma(xx, (f32x2){w4[0], w4[1]}, accv[2 * h4]); accv[2 * h4 + 1] = __builtin_elementwise_fma(xx, (f32x2){w4[2], w4[3]}, accv[2 * h4 + 1]); } }
          float acc[16];
#pragma unroll
          for (int h = 0; h < 8; ++h) { acc[2 * h] = accv[h][0]; acc[2 * h + 1] = accv[h][1]; }
          const float r = tred<16>(acc, lane);
          if ((lane & 3) == 0) DT[(size_t)t * 16 + hsel] = softplus_f(r + dtb);
      } }
    __syncthreads();
    float* tile = (float*)smem;
    int toff = 0, pp = 0; TBuf tbA, tbB;
    tconv<false>(wsp<bf16_t>(p, W0M), p.ev_w_in, EVEN_IN, 1024, MapIn0{}, nullptr, 0, 1, 0, 0, tile, bid, nblk, tid, toff, tbA, tbB, pp);
    tconv<false>(wsp<bf16_t>(p, W0V), p.ev_w_in, EVEN_IN, 1024, MapOff{512, 3600}, nullptr, 0, 1, 0, 0, tile, bid, nblk, tid, toff, tbA, tbB, pp);
    tconv<true>(wsp<bf16_t>(p, W0O), p.ev_w_out, 1024, 1536, MapOff{1024, 0}, p.ev_norm_g, 1024, 1, 0, 0, tile, bid, nblk, tid, toff, tbA, tbB, pp);
    tconv<false>(wsp<bf16_t>(p, W1M), p.od_w_in, ODD_IN, 1024, MapIn1{}, nullptr, 0, 1, 0, 0, tile, bid, nblk, tid, toff, tbA, tbB, pp);
    tconv<false>(wsp<bf16_t>(p, W1V), p.od_w_in, ODD_IN, 1024, MapOff{512, 1440}, nullptr, 0, 1, 0, 0, tile, bid, nblk, tid, toff, tbA, tbB, pp);
    tconv<true>(wsp<bf16_t>(p, W1Q), p.od_w_q_up, 768, 256, MapQup{}, p.od_q_norm_g, 256, 1, 0, 0, tile, bid, nblk, tid, toff, tbA, tbB, pp);
    tconv<true>(wsp<bf16_t>(p, W1K), p.od_w_kv_up, 1024, 128, MapKV{0}, p.od_kv_norm_g, 128, 1, 0, 0, tile, bid, nblk, tid, toff, tbA, tbB, pp);
    tconv<true>(wsp<bf16_t>(p, W1VV), p.od_w_kv_up, 1024, 128, MapKV{64}, p.od_kv_norm_g, 128, 1, 0, 0, tile, bid, nblk, tid, toff, tbA, tbB, pp);
    tconv<false>(wsp<bf16_t>(p, W1O), p.od_w_out, 1024, 1024, MapOff{1024, 0}, nullptr, 0, 1, 0, 0, tile, bid, nblk, tid, toff, tbA, tbB, pp);
    tconv<false>(wsp<bf16_t>(p, WGU), p.moe_w_gate, 256, 1024, MapGU{0}, nullptr, 0, 32, (size_t)512 * 1024, (size_t)1024 * 256, tile, bid, nblk, tid, toff, tbA, tbB, pp);
    tconv<false>(wsp<bf16_t>(p, WGU), p.moe_w_up, 256, 1024, MapGU{1}, nullptr, 0, 32, (size_t)512 * 1024, (size_t)1024 * 256, tile, bid, nblk, tid, toff, tbA, tbB, pp);
    tconv<false>(wsp<bf16_t>(p, WDN), p.moe_w_down, 1024, 256, MapOff{1024, 0}, nullptr, 0, 32, (size_t)1024 * 256, (size_t)256 * 1024, tile, bid, nblk, tid, toff, tbA, tbB, pp);
    if (pp == 1) tconv_finish(tbA, tile, tid); else if (pp == 2) tconv_finish(tbB, tile, tid);
    { const size_t gtid = (size_t)bid * NTHR + tid, gstride = (size_t)nblk * NTHR; float* tab = wsp<float>(p, OFF_TAB);
      for (size_t i = gtid; i < (size_t)S * 16; i += gstride) { const int s = (int)(i >> 4), f = (int)(i & 15);
        double inv = 1.0; for (int k = 0; k < f; ++k) inv *= 0.56234132519034908;
        const double rev = (double)s * inv * 0.15915494309189535; const double fr = rev - floor(rev);
        const double x = fr * 4.0; const double qd = floor(x + 0.5); const int qi = (int)qd & 3;
        const double y = (x - qd) * 1.5707963267948966, y2 = y * y;
        const double sy = y * (1.0 + y2 * (-1.0 / 6 + y2 * (1.0 / 120 + y2 * (-1.0 / 5040 + y2 * (1.0 / 362880 + y2 * (-1.0 / 39916800 + y2 * (1.0 / 6227020800.0)))))));
        const double cy = 1.0 + y2 * (-0.5 + y2 * (1.0 / 24 + y2 * (-1.0 / 720 + y2 * (1.0 / 40320 + y2 * (-1.0 / 3628800 + y2 * (1.0 / 479001600.0 + y2 * (-1.0 / 87178291200.0)))))));
        const double cv = (qi == 0) ? cy : (qi == 1) ? -sy : (qi == 2) ? -cy : sy;
        const double sv = (qi == 0) ? sy : (qi == 1) ? cy : (qi == 2) ? -sy : -cy;
        tab[i] = (float)cv; tab[S * 16 + i] = (float)sv; } }
}

__device__ __forceinline__ void ln_row2(f32x2 (&v)[8], const f32x2 (&g)[8], const f32x2 (&bt)[8]) {
    float s = 0.f;
#pragma unroll
    for (int i = 0; i < 8; ++i) s += v[i][0] + v[i][1];
    const float mu = wave_sum(s) * (1.0f / 1024.0f);
    float q = 0.f;
#pragma unroll
    for (int i = 0; i < 8; ++i) { const f32x2 d = v[i] - mu; q += d[0] * d[0] + d[1] * d[1]; }
    const float rstd = rsqrtf(wave_sum(q) * (1.0f / 1024.0f) + 1e-5f);
#pragma unroll
    for (int i = 0; i < 8; ++i) v[i] = (v[i] - mu) * rstd * g[i] + bt[i];
}
__device__ __forceinline__ void ph_ln1_router2(const P& p, int l, unsigned char* smem, int bid, int nblk, int tid_) {
    int tid = tid_; asm volatile("" : "+v"(tid));
    const int lane = tid & 63, wid = tid >> 6;
    const unsigned* MIX = wsp<unsigned>(p, R_XBZ); unsigned* X1B = wsp<unsigned>(p, R_XQ + 128 * MiB);
    const float* XIN = p.x;
    float* TOKW = wsp<float>(p, OFF_ROUTE + 256 * 1024); int* LIST = wsp<int>(p, OFF_LIST);
    unsigned* CNT = wsp<unsigned>(p, OFF_CTRL) + 64 * l;
    float* wl = (float*)smem;
    float* lgs = wl + 1024 * 20;
    int* ent = (int*)(lgs + 8 * 256);
    int* lcnt = ent + 256;
    int* lbase = lcnt + 32;
    { const f32x4* wgp = (const f32x4*)(p.moe_w_group + (size_t)l * 1024 * 4); const f32x4* wep = (const f32x4*)(p.moe_w_expert + (size_t)l * 1024 * 16);
      f32x4 wg4[2], we4[8];
#pragma unroll
      for (int j = 0; j < 2; ++j) wg4[j] = wgp[tid + NTHR * j];
#pragma unroll
      for (int j = 0; j < 8; ++j) we4[j] = wep[tid + NTHR * j];
#pragma unroll
      for (int j = 0; j < 2; ++j) *(f32x4*)(wl + kpos(tid + NTHR * j) * 20) = wg4[j];
#pragma unroll
      for (int j = 0; j < 8; ++j) { const int q = tid + NTHR * j; *(f32x4*)(wl + kpos(q >> 2) * 20 + 4 + 4 * (q & 3)) = we4[j]; } }
    f32x2 g[8], bt[8];
#pragma unroll
    for (int i = 0; i < 8; ++i) { g[i] = ((const f32x2*)(p.ln1_g + l * 1024))[lane + 64 * i]; bt[i] = ((const f32x2*)(p.ln1_b + l * 1024))[lane + 64 * i]; }
    const int gsel = tred_idx<4>(lane);
    for (int ch = bid; ch < T / 128; ch += nblk) {
        if (tid < 32) lcnt[tid] = 0;
        __syncthreads();
        f32x2 xn[8]; unsigned mn[8];
#pragma unroll
        for (int i = 0; i < 8; ++i) { const size_t o = (size_t)(ch * 128 + wid * 16) * 512 + lane + 64 * i; mn[i] = MIX[o];
            if (l == 0) xn[i] = ((const f32x2*)XIN)[o]; else { const unsigned xb = X1B[o]; xn[i] = (f32x2){bflo(xb), bfhi(xb)}; } }
        for (int r = 0; r < 16; ++r) {
            const int lr = wid * 16 + r, t = ch * 128 + lr;
            f32x2 v[8];
#pragma unroll
            for (int i = 0; i < 8; ++i) v[i] = xn[i] * ALPHA + (f32x2){bflo(mn[i]), bfhi(mn[i])};
            if (r + 1 < 16) {
#pragma unroll
                for (int i = 0; i < 8; ++i) { const size_t o = (size_t)(t + 1) * 512 + lane + 64 * i; mn[i] = MIX[o];
                    if (l == 0) xn[i] = ((const f32x2*)XIN)[o]; else { const unsigned xb = X1B[o]; xn[i] = (f32x2){bflo(xb), bfhi(xb)}; } } }
            ln_row2(v, g, bt);
#pragma unroll
            for (int i = 0; i < 8; ++i) X1B[(size_t)t * 512 + lane + 64 * i] = pk_bf16(v[i][0], v[i][1]);
            f32x2 agv[2];
#pragma unroll
            for (int e = 0; e < 2; ++e) agv[e] = (f32x2){0.f, 0.f};
#pragma unroll
            for (int i = 0; i < 8; ++i)
#pragma unroll
                for (int c = 0; c < 2; ++c) { const float* wrow = wl + (c * 512 + 64 * i + lane) * 20; const f32x2 xx = {v[i][c], v[i][c]};
                    const f32x4 w0 = *(const f32x4*)wrow;
                    agv[0] = __builtin_elementwise_fma(xx, (f32x2){w0[0], w0[1]}, agv[0]); agv[1] = __builtin_elementwise_fma(xx, (f32x2){w0[2], w0[3]}, agv[1]); }
            float ag[4];
#pragma unroll
            for (int e = 0; e < 2; ++e) { ag[2 * e] = agv[e][0]; ag[2 * e + 1] = agv[e][1]; }
            const float rg = tred<4>(ag, lane);
            float gl[4]; float gm = -INFINITY; int gs = 0;
#pragma unroll
            for (int e = 0; e < 4; ++e) { gl[e] = __int_as_float(__builtin_amdgcn_readlane(__float_as_int(rg), 16 * e)) + p.moe_b_group[l * 4 + e]; if (gl[e] > gm) { gm = gl[e]; gs = e; } }
            f32x2 aev[2];
#pragma unroll
            for (int e = 0; e < 2; ++e) aev[e] = (f32x2){0.f, 0.f};
#pragma unroll
            for (int i = 0; i < 8; ++i)
#pragma unroll
                for (int c = 0; c < 2; ++c) { const float* wrow = wl + (c * 512 + 64 * i + lane) * 20 + 4 + 4 * gs; const f32x2 xx = {v[i][c], v[i][c]};
                    const f32x4 w4 = *(const f32x4*)wrow;
                    aev[0] = __builtin_elementwise_fma(xx, (f32x2){w4[0], w4[1]}, aev[0]); aev[1] = __builtin_elementwise_fma(xx, (f32x2){w4[2], w4[3]}, aev[1]); }
            float ae[4];
#pragma unroll
            for (int e = 0; e < 2; ++e) { ae[2 * e] = aev[e][0]; ae[2 * e + 1] = aev[e][1]; }
            const float re = tred<4>(ae, lane);
            float* lw = lgs + wid * 256 + r * 16;
            if ((lane & 15) == 0) { lw[gsel] = rg + p.moe_b_group[l * 4 + gsel]; lw[4 + gsel] = re; }
            if (lane == 0) lw[8] = __int_as_float(gs);
        }
        __builtin_amdgcn_wave_barrier();
        if (lane < 16) {
            const int lr = wid * 16 + lane, t = ch * 128 + lr; const float* lw = lgs + wid * 256 + lane * 16;
            float gl[4]; float gm = -INFINITY;
#pragma unroll
            for (int e = 0; e < 4; ++e) { gl[e] = lw[e]; gm = fmaxf(gm, gl[e]); }
            const int gs = __float_as_int(lw[8]);
            float gsum = 0.f;
#pragma unroll
            for (int e = 0; e < 4; ++e) gsum += expf(gl[e] - gm);
            const float gp = 1.0f / gsum;
            float el[4]; float em = -INFINITY;
#pragma unroll
            for (int e = 0; e < 4; ++e) { el[e] = lw[4 + e] + p.moe_b_expert[l * 16 + gs * 4 + e]; em = fmaxf(em, el[e]); }
            int i0 = 0; float b0 = el[0];
#pragma unroll
            for (int e = 1; e < 4; ++e) if (el[e] > b0) { b0 = el[e]; i0 = e; }
            int i1 = 0; float b1 = -INFINITY;
#pragma unroll
            for (int e = 0; e < 4; ++e) if (e != i0 && el[e] > b1) { b1 = el[e]; i1 = e; }
            const float p0 = expf(b0 - em), p1 = expf(b1 - em);
            const float w0 = gp * p0 / (p0 + p1), w1 = gp * p1 / (p0 + p1);
            if (i1 == i0) i1 = (i0 + 1) & 3;
            const int lo = i0 < i1 ? i0 : i1, hi = i0 < i1 ? i1 : i0;
            const int lid = gs * 6 + (lo == 0 ? hi - 1 : (lo == 1 ? hi + 1 : 5));
            TOKW[t * 2] = i0 < i1 ? w0 : w1; TOKW[t * 2 + 1] = i0 < i1 ? w1 : w0;
            const int s0 = atomicAdd(&lcnt[lid], 1);
            ent[lr] = (lid << 16) | s0;
        }
        __syncthreads();
        if (tid < NLIST) lbase[tid] = (int)atomicAdd(&CNT[tid], (unsigned)lcnt[tid]);
        __syncthreads();
        if (tid < 128) { const int pe = ent[tid], e = pe >> 16, sl = pe & 0xffff; LIST[(size_t)e * T + lbase[e] + sl] = ch * 128 + tid; }
        __syncthreads();
    }
}
__device__ __forceinline__ void ph_ln2_2(const P& p, int l, unsigned char* smem, int bid, int nblk, int tid_) {
    int tid = tid_; asm volatile("" : "+v"(tid));
    const int lane = tid & 63, wid = tid >> 6;
    unsigned* X1B = wsp<unsigned>(p, R_XQ + 128 * MiB); const unsigned* Y = wsp<unsigned>(p, R_XBZ);
    float* LOGF = wsp<float>(p, OFF_DT);
    float* wl = (float*)smem;
    if (l == 0) { f32x4 w4[4];
#pragma unroll
        for (int j = 0; j < 4; ++j) { const int q = tid + NTHR * j; w4[j] = *(const f32x4*)(p.od_w_in + (size_t)(q >> 1) * ODD_IN + 1952 + 4 * (q & 1)); }
#pragma unroll
        for (int j = 0; j < 4; ++j) { const int q = tid + NTHR * j; *(f32x4*)(wl + kpos(q >> 1) * 12 + 4 * (q & 1)) = w4[j]; }
        __syncthreads(); }
    f32x2 g[8], bt[8];
#pragma unroll
    for (int i = 0; i < 8; ++i) { g[i] = ((const f32x2*)(p.ln2_g + l * 1024))[lane + 64 * i]; bt[i] = ((const f32x2*)(p.ln2_b + l * 1024))[lane + 64 * i]; }
    const int fsel = tred_idx<8>(lane); const float fb = p.od_f_bias[fsel];
    unsigned xn[8], ya[8];
    { const int t0 = bid * 8 + wid; if (t0 < T) {
#pragma unroll
        for (int i = 0; i < 8; ++i) { const size_t o = (size_t)t0 * 512 + lane + 64 * i; xn[i] = X1B[o]; ya[i] = Y[o]; } } }
    for (int t = bid * 8 + wid; t < T; t += nblk * 8) {
        f32x2 v[8];
#pragma unroll
        for (int i = 0; i < 8; ++i) v[i] = (f32x2){bflo(xn[i]), bfhi(xn[i])} * ALPHA + (f32x2){bflo(ya[i]), bfhi(ya[i])};
        { const int tn = t + nblk * 8; if (tn < T) {
#pragma unroll
            for (int i = 0; i < 8; ++i) { const size_t o = (size_t)tn * 512 + lane + 64 * i; xn[i] = X1B[o]; ya[i] = Y[o]; } } }
        ln_row2(v, g, bt);
        if (l == 1) {
#pragma unroll
            for (int i = 0; i < 8; ++i) ((f32x2*)(p.out + (size_t)t * 1024))[lane + 64 * i] = v[i];
        } else {
#pragma unroll
            for (int i = 0; i < 8; ++i) X1B[(size_t)t * 512 + lane + 64 * i] = pk_bf16(v[i][0], v[i][1]);
            f32x2 afv[4];
#pragma unroll
            for (int e = 0; e < 4; ++e) afv[e] = (f32x2){0.f, 0.f};
#pragma unroll
            for (int i = 0; i < 8; ++i)
#pragma unroll
                for (int c = 0; c < 2; ++c) { const float* wrow = wl + (c * 512 + 64 * i + lane) * 12; const f32x2 xx = {v[i][c], v[i][c]};
                    const f32x4 w0 = *(const f32x4*)wrow, w1 = *(const f32x4*)(wrow + 4);
                    afv[0] = __builtin_elementwise_fma(xx, (f32x2){w0[0], w0[1]}, afv[0]); afv[1] = __builtin_elementwise_fma(xx, (f32x2){w0[2], w0[3]}, afv[1]);
                    afv[2] = __builtin_elementwise_fma(xx, (f32x2){w1[0], w1[1]}, afv[2]); afv[3] = __builtin_elementwise_fma(xx, (f32x2){w1[2], w1[3]}, afv[3]); }
            float af[8];
#pragma unroll
            for (int e = 0; e < 4; ++e) { af[2 * e] = afv[e][0]; af[2 * e + 1] = afv[e][1]; }
            const float r = tred<8>(af, lane);
            if ((lane & 7) == 0) LOGF[(size_t)t * 8 + fsel] = logsigmoid_f(r + fb);
        }
    }
}

#ifndef USE_MF
#define USE_MF 1
#endif
#ifndef USE_ATT
#define USE_ATT 3
#endif
#ifndef USE_THIN
#define USE_THIN 1
#endif
#ifndef USE_SSD
#define USE_SSD 1
#endif
#ifndef REP_MASK
#define REP_MASK 0
#endif
#ifndef REP_SSD
#define REP_SSD 0
#endif
#ifndef REP_SB
#define REP_SB 0
#endif
constexpr int LDS_BYTES = LDS_STAGE + LDS_TAB_BYTES;
constexpr int NPH = 17;
template <int PH> __device__ __forceinline__ void run_phase(const P& p, unsigned char* smem, int bid, int nblk, int tid_) {
    float* lds = (float*)smem;
    if constexpr (PH == 0) { if (USE_THIN) ph_prologue2(p, smem, bid, nblk, tid_); else ph_prologue(p, bid, nblk, tid_); }
    if constexpr (PH == 1) { if (USE_MF) ph_inproj0_mf(p, smem, bid, nblk, tid_); else ph_inproj0(p, lds, bid, nblk, tid_); }
    if constexpr (PH == 2) { if (USE_SSD) ph_conv2(p, smem, bid, nblk, tid_); else ph_conv(p, bid, nblk, tid_); }
    if constexpr (PH == 3) { if (USE_SSD) ph_ssd_mf(p, smem, bid, nblk, tid_); else ph_ssd_naive(p, lds, bid, nblk, tid_); if (REP_SSD) ph_ssd_mf(p, smem, bid, nblk, tid_);
        if (USE_ATT & 1) ph_sb_mf(p, smem, bid, nblk, tid_); else ph_sb_naive(p, bid, nblk, tid_);
        if (REP_SB) ph_sb_mf(p, smem, bid, nblk, tid_); }
    if constexpr (PH == 4) { if (USE_MF) ph_outproj0_mf(p, smem, bid, nblk, tid_); else ph_outproj0(p, lds, bid, nblk, tid_); }
    if constexpr (PH == 5) { if (USE_THIN) ph_ln1_router2(p, 0, smem, bid, nblk, tid_); else ph_ln1_router(p, 0, bid, nblk, tid_); }
    if constexpr (PH == 6) { ph_moe1_mf(p, 0, smem, bid, nblk, tid_); __syncthreads(); ph_moe2_mf(p, 0, smem, bid, nblk, tid_); }
    if constexpr (PH == 8) { if (USE_THIN) ph_ln2_2(p, 0, smem, bid, nblk, tid_); else ph_ln2(p, 0, bid, nblk, tid_); }
    if constexpr (PH == 9) { if (USE_MF) ph_inproj1_mf(p, smem, bid, nblk, tid_); else ph_inproj1(p, lds, bid, nblk, tid_); }
    if constexpr (PH == 10) { if (USE_MF) ph_upproj_mf(p, smem, bid, nblk, tid_); else ph_upproj(p, lds, bid, nblk, tid_); }
    if constexpr (PH == 11) { if (USE_ATT & 2) ph_attn1_mf(p, smem, bid, nblk, tid_); else ph_attn1_naive(p, bid, nblk, tid_); }
    if constexpr (PH == 12) { if (USE_MF) ph_outproj1_mf(p, smem, bid, nblk, tid_); else ph_outproj1(p, lds, bid, nblk, tid_); }
    if constexpr (PH == 13) { if (USE_THIN) ph_ln1_router2(p, 1, smem, bid, nblk, tid_); else ph_ln1_router(p, 1, bid, nblk, tid_); }
    if constexpr (PH == 14) { ph_moe1_mf(p, 1, smem, bid, nblk, tid_); __syncthreads(); ph_moe2_mf(p, 1, smem, bid, nblk, tid_); }
    if constexpr (PH == 16) { if (USE_THIN) ph_ln2_2(p, 1, smem, bid, nblk, tid_); else ph_ln2(p, 1, bid, nblk, tid_); }
}

__device__ __forceinline__ void load_kargs(P& pl) {
#if defined(__HIP_DEVICE_COMPILE__)
    typedef __attribute__((address_space(4))) const P* kargp_t;
    kargp_t kp = (kargp_t)__builtin_amdgcn_kernarg_segment_ptr(); asm volatile("" : "+s"(kp));
    pl.x = kp->x; pl.ev_w_in = kp->ev_w_in; pl.ev_conv_w = kp->ev_conv_w; pl.ev_conv_b = kp->ev_conv_b; pl.ev_dt_bias = kp->ev_dt_bias; pl.ev_a_log = kp->ev_a_log; pl.ev_d_skip = kp->ev_d_skip; pl.ev_norm_g = kp->ev_norm_g; pl.ev_w_out = kp->ev_w_out; pl.od_w_in = kp->od_w_in; pl.od_q_norm_g = kp->od_q_norm_g; pl.od_w_q_up = kp->od_w_q_up; pl.od_kv_norm_g = kp->od_kv_norm_g; pl.od_w_kv_up = kp->od_w_kv_up; pl.od_f_bias = kp->od_f_bias; pl.od_w_out = kp->od_w_out; pl.ln1_g = kp->ln1_g; pl.ln1_b = kp->ln1_b; pl.ln2_g = kp->ln2_g; pl.ln2_b = kp->ln2_b; pl.moe_w_group = kp->moe_w_group; pl.moe_b_group = kp->moe_b_group; pl.moe_w_expert = kp->moe_w_expert; pl.moe_b_expert = kp->moe_b_expert; pl.moe_w_gate = kp->moe_w_gate; pl.moe_w_up = kp->moe_w_up; pl.moe_w_down = kp->moe_w_down; pl.out = kp->out; pl.ws = kp->ws;
#else
    (void)pl;
#endif
}
#if MK_MULTI
template <int PH> __global__ void __launch_bounds__(NTHR, 2) k_phase(P p) {
    extern __shared__ __attribute__((aligned(16))) unsigned char smem[];
    run_phase<PH>(p, smem, blockIdx.x, gridDim.x, threadIdx.x);
}
template <int PH> static void launch_phases(const P& p, int grid, hipStream_t stream) {
    if constexpr (PH < NPH) {
        (void)hipFuncSetAttribute((const void*)k_phase<PH>, hipFuncAttributeMaxDynamicSharedMemorySize, LDS_BYTES);
        hipLaunchKernelGGL(k_phase<PH>, dim3(grid), dim3(NTHR), LDS_BYTES, stream, p);
        launch_phases<PH + 1>(p, grid, stream);
    }
}
#else
template <int PH> __device__ __forceinline__ void run_all(unsigned char* smem, const XcdBarrier& bar, int wave_s) {
    if constexpr (PH < NPH) {
        asm volatile("; PHASE_MARK %0" :: "n"(PH));
#define RUN_ONE_PHASE() do { int bid_ = blockIdx.x, nblk_ = gridDim.x, w_ = wave_s; asm volatile("" : "+s"(bid_), "+s"(nblk_), "+s"(w_)); \
        int tid_ = (w_ << 6) | lane_id(); asm volatile("" : "+v"(tid_)); P pl; load_kargs(pl); run_phase<PH>(pl, smem, bid_, nblk_, tid_); } while (0)
        RUN_ONE_PHASE();
        if constexpr ((REP_MASK >> PH) & 1) { xcd_barrier(bar); RUN_ONE_PHASE(); }
#undef RUN_ONE_PHASE
        if constexpr (PH < NPH - 1 && PH != 7 && PH != 15) xcd_barrier(bar);
        run_all<PH + 1>(smem, bar, wave_s);
    }
}
__global__ void __launch_bounds__(NTHR, 2) k_all(P p) {
    extern __shared__ __attribute__((aligned(16))) unsigned char smem[];
    volatile LAS unsigned* st = (volatile LAS unsigned*)(smem + LDS_BYTES);
    if (threadIdx.x == 0) { st[0] = 0u; st[1] = 0u; st[2] = 0u; st[3] = 0u; }
    __syncthreads();
    XcdBarrier bar = xcd_barrier_post((unsigned*)(p.ws + OFF_BAR), st);
    const int wave_s = __builtin_amdgcn_readfirstlane(threadIdx.x >> 6);
    run_all<0>(smem, bar, wave_s);
}
#endif

extern "C" void kernel_launch(void* const* d_in, const int* in_sizes, int n_in, void* d_out, int out_size, void* d_ws, size_t ws_size, hipStream_t stream) {
    (void)in_sizes; (void)n_in; (void)out_size;
    if (ws_size < WS_NEED) { fprintf(stderr, "workspace too small: %zu < %zu\n", ws_size, WS_NEED); return; }
    P p{};
    const float** f = (const float**)&p;
    for (int i = 0; i < 27; ++i) f[i] = (const float*)d_in[i];
    p.out = (float*)d_out; p.ws = (unsigned char*)d_ws;
    (void)hipMemsetAsync(d_ws, 0, OFF_CTRL + CTRL_BYTES, stream);
#if MK_MULTI
    launch_phases<0>(p, 256, stream);
#else
    static int grid = 0;
    if (!grid) {
        int dev = 0, cus = 0, per_cu = 0;
        hipGetDevice(&dev);
        hipDeviceGetAttribute(&cus, hipDeviceAttributeMultiprocessorCount, dev);
        (void)hipFuncSetAttribute((const void*)k_all, hipFuncAttributeMaxDynamicSharedMemorySize, LDS_BYTES + 16);
        (void)hipOccupancyMaxActiveBlocksPerMultiprocessor(&per_cu, k_all, NTHR, LDS_BYTES + 16);
        grid = cus * (per_cu < 1 ? per_cu : 1);
        if (grid <= 0) grid = cus;
    }
    hipLaunchKernelGGL(k_all, dim3(grid), dim3(NTHR), LDS_BYTES + 16, stream, p);
#endif
}
```

```cpp
#include <hip/hip_runtime.h>
#include <stdint.h>
#include <stdio.h>

#ifndef MK_MULTI
#define MK_MULTI 0
#endif

#ifndef USE_SSD
#define USE_SSD 1
#endif
typedef unsigned short bf16_t;
typedef float f32x4 __attribute__((ext_vector_type(4)));
typedef float f32x2 __attribute__((ext_vector_type(2)));
typedef unsigned u32x4 __attribute__((ext_vector_type(4)));
typedef unsigned u32x2 __attribute__((ext_vector_type(2)));

constexpr int NB = 16, S = 2048, T = NB * S, D = 1024;
constexpr int EVEN_IN = 4112, ODD_IN = 1960;
constexpr float ALPHA = 1.4142135623730951f;
constexpr float LOG2E = 1.4426950408889634f;
constexpr float C2_64 = 0.125f * LOG2E;
constexpr float C2_96 = 0.10206207261596577f * LOG2E;
constexpr int NTHR = 512;

constexpr size_t MiB = 1024 * 1024;
constexpr size_t OFF_BAR = 0;
constexpr size_t OFF_CTRL = 16 * 1024;
constexpr size_t CTRL_BYTES = 16 * 1024;
constexpr size_t OFF_TAB = 64 * 1024;
constexpr size_t OFF_DT = 1 * MiB;
constexpr size_t OFF_SSQ = 3 * MiB;
constexpr size_t OFF_ROUTE = 5 * MiB;
constexpr size_t OFF_W = 8 * MiB;
constexpr size_t W0M = OFF_W;
constexpr size_t W0V = W0M + (size_t)3584 * 1024 * 2;
constexpr size_t W0O = W0V + (size_t)512 * 1024 * 2;
constexpr size_t W1M = W0O + (size_t)1024 * 1536 * 2;
constexpr size_t W1V = W1M + (size_t)1536 * 1024 * 2;
constexpr size_t W1Q = W1V + (size_t)512 * 1024 * 2;
constexpr size_t W1K = W1Q + (size_t)768 * 256 * 2;
constexpr size_t W1VV = W1K + (size_t)512 * 128 * 2;
constexpr size_t W1O = W1VV + (size_t)512 * 128 * 2;
constexpr size_t WGU = W1O + (size_t)1024 * 1024 * 2;
constexpr size_t WDN = WGU + (size_t)2 * 16 * 512 * 1024 * 2;
constexpr size_t W_END = WDN + (size_t)2 * 16 * 1024 * 256 * 2;
static_assert(W_END <= 76 * MiB, "weights region");
constexpr size_t R_XBZ = 76 * MiB;
constexpr size_t R_XQ = 204 * MiB;
constexpr size_t R_A2 = 396 * MiB;
constexpr size_t WS_NEED = 512 * MiB;

struct P {
    const float* x; const float* ev_w_in; const float* ev_conv_w; const float* ev_conv_b; const float* ev_dt_bias; const float* ev_a_log;
    const float* ev_d_skip; const float* ev_norm_g; const float* ev_w_out; const float* od_w_in; const float* od_q_norm_g; const float* od_w_q_up;
    const float* od_kv_norm_g; const float* od_w_kv_up; const float* od_f_bias; const float* od_w_out; const float* ln1_g; const float* ln1_b;
    const float* ln2_g; const float* ln2_b; const float* moe_w_group; const float* moe_b_group; const float* moe_w_expert; const float* moe_b_expert;
    const float* moe_w_gate; const float* moe_w_up; const float* moe_w_down;
    float* out; unsigned char* ws;
};

__device__ __forceinline__ float bf2f(bf16_t v) { return __uint_as_float(((unsigned)v) << 16); }
__device__ __forceinline__ unsigned pk_bf16(float lo, float hi) {
    typedef __bf16 b2 __attribute__((ext_vector_type(2)));
    f32x2 v = {lo, hi}; b2 b = __builtin_convertvector(v, b2); return __builtin_bit_cast(unsigned, b);
}
__device__ __forceinline__ bf16_t f2bf(float f) { return (bf16_t)(pk_bf16(f, 0.f) & 0xffffu); }
__device__ __forceinline__ float bflo(unsigned w) { return __uint_as_float(w << 16); }
__device__ __forceinline__ float bfhi(unsigned w) { return __uint_as_float(w & 0xffff0000u); }
__device__ __forceinline__ float silu_f(float x) { return x * __builtin_amdgcn_rcpf(1.0f + __builtin_amdgcn_exp2f(-1.4426950408889634f * x)); }
__device__ __forceinline__ float softplus_f(float x) { return x > 20.f ? x : log1pf(expf(x)); }
__device__ __forceinline__ float logsigmoid_f(float x) { return fminf(x, 0.f) - log1pf(expf(-fabsf(x))); }
template <int CTRL> __device__ __forceinline__ float dpp_f(float x) { return __int_as_float(__builtin_amdgcn_update_dpp(0, __float_as_int(x), CTRL, 0xF, 0xF, true)); }
template <int G> __device__ __forceinline__ float group_sum(float r) {
    if constexpr (G >= 16) r += dpp_f<0x140>(r);
    if constexpr (G >= 8) r += dpp_f<0x141>(r);
    r += dpp_f<0x4E>(r);
    r += dpp_f<0xB1>(r);
    return r;
}
__device__ __forceinline__ float other16(float x, bool odd) { auto rr = __builtin_amdgcn_permlane16_swap(__float_as_uint(x), __float_as_uint(x), false, false); return __uint_as_float(odd ? rr[0] : rr[1]); }
__device__ __forceinline__ float other32(float x, bool hi) { auto rr = __builtin_amdgcn_permlane32_swap(__float_as_uint(x), __float_as_uint(x), false, false); return __uint_as_float(hi ? rr[0] : rr[1]); }
__device__ __forceinline__ float wave_sum(float v) {
    v = group_sum<16>(v);
    { auto rr = __builtin_amdgcn_permlane16_swap(__float_as_uint(v), __float_as_uint(v), false, false); v = __uint_as_float(rr[0]) + __uint_as_float(rr[1]); }
    { auto rr = __builtin_amdgcn_permlane32_swap(__float_as_uint(v), __float_as_uint(v), false, false); v = __uint_as_float(rr[0]) + __uint_as_float(rr[1]); }
    return v;
}
__device__ __forceinline__ int lane_id() { unsigned z = 0u; asm volatile("" : "+v"(z)); return (int)__builtin_amdgcn_mbcnt_hi(~0u, __builtin_amdgcn_mbcnt_lo(~0u, z)); }
#define LDS_BARRIER() do { asm volatile("s_waitcnt lgkmcnt(0)" ::: "memory"); __builtin_amdgcn_s_barrier(); asm volatile("" ::: "memory"); } while (0)
template <class T_> __device__ __forceinline__ T_* wsp(const P& p, size_t off) { return (T_*)(p.ws + off); }

#define XB_TMO      128
#define XB_XCNT(j)  (256  + 64 * (j))
#define XB_XSUB(j)  (1280 + 64 * (j))
#define XB_XGEN(j)  (2304 + 64 * (j))
#define XB_TOP      3328
#define XB_TOPGEN   3392
#define XCD_BAR_WORDS 3456
#define XB_SPIN_CAP (1u << 18)
#define LAS __attribute__((address_space(3)))

__device__ __forceinline__ unsigned xb_ld(unsigned* p)              { return __hip_atomic_load(p, __ATOMIC_RELAXED, __HIP_MEMORY_SCOPE_AGENT); }
__device__ __forceinline__ unsigned xb_add(unsigned* p, unsigned v) { return __hip_atomic_fetch_add(p, v, __ATOMIC_RELAXED, __HIP_MEMORY_SCOPE_AGENT); }
__device__ __forceinline__ unsigned xb_xcc_id() { return (unsigned)__builtin_amdgcn_s_getreg((3 << 11) | 20) & 0xFu; }
#define XB_SPIN(cond, bar) do { unsigned _sp = 0; while (cond) { __builtin_amdgcn_s_sleep(1); \
    if ((++_sp & 255u) == 0u) { if (xb_ld(&(bar)[XB_TMO])) break; if (_sp > XB_SPIN_CAP) { atomicAdd(&(bar)[XB_TMO], 1u); break; } } } } while (0)

struct XcdBarrier { unsigned* bar; unsigned x; volatile LAS unsigned* st; };

__device__ __forceinline__ XcdBarrier xcd_barrier_post(unsigned* bar, volatile LAS unsigned* st) {
    XcdBarrier b; b.bar = bar; b.x = xb_xcc_id(); b.st = st;
    if (threadIdx.x == 0) (void)xb_add(&bar[XB_XCNT(b.x)], 1u);
    return b;
}
__device__ __forceinline__ void xcd_barrier_complete(unsigned* bar, unsigned x, unsigned& nloc, unsigned& nx) {
    const unsigned G = gridDim.x * gridDim.y * gridDim.z;
    unsigned sum, cnt, mine, sp = 0u;
    for (;;) {
        sum = 0u; cnt = 0u; mine = 0u;
#pragma unroll
        for (unsigned j = 0; j < 16; ++j) { const unsigned c = xb_ld(&bar[XB_XCNT(j)]); sum += c; cnt += (c > 0u) ? 1u : 0u; mine = (j == x) ? c : mine; }
        if (sum == G) break;
        __builtin_amdgcn_s_sleep(1);
        if ((++sp & 255u) == 0u) { if (xb_ld(&bar[XB_TMO])) break; if (sp > XB_SPIN_CAP) { atomicAdd(&bar[XB_TMO], 1u); break; } }
    }
    nloc = mine > 0u ? mine : 1u; nx = cnt > 0u ? cnt : 1u;
}
__device__ __forceinline__ void xcd_barrier(const XcdBarrier& b) {
    asm volatile("s_waitcnt vmcnt(0)" ::: "memory");
    __syncthreads();
    if (threadIdx.x == 0) {
        unsigned* bar = b.bar;
        __builtin_amdgcn_s_waitcnt(0);
        unsigned nloc = b.st[0], nx = b.st[1];
        if (nloc == 0u) { xcd_barrier_complete(bar, b.x, nloc, nx); b.st[0] = nloc; b.st[1] = nx; }
        const unsigned old = xb_add(&bar[XB_XSUB(b.x)], 1u);
        const unsigned gen = old / nloc;
        if (old + 1u == (gen + 1u) * nloc) {
            __builtin_amdgcn_fence(__ATOMIC_RELEASE, "agent");
            asm volatile("s_waitcnt vmcnt(0)" ::: "memory");
            const unsigned og = xb_add(&bar[XB_TOP], 1u);
            const unsigned tg = og / nx;
            if (og + 1u == (tg + 1u) * nx) xb_add(&bar[XB_TOPGEN], 1u);
            else XB_SPIN(xb_ld(&bar[XB_TOPGEN]) == tg, bar);
            __builtin_amdgcn_fence(__ATOMIC_ACQUIRE, "agent");
            xb_add(&bar[XB_XGEN(b.x)], 1u);
            asm volatile("s_waitcnt vmcnt(0)" ::: "memory");
        } else {
            XB_SPIN(xb_ld(&bar[XB_XGEN(b.x)]) == gen, bar);
            __builtin_amdgcn_fence(__ATOMIC_ACQUIRE, "agent");
            asm volatile("s_waitcnt vmcnt(0)" ::: "memory");
        }
    }
    __syncthreads();
}

struct NoMid { static constexpr int ksplit = -1; __device__ __forceinline__ float scale(int) const { return 1.f; } };
template <bool DUAL, class Epi, class Mid> __attribute__((always_inline))
__device__ void gemm_naive(const bf16_t* __restrict__ A, int lda, const int* __restrict__ gidx, const bf16_t* __restrict__ Bt, int ldb,
                           int M, int N, int K, const Epi& epi, const Mid& mid, float* lds, int bid, int nblk, int tid_) {
    float* As = lds;
    float* Bs = lds + 32 * 132;
    float* Bs2 = Bs + 32 * 68;
    const int tid = tid_, ty = tid >> 4, tx = tid & 15;
    const int ntn = N / 64, ntiles = (M / 128) * ntn;
    for (int tile = bid; tile < ntiles; tile += nblk) {
        const int tm = tile / ntn, tn = tile % ntn;
        float acc[4][4], acc2[4][4];
#pragma unroll
        for (int i = 0; i < 4; ++i)
#pragma unroll
            for (int j = 0; j < 4; ++j) { acc[i][j] = 0.f; acc2[i][j] = 0.f; }
        const int lrow = tid >> 2, kc = (tid & 3) * 8;
        long arow = tm * 128 + lrow;
        if (gidx) { const int e = gidx[arow]; arow = e < 0 ? -1 : (e >> 1); }
        int brow = tn * 64 + (lrow & 63);
        if (DUAL) brow = (tn >> 1) * 256 + (tn & 1) * 64 + (lrow & 63);
        for (int k0 = 0; k0 < K; k0 += 32) {
            if (k0 == Mid::ksplit) {
#pragma unroll
                for (int i = 0; i < 4; ++i) { const float s = mid.scale(tm * 128 + ty * 4 + i);
#pragma unroll
                    for (int j = 0; j < 4; ++j) acc[i][j] *= s; }
            }
            u32x4 va = {0u, 0u, 0u, 0u};
            if (arow >= 0) va = *(const u32x4*)(A + (size_t)arow * lda + k0 + kc);
#pragma unroll
            for (int j = 0; j < 4; ++j) { As[(kc + 2 * j) * 132 + lrow] = bflo(va[j]); As[(kc + 2 * j + 1) * 132 + lrow] = bfhi(va[j]); }
            if (tid < 256) {
                const u32x4 vb = *(const u32x4*)(Bt + (size_t)brow * ldb + k0 + kc);
#pragma unroll
                for (int j = 0; j < 4; ++j) { Bs[(kc + 2 * j) * 68 + lrow] = bflo(vb[j]); Bs[(kc + 2 * j + 1) * 68 + lrow] = bfhi(vb[j]); }
            } else if (DUAL) {
                const u32x4 vb = *(const u32x4*)(Bt + (size_t)(brow + 128) * ldb + k0 + kc);
#pragma unroll
                for (int j = 0; j < 4; ++j) { Bs2[(kc + 2 * j) * 68 + (lrow & 63)] = bflo(vb[j]); Bs2[(kc + 2 * j + 1) * 68 + (lrow & 63)] = bfhi(vb[j]); }
            }
            __syncthreads();
#pragma unroll 8
            for (int k = 0; k < 32; ++k) {
                const f32x4 a = *(const f32x4*)(As + k * 132 + ty * 4);
                const f32x4 b = *(const f32x4*)(Bs + k * 68 + tx * 4);
#pragma unroll
                for (int i = 0; i < 4; ++i)
#pragma unroll
                    for (int j = 0; j < 4; ++j) acc[i][j] += a[i] * b[j];
                if (DUAL) {
                    const f32x4 b2 = *(const f32x4*)(Bs2 + k * 68 + tx * 4);
#pragma unroll
                    for (int i = 0; i < 4; ++i)
#pragma unroll
                        for (int j = 0; j < 4; ++j) acc2[i][j] += a[i] * b2[j];
                }
            }
            __syncthreads();
        }
#pragma unroll
        for (int i = 0; i < 4; ++i) {
            f32x4 v = {acc[i][0], acc[i][1], acc[i][2], acc[i][3]};
            if (DUAL) {
#pragma unroll
                for (int j = 0; j < 4; ++j) v[j] = silu_f(acc[i][j]) * acc2[i][j];
            }
            epi(tm * 128 + ty * 4 + i, tn * 64 + tx * 4, v);
        }
    }
}

__device__ __forceinline__ void st_bf16x4(bf16_t* p, f32x4 v) { u32x2 w; w.x = pk_bf16(v[0], v[1]); w.y = pk_bf16(v[2], v[3]); *(u32x2*)p = w; }

namespace pg8 {
#define PG8_LAS __attribute__((address_space(3)))
typedef short bf16x8 __attribute__((ext_vector_type(8)));
constexpr int BM = 256, BK = 64, HALF = 128, HTB = HALF * BK * 2, STAGE_BYTES = 8 * HTB, NXCD = 8, WGM = 4;
__host__ __device__ __forceinline__ int lds_byte(int r, int c) { const int st = (r >> 4) * 2 + (c >> 5), rr = r & 15, cc = c & 31, ob = rr * 64 + cc * 2; return st * 1024 + (ob ^ (((ob >> 9) & 1) << 5)); }
__host__ __device__ __forceinline__ void stage_rc(int b, int& R, int& C) { const int st = b / 1024, sb = b % 1024, swz = sb ^ (((sb >> 9) & 1) << 5); R = (st >> 1) * 16 + swz / 64; C = (st & 1) * 32 + (swz % 64) / 2; }

struct Unit { int pm, pn, e, g0; size_t aoff, boff, boff2; };
struct Gemm { const bf16_t* A; const bf16_t* Bt; int lda, ldb, K; const PG8_LAS int* gl; };

struct DenseOrder {
    static constexpr bool HOOK = false; static constexpr int BSEAM = 0;
    int nM, nN, nwg, G, c, lda, ldb;
    __device__ __forceinline__ void init(int M, int N, int lda_, int ldb_, int G_, int c_) { nM = M / BM; nN = N / BM; nwg = nM * nN; G = G_; c = c_; lda = lda_; ldb = ldb_; }
    __device__ __forceinline__ bool next(int i, Unit& u) const { return at((long)i * G + c, u); }
    __device__ __forceinline__ bool at(long L, Unit& u) const {
        if (L >= nwg) return false;
        int wgid = (int)L; { const int q = nwg / NXCD, r = nwg % NXCD, xcd = wgid % NXCD, off = wgid / NXCD; wgid = (xcd < r ? xcd * (q + 1) : r * (q + 1) + (xcd - r) * q) + off; }
        const int nig = WGM * nN, gid = wgid / nig, fm = gid * WGM, gsz = (nM - fm) < WGM ? (nM - fm) : WGM;
        u.pm = fm + ((wgid % nig) % gsz); u.pn = (wgid % nig) / gsz; u.e = 0; u.g0 = 0;
        u.aoff = (size_t)u.pm * BM * lda * 2; u.boff = (size_t)u.pn * BM * ldb * 2; u.boff2 = u.boff; return true;
    }
};
struct DualOrder {
    static constexpr bool HOOK = false; static constexpr int BSEAM = 0;
    DenseOrder s1, s2; long a2off, b2off;
    __device__ __forceinline__ bool next(int i, Unit& u) const {
        const long L = (long)i * s1.G + s1.c;
        if (L < s1.nwg) return s1.at(L, u);
        if (!s2.at(L - s1.nwg, u)) return false;
        u.e = 1; u.aoff = (size_t)((long)u.aoff + a2off); u.boff = (size_t)((long)u.boff + b2off); u.boff2 = u.boff; return true; }
};
struct NoMidK { static constexpr int ktile = -1; __device__ __forceinline__ void apply(f32x4 (&)[2][2][4][2], int, int, int) const {} };

__host__ __device__ __forceinline__ int perm32(int rho) { const int n = rho >> 4, i = rho & 15; return 8 * (i >> 2) + 4 * n + (i & 3); }
template <class Epi, class Sched, class MidK, bool GATHER, bool PERM = false>
__device__ __forceinline__ void gemm_phase(PG8_LAS unsigned char* lds, const Gemm g, const Sched& S, const Epi& E, const MidK& mid, int tid_) {
    int tid = tid_; asm volatile("" : "+v"(tid));
    const int wid = __builtin_amdgcn_readfirstlane(tid >> 6), lane = tid & 63, wr = wid >> 2, wc = wid & 3, fr = lane & 15, fq = lane >> 4;
    const int K = g.K, nt = K / BK;
    int R_[2], C_[2];
#pragma unroll
    for (int i = 0; i < 2; ++i) stage_rc(tid * 16 + i * 8192, R_[i], C_[i]);
    unsigned vB[2], vAd[2], vAc[2][2], vAn[2][2];
#pragma unroll
    for (int i = 0; i < 2; ++i) { const int Rb = PERM ? ((R_[i] & ~31) + perm32(R_[i] & 31)) : R_[i]; vB[i] = (unsigned)(Rb * g.ldb + C_[i]) * 2u; vAd[i] = (unsigned)(R_[i] * g.lda + C_[i]) * 2u; }
#pragma unroll
    for (int h = 0; h < 2; ++h)
#pragma unroll
        for (int i = 0; i < 2; ++i) { vAc[h][i] = 0u; vAn[h][i] = 0u; }
    const size_t hstepA = GATHER ? (size_t)0 : (size_t)HALF * g.lda * 2, hstepB = (size_t)HALF * g.ldb * 2;
#define PG8_GATHER_SET(v, ui_) do { if constexpr (GATHER) { _Pragma("unroll") for (int h_ = 0; h_ < 2; ++h_) _Pragma("unroll") for (int i_ = 0; i_ < 2; ++i_) \
        v[h_][i_] = (unsigned)(g.gl[(ui_) * 256 + h_ * HALF + R_[i_]] * g.lda + C_[i_]) * 2u; } } while (0)
    const size_t kstep = (size_t)(BK * 2);
    const unsigned ldsw = (unsigned)wid * 1024u;
    const int aoff = lds_byte(wr * 64 + fr, fq * 8), boff = lds_byte(wc * 32 + fr, fq * 8);
#define PG8_SA(b, h) (((b) * 2 + (h)) * HTB)
#define PG8_SB(b, h) ((4 + (b) * 2 + (h)) * HTB)
#define PG8_STAGE(bufoff, gbase, voff) do { _Pragma("unroll") for (int _i = 0; _i < 2; ++_i) \
        __builtin_amdgcn_global_load_lds((const unsigned*)((const char*)(gbase) + (voff)[_i]), (PG8_LAS unsigned*)(lds + (bufoff) + ldsw + _i * 8192), 16, 0, 0); } while (0)
#define PG8_STB(bufoff, gbase, h) PG8_STAGE(bufoff, (gbase) + (h) * hstepB, vB)
#define PG8_STA(bufoff, gbase, h, VG) do { if constexpr (GATHER) { PG8_STAGE(bufoff, gbase, VG[h]); } else { PG8_STAGE(bufoff, (gbase) + (h) * hstepA, vAd); } } while (0)
#define PG8_LDA(dst, b, h) do { _Pragma("unroll") for (int m = 0; m < 4; ++m) _Pragma("unroll") for (int k = 0; k < 2; ++k) dst[m][k] = *(const PG8_LAS bf16x8*)(lds + PG8_SA(b, h) + aoff + m * 2048 + k * 1024); } while (0)
#define PG8_LDB(dst, b, h) do { _Pragma("unroll") for (int n = 0; n < 2; ++n) _Pragma("unroll") for (int k = 0; k < 2; ++k) dst[n][k] = *(const PG8_LAS bf16x8*)(lds + PG8_SB(b, h) + boff + n * 2048 + k * 1024); } while (0)
#define PG8_MMA(ai, bj, At, Bt) do { __builtin_amdgcn_s_setprio(1); _Pragma("unroll") for (int m = 0; m < 4; ++m) _Pragma("unroll") for (int n = 0; n < 2; ++n) _Pragma("unroll") for (int k = 0; k < 2; ++k) \
        acc[ai][bj][m][n] = __builtin_amdgcn_mfma_f32_16x16x32_bf16(Bt[n][k], At[m][k], acc[ai][bj][m][n], 0, 0, 0); __builtin_amdgcn_s_setprio(0); } while (0)
#define PG8_WAIT_V(n) asm volatile("s_waitcnt vmcnt(" #n ")" ::: "memory")
#define PG8_WAIT_L(n) asm volatile("s_waitcnt lgkmcnt(" #n ")" ::: "memory")
#define PG8_BAR __builtin_amdgcn_s_barrier()
#define PG8_SCHED __builtin_amdgcn_sched_barrier(0)
    Unit cur, nxt; int ui = 0;
    if (!S.next(0, cur)) return;
    f32x4 acc[2][2][4][2];
#pragma unroll
    for (int a = 0; a < 2; ++a)
#pragma unroll
        for (int b = 0; b < 2; ++b)
#pragma unroll
            for (int m = 0; m < 4; ++m)
#pragma unroll
                for (int n = 0; n < 2; ++n) acc[a][b][m][n] = (f32x4){0.f, 0.f, 0.f, 0.f};
    bf16x8 At[4][2], B0[2][2], B1[2][2];
    const char* cA = (const char*)g.A + cur.aoff; const char* cB = (const char*)g.Bt + cur.boff; const char* cB2 = (const char*)g.Bt + cur.boff2;
    if constexpr (Sched::HOOK) S.a_ready(cur, wid);
    PG8_GATHER_SET(vAc, 0);
    if constexpr (GATHER) PG8_WAIT_L(0);
    PG8_STB(PG8_SB(0, 0), cB, 0); PG8_STB(PG8_SB(0, 1), cB, 1); PG8_STA(PG8_SA(0, 0), cA, 0, vAc); PG8_STA(PG8_SA(0, 1), cA, 1, vAc);
    if (wr == 1) PG8_BAR;
    PG8_WAIT_V(2); PG8_BAR;
    PG8_STB(PG8_SB(1, 0), cB + kstep, 0); PG8_STA(PG8_SA(1, 0), cA + kstep, 0, vAc); PG8_STB(PG8_SB(1, 1), cB + kstep, 1);
    PG8_WAIT_V(6); PG8_BAR;
    for (;;) {
        const bool has_next = S.next(ui + 1, nxt);
        const char* nA = has_next ? (const char*)g.A + nxt.aoff : cA; const char* nB = has_next ? (const char*)g.Bt + nxt.boff : cB; const char* nB2 = has_next ? (const char*)g.Bt + nxt.boff2 : cB2;
        if constexpr (GATHER) { if (has_next) { PG8_GATHER_SET(vAn, ui + 1); } else {
#pragma unroll
            for (int h = 0; h < 2; ++h)
#pragma unroll
                for (int i = 0; i < 2; ++i) vAn[h][i] = vAc[h][i]; } }
#pragma unroll 1
        for (int t = 0; t < nt; t += 2) {
            const bool last = (t == nt - 2);
            if constexpr (Sched::HOOK) { if (last && has_next) S.a_ready(nxt, wid); }
            if constexpr (MidK::ktile >= 0) { if (t == MidK::ktile) mid.apply(acc, ui, wr, fr); }
            const char* a1 = cA + (size_t)(t + 1) * kstep;
            const char* cBs = (Sched::BSEAM > 0 && t + 2 >= Sched::BSEAM) ? cB2 : cB;
            const char* a2 = last ? nA : cA + (size_t)(t + 2) * kstep; const char* b2 = last ? nB : cBs + (size_t)(t + 2) * kstep;
            const char* a3 = a2 + kstep; const char* b3 = b2 + kstep;
            unsigned vA2[2][2];
#pragma unroll
            for (int h = 0; h < 2; ++h)
#pragma unroll
                for (int i = 0; i < 2; ++i) vA2[h][i] = (GATHER && last) ? vAn[h][i] : vAc[h][i];
            PG8_LDB(B0, 0, 0); PG8_LDB(B1, 0, 1); PG8_SCHED; PG8_LDA(At, 0, 0); PG8_STA(PG8_SA(1, 1), a1, 1, vAc);
            PG8_WAIT_V(8); PG8_WAIT_L(0); PG8_BAR; PG8_MMA(0, 0, At, B0); PG8_MMA(0, 1, At, B1); PG8_BAR; PG8_SCHED;
            PG8_LDA(At, 0, 1); PG8_STB(PG8_SB(0, 0), b2, 0); PG8_STB(PG8_SB(0, 1), b2, 1); PG8_STA(PG8_SA(0, 0), a2, 0, vA2);
            PG8_WAIT_V(8); PG8_WAIT_L(0); PG8_BAR; PG8_MMA(1, 0, At, B0); PG8_MMA(1, 1, At, B1); PG8_BAR; PG8_SCHED;
            PG8_LDB(B0, 1, 0); PG8_LDB(B1, 1, 1); PG8_SCHED; PG8_LDA(At, 1, 0); PG8_STA(PG8_SA(0, 1), a2, 1, vA2);
            PG8_WAIT_V(8); PG8_WAIT_L(0); PG8_BAR; PG8_MMA(0, 0, At, B0); PG8_MMA(0, 1, At, B1); PG8_BAR; PG8_SCHED;
            PG8_LDA(At, 1, 1); PG8_STB(PG8_SB(1, 0), b3, 0); PG8_STB(PG8_SB(1, 1), b3, 1); PG8_STA(PG8_SA(1, 0), a3, 0, vA2);
            PG8_WAIT_V(8); PG8_WAIT_L(0); PG8_BAR; PG8_MMA(1, 0, At, B0); PG8_MMA(1, 1, At, B1); PG8_BAR; PG8_SCHED;
        }
        if (wr == 0) PG8_BAR;
        { int le = lane_id(); asm volatile("" : "+v"(le)); E(acc, cur, ui, wr, wc, le & 15, le >> 4); }
        if (!has_next) break;
#pragma unroll
        for (int a = 0; a < 2; ++a)
#pragma unroll
            for (int b = 0; b < 2; ++b)
#pragma unroll
                for (int m = 0; m < 4; ++m)
#pragma unroll
                    for (int n = 0; n < 2; ++n) acc[a][b][m][n] = (f32x4){0.f, 0.f, 0.f, 0.f};
        cur = nxt; cA = nA; cB = nB; cB2 = nB2; ++ui;
        if constexpr (GATHER) {
#pragma unroll
            for (int h = 0; h < 2; ++h)
#pragma unroll
                for (int i = 0; i < 2; ++i) vAc[h][i] = vAn[h][i]; }
        if (wr == 1) PG8_BAR;
    }
    PG8_WAIT_V(0);
    PG8_BAR;
#undef PG8_GATHER_SET
#undef PG8_SA
#undef PG8_SB
#undef PG8_STAGE
#undef PG8_STA
#undef PG8_STB
#undef PG8_LDA
#undef PG8_LDB
#undef PG8_MMA
#undef PG8_WAIT_V
#undef PG8_WAIT_L
#undef PG8_BAR
#undef PG8_SCHED
}
template <class F> __device__ __forceinline__ void epi_each(const f32x4 (&acc)[2][2][4][2], const Unit& u, int wr, int wc, int fr, int fq, const F& f) {
#pragma unroll
    for (int ai = 0; ai < 2; ++ai)
#pragma unroll
        for (int m = 0; m < 4; ++m) { const int row = u.pm * BM + ai * HALF + wr * 64 + m * 16 + fr;
#pragma unroll
            for (int bj = 0; bj < 2; ++bj)
#pragma unroll
                for (int n = 0; n < 2; ++n) f(row, u.pn * BM + bj * HALF + wc * 32 + n * 16 + fq * 4, acc[ai][bj][m][n]); }
}
template <class F> struct EpiWrap { F f; __device__ __forceinline__ void operator()(const f32x4 (&acc)[2][2][4][2], const Unit& u, int, int wr, int wc, int fr, int fq) const { epi_each(acc, u, wr, wc, fr, fq, f); } };
}

template <class F> __device__ __forceinline__ void conv_rows(bf16_t* dst, int nrows, int K, F f, size_t gtid, size_t gstride) {
    const size_t n_el = (size_t)nrows * K;
    for (size_t i = gtid; i < n_el; i += gstride) { const int n = (int)(i / K), k = (int)(i % K); dst[i] = f2bf(f(n, k)); }
}
__device__ __forceinline__ void ph_prologue(const P& p, int bid, int nblk, int tid_) {
    const size_t gtid = (size_t)bid * NTHR + tid_, gstride = (size_t)nblk * NTHR;
    { const f32x4* src = (const f32x4*)p.x; u32x2* dst = wsp<u32x2>(p, R_XBZ);
      for (size_t i = gtid; i < (size_t)T * D / 4; i += gstride) { const f32x4 v = src[i]; u32x2 o; o.x = pk_bf16(v[0], v[1]); o.y = pk_bf16(v[2], v[3]); dst[i] = o; } }
    { float* DT = wsp<float>(p, OFF_DT);
      for (size_t i = gtid; i < (size_t)T * 16; i += gstride) { const int t = (int)(i >> 4), h = (int)(i & 15); const float* xr = p.x + (size_t)t * D; const float* w = p.ev_w_in + 2560 + h;
        float a = 0.f; for (int k = 0; k < D; ++k) a += xr[k] * w[(size_t)k * EVEN_IN]; DT[i] = softplus_f(a + p.ev_dt_bias[h]); } }
    { const float* w = p.ev_w_in;
      conv_rows(wsp<bf16_t>(p, W0M), 3584, 1024, [=](int n, int k) { const int c = n < 2560 ? n : (n < 3072 ? 2576 + (n - 2560) : 3088 + (n - 3072)); return w[(size_t)k * EVEN_IN + c]; }, gtid, gstride);
      conv_rows(wsp<bf16_t>(p, W0V), 512, 1024, [=](int n, int k) { return w[(size_t)k * EVEN_IN + 3600 + n]; }, gtid, gstride); }
    { const float* w = p.ev_w_out; const float* g = p.ev_norm_g;
      conv_rows(wsp<bf16_t>(p, W0O), 1024, 1536, [=](int n, int k) { return w[(size_t)k * 1024 + n] * (k < 1024 ? g[k] : 1.f); }, gtid, gstride); }
    { const float* w = p.od_w_in;
      conv_rows(wsp<bf16_t>(p, W1M), 1536, 1024, [=](int n, int k) {
          int c;
          if (n < 384) c = n;
          else if (n < 416) { const int j = n - 384, i = j >> 1; c = 384 + ((j & 1) ? i + 16 : i); }
          else if (n < 512) return 0.f;
          else if (n < 1024) c = 416 + (n - 512);
          else c = 928 + (n - 1024);
          return w[(size_t)k * ODD_IN + c]; }, gtid, gstride);
      conv_rows(wsp<bf16_t>(p, W1V), 512, 1024, [=](int n, int k) { return w[(size_t)k * ODD_IN + 1440 + n]; }, gtid, gstride); }
    { const float* w = p.od_w_q_up; const float* g = p.od_q_norm_g;
      conv_rows(wsp<bf16_t>(p, W1Q), 768, 256, [=](int n, int k) { const int h = n / 96, j = n % 96; int c = n;
          if (j >= 64) { const int jj = j - 64, i = jj >> 1; c = 96 * h + 64 + ((jj & 1) ? i + 16 : i); }
          return w[(size_t)k * 768 + c] * g[k]; }, gtid, gstride); }
    { const float* w = p.od_w_kv_up; const float* g = p.od_kv_norm_g;
      conv_rows(wsp<bf16_t>(p, W1K), 512, 128, [=](int n, int k) { const int h = n >> 6, d = n & 63; return w[(size_t)k * 1024 + 128 * h + d] * g[k]; }, gtid, gstride);
      conv_rows(wsp<bf16_t>(p, W1VV), 512, 128, [=](int n, int k) { const int h = n >> 6, d = n & 63; return w[(size_t)k * 1024 + 128 * h + 64 + d] * g[k]; }, gtid, gstride); }
    { const float* w = p.od_w_out;
      conv_rows(wsp<bf16_t>(p, W1O), 1024, 1024, [=](int n, int k) { return w[(size_t)k * 1024 + n]; }, gtid, gstride); }
    { const float* wg = p.moe_w_gate; const float* wu = p.moe_w_up; const float* wd = p.moe_w_down;
      { bf16_t* dst = wsp<bf16_t>(p, WGU);
        for (size_t i = gtid; i < (size_t)32 * 256 * 1024; i += gstride) { const int k = (int)(i & 1023), n = (int)(i >> 10), le = n >> 8, c = n & 255, j = c >> 7, r = c & 127;
          const size_t row = (size_t)le * 512 + j * 256 + r, si = ((size_t)le * 1024 + k) * 256 + c;
          dst[row * 1024 + k] = f2bf(wg[si]); dst[(row + 128) * 1024 + k] = f2bf(wu[si]); } }
      conv_rows(wsp<bf16_t>(p, WDN), 32 * 1024, 256, [=](int n, int k) { const int le = n >> 10, c = n & 1023; return wd[((size_t)le * 256 + k) * 1024 + c]; }, gtid, gstride); }
    { float* tab = wsp<float>(p, OFF_TAB);
      for (size_t i = gtid; i < (size_t)S * 16; i += gstride) { const int s = (int)(i >> 4), f = (int)(i & 15);
        double inv = 1.0; for (int k = 0; k < f; ++k) inv *= 0.56234132519034908;
        const double rev = (double)s * inv * 0.15915494309189535; const double fr = rev - floor(rev);
        const double x = fr * 4.0; const double qd = floor(x + 0.5); const int qi = (int)qd & 3;
        const double y = (x - qd) * 1.5707963267948966, y2 = y * y;
        const double sy = y * (1.0 + y2 * (-1.0 / 6 + y2 * (1.0 / 120 + y2 * (-1.0 / 5040 + y2 * (1.0 / 362880 + y2 * (-1.0 / 39916800 + y2 * (1.0 / 6227020800.0)))))));
        const double cy = 1.0 + y2 * (-0.5 + y2 * (1.0 / 24 + y2 * (-1.0 / 720 + y2 * (1.0 / 40320 + y2 * (-1.0 / 3628800 + y2 * (1.0 / 479001600.0 + y2 * (-1.0 / 87178291200.0)))))));
        const double cv = (qi == 0) ? cy : (qi == 1) ? -sy : (qi == 2) ? -cy : sy;
        const double sv = (qi == 0) ? sy : (qi == 1) ? cy : (qi == 2) ? -sy : -cy;
        tab[i] = (float)cv; tab[S * 16 + i] = (float)sv; } }
}

struct EpiIn0 {
    bf16_t* Z; bf16_t* XBCR; bf16_t* Q; bf16_t* K;
    __device__ __forceinline__ void operator()(int row, int col, f32x4 v) const {
        if (col < 1024) st_bf16x4(Z + (size_t)row * 1024 + col, v);
        else if (col < 2560) st_bf16x4(XBCR + (size_t)row * 1536 + (col - 1024), v);
        else if (col < 3072) st_bf16x4(Q + (size_t)row * 512 + (col - 2560), v * C2_64);
        else st_bf16x4(K + (size_t)row * 512 + (col - 3072), v);
    }
};
struct EpiVt { bf16_t* Vt; __device__ __forceinline__ void operator()(int row, int col, f32x4 v) const { st_bf16x4(Vt + (size_t)row * T + col, v); } };

__device__ __forceinline__ void ph_inproj0(const P& p, float* lds, int bid, int nblk, int tid_) {
    const bf16_t* XB = wsp<bf16_t>(p, R_XBZ);
    EpiIn0 e{wsp<bf16_t>(p, R_XBZ + 64 * MiB), wsp<bf16_t>(p, R_A2), wsp<bf16_t>(p, R_XQ + 96 * MiB), wsp<bf16_t>(p, R_XQ + 128 * MiB)};
    gemm_naive<false>(XB, 1024, nullptr, wsp<bf16_t>(p, W0M), 1024, T, 3584, 1024, e, NoMid{}, lds, bid, nblk, tid_);
    EpiVt ev{wsp<bf16_t>(p, R_XQ + 160 * MiB)};
    gemm_naive<false>(wsp<bf16_t>(p, W0V), 1024, nullptr, XB, 1024, 512, T, 1024, ev, NoMid{}, lds, bid, nblk, tid_);
}
__device__ __forceinline__ void ph_conv(const P& p, int bid, int nblk, int tid_) {
    const bf16_t* XR = wsp<bf16_t>(p, R_A2); bf16_t* XC = wsp<bf16_t>(p, R_XQ);
    const size_t gtid = (size_t)bid * NTHR + tid_, gstride = (size_t)nblk * NTHR;
    for (size_t i = gtid; i < (size_t)T * 1536; i += gstride) {
        const int t = (int)(i / 1536), c = (int)(i % 1536), s = t & (S - 1);
        float a = p.ev_conv_b[c];
#pragma unroll
        for (int k = 0; k < 4; ++k) { const int ss = s - 3 + k; if (ss >= 0) a += p.ev_conv_w[k * 1536 + c] * bf2f(XR[(size_t)(t - 3 + k) * 1536 + c]); }
        XC[i] = f2bf(silu_f(a));
    }
}
__device__ __forceinline__ void ph_ssd_naive(const P& p, float* lds, int bid, int nblk, int tid_) {
    const bf16_t* XC = wsp<bf16_t>(p, R_XQ); const bf16_t* Z = wsp<bf16_t>(p, R_XBZ + 64 * MiB); const float* DT = wsp<float>(p, OFF_DT);
    bf16_t* A2 = wsp<bf16_t>(p, R_A2); float* SSQ = wsp<float>(p, OFF_SSQ);
    float* Bs = lds; float* Cs = Bs + 16 * 128; float* xs = Cs + 16 * 128; float* dts = xs + 16 * 64; float* yp = dts + 16;
    const int tid = tid_, pp = tid & 63, nq = tid >> 6, lane = tid & 63;
    for (int u = bid; u < NB * 16; u += nblk) {
        const int b = u >> 4, h = u & 15, g = h >> 3;
        const float a = -expf(p.ev_a_log[h]), dsk = p.ev_d_skip[h];
        float st[16];
#pragma unroll
        for (int n = 0; n < 16; ++n) st[n] = 0.f;
        for (int c0 = 0; c0 < S; c0 += 16) {
            const size_t r0 = (size_t)b * S + c0;
            for (int idx = tid; idx < 16 * 128; idx += NTHR) { const int i = idx >> 7, n = idx & 127; const bf16_t* r = XC + (r0 + i) * 1536;
                Bs[idx] = bf2f(r[1024 + g * 128 + n]); Cs[idx] = bf2f(r[1280 + g * 128 + n]); }
            for (int idx = tid; idx < 16 * 64; idx += NTHR) { const int i = idx >> 6, q = idx & 63; xs[idx] = bf2f(XC[(r0 + i) * 1536 + h * 64 + q]); }
            if (tid < 16) dts[tid] = DT[(r0 + tid) * 16 + h];
            __syncthreads();
            for (int i = 0; i < 16; ++i) {
                const float dt = dts[i], dA = expf(dt * a), dtx = dt * xs[i * 64 + pp];
                float y = 0.f;
#pragma unroll
                for (int n = 0; n < 16; ++n) { st[n] = st[n] * dA + dtx * Bs[i * 128 + nq * 16 + n]; y += Cs[i * 128 + nq * 16 + n] * st[n]; }
                yp[(nq * 16 + i) * 64 + pp] = y;
            }
            __syncthreads();
            for (int idx = tid; idx < 16 * 64; idx += NTHR) {
                const int i = idx >> 6, q = idx & 63; float y = 0.f;
#pragma unroll
                for (int w = 0; w < 8; ++w) y += yp[(w * 16 + i) * 64 + q];
                y += dsk * xs[idx];
                const float z = bf2f(Z[(r0 + i) * 1024 + h * 64 + q]);
                const float uu = y * silu_f(z);
                A2[(r0 + i) * 1536 + h * 64 + q] = f2bf(uu);
                const float ss = wave_sum(uu * uu);
                if (lane == 0) SSQ[(r0 + i) * 16 + h] = ss;
            }
            __syncthreads();
        }
    }
}
__device__ __forceinline__ void ph_sb_naive(const P& p, int bid, int nblk, int tid_) {
    const bf16_t* Q = wsp<bf16_t>(p, R_XQ + 96 * MiB); const bf16_t* K = wsp<bf16_t>(p, R_XQ + 128 * MiB); const bf16_t* Vt = wsp<bf16_t>(p, R_XQ + 160 * MiB);
    bf16_t* A2 = wsp<bf16_t>(p, R_A2);
    const int lane = tid_ & 63, wid = tid_ >> 6;
    const int nunits = NB * 8 * (S / 64);
    for (int u = bid * 8 + wid; u < nunits; u += nblk * 8) {
        const int tb = (S / 64 - 1) - (u % (S / 64)), bh = u / (S / 64), b = bh >> 3, h = bh & 7;
        const int t0 = tb * 64, t = t0 + lane; const size_t row = (size_t)b * S + t;
        unsigned qp[32]; float o[64];
#pragma unroll
        for (int d = 0; d < 64; d += 8) { const u32x4 v = *(const u32x4*)(Q + row * 512 + h * 64 + d);
#pragma unroll
            for (int j = 0; j < 4; ++j) qp[d / 2 + j] = v[j]; }
#pragma unroll
        for (int d = 0; d < 64; ++d) o[d] = 0.f;
        float csum = 0.f;
        for (int s = t0 + 62; s >= 0; --s) {
            const bf16_t* kr = K + ((size_t)b * S + s) * 512 + h * 64;
            float z = 0.f;
#pragma unroll
            for (int d = 0; d < 64; d += 8) { const u32x4 v = *(const u32x4*)(kr + d);
#pragma unroll
                for (int j = 0; j < 4; ++j) { z += bflo(qp[d / 2 + j]) * bflo(v[j]); z += bfhi(qp[d / 2 + j]) * bfhi(v[j]); } }
            float w = 0.f;
            if (s < t) { const float l = fmaxf(z, 0.f) + log2f(1.f + exp2f(-fabsf(z))); csum += l; w = exp2f(z - csum); }
            const bf16_t* vc = Vt + (size_t)(h * 64) * T + (size_t)b * S + s;
#pragma unroll
            for (int d = 0; d < 64; ++d) o[d] += w * bf2f(vc[(size_t)d * T]);
        }
#pragma unroll
        for (int d = 0; d < 64; d += 4) st_bf16x4(A2 + row * 1536 + 1024 + h * 64 + d, (f32x4){o[d], o[d + 1], o[d + 2], o[d + 3]});
    }
}
struct MidRms0 { static constexpr int ksplit = 1024; const float* SSQ;
    __device__ __forceinline__ float scale(int row) const { float s = 0.f;
#pragma unroll
        for (int h = 0; h < 16; ++h) s += SSQ[(size_t)row * 16 + h];
        return rsqrtf(s * (1.0f / 1024.0f) + 1e-6f); } };
struct EpiRes { const float* X; float* PRE; __device__ __forceinline__ void operator()(int row, int col, f32x4 v) const {
        const f32x4 xr = *(const f32x4*)(X + (size_t)row * 1024 + col); *(f32x4*)(PRE + (size_t)row * 1024 + col) = xr * ALPHA + v; } };
struct EpiMixMf { bf16_t* MIX; __device__ __forceinline__ void operator()(const f32x4 (&acc)[2][2][4][2], const pg8::Unit& u, int, int wr, int wc, int fr, int fq) const; };
__device__ __forceinline__ void ph_outproj0(const P& p, float* lds, int bid, int nblk, int tid_) {
    MidRms0 mid{wsp<float>(p, OFF_SSQ)}; EpiRes e{p.x, wsp<float>(p, R_XBZ)};
    gemm_naive<false>(wsp<bf16_t>(p, R_A2), 1536, nullptr, wsp<bf16_t>(p, W0O), 1536, T, 1024, 1536, e, mid, lds, bid, nblk, tid_);
}

__device__ __forceinline__ void ln_row(f32x4 (&v)[4], const float* g, const float* bta, int lane) {
    float s = 0.f;
#pragma unroll
    for (int j = 0; j < 4; ++j) s += (v[j][0] + v[j][1]) + (v[j][2] + v[j][3]);
    const float mu = wave_sum(s) * (1.0f / 1024.0f);
    float q = 0.f;
#pragma unroll
    for (int j = 0; j < 4; ++j) { const f32x4 d = v[j] - mu; q += (d[0] * d[0] + d[1] * d[1]) + (d[2] * d[2] + d[3] * d[3]); }
    const float rstd = rsqrtf(wave_sum(q) * (1.0f / 1024.0f) + 1e-5f);
#pragma unroll
    for (int j = 0; j < 4; ++j) { const f32x4 gg = *(const f32x4*)(g + j * 256 + lane * 4), bb = *(const f32x4*)(bta + j * 256 + lane * 4); v[j] = (v[j] - mu) * rstd * gg + bb; }
}
__device__ __forceinline__ void ph_ln1_router(const P& p, int l, int bid, int nblk, int tid_) {
    const float* PRE = wsp<float>(p, R_XBZ); float* X1F = wsp<float>(p, R_XQ); bf16_t* X1B = wsp<bf16_t>(p, R_XQ + 128 * MiB);
    int* TOKE = wsp<int>(p, OFF_ROUTE); float* TOKW = wsp<float>(p, OFF_ROUTE + 256 * 1024); int* LIST = wsp<int>(p, OFF_ROUTE + 512 * 1024);
    unsigned* CNT = wsp<unsigned>(p, OFF_CTRL) + 64 * l;
    const float* g = p.ln1_g + l * 1024; const float* bta = p.ln1_b + l * 1024;
    const float* wgp = p.moe_w_group + (size_t)l * 1024 * 4; const float* wep = p.moe_w_expert + (size_t)l * 1024 * 16;
    const int lane = tid_ & 63, wid = tid_ >> 6;
    for (int t = bid * 8 + wid; t < T; t += nblk * 8) {
        f32x4 v[4];
#pragma unroll
        for (int j = 0; j < 4; ++j) v[j] = *(const f32x4*)(PRE + (size_t)t * 1024 + j * 256 + lane * 4);
        ln_row(v, g, bta, lane);
#pragma unroll
        for (int j = 0; j < 4; ++j) { *(f32x4*)(X1F + (size_t)t * 1024 + j * 256 + lane * 4) = v[j]; st_bf16x4(X1B + (size_t)t * 1024 + j * 256 + lane * 4, v[j]); }
        float lg[20];
#pragma unroll
        for (int e = 0; e < 20; ++e) lg[e] = 0.f;
#pragma unroll
        for (int j = 0; j < 4; ++j)
#pragma unroll
            for (int i = 0; i < 4; ++i) { const int k = j * 256 + lane * 4 + i; const float xv = v[j][i];
                const f32x4 wg4 = *(const f32x4*)(wgp + (size_t)k * 4);
#pragma unroll
                for (int e = 0; e < 4; ++e) lg[e] += xv * wg4[e];
#pragma unroll
                for (int e4 = 0; e4 < 4; ++e4) { const f32x4 we4 = *(const f32x4*)(wep + (size_t)k * 16 + e4 * 4);
#pragma unroll
                    for (int e = 0; e < 4; ++e) lg[4 + e4 * 4 + e] += xv * we4[e]; } }
#pragma unroll
        for (int e = 0; e < 20; ++e) lg[e] = wave_sum(lg[e]);
        if (lane == 0) {
            float gl[4]; float gm = -INFINITY; int gs = 0;
#pragma unroll
            for (int e = 0; e < 4; ++e) { gl[e] = lg[e] + p.moe_b_group[l * 4 + e]; if (gl[e] > gm) { gm = gl[e]; gs = e; } }
            float gsum = 0.f;
#pragma unroll
            for (int e = 0; e < 4; ++e) gsum += expf(gl[e] - gm);
            const float gp = 1.0f / gsum;
            float el[4]; float em = -INFINITY;
#pragma unroll
            for (int e = 0; e < 4; ++e) { float vv = 0.f;
#pragma unroll
                for (int gg = 0; gg < 4; ++gg) vv = (gg == gs) ? lg[4 + gg * 4 + e] : vv;
                el[e] = vv + p.moe_b_expert[l * 16 + gs * 4 + e]; em = fmaxf(em, el[e]); }
            int i0 = 0; float b0 = el[0];
#pragma unroll
            for (int e = 1; e < 4; ++e) if (el[e] > b0) { b0 = el[e]; i0 = e; }
            int i1 = 0; float b1 = -INFINITY;
#pragma unroll
            for (int e = 0; e < 4; ++e) if (e != i0 && el[e] > b1) { b1 = el[e]; i1 = e; }
            const float p0 = expf(b0 - em), p1 = expf(b1 - em);
            const float w0 = gp * p0 / (p0 + p1), w1 = gp * p1 / (p0 + p1);
            const int e0 = gs * 4 + i0, e1 = gs * 4 + i1;
            TOKE[t * 2] = e0; TOKE[t * 2 + 1] = e1; TOKW[t * 2] = w0; TOKW[t * 2 + 1] = w1;
            const unsigned s0 = atomicAdd(&CNT[e0], 1u); LIST[(size_t)e0 * T + s0] = t * 2;
            const unsigned s1 = atomicAdd(&CNT[e1], 1u); LIST[(size_t)e1 * T + s1] = t * 2 + 1;
        }
    }
}
struct EpiHid { bf16_t* HID; __device__ __forceinline__ void operator()(int row, int col, f32x4 v) const { st_bf16x4(HID + (size_t)row * 256 + col, v); } };
struct EpiDown { bf16_t* Y; const int* gidx; const float* TOKW;
    __device__ __forceinline__ void operator()(int row, int col, f32x4 v) const { const int e = gidx[row]; if (e < 0) return; const float w = TOKW[e];
        st_bf16x4(Y + ((size_t)(e & 1) * T + (e >> 1)) * 1024 + col, v * w); } };
__device__ __forceinline__ void moe_range(const unsigned* CNT, int e, int& off_e, int& rows) {
    int o = 0; off_e = 0; rows = 0;
#pragma unroll
    for (int k = 0; k < 16; ++k) { const int r = ((int)CNT[k] + 255) & ~255; if (k == e) { off_e = o; rows = r; } o += r; }
}
__device__ __forceinline__ void ph_moe_index(const P& p, int l, int bid, int nblk, int tid_) {
    const unsigned* CNT = wsp<unsigned>(p, OFF_CTRL) + 64 * l; const int* LIST = wsp<int>(p, OFF_ROUTE + 512 * 1024); int* GIDX = wsp<int>(p, OFF_ROUTE + 512 * 1024 + 2 * MiB);
    int total = 0;
#pragma unroll
    for (int k = 0; k < 16; ++k) total += ((int)CNT[k] + 255) & ~255;
    const size_t gtid = (size_t)bid * NTHR + tid_, gstride = (size_t)nblk * NTHR;
    for (size_t i = gtid; i < (size_t)total; i += gstride) {
        int o = 0, e_off = 0, e_n = 0, e_id = 0;
#pragma unroll
        for (int k = 0; k < 16; ++k) { const int nk = (int)CNT[k], r = (nk + 255) & ~255; if ((int)i >= o && (int)i < o + r) { e_off = o; e_n = nk; e_id = k; } o += r; }
        const int r = (int)i - e_off; GIDX[i] = r < e_n ? LIST[(size_t)e_id * T + r] : -1;
    }
}
__device__ __forceinline__ void ph_moe1(const P& p, int l, float* lds, int bid, int nblk, int tid_) {
    const unsigned* CNT = wsp<unsigned>(p, OFF_CTRL) + 64 * l; const int* GIDX = wsp<int>(p, OFF_ROUTE + 512 * 1024 + 2 * MiB);
    const bf16_t* X1B = wsp<bf16_t>(p, R_XQ + 128 * MiB);
    for (int e = 0; e < 16; ++e) {
        int off_e, rows; moe_range(CNT, e, off_e, rows); if (rows == 0) continue;
        EpiHid ep{wsp<bf16_t>(p, R_A2) + (size_t)off_e * 256};
        gemm_naive<true>(X1B, 1024, GIDX + off_e, wsp<bf16_t>(p, WGU) + (size_t)(l * 16 + e) * 512 * 1024, 1024, rows, 256, 1024, ep, NoMid{}, lds, bid, nblk, tid_);
    }
}
__device__ __forceinline__ void ph_moe2(const P& p, int l, float* lds, int bid, int nblk, int tid_) {
    const unsigned* CNT = wsp<unsigned>(p, OFF_CTRL) + 64 * l; const int* GIDX = wsp<int>(p, OFF_ROUTE + 512 * 1024 + 2 * MiB);
    for (int e = 0; e < 16; ++e) {
        int off_e, rows; moe_range(CNT, e, off_e, rows); if (rows == 0) continue;
        EpiDown ep{wsp<bf16_t>(p, R_XBZ), GIDX + off_e, wsp<float>(p, OFF_ROUTE + 256 * 1024)};
        gemm_naive<false>(wsp<bf16_t>(p, R_A2) + (size_t)off_e * 256, 256, nullptr, wsp<bf16_t>(p, WDN) + (size_t)(l * 16 + e) * 1024 * 256, 256, rows, 1024, 256, ep, NoMid{}, lds, bid, nblk, tid_);
    }
}
__device__ __forceinline__ void ph_ln2(const P& p, int l, int bid, int nblk, int tid_) {
    float* X1F = wsp<float>(p, R_XQ); bf16_t* X1B = wsp<bf16_t>(p, R_XQ + 128 * MiB); const bf16_t* Y = wsp<bf16_t>(p, R_XBZ);
    float* LOGF = wsp<float>(p, OFF_DT);
    const float* g = p.ln2_g + l * 1024; const float* bta = p.ln2_b + l * 1024;
    const int lane = tid_ & 63, wid = tid_ >> 6;
    for (int t = bid * 8 + wid; t < T; t += nblk * 8) {
        f32x4 v[4];
#pragma unroll
        for (int j = 0; j < 4; ++j) { const size_t o = (size_t)t * 1024 + j * 256 + lane * 4; const f32x4 xv = *(const f32x4*)(X1F + o);
            const u32x2 a = *(const u32x2*)(Y + o), b = *(const u32x2*)(Y + (size_t)T * 1024 + o);
            v[j] = xv * ALPHA + (f32x4){bflo(a.x) + bflo(b.x), bfhi(a.x) + bfhi(b.x), bflo(a.y) + bflo(b.y), bfhi(a.y) + bfhi(b.y)}; }
        ln_row(v, g, bta, lane);
        if (l == 1) {
#pragma unroll
            for (int j = 0; j < 4; ++j) *(f32x4*)(p.out + (size_t)t * 1024 + j * 256 + lane * 4) = v[j];
        } else {
#pragma unroll
            for (int j = 0; j < 4; ++j) { *(f32x4*)(X1F + (size_t)t * 1024 + j * 256 + lane * 4) = v[j]; st_bf16x4(X1B + (size_t)t * 1024 + j * 256 + lane * 4, v[j]); }
            float f[8];
#pragma unroll
            for (int e = 0; e < 8; ++e) f[e] = 0.f;
#pragma unroll
            for (int j = 0; j < 4; ++j)
#pragma unroll
                for (int i = 0; i < 4; ++i) { const int k = j * 256 + lane * 4 + i; const float* w = p.od_w_in + (size_t)k * ODD_IN + 1952;
#pragma unroll
                    for (int e = 0; e < 8; ++e) f[e] += v[j][i] * w[e]; }
#pragma unroll
            for (int e = 0; e < 8; ++e) f[e] = wave_sum(f[e]);
            if (lane < 8) { float fv = 0.f;
#pragma unroll
                for (int e = 0; e < 8; ++e) fv = (e == lane) ? f[e] : fv;
                LOGF[(size_t)t * 8 + lane] = logsigmoid_f(fv + p.od_f_bias[lane]); }
        }
    }
}

struct EpiIn1 {
    bf16_t* CQ; bf16_t* CKV; bf16_t* Q; bf16_t* K; float* SSQQ; float* SSQK; const float* tab;
    __device__ __forceinline__ void operator()(int row, int col, f32x4 v) const {
        const int tx = lane_id() & 15;
        if (col < 512) {
            const bool isq = col < 256; const bool iskv = (col >= 256 && col < 384);
            float s = (isq || iskv) ? (v[0] * v[0] + v[1] * v[1]) + (v[2] * v[2] + v[3] * v[3]) : 0.f;
            s += __shfl_xor(s, 1); s += __shfl_xor(s, 2); s += __shfl_xor(s, 4); s += __shfl_xor(s, 8);
            if (tx == 0) { if (isq) SSQQ[(size_t)row * 4 + (col >> 6)] = s; else SSQK[(size_t)row * 4 + ((col - 256) >> 6)] = s; }
            if (isq) st_bf16x4(CQ + (size_t)row * 256 + col, v);
            else {
                if (col >= 384 && col < 416) { const int sp = row & (S - 1), i0 = (col - 384) >> 1;
                    const float c0 = tab[sp * 16 + i0], s0 = tab[S * 16 + sp * 16 + i0], c1 = tab[sp * 16 + i0 + 1], s1 = tab[S * 16 + sp * 16 + i0 + 1];
                    v = (f32x4){v[0] * c0 - v[1] * s0, v[1] * c0 + v[0] * s0, v[2] * c1 - v[3] * s1, v[3] * c1 + v[2] * s1}; }
                st_bf16x4(CKV + (size_t)row * 256 + (col - 256), v);
            }
        } else if (col < 1024) st_bf16x4(Q + (size_t)row * 512 + (col - 512), v * C2_64);
        else st_bf16x4(K + (size_t)row * 512 + (col - 1024), v);
    }
};
__device__ __forceinline__ void ph_inproj1(const P& p, float* lds, int bid, int nblk, int tid_) {
    const bf16_t* XB = wsp<bf16_t>(p, R_XQ + 128 * MiB);
    EpiIn1 e{wsp<bf16_t>(p, R_XBZ), wsp<bf16_t>(p, R_XBZ + 16 * MiB), wsp<bf16_t>(p, R_XBZ + 32 * MiB), wsp<bf16_t>(p, R_XBZ + 64 * MiB),
             wsp<float>(p, OFF_SSQ), wsp<float>(p, OFF_SSQ + 512 * 1024), wsp<float>(p, OFF_TAB)};
    gemm_naive<false>(XB, 1024, nullptr, wsp<bf16_t>(p, W1M), 1024, T, 1536, 1024, e, NoMid{}, lds, bid, nblk, tid_);
    EpiVt ev{wsp<bf16_t>(p, R_XBZ + 96 * MiB)};
    gemm_naive<false>(wsp<bf16_t>(p, W1V), 1024, nullptr, XB, 1024, 512, T, 1024, ev, NoMid{}, lds, bid, nblk, tid_);
}
__device__ __forceinline__ float rs4(const float* s, int row, float inv_n) { const f32x4 v = *(const f32x4*)(s + (size_t)row * 4); return rsqrtf(((v[0] + v[1]) + (v[2] + v[3])) * inv_n + 1e-6f); }
struct EpiQup { bf16_t* QM; const float* SSQQ; const float* tab;
    __device__ __forceinline__ void operator()(int row, int col, f32x4 v) const {
        v = v * rs4(SSQQ, row, 1.0f / 256.0f);
        const int j = col % 96;
        if (j >= 64) { const int sp = row & (S - 1), i0 = (j - 64) >> 1;
            const float c0 = tab[sp * 16 + i0], s0 = tab[S * 16 + sp * 16 + i0], c1 = tab[sp * 16 + i0 + 1], s1 = tab[S * 16 + sp * 16 + i0 + 1];
            v = (f32x4){v[0] * c0 - v[1] * s0, v[1] * c0 + v[0] * s0, v[2] * c1 - v[3] * s1, v[3] * c1 + v[2] * s1}; }
        st_bf16x4(QM + (size_t)row * 768 + col, v * C2_96);
    } };
struct EpiKup { bf16_t* KN; const float* SSQK; __device__ __forceinline__ void operator()(int row, int col, f32x4 v) const { st_bf16x4(KN + (size_t)row * 512 + col, v * rs4(SSQK, row, 1.0f / 128.0f)); } };
struct EpiVup { bf16_t* VtM; const float* SSQK; __device__ __forceinline__ void operator()(int row, int col, f32x4 v) const {
        v = (f32x4){v[0] * rs4(SSQK, col, 1.0f / 128.0f), v[1] * rs4(SSQK, col + 1, 1.0f / 128.0f), v[2] * rs4(SSQK, col + 2, 1.0f / 128.0f), v[3] * rs4(SSQK, col + 3, 1.0f / 128.0f)};
        st_bf16x4(VtM + (size_t)row * T + col, v); } };
__device__ __forceinline__ void ph_upproj(const P& p, float* lds, int bid, int nblk, int tid_) {
    const bf16_t* CQ = wsp<bf16_t>(p, R_XBZ); const bf16_t* CKV = wsp<bf16_t>(p, R_XBZ + 16 * MiB);
    const float* SSQQ = wsp<float>(p, OFF_SSQ); const float* SSQK = wsp<float>(p, OFF_SSQ + 512 * 1024);
    EpiQup eq{wsp<bf16_t>(p, R_A2), SSQQ, wsp<float>(p, OFF_TAB)};
    gemm_naive<false>(CQ, 256, nullptr, wsp<bf16_t>(p, W1Q), 256, T, 768, 256, eq, NoMid{}, lds, bid, nblk, tid_);
    EpiKup ek{wsp<bf16_t>(p, R_A2 + 48 * MiB), SSQK};
    gemm_naive<false>(CKV, 256, nullptr, wsp<bf16_t>(p, W1K), 128, T, 512, 128, ek, NoMid{}, lds, bid, nblk, tid_);
    EpiVup ev{wsp<bf16_t>(p, R_A2 + 80 * MiB), SSQK};
    gemm_naive<false>(wsp<bf16_t>(p, W1VV), 128, nullptr, CKV, 256, 512, T, 128, ev, NoMid{}, lds, bid, nblk, tid_);
    const float* LOGF = wsp<float>(p, OFF_DT); float* FH2 = wsp<float>(p, OFF_DT + 1 * MiB);
    const int lane = tid_ & 63, wid = tid_ >> 6;
    for (int u = bid * 8 + wid; u < NB * 8; u += nblk * 8) {
        const int b = u >> 3, h = u & 7;
        float loc[32]; float run = 0.f;
#pragma unroll
        for (int i = 0; i < 32; ++i) { run += LOGF[((size_t)b * S + lane * 32 + i) * 8 + h]; loc[i] = run; }
        float incl = run;
#pragma unroll
        for (int o = 1; o < 64; o <<= 1) { const float nb = __shfl_up(incl, o); if (lane >= o) incl += nb; }
        const float excl = incl - run;
#pragma unroll
        for (int i = 0; i < 32; ++i) FH2[(size_t)u * S + lane * 32 + i] = (excl + loc[i]) * LOG2E;
    }
}
__device__ __forceinline__ void ph_attn1_naive(const P& p, int bid, int nblk, int tid_) {
    const bf16_t* QM = wsp<bf16_t>(p, R_A2); const bf16_t* KN = wsp<bf16_t>(p, R_A2 + 48 * MiB); const bf16_t* VtM = wsp<bf16_t>(p, R_A2 + 80 * MiB);
    const bf16_t* CKV = wsp<bf16_t>(p, R_XBZ + 16 * MiB);
    const bf16_t* Qf = wsp<bf16_t>(p, R_XBZ + 32 * MiB); const bf16_t* Kf = wsp<bf16_t>(p, R_XBZ + 64 * MiB); const bf16_t* Vtf = wsp<bf16_t>(p, R_XBZ + 96 * MiB);
    const float* FH2 = wsp<float>(p, OFF_DT + 1 * MiB);
    bf16_t* A2 = wsp<bf16_t>(p, R_XQ + 128 * MiB);
    const int lane = tid_ & 63, wid = tid_ >> 6;
    const int nper = NB * 8 * (S / 64);
    for (int u = bid * 8 + wid; u < 2 * nper; u += nblk * 8) {
        const bool fox = u >= nper; const int uu = fox ? u - nper : u;
        const int tb = (S / 64 - 1) - (uu % (S / 64)), bh = uu / (S / 64), b = bh >> 3, h = bh & 7;
        const int t0 = tb * 64, t = t0 + lane; const size_t row = (size_t)b * S + t;
        float o[64];
#pragma unroll
        for (int d = 0; d < 64; ++d) o[d] = 0.f;
        float m = -INFINITY, lsum = 0.f;
        if (!fox) {
            unsigned qp[48];
#pragma unroll
            for (int d = 0; d < 96; d += 8) { const u32x4 v = *(const u32x4*)(QM + row * 768 + h * 96 + d);
#pragma unroll
                for (int j = 0; j < 4; ++j) qp[d / 2 + j] = v[j]; }
            for (int s = 0; s < t0 + 64; ++s) {
                const size_t kr = (size_t)b * S + s; float z = 0.f;
#pragma unroll
                for (int d = 0; d < 64; d += 8) { const u32x4 v = *(const u32x4*)(KN + kr * 512 + h * 64 + d);
#pragma unroll
                    for (int j = 0; j < 4; ++j) { z += bflo(qp[d / 2 + j]) * bflo(v[j]); z += bfhi(qp[d / 2 + j]) * bfhi(v[j]); } }
#pragma unroll
                for (int d = 0; d < 32; d += 8) { const u32x4 v = *(const u32x4*)(CKV + kr * 256 + 128 + d);
#pragma unroll
                    for (int j = 0; j < 4; ++j) { z += bflo(qp[32 + d / 2 + j]) * bflo(v[j]); z += bfhi(qp[32 + d / 2 + j]) * bfhi(v[j]); } }
                const float mn = fmaxf(m, z), corr = exp2f(m - mn), pw = exp2f(z - mn); m = mn; lsum = lsum * corr + pw;
                const bf16_t* vc = VtM + (size_t)(h * 64) * T + kr;
#pragma unroll
                for (int d = 0; d < 64; ++d) o[d] = o[d] * corr + pw * bf2f(vc[(size_t)d * T]);
            }
        } else {
            unsigned qp[32];
#pragma unroll
            for (int d = 0; d < 64; d += 8) { const u32x4 v = *(const u32x4*)(Qf + row * 512 + h * 64 + d);
#pragma unroll
                for (int j = 0; j < 4; ++j) qp[d / 2 + j] = v[j]; }
            const float fht = FH2[(size_t)bh * S + t];
            for (int s = 0; s < t0 + 64; ++s) {
                const size_t kr = (size_t)b * S + s; float z = 0.f;
#pragma unroll
                for (int d = 0; d < 64; d += 8) { const u32x4 v = *(const u32x4*)(Kf + kr * 512 + h * 64 + d);
#pragma unroll
                    for (int j = 0; j < 4; ++j) { z += bflo(qp[d / 2 + j]) * bflo(v[j]); z += bfhi(qp[d / 2 + j]) * bfhi(v[j]); } }
                z += fht - FH2[(size_t)bh * S + s];
                if (s <= t) {
                    const float mn = fmaxf(m, z), corr = exp2f(m - mn), pw = exp2f(z - mn); m = mn; lsum = lsum * corr + pw;
                    const bf16_t* vc = Vtf + (size_t)(h * 64) * T + kr;
#pragma unroll
                    for (int d = 0; d < 64; ++d) o[d] = o[d] * corr + pw * bf2f(vc[(size_t)d * T]);
                }
            }
        }
        const float inv = 1.0f / lsum;
#pragma unroll
        for (int d = 0; d < 64; d += 4) st_bf16x4(A2 + row * 1024 + (fox ? 512 : 0) + h * 64 + d, (f32x4){o[d] * inv, o[d + 1] * inv, o[d + 2] * inv, o[d + 3] * inv});
    }
}
__device__ __forceinline__ void ph_outproj1(const P& p, float* lds, int bid, int nblk, int tid_) {
    EpiRes e{wsp<float>(p, R_XQ), wsp<float>(p, R_XBZ)};
    gemm_naive<false>(wsp<bf16_t>(p, R_XQ + 128 * MiB), 1024, nullptr, wsp<bf16_t>(p, W1O), 1024, T, 1024, 1024, e, NoMid{}, lds, bid, nblk, tid_);
}

constexpr int LDS_STAGE = pg8::STAGE_BYTES;
constexpr int LDS_TAB_OFF = LDS_STAGE;
constexpr int LDS_TAB_BYTES = 16 * 1024;
#define LDSP(smem) ((PG8_LAS unsigned char*)(smem))

__device__ __forceinline__ void st_bf16x8(bf16_t* p, f32x4 a, f32x4 b) { u32x4 w; w[0] = pk_bf16(a[0], a[1]); w[1] = pk_bf16(a[2], a[3]); w[2] = pk_bf16(b[0], b[1]); w[3] = pk_bf16(b[2], b[3]); *(u32x4*)p = w; }
__device__ __forceinline__ void epi_store_bf16p(const f32x4 (&acc)[2][2][4][2], const pg8::Unit& u, int wr, int wc, int fr, int fq, bf16_t* base, int ld, int c0, float sc) {
#pragma unroll
    for (int ai = 0; ai < 2; ++ai)
#pragma unroll
        for (int m = 0; m < 4; ++m) { bf16_t* rp = base + (size_t)(u.pm * 256 + ai * 128 + wr * 64 + m * 16 + fr) * ld + c0 + wc * 32 + fq * 8;
#pragma unroll
            for (int bj = 0; bj < 2; ++bj) st_bf16x8(rp + bj * 128, acc[ai][bj][m][0] * sc, acc[ai][bj][m][1] * sc); }
}
__device__ __forceinline__ void epi_store_bf16(const f32x4 (&acc)[2][2][4][2], const pg8::Unit& u, int wr, int wc, int fr, int fq, bf16_t* base, int ld, int c0, float sc) {
#pragma unroll
    for (int ai = 0; ai < 2; ++ai)
#pragma unroll
        for (int m = 0; m < 4; ++m) { bf16_t* rp = base + (size_t)(u.pm * 256 + ai * 128 + wr * 64 + m * 16 + fr) * ld + c0 + wc * 32 + fq * 4;
#pragma unroll
            for (int bj = 0; bj < 2; ++bj)
#pragma unroll
                for (int n = 0; n < 2; ++n) st_bf16x4(rp + bj * 128 + n * 16, acc[ai][bj][m][n] * sc); }
}
__device__ __forceinline__ void EpiMixMf::operator()(const f32x4 (&acc)[2][2][4][2], const pg8::Unit& u, int, int wr, int wc, int fr, int fq) const { epi_store_bf16p(acc, u, wr, wc, fr, fq, MIX, 1024, u.pn * 256, 1.f); }
struct EpiIn0Mf { bf16_t* Z; bf16_t* XBCR; bf16_t* Q; bf16_t* K;
    __device__ __forceinline__ void operator()(const f32x4 (&acc)[2][2][4][2], const pg8::Unit& u, int, int wr, int wc, int fr, int fq) const {
        bf16_t* base; int ld, c0; float sc = 1.f;
        if (u.pn < 4) { base = Z; ld = 1024; c0 = u.pn * 256; }
        else if (u.pn < 10) { base = XBCR; ld = 1536; c0 = (u.pn - 4) * 256; }
        else if (u.pn < 12) { base = Q; ld = 512; c0 = (u.pn - 10) * 256; sc = C2_64; }
        else { base = K; ld = 512; c0 = (u.pn - 12) * 256; }
        epi_store_bf16p(acc, u, wr, wc, fr, fq, base, ld, c0, sc); } };
struct EpiVtMf { bf16_t* Vt; __device__ __forceinline__ void operator()(const f32x4 (&acc)[2][2][4][2], const pg8::Unit& u, int, int wr, int wc, int fr, int fq) const {
        epi_store_bf16p(acc, u, wr, wc, fr, fq, Vt, T, u.pn * 256, 1.f); } };
template <class E1, class E2> struct EpiDual { E1 e1; E2 e2;
    __device__ __forceinline__ void operator()(const f32x4 (&acc)[2][2][4][2], const pg8::Unit& u, int ui, int wr, int wc, int fr, int fq) const {
        if (u.e == 0) e1(acc, u, ui, wr, wc, fr, fq); else e2(acc, u, ui, wr, wc, fr, fq); } };
template <class F> __device__ __forceinline__ void mf_dense(unsigned char* smem, const bf16_t* A, int lda, const bf16_t* Bt, int ldb, int M, int N, int K, const F& f, int bid, int nblk, int tid_) {
    pg8::Gemm g{A, Bt, lda, ldb, K, nullptr}; pg8::DenseOrder S; S.init(M, N, lda, ldb, nblk, bid);
    pg8::EpiWrap<F> E{f};
    pg8::gemm_phase<pg8::EpiWrap<F>, pg8::DenseOrder, pg8::NoMidK, false>(LDSP(smem), g, S, E, pg8::NoMidK{}, tid_);
}
template <bool PERM, class E_> __device__ __forceinline__ void mf_dense_e(unsigned char* smem, const bf16_t* A, int lda, const bf16_t* Bt, int ldb, int M, int N, int K, const E_& E, int bid, int nblk, int tid_) {
    pg8::Gemm g{A, Bt, lda, ldb, K, nullptr}; pg8::DenseOrder S; S.init(M, N, lda, ldb, nblk, bid);
    pg8::gemm_phase<E_, pg8::DenseOrder, pg8::NoMidK, false, PERM>(LDSP(smem), g, S, E, pg8::NoMidK{}, tid_);
}
__device__ __forceinline__ void ph_inproj0_mf(const P& p, unsigned char* smem, int bid, int nblk, int tid_) {
    const bf16_t* XB = wsp<bf16_t>(p, R_XBZ);
    EpiIn0Mf e{wsp<bf16_t>(p, R_XBZ + 64 * MiB), wsp<bf16_t>(p, R_A2), wsp<bf16_t>(p, R_XQ + 96 * MiB), wsp<bf16_t>(p, R_XQ + 128 * MiB)};
    EpiVtMf ev{wsp<bf16_t>(p, R_XQ + 160 * MiB)};
    const bf16_t* W0Mp = wsp<bf16_t>(p, W0M); const bf16_t* W0Vp = wsp<bf16_t>(p, W0V);
    pg8::DualOrder S; S.s1.init(T, 3584, 1024, 1024, nblk, bid); S.s2.init(512, T, 1024, 1024, nblk, bid);
    S.a2off = (const char*)W0Vp - (const char*)XB; S.b2off = (const char*)XB - (const char*)W0Mp;
    EpiDual<EpiIn0Mf, EpiVtMf> E{e, ev};
    pg8::Gemm g{XB, W0Mp, 1024, 1024, 1024, nullptr};
    pg8::gemm_phase<EpiDual<EpiIn0Mf, EpiVtMf>, pg8::DualOrder, pg8::NoMidK, false, true>(LDSP(smem), g, S, E, pg8::NoMidK{}, tid_);
}
struct MidRmsK { static constexpr int ktile = 16; const PG8_LAS float* rs;
    __device__ __forceinline__ void apply(f32x4 (&acc)[2][2][4][2], int ui, int wr, int fr) const {
#pragma unroll
        for (int ai = 0; ai < 2; ++ai)
#pragma unroll
            for (int m = 0; m < 4; ++m) { const float s = rs[ui * 256 + ai * 128 + wr * 64 + m * 16 + fr];
#pragma unroll
                for (int bj = 0; bj < 2; ++bj)
#pragma unroll
                    for (int n = 0; n < 2; ++n) acc[ai][bj][m][n] *= s; } } };
constexpr int NSSQ = USE_SSD ? 32 : 16;
__device__ __forceinline__ void ph_outproj0_mf(const P& p, unsigned char* smem, int bid, int nblk, int tid_) {
    const float* SSQ = wsp<float>(p, OFF_SSQ);
    PG8_LAS float* rs = (PG8_LAS float*)(LDSP(smem) + LDS_TAB_OFF);
    pg8::Gemm g{wsp<bf16_t>(p, R_A2), wsp<bf16_t>(p, W0O), 1536, 1536, 1536, nullptr}; pg8::DenseOrder S; S.init(T, 1024, 1536, 1536, nblk, bid);
    for (int idx = tid_; idx < 8 * 256; idx += NTHR) { pg8::Unit u; const int ui = idx >> 8, r = idx & 255;
        if (S.next(ui, u)) { const int row = u.pm * 256 + r; float s = 0.f;
#pragma unroll
            for (int h = 0; h < NSSQ; h += 4) { const f32x4 v = *(const f32x4*)(SSQ + (size_t)row * NSSQ + h); s += (v[0] + v[1]) + (v[2] + v[3]); }
            rs[idx] = rsqrtf(s * (1.0f / 1024.0f) + 1e-6f); } }
    __syncthreads();
    EpiMixMf E{wsp<bf16_t>(p, R_XBZ)}; MidRmsK mid{rs};
    pg8::gemm_phase<EpiMixMf, pg8::DenseOrder, MidRmsK, false, true>(LDSP(smem), g, S, E, mid, tid_);
}
constexpr size_t OFF_DONE = OFF_CTRL + 4096;
constexpr size_t OFF_LIST = R_A2 + 100 * MiB;
constexpr int NLIST = 24;
__device__ __forceinline__ void pair_experts(int lid, int& elo, int& ehi) { const int gs = lid / 6, pid = lid % 6;
    const int lo = pid < 3 ? 0 : (pid < 5 ? 1 : 2), hi = pid < 3 ? pid + 1 : (pid < 5 ? pid - 1 : 3); elo = gs * 4 + lo; ehi = gs * 4 + hi; }
template <int PHASE> struct MoeOrder {
    static constexpr int NPN = 4;
    static constexpr bool HOOK = PHASE == 2;
    static constexpr int BSEAM = PHASE == 2 ? 4 : 0;
    int cnt[NLIST]; int G, c; unsigned* done; int nA, nB, qlo, NBtot, N2;
    __device__ __forceinline__ void init(const unsigned* CNT, unsigned* done_, int G_, int c_) {
        int tiles = 0;
#pragma unroll
        for (int k = 0; k < NLIST; ++k) { cnt[k] = (int)CNT[k]; tiles += (cnt[k] + 255) >> 8; }
        G = G_; c = c_; done = done_;
        const int n1 = tiles * 4; N2 = tiles * 4; nA = n1 % G; nB = G - nA;
        int q = (N2 + G - 1) / G;
        while (nB * q + nA * (q > 2 ? q - 2 : 0) < N2) ++q;
        qlo = q > 2 ? q - 2 : 0; NBtot = N2 - nA * qlo; if (NBtot < 0) NBtot = 0; }
    __device__ __forceinline__ bool next(int i, pg8::Unit& u) const {
        int L;
        if (PHASE == 1) L = i * G + c;
        else if (c >= nA) { L = i * nB + (c - nA); if (L >= NBtot) L = 1 << 30; }
        else { L = NBtot + i * nA + c; if (i >= qlo) L = 1 << 30; }
        int base = 0, off = 0; bool found = false;
        u.pm = 0; u.pn = 0; u.e = 0; u.g0 = 0;
#pragma unroll
        for (int k = 0; k < NLIST; ++k) { const int te = (cnt[k] + 255) >> 8, nu = te * NPN;
            if (!found && L < base + nu) { const int loc = L - base; u.e = k; u.pm = loc / NPN; u.pn = loc % NPN; u.g0 = off + u.pm * 256; found = true; }
            base += nu; off += te * 256; }
        int elo, ehi; pair_experts(u.e, elo, ehi);
        if (PHASE == 1) { u.aoff = 0; u.boff = ((size_t)((u.pn >> 1) ? ehi : elo) * 512 + (u.pn & 1) * 256) * 1024 * 2; u.boff2 = u.boff; }
        else { u.aoff = (size_t)u.g0 * 512 * 2; u.boff = ((size_t)elo * 1024 + u.pn * 256) * 256 * 2; u.boff2 = ((size_t)ehi * 1024 + u.pn * 256) * 256 * 2 - (size_t)BSEAM * 128; }
        return found; }
    __device__ __forceinline__ int count(int e) const { int r = 0;
#pragma unroll
        for (int k = 0; k < NLIST; ++k) r = (k == e) ? cnt[k] : r;
        return r; }
    __device__ __forceinline__ void a_ready(const pg8::Unit& u, int wid) const {
        if (wid == 0) { unsigned* w = done + (u.g0 >> 8); unsigned sp = 0;
            while (__hip_atomic_load(w, __ATOMIC_RELAXED, __HIP_MEMORY_SCOPE_AGENT) < 32u) { __builtin_amdgcn_s_sleep(2); if (++sp > (1u << 22)) break; }
            __builtin_amdgcn_fence(__ATOMIC_ACQUIRE, "agent"); asm volatile("s_waitcnt vmcnt(0)" ::: "memory"); }
        __builtin_amdgcn_s_barrier(); asm volatile("" ::: "memory"); }
};
__device__ __forceinline__ void st16_sc1(void* p, u32x4 v) { asm volatile("global_store_dwordx4 %0, %1, off sc1" :: "v"(p), "v"(v) : "memory"); }
struct EpiHidMf { bf16_t* HID; unsigned* done; const PG8_LAS int* gl; const float* TOKW;
    __device__ __forceinline__ void operator()(const f32x4 (&acc)[2][2][4][2], const pg8::Unit& u, int ui, int wr, int wc, int fr, int fq) const {
        const int hi = u.pn >> 1;
#pragma unroll
        for (int ai = 0; ai < 2; ++ai)
#pragma unroll
            for (int m = 0; m < 4; ++m) { const int rl = ai * 128 + wr * 64 + m * 16 + fr; const size_t hrow = (size_t)u.g0 + rl; u32x4 w;
                const float tw = TOKW[gl[ui * 256 + rl] * 2 + hi];
#pragma unroll
                for (int n = 0; n < 2; ++n) { const f32x4 gt = acc[ai][0][m][n], up = acc[ai][1][m][n] * tw;
                    w[2 * n] = pk_bf16(silu_f(gt[0]) * up[0], silu_f(gt[1]) * up[1]); w[2 * n + 1] = pk_bf16(silu_f(gt[2]) * up[2], silu_f(gt[3]) * up[3]); }
                st16_sc1(HID + hrow * 512 + hi * 256 + (u.pn & 1) * 128 + wc * 32 + fq * 8, w); }
        asm volatile("s_waitcnt vmcnt(0)" ::: "memory");
        if (fr == 0 && fq == 0) __hip_atomic_fetch_add(done + (u.g0 >> 8), 1u, __ATOMIC_RELAXED, __HIP_MEMORY_SCOPE_AGENT); } };
__device__ __forceinline__ void ph_moe1_mf(const P& p, int l, unsigned char* smem, int bid, int nblk, int tid_) {
    const unsigned* CNT = wsp<unsigned>(p, OFF_CTRL) + 64 * l; const int* LIST = wsp<int>(p, OFF_LIST);
    PG8_LAS int* gl = (PG8_LAS int*)(LDSP(smem) + LDS_TAB_OFF);
    unsigned* done = wsp<unsigned>(p, OFF_DONE) + 512 * l;
    MoeOrder<1> S; S.init(CNT, done, nblk, bid);
    for (int idx = tid_; idx < 8 * 256; idx += NTHR) { pg8::Unit u; const int ui = idx >> 8, r = idx & 255;
        if (S.next(ui, u)) { const int li = u.pm * 256 + r; gl[idx] = (li < S.count(u.e)) ? LIST[(size_t)u.e * T + li] : 0; } }
    __syncthreads();
    pg8::Gemm g{wsp<bf16_t>(p, R_XQ + 128 * MiB), wsp<bf16_t>(p, WGU) + (size_t)l * 16 * 512 * 1024, 1024, 1024, 1024, gl};
    EpiHidMf E{wsp<bf16_t>(p, R_A2), done, gl, wsp<float>(p, OFF_ROUTE + 256 * 1024)};
    pg8::gemm_phase<EpiHidMf, MoeOrder<1>, pg8::NoMidK, true, true>(LDSP(smem), g, S, E, pg8::NoMidK{}, tid_);
}
struct EpiDownMf { bf16_t* Y; const PG8_LAS int* ent;
    __device__ __forceinline__ void operator()(const f32x4 (&acc)[2][2][4][2], const pg8::Unit& u, int ui, int wr, int wc, int fr, int fq) const {
#pragma unroll
        for (int ai = 0; ai < 2; ++ai)
#pragma unroll
            for (int m = 0; m < 4; ++m) { const int r = ui * 256 + ai * 128 + wr * 64 + m * 16 + fr; const int en = ent[r];
                if (en >= 0) { bf16_t* yr = Y + (size_t)en * 1024 + u.pn * 256 + wc * 32 + fq * 8;
#pragma unroll
                    for (int bj = 0; bj < 2; ++bj) st_bf16x8(yr + bj * 128, acc[ai][bj][m][0], acc[ai][bj][m][1]); } } } };
__device__ __forceinline__ void ph_moe2_mf(const P& p, int l, unsigned char* smem, int bid, int nblk, int tid_) {
    const unsigned* CNT = wsp<unsigned>(p, OFF_CTRL) + 64 * l; const int* LIST = wsp<int>(p, OFF_LIST);
    PG8_LAS int* ent = (PG8_LAS int*)(LDSP(smem) + LDS_TAB_OFF);
    MoeOrder<2> S; S.init(CNT, wsp<unsigned>(p, OFF_DONE) + 512 * l, nblk, bid);
    for (int idx = tid_; idx < 8 * 256; idx += NTHR) { pg8::Unit u; const int ui = idx >> 8, r = idx & 255;
        if (S.next(ui, u)) { const int li = u.pm * 256 + r; ent[idx] = (li < S.count(u.e)) ? LIST[(size_t)u.e * T + li] : -1; } }
    __syncthreads();
    pg8::Gemm g{wsp<bf16_t>(p, R_A2), wsp<bf16_t>(p, WDN) + (size_t)l * 16 * 1024 * 256, 512, 256, 512, nullptr};
    EpiDownMf E{wsp<bf16_t>(p, R_XBZ), ent};
    pg8::gemm_phase<EpiDownMf, MoeOrder<2>, pg8::NoMidK, false, true>(LDSP(smem), g, S, E, pg8::NoMidK{}, tid_);
}
struct EpiIn1Mf { bf16_t* CQ; bf16_t* CKV; bf16_t* Q; bf16_t* K; float* SSQQ; float* SSQK; const float* tab;
    __device__ __forceinline__ void operator()(const f32x4 (&acc)[2][2][4][2], const pg8::Unit& u, int, int wr, int wc, int fr, int fq) const {
        if (u.pn == 0) {
#pragma unroll
            for (int ai = 0; ai < 2; ++ai)
#pragma unroll
                for (int m = 0; m < 4; ++m) { const size_t row = (size_t)u.pm * 256 + ai * 128 + wr * 64 + m * 16 + fr; float s = 0.f;
#pragma unroll
                    for (int bj = 0; bj < 2; ++bj) {
#pragma unroll
                        for (int n = 0; n < 2; ++n) { const f32x4 v = acc[ai][bj][m][n]; s += (v[0] * v[0] + v[1] * v[1]) + (v[2] * v[2] + v[3] * v[3]); }
                        st_bf16x8(CQ + row * 256 + bj * 128 + wc * 32 + fq * 8, acc[ai][bj][m][0], acc[ai][bj][m][1]); }
                    s += __shfl_xor(s, 16); s += __shfl_xor(s, 32);
                    if (fq == 0) SSQQ[row * 4 + wc] = s; }
        } else if (u.pn == 1) {
#pragma unroll
            for (int ai = 0; ai < 2; ++ai)
#pragma unroll
                for (int m = 0; m < 4; ++m) { const size_t row = (size_t)u.pm * 256 + ai * 128 + wr * 64 + m * 16 + fr; float s = 0.f;
#pragma unroll
                    for (int n = 0; n < 2; ++n) { const f32x4 v = acc[ai][0][m][n]; s += (v[0] * v[0] + v[1] * v[1]) + (v[2] * v[2] + v[3] * v[3]); }
                    st_bf16x8(CKV + row * 256 + wc * 32 + fq * 8, acc[ai][0][m][0], acc[ai][0][m][1]);
                    s += __shfl_xor(s, 16); s += __shfl_xor(s, 32);
                    if (fq == 0) SSQK[row * 4 + wc] = s;
                    if (wc == 0) { const int sp = (int)(row & (S - 1)); f32x4 vv[2];
#pragma unroll
                        for (int n = 0; n < 2; ++n) { f32x4 v = acc[ai][1][m][n]; const int cp = fq * 8 + n * 4, i0 = cp >> 1;
                            const float c0 = tab[sp * 16 + i0], s0 = tab[S * 16 + sp * 16 + i0], c1 = tab[sp * 16 + i0 + 1], s1 = tab[S * 16 + sp * 16 + i0 + 1];
                            vv[n] = (f32x4){v[0] * c0 - v[1] * s0, v[1] * c0 + v[0] * s0, v[2] * c1 - v[3] * s1, v[3] * c1 + v[2] * s1}; }
                        st_bf16x8(CKV + row * 256 + 128 + fq * 8, vv[0], vv[1]); } }
        } else {
            const bool isq = u.pn < 4;
            epi_store_bf16p(acc, u, wr, wc, fr, fq, isq ? Q : K, 512, (isq ? u.pn - 2 : u.pn - 4) * 256, isq ? C2_64 : 1.f);
        } } };
__device__ __forceinline__ void ph_inproj1_mf(const P& p, unsigned char* smem, int bid, int nblk, int tid_) {
    const bf16_t* XB = wsp<bf16_t>(p, R_XQ + 128 * MiB);
    EpiIn1Mf E{wsp<bf16_t>(p, R_XBZ), wsp<bf16_t>(p, R_XBZ + 16 * MiB), wsp<bf16_t>(p, R_XBZ + 32 * MiB), wsp<bf16_t>(p, R_XBZ + 64 * MiB),
               wsp<float>(p, OFF_SSQ), wsp<float>(p, OFF_SSQ + 512 * 1024), wsp<float>(p, OFF_TAB)};
    EpiVtMf ev{wsp<bf16_t>(p, R_XBZ + 96 * MiB)};
    const bf16_t* W1Mp = wsp<bf16_t>(p, W1M); const bf16_t* W1Vp = wsp<bf16_t>(p, W1V);
    pg8::DualOrder S; S.s1.init(T, 1536, 1024, 1024, nblk, bid); S.s2.init(512, T, 1024, 1024, nblk, bid);
    S.a2off = (const char*)W1Vp - (const char*)XB; S.b2off = (const char*)XB - (const char*)W1Mp;
    EpiDual<EpiIn1Mf, EpiVtMf> E2{E, ev};
    pg8::Gemm g{XB, W1Mp, 1024, 1024, 1024, nullptr};
    pg8::gemm_phase<EpiDual<EpiIn1Mf, EpiVtMf>, pg8::DualOrder, pg8::NoMidK, false, true>(LDSP(smem), g, S, E2, pg8::NoMidK{}, tid_);
}
__device__ __forceinline__ void ph_fh_cumsum(const P& p, int bid, int nblk, int tid_) {
    const float* LOGF = wsp<float>(p, OFF_DT); float* FH2 = wsp<float>(p, OFF_DT + 1 * MiB);
    const int lane = tid_ & 63, wid = tid_ >> 6;
    for (int u = bid * 8 + wid; u < NB * 8; u += nblk * 8) {
        const int b = u >> 3, h = u & 7;
        float loc[32]; float run = 0.f;
#pragma unroll
        for (int i = 0; i < 32; ++i) { run += LOGF[((size_t)b * S + lane * 32 + i) * 8 + h]; loc[i] = run; }
        float incl = run;
#pragma unroll
        for (int o = 1; o < 64; o <<= 1) { const float nb = __shfl_up(incl, o); if (lane >= o) incl += nb; }
        const float excl = incl - run;
#pragma unroll
        for (int i = 0; i < 32; ++i) FH2[(size_t)u * S + lane * 32 + i] = (excl + loc[i]) * LOG2E;
    }
}
template <bool BYCOL> __device__ __forceinline__ void fill_scale(const pg8::DenseOrder& S, PG8_LAS float* tab, const float* SSQ, float inv_n, int tid_) {
    for (int idx = tid_; idx < 8 * 256; idx += NTHR) { pg8::Unit u; const int ui = idx >> 8, r = idx & 255;
        if (S.next(ui, u)) tab[idx] = rs4(SSQ, (BYCOL ? u.pn : u.pm) * 256 + r, inv_n); }
    __syncthreads();
}
struct EpiQupMf { bf16_t* QM; const PG8_LAS float* rs; const float* tab;
    __device__ __forceinline__ void operator()(const f32x4 (&acc)[2][2][4][2], const pg8::Unit& u, int ui, int wr, int wc, int fr, int fq) const {
#pragma unroll
        for (int ai = 0; ai < 2; ++ai)
#pragma unroll
            for (int m = 0; m < 4; ++m) { const int r = ai * 128 + wr * 64 + m * 16 + fr; const size_t row = (size_t)u.pm * 256 + r; const float sc = rs[ui * 256 + r] * C2_96; const int sp = (int)(row & (S - 1));
#pragma unroll
                for (int bj = 0; bj < 2; ++bj) { f32x4 vv[2]; const int col8 = u.pn * 256 + bj * 128 + wc * 32 + fq * 8;
#pragma unroll
                    for (int n = 0; n < 2; ++n) { const int col = col8 + 4 * n; f32x4 v = acc[ai][bj][m][n] * sc; const int j = col % 96;
                        if (j >= 64) { const int i0 = (j - 64) >> 1;
                            const float c0 = tab[sp * 16 + i0], s0 = tab[S * 16 + sp * 16 + i0], c1 = tab[sp * 16 + i0 + 1], s1 = tab[S * 16 + sp * 16 + i0 + 1];
                            v = (f32x4){v[0] * c0 - v[1] * s0, v[1] * c0 + v[0] * s0, v[2] * c1 - v[3] * s1, v[3] * c1 + v[2] * s1}; }
                        vv[n] = v; }
                    st_bf16x8(QM + row * 768 + col8, vv[0], vv[1]); }
                asm volatile("" ::: "memory"); } } };
struct EpiKupMf { bf16_t* KN; const PG8_LAS float* rs;
    __device__ __forceinline__ void operator()(const f32x4 (&acc)[2][2][4][2], const pg8::Unit& u, int ui, int wr, int wc, int fr, int fq) const {
#pragma unroll
        for (int ai = 0; ai < 2; ++ai)
#pragma unroll
            for (int m = 0; m < 4; ++m) { const int r = ai * 128 + wr * 64 + m * 16 + fr; const size_t row = (size_t)u.pm * 256 + r; const float sc = rs[ui * 256 + r];
#pragma unroll
                for (int bj = 0; bj < 2; ++bj) st_bf16x8(KN + row * 512 + u.pn * 256 + bj * 128 + wc * 32 + fq * 8, acc[ai][bj][m][0] * sc, acc[ai][bj][m][1] * sc); } } };
struct EpiVupMf { bf16_t* VtM; const PG8_LAS float* cs;
    __device__ __forceinline__ void operator()(const f32x4 (&acc)[2][2][4][2], const pg8::Unit& u, int ui, int wr, int wc, int fr, int fq) const {
        f32x4 sc[2][2];
#pragma unroll
        for (int bj = 0; bj < 2; ++bj)
#pragma unroll
            for (int n = 0; n < 2; ++n) sc[bj][n] = *(const PG8_LAS f32x4*)(cs + ui * 256 + bj * 128 + wc * 32 + fq * 8 + n * 4);
#pragma unroll
        for (int ai = 0; ai < 2; ++ai)
#pragma unroll
            for (int m = 0; m < 4; ++m) { const size_t row = (size_t)u.pm * 256 + ai * 128 + wr * 64 + m * 16 + fr;
#pragma unroll
                for (int bj = 0; bj < 2; ++bj) st_bf16x8(VtM + row * T + u.pn * 256 + bj * 128 + wc * 32 + fq * 8, acc[ai][bj][m][0] * sc[bj][0], acc[ai][bj][m][1] * sc[bj][1]); } } };
__device__ __forceinline__ void ph_knorm(const P& p, int bid, int nblk, int tid_) {
    const bf16_t* Kf = wsp<bf16_t>(p, R_XBZ + 64 * MiB); float* KMAXT = wsp<float>(p, OFF_SSQ + 1 * MiB);
    const int lane = tid_ & 63, wid = tid_ >> 6;
    for (int it = bid * 8 + wid; it < 128 * 32; it += nblk * 8) {
        const int bh = it >> 5, tile = it & 31, b = bh >> 3, h = bh & 7;
        const bf16_t* kr = Kf + ((size_t)b * S + tile * 64 + lane) * 512 + h * 64; float s2 = 0.f;
#pragma unroll
        for (int c = 0; c < 8; ++c) { const u32x4 v = *(const u32x4*)(kr + c * 8);
#pragma unroll
            for (int j = 0; j < 4; ++j) { const float lo = bflo(v[j]), hi_ = bfhi(v[j]); s2 += lo * lo + hi_ * hi_; } }
        float m = sqrtf(s2);
#pragma unroll
        for (int o = 32; o >= 1; o >>= 1) m = fmaxf(m, __shfl_xor(m, o));
        if (lane == 0) KMAXT[it] = m;
    }
}
__device__ __forceinline__ void ph_upproj_mf(const P& p, unsigned char* smem, int bid, int nblk, int tid_) {
    const bf16_t* CQ = wsp<bf16_t>(p, R_XBZ); const bf16_t* CKV = wsp<bf16_t>(p, R_XBZ + 16 * MiB);
    const float* SSQQ = wsp<float>(p, OFF_SSQ); const float* SSQK = wsp<float>(p, OFF_SSQ + 512 * 1024);
    PG8_LAS float* tabl = (PG8_LAS float*)(LDSP(smem) + LDS_TAB_OFF);
    { pg8::Gemm g{CQ, wsp<bf16_t>(p, W1Q), 256, 256, 256, nullptr}; pg8::DenseOrder S; S.init(T, 768, 256, 256, nblk, bid);
      fill_scale<false>(S, tabl, SSQQ, 1.0f / 256.0f, tid_);
      EpiQupMf E{wsp<bf16_t>(p, R_A2), tabl, wsp<float>(p, OFF_TAB)};
      pg8::gemm_phase<EpiQupMf, pg8::DenseOrder, pg8::NoMidK, false, true>(LDSP(smem), g, S, E, pg8::NoMidK{}, tid_); }
    { pg8::Gemm g{CKV, wsp<bf16_t>(p, W1K), 256, 128, 128, nullptr}; pg8::DenseOrder S; S.init(T, 512, 256, 128, nblk, bid);
      fill_scale<false>(S, tabl, SSQK, 1.0f / 128.0f, tid_);
      EpiKupMf E{wsp<bf16_t>(p, R_A2 + 48 * MiB), tabl};
      pg8::gemm_phase<EpiKupMf, pg8::DenseOrder, pg8::NoMidK, false, true>(LDSP(smem), g, S, E, pg8::NoMidK{}, tid_); }
    { pg8::Gemm g{wsp<bf16_t>(p, W1VV), CKV, 128, 256, 128, nullptr}; pg8::DenseOrder S; S.init(512, T, 128, 256, nblk, bid);
      fill_scale<true>(S, tabl, SSQK, 1.0f / 128.0f, tid_);
      EpiVupMf E{wsp<bf16_t>(p, R_A2 + 80 * MiB), tabl};
      pg8::gemm_phase<EpiVupMf, pg8::DenseOrder, pg8::NoMidK, false, true>(LDSP(smem), g, S, E, pg8::NoMidK{}, tid_); }
    ph_fh_cumsum(p, bid, nblk, tid_);
    ph_knorm(p, bid, nblk, tid_);
}
__device__ __forceinline__ void ph_outproj1_mf(const P& p, unsigned char* smem, int bid, int nblk, int tid_) {
    EpiMixMf E{wsp<bf16_t>(p, R_XBZ)};
    mf_dense_e<true>(smem, wsp<bf16_t>(p, R_XQ), 1024, wsp<bf16_t>(p, W1O), 1024, T, 1024, 1024, E, bid, nblk, tid_);
}

namespace att {
typedef short bf16x8 __attribute__((ext_vector_type(8)));
typedef float f32x16 __attribute__((ext_vector_type(16)));
struct Args { const bf16_t* Q; int ldq; const bf16_t* K; int ldk; const bf16_t* K2; const bf16_t* Vt; bf16_t* O; int ldo; const float* FH2; const float* KMAXT; };
template <int MODE> struct Cfg { static constexpr int DK = MODE == 2 ? 96 : 64, DKX = DK + (MODE == 1 ? 16 : 0), KROW = DKX * 2 + 16, VROW = 144, K_BYTES = 64 * KROW, V_BYTES = 64 * VROW, TILE = K_BYTES + V_BYTES + 256; };
__device__ __forceinline__ float swap_sum(float x) { auto rr = __builtin_amdgcn_permlane32_swap(__float_as_uint(x), __float_as_uint(x), false, false); return __uint_as_float(rr[0]) + __uint_as_float(rr[1]); }
__device__ __forceinline__ float swap_max(float x) { auto rr = __builtin_amdgcn_permlane32_swap(__float_as_uint(x), __float_as_uint(x), false, false); return fmaxf(__uint_as_float(rr[0]), __uint_as_float(rr[1])); }
__device__ __forceinline__ float swap_other(float x, int hi) { auto rr = __builtin_amdgcn_permlane32_swap(__float_as_uint(x), __float_as_uint(x), false, false); return __uint_as_float(hi ? rr[0] : rr[1]); }

template <int MODE, int HP = 1>
__device__ __forceinline__ void attn_unit(const Args& a, int b, int h0, int qb, unsigned char* smem, int tid_) {
    typedef Cfg<MODE> C;
    constexpr int BUF = HP * C::TILE, QROWS = 256 / HP;
    constexpr int NKS = C::DK / 16, NKX = C::DKX / 16;
    int tid = tid_; asm volatile("" : "+v"(tid));
    const int lane = tid & 63, wid = __builtin_amdgcn_readfirstlane(tid >> 6), r32 = lane & 31, hi = lane >> 5;
    PG8_LAS unsigned char* lds = (PG8_LAS unsigned char*)smem;
    const int hsw = (HP == 2) ? (wid >> 2) : 0, h = h0 + hsw, wq = (HP == 2) ? (wid & 3) : wid;
    const int q0 = qb * QROWS, qw = q0 + wq * 32;
    const size_t rowb = (size_t)b * S;
    const int jmax = q0 / 64 + QROWS / 64 - 1;
    const int hoff = hsw * C::TILE;
    const int jw = (MODE == 2) ? (qw >> 6) : ((qw + 31) >> 6);
    bf16x8 qf[NKX];
    { const bf16_t* qp = a.Q + (rowb + qw + r32) * a.ldq + h * C::DK + hi * 8;
#pragma unroll
      for (int ks = 0; ks < NKS; ++ks) qf[ks] = *(const bf16x8*)(qp + ks * 16);
      if (MODE == 1) { const u32x4 m1 = {hi ? 0u : 0xBF80BF80u, hi ? 0u : 0x0000BF80u, 0u, 0u}; qf[NKX - 1] = __builtin_bit_cast(bf16x8, m1); } }
    const u32x4 ones_u = {0x3F803F80u, 0x3F803F80u, 0x3F803F80u, 0x3F803F80u}; const bf16x8 ones8 = __builtin_bit_cast(bf16x8, ones_u);
    float qn = 0.f;
    if (MODE == 1) {
#pragma unroll
        for (int ks = 0; ks < NKS; ++ks)
#pragma unroll
            for (int e = 0; e < 8; ++e) { const float qv = __uint_as_float(((unsigned)(unsigned short)qf[ks][e]) << 16); qn += qv * qv; }
        qn = sqrtf(swap_sum(qn)) * 1.001f; }
    const int kkey = tid >> 3, kch = tid & 7;
    const bf16_t* kg = a.K + (rowb + kkey) * a.ldk + h0 * 64 + kch * 8;
    const bf16_t* k2g = a.K2 + (rowb + (tid >> 2)) * 256 + 128 + (tid & 3) * 8;
    const bf16_t* vg = a.Vt + (size_t)(h0 * 64 + kkey) * T + rowb + kch * 8;
    const float* fg0 = a.FH2 + (size_t)(b * 8 + h0) * S;
    const float* fg = fg0 + (size_t)hsw * S;
    const int k_l = kkey * C::KROW + kch * 16, k2_l = (tid >> 2) * C::KROW + 128 + (tid & 3) * 16, v_l = C::K_BYTES + kkey * C::VROW + (kch >> 1) * 32 + (kch & 1) * 8, f_l = C::K_BYTES + C::V_BYTES + tid * 4;
    u32x4 sk[HP], sv[HP], sk2; float sf[HP];
#pragma unroll
    for (int hs = 0; hs < HP; ++hs) sf[hs] = 0.f;
#define ATT_LOAD(j) do { _Pragma("unroll") for (int hs_ = 0; hs_ < HP; ++hs_) { sk[hs_] = *(const u32x4*)(kg + (size_t)(j) * 64 * a.ldk + hs_ * 64); sv[hs_] = *(const u32x4*)(vg + (size_t)hs_ * 64 * T + (j) * 64); \
            if (MODE == 1) { if (tid < 64) sf[hs_] = fg0[(size_t)hs_ * S + (j) * 64 + tid]; } } \
        if (MODE == 2) { if (tid < 256) sk2 = *(const u32x4*)(k2g + (size_t)(j) * 64 * 256); } } while (0)
#define ATT_STORE(bufo) do { _Pragma("unroll") for (int hs_ = 0; hs_ < HP; ++hs_) { const int bo_ = (bufo) + hs_ * C::TILE; *(PG8_LAS u32x4*)(lds + bo_ + k_l) = sk[hs_]; \
            *(PG8_LAS u32x2*)(lds + bo_ + v_l) = (u32x2){sv[hs_][0], sv[hs_][1]}; *(PG8_LAS u32x2*)(lds + bo_ + v_l + 16) = (u32x2){sv[hs_][2], sv[hs_][3]}; \
            if (MODE == 1) { if (tid < 64) { const float f_ = sf[hs_]; const unsigned h1_ = pk_bf16(f_, 0.f) & 0xffffu; const float r1_ = f_ - bflo(h1_); const unsigned h2_ = pk_bf16(r1_, 0.f) & 0xffffu; const float r2_ = r1_ - bflo(h2_); const unsigned h3_ = pk_bf16(r2_, 0.f) & 0xffffu; \
                *(PG8_LAS u32x4*)(lds + bo_ + tid * C::KROW + 128) = (u32x4){h1_ | (h2_ << 16), h3_, 0u, 0u}; *(PG8_LAS u32x4*)(lds + bo_ + tid * C::KROW + 144) = (u32x4){0u, 0u, 0u, 0u}; } } } \
        if (MODE == 2) { if (tid < 256) *(PG8_LAS u32x4*)(lds + (bufo) + k2_l) = sk2; } } while (0)
    f32x16 o[2];
#pragma unroll
    for (int i = 0; i < 16; ++i) { o[0][i] = 0.f; o[1][i] = 0.f; }
    float R = 0.f; bool first = true;
    f32x16 lacc;
#pragma unroll
    for (int i = 0; i < 16; ++i) lacc[i] = 0.f;
    float fht = 0.f; if (MODE == 1) fht = fg[qw + r32];
    f32x16 negm;
#pragma unroll
    for (int i = 0; i < 16; ++i) negm[i] = (MODE == 0) ? 0.f : fht;
    const int qi = qw + r32;
    const int nt = jmax + 1;
    PG8_LAS int* dflag = (PG8_LAS int*)(lds + 2 * BUF);
    PG8_LAS float* kpm0 = (PG8_LAS float*)(lds + 2 * BUF + 64);
    PG8_LAS float* kpm = kpm0 + hsw * 64;
    PG8_LAS float* fedge = kpm + 32;
    if (MODE != 2) { if (tid < 8) dflag[tid] = 0; }
    if (MODE == 1) { if (tid < 32 * HP) { const int hs = tid >> 5, ti = tid & 31; float v = a.KMAXT[(b * 8 + h0 + hs) * 32 + ti];
#pragma unroll
            for (int o = 1; o < 32; o <<= 1) { const float u_ = __shfl_up(v, o, 32); if (ti >= o) v = fmaxf(v, u_); }
            kpm0[hs * 64 + ti] = v; kpm0[hs * 64 + 32 + ti] = fg0[(size_t)hs * S + 64 * (ti + 1) - 1]; } }
    { const int j0 = (MODE != 2) ? jmax : 0; ATT_LOAD(j0); ATT_STORE(0); }
    __syncthreads();
    for (int it = 0; it < nt; ++it) {
        const int j = (MODE != 2) ? (jmax - it) : it;
        const int bufo = (it & 1) * BUF, nbufo = ((it + 1) & 1) * BUF;
        const bool more = (it + 1 < nt);
        if (more) { const int jn = (MODE != 2) ? (j - 1) : (j + 1); ATT_LOAD(jn); }
        if (j <= jw) {
            f32x16 p0 = negm, p1 = negm;
            { const PG8_LAS unsigned char* kb = lds + bufo + hoff + r32 * C::KROW + hi * 16;
              __builtin_amdgcn_s_setprio(1);
#pragma unroll
              for (int ks = 0; ks < NKX; ++ks) {
                  const bf16x8 a0 = *(const PG8_LAS bf16x8*)(kb + ks * 32), a1 = *(const PG8_LAS bf16x8*)(kb + 32 * C::KROW + ks * 32);
                  p0 = __builtin_amdgcn_mfma_f32_32x32x16_bf16(a0, qf[ks], p0, 0, 0, 0);
                  p1 = __builtin_amdgcn_mfma_f32_32x32x16_bf16(a1, qf[ks], p1, 0, 0, 0); }
              __builtin_amdgcn_s_setprio(0); }
            const int kbase = j * 64 + 4 * hi;
            if (MODE != 0) {
                if (MODE == 1 && j == jw) {
#pragma unroll
                    for (int i = 0; i < 16; ++i) { const int kp = kbase + 8 * (i >> 2) + (i & 3); if (kp > qi) p0[i] = -INFINITY; if (kp + 32 > qi) p1[i] = -INFINITY; }
                }
                float mx = __builtin_fmaxf(__builtin_fmaxf(p0[0], p0[1]), p1[0]), mx2 = __builtin_fmaxf(__builtin_fmaxf(p0[2], p0[3]), p1[1]);
                mx = __builtin_fmaxf(__builtin_fmaxf(mx, p1[2]), p1[3]);
#pragma unroll
                for (int i = 4; i < 16; i += 4) { mx = __builtin_fmaxf(__builtin_fmaxf(mx, p0[i]), p0[i + 1]); mx2 = __builtin_fmaxf(__builtin_fmaxf(mx2, p0[i + 2]), p0[i + 3]);
                    mx = __builtin_fmaxf(__builtin_fmaxf(mx, p1[i]), p1[i + 1]); mx2 = __builtin_fmaxf(__builtin_fmaxf(mx2, p1[i + 2]), p1[i + 3]); }
                mx = swap_max(__builtin_fmaxf(mx, mx2));
                if (first || __any(mx > 8.0f)) {
                    const float dl = first ? mx : __builtin_fmaxf(mx, 0.f);
                    const float alpha = first ? 0.f : __builtin_amdgcn_exp2f(-dl);
#pragma unroll
                    for (int i = 0; i < 16; ++i) { p0[i] -= dl; p1[i] -= dl; negm[i] -= dl; o[0][i] *= alpha; o[1][i] *= alpha; lacc[i] *= alpha; }
                    first = false;
                }
#pragma unroll
                for (int i = 0; i < 16; ++i) { p0[i] = __builtin_amdgcn_exp2f(p0[i]); p1[i] = __builtin_amdgcn_exp2f(p1[i]); }
            } else {
                const bool diag = (j == jw);
#pragma unroll
                for (int blk = 1; blk >= 0; --blk) {
                    f32x16& pz = blk ? p1 : p0;
                    float L[16];
#pragma unroll
                    for (int i = 0; i < 16; ++i) { const float z = pz[i]; float l = fmaxf(z, 0.f) + __builtin_amdgcn_logf(1.f + __builtin_amdgcn_exp2f(-fabsf(z)));
                        if (diag) { const int kp = kbase + 32 * blk + 8 * (i >> 2) + (i & 3); if (kp >= qi) l = 0.f; }
                        L[i] = l; }
                    float tail = R;
#pragma unroll
                    for (int g = 3; g >= 0; --g) {
                        const float s3 = L[4 * g + 3], s2 = s3 + L[4 * g + 2], s1 = s2 + L[4 * g + 1], s0 = s1 + L[4 * g];
                        const float gp = swap_other(s0, hi);
                        const float base = tail + (hi ? 0.f : gp);
                        tail += s0 + gp;
                        const float c0 = base + s0, c1 = base + s1, c2 = base + s2, c3 = base + s3;
                        pz[4 * g] = __builtin_amdgcn_exp2f(pz[4 * g] - c0); pz[4 * g + 1] = __builtin_amdgcn_exp2f(pz[4 * g + 1] - c1);
                        pz[4 * g + 2] = __builtin_amdgcn_exp2f(pz[4 * g + 2] - c2); pz[4 * g + 3] = __builtin_amdgcn_exp2f(pz[4 * g + 3] - c3);
                    }
                    R = tail;
                    if (diag) {
#pragma unroll
                        for (int i = 0; i < 16; ++i) { const int kp = kbase + 32 * blk + 8 * (i >> 2) + (i & 3); if (kp >= qi) pz[i] = 0.f; }
                    }
                }
            }
            bf16x8 pf[4];
#pragma unroll
            for (int s = 0; s < 4; ++s) { const f32x16& pp = (s < 2) ? p0 : p1; const int o8 = (s & 1) * 8; u32x4 w;
                w[0] = pk_bf16(pp[o8], pp[o8 + 1]); w[1] = pk_bf16(pp[o8 + 2], pp[o8 + 3]); w[2] = pk_bf16(pp[o8 + 4], pp[o8 + 5]); w[3] = pk_bf16(pp[o8 + 6], pp[o8 + 7]);
                pf[s] = __builtin_bit_cast(bf16x8, w); }
            __builtin_amdgcn_s_setprio(1);
            if (MODE != 0) {
#pragma unroll
                for (int s = 0; s < 4; ++s) lacc = __builtin_amdgcn_mfma_f32_32x32x16_bf16(ones8, pf[s], lacc, 0, 0, 0); }
            { const PG8_LAS unsigned char* vb = lds + bufo + hoff + C::K_BYTES + r32 * C::VROW + hi * 16;
#pragma unroll
              for (int db = 0; db < 2; ++db)
#pragma unroll
                  for (int s = 0; s < 4; ++s) o[db] = __builtin_amdgcn_mfma_f32_32x32x16_bf16(*(const PG8_LAS bf16x8*)(vb + db * 32 * C::VROW + s * 32), pf[s], o[db], 0, 0, 0); }
            __builtin_amdgcn_s_setprio(0);
        }
        if (more) ATT_STORE(nbufo);
        if (MODE == 0) {
            if (j <= jw) { const bool dn = __all(R >= 150.f) != 0; if (lane == 0) dflag[wid] = dn ? 1 : 0; }
        }
        if (MODE == 1) {
            if (j <= jw) { bool dn = true; if (j > 0) { const float bnd = qn * kpm[j - 1] + negm[0] - fedge[j - 1]; dn = __all(bnd < -150.f) != 0; } if (lane == 0) dflag[wid] = dn ? 1 : 0; }
        }
        LDS_BARRIER();
        if (MODE != 2) { const u32x4 f0 = *(const PG8_LAS u32x4*)dflag, f1 = *(const PG8_LAS u32x4*)(dflag + 4);
            if ((f0[0] & f0[1] & f0[2] & f0[3] & f1[0] & f1[1] & f1[2] & f1[3]) != 0u) break; }
    }
    if (MODE != 2) __syncthreads();
    float inv = 1.f;
    if (MODE != 0) inv = 1.0f / lacc[0];
    { bf16_t* op = a.O + (rowb + qw + r32) * a.ldo + h * 64 + 4 * hi;
#pragma unroll
      for (int db = 0; db < 2; ++db)
#pragma unroll
          for (int g = 0; g < 4; ++g) st_bf16x4(op + db * 32 + g * 8, (f32x4){o[db][4 * g] * inv, o[db][4 * g + 1] * inv, o[db][4 * g + 2] * inv, o[db][4 * g + 3] * inv}); }
#undef ATT_LOAD
#undef ATT_STORE
}
}

constexpr size_t O_XT = R_XQ, O_BN = R_XQ + 64 * MiB, O_CN = R_XQ + 80 * MiB, O_BT = R_A2 + 96 * MiB;
__device__ __forceinline__ void ph_conv2(const P& p, unsigned char* smem, int bid, int nblk, int tid_) {
    int tid = tid_; asm volatile("" : "+v"(tid));
    const bf16_t* XR = wsp<bf16_t>(p, R_A2);
    bf16_t* tile = (bf16_t*)smem;
    const int l = tid >> 3, cg = tid & 7;
    constexpr int NH = 4;
    for (int it = bid; it < 24 * 16 * (32 / NH); it += nblk) {
        const int cb = it / (16 * (32 / NH)), bc = it % (16 * (32 / NH)), b = bc / (32 / NH), c0 = (bc % (32 / NH)) * NH;
        const int ch0 = cb * 64 + cg * 8;
        u32x4 tap[NH][4];
#pragma unroll
        for (int hf = 0; hf < NH; ++hf) { const int s = (c0 + hf) * 64 + l; const size_t t = (size_t)b * S + s;
#pragma unroll
            for (int k = 0; k < 4; ++k) { tap[hf][k] = (u32x4){0u, 0u, 0u, 0u}; if (s - 3 + k >= 0) tap[hf][k] = *(const u32x4*)(XR + (t - 3 + k) * 1536 + ch0); } }
        f32x4 wv[4][2]; f32x4 bv[2];
        bv[0] = *(const f32x4*)(p.ev_conv_b + ch0); bv[1] = *(const f32x4*)(p.ev_conv_b + ch0 + 4);
#pragma unroll
        for (int k = 0; k < 4; ++k) { wv[k][0] = *(const f32x4*)(p.ev_conv_w + k * 1536 + ch0); wv[k][1] = *(const f32x4*)(p.ev_conv_w + k * 1536 + ch0 + 4); }
        u32x4 ov[NH];
#pragma unroll
        for (int hf = 0; hf < NH; ++hf) {
            f32x2 acc2[4] = {{bv[0][0], bv[0][1]}, {bv[0][2], bv[0][3]}, {bv[1][0], bv[1][1]}, {bv[1][2], bv[1][3]}};
#pragma unroll
            for (int k = 0; k < 4; ++k) { const u32x4 v = tap[hf][k];
#pragma unroll
                for (int j = 0; j < 4; ++j) acc2[j] = __builtin_elementwise_fma((f32x2){wv[k][j >> 1][(j & 1) * 2], wv[k][j >> 1][(j & 1) * 2 + 1]}, (f32x2){bflo(v[j]), bfhi(v[j])}, acc2[j]); }
#pragma unroll
            for (int j = 0; j < 4; ++j) ov[hf][j] = pk_bf16(silu_f(acc2[j][0]), silu_f(acc2[j][1]));
        }
        if (cb >= 16) { bf16_t* nat = wsp<bf16_t>(p, O_BN + (cb >= 20 ? 16 * MiB : 0));
#pragma unroll
            for (int hf = 0; hf < NH; ++hf) *(u32x4*)(nat + ((size_t)b * S + (c0 + hf) * 64 + l) * 256 + ((cb - 16) & 3) * 64 + cg * 8) = ov[hf]; }
        if (cb < 20) {
#pragma unroll
            for (int hf = 0; hf < NH; ++hf) *(u32x4*)(tile + hf * 64 * 72 + l * 72 + cg * 8) = ov[hf];
            LDS_BARRIER();
            const int r = tid >> 3, lg = tid & 7;
#pragma unroll
            for (int hf = 0; hf < NH; ++hf) { u32x4 tv; const int c = c0 + hf;
#pragma unroll
                for (int j = 0; j < 4; ++j) tv[j] = (unsigned)tile[hf * 64 * 72 + (lg * 8 + 2 * j) * 72 + r] | ((unsigned)tile[hf * 64 * 72 + (lg * 8 + 2 * j + 1) * 72 + r] << 16);
                bf16_t* dst;
                if (cb < 16) dst = wsp<bf16_t>(p, O_XT) + ((((size_t)(b * 16 + cb)) * 32 + c) * 64 + r) * 64 + lg * 8;
                else { const int g = (cb - 16) >> 1, n = ((cb - 16) & 1) * 64 + r; dst = wsp<bf16_t>(p, O_BT) + ((((size_t)(b * 2 + g)) * 32 + c) * 128 + n) * 64 + lg * 8; }
                *(u32x4*)dst = tv; }
            LDS_BARRIER();
        }
    }
}
namespace ssd {
typedef short bf16x8 __attribute__((ext_vector_type(8)));
typedef float f32x16 __attribute__((ext_vector_type(16)));
constexpr int RC = 272, RS = 144;
constexpr int O_CM = 0, O_BM = O_CM + 64 * RC, O_BMT = O_BM + 64 * RC, O_XST = O_BMT + 128 * RS, O_XDT = O_XST + 2 * 64 * RS, O_M = O_XDT + 64 * RS, O_HB = O_M + 64 * RS, O_TAB = O_HB + 64 * RC, LDS_END = O_TAB + 2 * 1024;
static_assert(LDS_END <= 128 * 1024, "ssd lds");
#define SSD_FRAG(off) (*(const PG8_LAS bf16x8*)(lds + (off)))
__device__ __forceinline__ void ssd_unit(const P& p, int b, int h, unsigned char* smem, int tid_) {
    int tid = tid_; asm volatile("" : "+v"(tid));
    const int lane = tid & 63, wid = __builtin_amdgcn_readfirstlane(tid >> 6), r32 = lane & 31, hi = lane >> 5;
    PG8_LAS unsigned char* lds = (PG8_LAS unsigned char*)smem;
    const int g = h >> 3;
    const float a = -expf(p.ev_a_log[h]), dsk = p.ev_d_skip[h];
    const bf16_t* XTu = wsp<bf16_t>(p, O_XT) + ((size_t)(b * 16 + h) * 32) * 4096 + tid * 8;
    const bf16_t* BTu = wsp<bf16_t>(p, O_BT) + ((size_t)(b * 2 + g) * 32) * 8192 + tid * 8;
    const bf16_t* BNu = wsp<bf16_t>(p, O_BN) + ((size_t)b * S + (tid >> 4)) * 256 + g * 128 + (tid & 15) * 8;
    const bf16_t* CNu = wsp<bf16_t>(p, O_CN) + ((size_t)b * S + (tid >> 4)) * 256 + g * 128 + (tid & 15) * 8;
    const float* DTu = wsp<float>(p, OFF_DT) + ((size_t)b * S + lane) * 16 + h;
    const bf16_t* Zu = wsp<bf16_t>(p, R_XBZ + 64 * MiB) + ((size_t)b * S) * 1024 + h * 64;
    bf16_t* A2u = wsp<bf16_t>(p, R_A2) + ((size_t)b * S) * 1536 + h * 64;
    float* SSQu = wsp<float>(p, OFF_SSQ) + ((size_t)b * S) * 32 + h * 2;
    u32x4 rxA, rbA[2], rbtA[2], rcA[2], rxB, rbB[2], rbtB[2], rcB[2]; float rdtA = 0.f, rdtB = 0.f;
#define SSD_LOAD(c, P) do { rx##P = *(const u32x4*)(XTu + (size_t)(c) * 4096); \
        rbt##P[0] = *(const u32x4*)(BTu + (size_t)(c) * 8192); rbt##P[1] = *(const u32x4*)(BTu + (size_t)(c) * 8192 + 4096); \
        rb##P[0] = *(const u32x4*)(BNu + (size_t)(c) * 64 * 256); rb##P[1] = *(const u32x4*)(BNu + ((size_t)(c) * 64 + 32) * 256); \
        rc##P[0] = *(const u32x4*)(CNu + (size_t)(c) * 64 * 256); rc##P[1] = *(const u32x4*)(CNu + ((size_t)(c) * 64 + 32) * 256); \
        if (wid == 2) rdt##P = DTu[(size_t)(c) * 64 * 16]; } while (0)
#define SSD_TABLES(par, P) do { PG8_LAS float* tb_ = (PG8_LAS float*)(lds + O_TAB + (par) * 1024); float x_ = rdt##P * a; \
        _Pragma("unroll") for (int o_ = 1; o_ < 64; o_ <<= 1) { const float y_ = __shfl_up(x_, o_); if (lane >= o_) x_ += y_; } \
        const float a63_ = __shfl(x_, 63); tb_[lane] = x_; tb_[64 + lane] = rdt##P; tb_[128 + lane] = rdt##P * __expf(a63_ - x_); tb_[192 + lane] = __expf(x_); } while (0)
#define SSD_FILL(c, P) do { const int par_ = (c) & 1; const PG8_LAS float* tw = (const PG8_LAS float*)(lds + O_TAB + par_ * 1024 + 512) + (tid & 7) * 8; \
        *(PG8_LAS u32x4*)(lds + O_XST + par_ * 64 * RS + (tid >> 3) * RS + (tid & 7) * 16) = rx##P; \
        { const f32x4 w0_ = *(const PG8_LAS f32x4*)tw, w1_ = *(const PG8_LAS f32x4*)(tw + 4); u32x4 xd_; \
          xd_[0] = pk_bf16(bflo(rx##P[0]) * w0_[0], bfhi(rx##P[0]) * w0_[1]); xd_[1] = pk_bf16(bflo(rx##P[1]) * w0_[2], bfhi(rx##P[1]) * w0_[3]); \
          xd_[2] = pk_bf16(bflo(rx##P[2]) * w1_[0], bfhi(rx##P[2]) * w1_[1]); xd_[3] = pk_bf16(bflo(rx##P[3]) * w1_[2], bfhi(rx##P[3]) * w1_[3]); \
          *(PG8_LAS u32x4*)(lds + O_XDT + (tid >> 3) * RS + (tid & 7) * 16) = xd_; } \
        *(PG8_LAS u32x4*)(lds + O_BMT + (tid >> 3) * RS + (tid & 7) * 16) = rbt##P[0]; *(PG8_LAS u32x4*)(lds + O_BMT + (64 + (tid >> 3)) * RS + (tid & 7) * 16) = rbt##P[1]; \
        *(PG8_LAS u32x4*)(lds + O_BM + (tid >> 4) * RC + (tid & 15) * 16) = rb##P[0]; *(PG8_LAS u32x4*)(lds + O_BM + (32 + (tid >> 4)) * RC + (tid & 15) * 16) = rb##P[1]; \
        *(PG8_LAS u32x4*)(lds + O_CM + (tid >> 4) * RC + (tid & 15) * 16) = rc##P[0]; *(PG8_LAS u32x4*)(lds + O_CM + (32 + (tid >> 4)) * RC + (tid & 15) * 16) = rc##P[1]; } while (0)
    for (int i = tid; i < 64 * RC / 16; i += NTHR) *(PG8_LAS u32x4*)(lds + O_HB + i * 16) = (u32x4){0u, 0u, 0u, 0u};
    f32x16 acch, accy;
#pragma unroll
    for (int i = 0; i < 16; ++i) { acch[i] = 0.f; accy[i] = 0.f; }
    const int nb = wid >> 1, pbh = wid & 1;
    const int w4 = wid & 3, t_a = w4 >> 1, t_b = w4 & 1;
#define SSD_BODY(c, P, Q) do { \
        const int par = (c) & 1; \
        if ((c) + 2 < 32) SSD_LOAD((c) + 2, P); \
        u32x2 zz[4] = {}; \
        if (wid >= 4) { \
_Pragma("unroll") \
            for (int g_ = 0; g_ < 4; ++g_) zz[g_] = *(const u32x2*)(Zu + ((size_t)(c) * 64 + 32 * t_b + r32) * 1024 + 32 * t_a + 8 * g_ + 4 * hi); } \
        LDS_BARRIER(); \
        const PG8_LAS float* tb = (const PG8_LAS float*)(lds + O_TAB + par * 1024); \
        { const float d63 = tb[192 + 63]; \
_Pragma("unroll") \
          for (int i = 0; i < 16; ++i) acch[i] *= d63; } \
        if (wid < 4) { \
            f32x16 cbt; \
_Pragma("unroll") \
            for (int i = 0; i < 16; ++i) cbt[i] = 0.f; \
            if (t_a <= t_b) { \
_Pragma("unroll") \
                for (int ks = 0; ks < 8; ++ks) { cbt = __builtin_amdgcn_mfma_f32_32x32x16_bf16(SSD_FRAG(O_BM + (32 * t_a + r32) * RC + ks * 32 + hi * 16), SSD_FRAG(O_CM + (32 * t_b + r32) * RC + ks * 32 + hi * 16), cbt, 0, 0, 0); \
                    if (ks < 4) { acch = __builtin_amdgcn_mfma_f32_32x32x16_bf16(SSD_FRAG(O_BMT + (32 * nb + r32) * RS + ks * 32 + hi * 16), SSD_FRAG(O_XDT + (32 * pbh + r32) * RS + ks * 32 + hi * 16), acch, 0, 0, 0); } } \
            } else { \
_Pragma("unroll") \
                for (int ks = 0; ks < 4; ++ks) { acch = __builtin_amdgcn_mfma_f32_32x32x16_bf16(SSD_FRAG(O_BMT + (32 * nb + r32) * RS + ks * 32 + hi * 16), SSD_FRAG(O_XDT + (32 * pbh + r32) * RS + ks * 32 + hi * 16), acch, 0, 0, 0); } \
            } \
            const int l = 32 * t_b + r32; const float Al = tb[l]; \
_Pragma("unroll") \
            for (int g_ = 0; g_ < 4; ++g_) { const int s0 = 32 * t_a + 8 * g_ + 4 * hi; \
                const f32x4 As = *(const PG8_LAS f32x4*)(tb + s0), ds = *(const PG8_LAS f32x4*)(tb + 64 + s0); \
                float m[4]; \
_Pragma("unroll") \
                for (int j = 0; j < 4; ++j) m[j] = (s0 + j <= l) ? cbt[4 * g_ + j] * __expf(Al - As[j]) * ds[j] : 0.f; \
                *(PG8_LAS u32x2*)(lds + O_M + l * RS + s0 * 2) = (u32x2){pk_bf16(m[0], m[1]), pk_bf16(m[2], m[3])}; } \
            if (wid == 2 && (c) + 1 < 32) SSD_TABLES(((c) + 1) & 1, Q); \
        } else { \
_Pragma("unroll") \
            for (int i = 0; i < 16; ++i) accy[i] = 0.f; \
_Pragma("unroll") \
            for (int ks = 0; ks < 8; ++ks) { accy = __builtin_amdgcn_mfma_f32_32x32x16_bf16(SSD_FRAG(O_HB + (32 * t_a + r32) * RC + ks * 32 + hi * 16), SSD_FRAG(O_CM + (32 * t_b + r32) * RC + ks * 32 + hi * 16), accy, 0, 0, 0); \
                if (ks < 4) { acch = __builtin_amdgcn_mfma_f32_32x32x16_bf16(SSD_FRAG(O_BMT + (32 * nb + r32) * RS + ks * 32 + hi * 16), SSD_FRAG(O_XDT + (32 * pbh + r32) * RS + ks * 32 + hi * 16), acch, 0, 0, 0); } } \
            const float eAl = tb[192 + 32 * t_b + r32]; \
_Pragma("unroll") \
            for (int i = 0; i < 16; ++i) accy[i] *= eAl; \
        } \
        LDS_BARRIER(); \
_Pragma("unroll") \
        for (int g_ = 0; g_ < 4; ++g_) *(PG8_LAS u32x2*)(lds + O_HB + (32 * pbh + r32) * RC + (32 * nb + 8 * g_ + 4 * hi) * 2) = (u32x2){pk_bf16(acch[4 * g_], acch[4 * g_ + 1]), pk_bf16(acch[4 * g_ + 2], acch[4 * g_ + 3])}; \
        if (wid >= 4) { \
            const int l = 32 * t_b + r32; const size_t trow = (size_t)(c) * 64 + l; \
_Pragma("unroll") \
            for (int ks = 0; ks < 4; ++ks) accy = __builtin_amdgcn_mfma_f32_32x32x16_bf16(SSD_FRAG(O_XST + par * 64 * RS + (32 * t_a + r32) * RS + ks * 32 + hi * 16), SSD_FRAG(O_M + (32 * t_b + r32) * RS + ks * 32 + hi * 16), accy, 0, 0, 0); \
            float ss = 0.f; \
_Pragma("unroll") \
            for (int g_ = 0; g_ < 4; ++g_) { const int p0 = 32 * t_a + 8 * g_ + 4 * hi; float u[4]; \
                const float z4[4] = {bflo(zz[g_][0]), bfhi(zz[g_][0]), bflo(zz[g_][1]), bfhi(zz[g_][1])}; \
_Pragma("unroll") \
                for (int j = 0; j < 4; ++j) { const float xs = bf2f(*(const PG8_LAS bf16_t*)(lds + O_XST + par * 64 * RS + (p0 + j) * RS + l * 2)); \
                    u[j] = (accy[4 * g_ + j] + dsk * xs) * silu_f(z4[j]); ss += u[j] * u[j]; } \
                st_bf16x4(A2u + trow * 1536 + p0, (f32x4){u[0], u[1], u[2], u[3]}); } \
            ss = att::swap_sum(ss); \
            if (hi == 0) SSQu[trow * 32 + t_a] = ss; \
        } \
        if ((c) + 1 < 32) SSD_FILL((c) + 1, Q); \
    } while (0)
    SSD_LOAD(0, A); SSD_LOAD(1, B);
    if (wid == 2) SSD_TABLES(0, A);
    __syncthreads();
    SSD_FILL(0, A);
    for (int c2 = 0; c2 < 32; c2 += 2) { SSD_BODY(c2, A, B); SSD_BODY(c2 + 1, B, A); }
    __syncthreads();
#undef SSD_LOAD
#undef SSD_BODY
#undef SSD_TABLES
#undef SSD_FILL
}
#undef SSD_FRAG
}
__device__ __forceinline__ void ph_ssd_mf(const P& p, unsigned char* smem, int bid, int nblk, int tid_) {
    for (int u = bid; u < NB * 16; u += nblk) ssd::ssd_unit(p, u >> 4, u & 15, smem, tid_);
}

__device__ __forceinline__ void hp_unit(int bid, int nblk, int i, int& b, int& h0, int& blk) {
    int pairidx;
    if (nblk == 256) { pairidx = (bid >> 4) + 16 * i; blk = ((bid & 15) + 4 * i) & 15; } else { const int u = bid + nblk * i; pairidx = u >> 4; blk = u & 15; }
    b = pairidx >> 2; h0 = (pairidx & 3) * 2;
}
__device__ __forceinline__ void ph_sb_mf(const P& p, unsigned char* smem, int bid, int nblk, int tid_) {
    att::Args a{wsp<bf16_t>(p, R_XQ + 96 * MiB), 512, wsp<bf16_t>(p, R_XQ + 128 * MiB), 512, nullptr, wsp<bf16_t>(p, R_XQ + 160 * MiB), wsp<bf16_t>(p, R_A2) + 1024, 1536, nullptr, nullptr};
    for (int i = 0; bid + nblk * i < 1024; ++i) { int b, h0, blk; hp_unit(bid, nblk, i, b, h0, blk); att::attn_unit<0, 2>(a, b, h0, blk, smem, tid_); }
}
__device__ __forceinline__ void ph_attn1_mf(const P& p, unsigned char* smem, int bid, int nblk, int tid_) {
    att::Args am{wsp<bf16_t>(p, R_A2), 768, wsp<bf16_t>(p, R_A2 + 48 * MiB), 512, wsp<bf16_t>(p, R_XBZ + 16 * MiB), wsp<bf16_t>(p, R_A2 + 80 * MiB), wsp<bf16_t>(p, R_XQ), 1024, nullptr, nullptr};
    att::Args af{wsp<bf16_t>(p, R_XBZ + 32 * MiB), 512, wsp<bf16_t>(p, R_XBZ + 64 * MiB), 512, nullptr, wsp<bf16_t>(p, R_XBZ + 96 * MiB), wsp<bf16_t>(p, R_XQ) + 512, 1024, wsp<float>(p, OFF_DT + 1 * MiB), wsp<float>(p, OFF_SSQ + 1 * MiB)};
    for (int pi = bid; pi < 512; pi += nblk) { const int bh = pi >> 2, pr = pi & 3;
        att::attn_unit<2>(am, bh >> 3, bh & 7, 7 - pr, smem, tid_); att::attn_unit<2>(am, bh >> 3, bh & 7, pr, smem, tid_); }
    for (int i = 0; bid + nblk * i < 1024; ++i) { int b, h0, blk; hp_unit(bid, nblk, i, b, h0, blk); att::attn_unit<1, 2>(af, b, h0, blk, smem, tid_); }
}
template <int N, int OFF, int NTOT> __device__ __forceinline__ void tred_rec(float (&v)[NTOT], int lane) {
    if constexpr (N > 1) {
        const bool up = (lane & OFF) != 0;
#pragma unroll
        for (int i = 0; i < N / 2; ++i) { const float keep = up ? v[i + N / 2] : v[i], send = up ? v[i] : v[i + N / 2];
            float got;
            if constexpr (OFF == 32) got = other32(send, up); else if constexpr (OFF == 16) got = other16(send, up); else if constexpr (OFF == 8) got = dpp_f<0x128>(send); else got = __shfl_xor(send, OFF);
            v[i] = keep + got; }
        tred_rec<N / 2, OFF / 2, NTOT>(v, lane);
    }
}
template <int N> __device__ __forceinline__ float tred(float (&v)[N], int lane) {
    tred_rec<N, 32, N>(v, lane);
    return group_sum<64 / N>(v[0]);
}
template <int N> __device__ __forceinline__ int tred_idx(int lane) { return lane / (64 / N); }
__device__ __forceinline__ int kpos(int k) { return (k & 1) * 512 + (k >> 1); }

struct TBuf { float v[4][8]; float g[8]; bf16_t* d; int ro[4]; int zm, gf; };
__device__ __forceinline__ void tconv_finish(const TBuf& pd, float* tile, int tid) {
    const int cq = tid & 63, rk = tid >> 6;
    const int wr_ = tid >> 3, wk = (tid & 7) * 8;
#pragma unroll
    for (int c = 0; c < 4; ++c)
#pragma unroll
        for (int i = 0; i < 8; ++i) { const float gv = pd.gf ? pd.g[i] : 1.f; tile[(rk + 8 * i) * 257 + cq + 64 * c] = ((pd.zm >> c) & 1) ? 0.f : pd.v[c][i] * gv; }
    LDS_BARRIER();
#pragma unroll
    for (int c = 0; c < 4; ++c) { u32x4 w;
#pragma unroll
      for (int j = 0; j < 4; ++j) w[j] = pk_bf16(tile[(wk + 2 * j) * 257 + wr_ + 64 * c], tile[(wk + 2 * j + 1) * 257 + wr_ + 64 * c]);
      *(u32x4*)(pd.d + pd.ro[c]) = w; }
    LDS_BARRIER();
}
template <bool GAIN, class Map> __device__ __forceinline__ void tconv(bf16_t* dst, const float* src, int src_ld, int K, const Map& map, const float* gain, int gain_n,
                                                          int nbatch, size_t dst_bstride, size_t src_bstride, float* tile, int bid, int nblk, int tid, int& toff, TBuf& A, TBuf& B, int& pp) {
    const int nkt = K / 64, nqt = map.nq / 256, per = nkt * nqt, total = per * nbatch;
    const int first = (bid - toff % nblk + nblk) % nblk;
    toff += total;
    const int cq = tid & 63, rk = tid >> 6;
    const int wr_ = tid >> 3, wk = (tid & 7) * 8;
#define TCONV_LOAD(X) do { \
        X.zm = 0; \
        _Pragma("unroll") for (int c = 0; c < 4; ++c) { const int sc = map.scol(q0 + cq + 64 * c); const int scc = sc < 0 ? 0 : sc; X.zm |= (sc < 0 ? 1 : 0) << c; \
            _Pragma("unroll") for (int i = 0; i < 8; ++i) X.v[c][i] = s[(size_t)(k0 + rk + 8 * i) * src_ld + scc]; } \
        if constexpr (GAIN) { X.gf = k0 < gain_n;             \
            _Pragma("unroll") for (int i = 0; i < 8; ++i) { const int k = k0 + rk + 8 * i; X.g[i] = gain[k < gain_n ? k : 0]; } } \
        else { X.gf = 0; _Pragma("unroll") for (int i = 0; i < 8; ++i) X.g[i] = 1.f; } \
        _Pragma("unroll") for (int c = 0; c < 4; ++c) X.ro[c] = map.drow(q0 + wr_ + 64 * c) * K + k0 + wk; \
        X.d = dst + (size_t)bt * dst_bstride; } while (0)
    for (int tI = first; tI < total; tI += nblk) {
        const int bt = tI / per, rem = tI % per, kt = rem / nqt, qt = rem % nqt, k0 = kt * 64, q0 = qt * 256;
        const float* s = src + (size_t)bt * src_bstride;
        if (pp == 1) { TCONV_LOAD(B); tconv_finish(A, tile, tid); pp = 2; }
        else { TCONV_LOAD(A); if (pp == 2) tconv_finish(B, tile, tid); pp = 1; }
    }
#undef TCONV_LOAD
}
struct MapIn0 { static constexpr int nq = 3584; __device__ __forceinline__ int drow(int q) const { return q; } __device__ __forceinline__ int scol(int q) const { return q < 2560 ? q : (q < 3072 ? 2576 + (q - 2560) : 3088 + (q - 3072)); } };
struct MapOff { int nq, off; __device__ __forceinline__ int drow(int q) const { return q; } __device__ __forceinline__ int scol(int q) const { return off + q; } };
struct MapIn1 { static constexpr int nq = 1536; __device__ __forceinline__ int drow(int q) const { return q; }
    __device__ __forceinline__ int scol(int q) const { if (q < 384) return q; if (q < 416) { const int j = q - 384, i = j >> 1; return 384 + ((j & 1) ? i + 16 : i); } if (q < 512) return -1; if (q < 1024) return 416 + (q - 512); return 928 + (q - 1024); } };
struct MapQup { static constexpr int nq = 768; __device__ __forceinline__ int drow(int q) const { return q; }
    __device__ __forceinline__ int scol(int q) const { const int h = q / 96, j = q % 96; if (j < 64) return q; const int jj = j - 64, i = jj >> 1; return 96 * h + 64 + ((jj & 1) ? i + 16 : i); } };
struct MapKV { static constexpr int nq = 512; int off; __device__ __forceinline__ int drow(int q) const { return q; } __device__ __forceinline__ int scol(int q) const { return 128 * (q >> 6) + off + (q & 63); } };
struct MapGU { static constexpr int nq = 256; int up; __device__ __forceinline__ int drow(int q) const { return 256 * (q >> 7) + 128 * up + (q & 127); } __device__ __forceinline__ int scol(int q) const { return q; } };

__device__ __forceinline__ void ph_prologue2(const P& p, unsigned char* smem, int bid, int nblk, int tid_) {
    int tid = tid_; asm volatile("" : "+v"(tid));
    const int lane = tid & 63, wid = tid >> 6;
    float* wl = (float*)smem;
    { f32x4 w4[8];
#pragma unroll
      for (int j = 0; j < 8; ++j) { const int q = tid + NTHR * j; w4[j] = *(const f32x4*)(p.ev_w_in + (size_t)(q >> 2) * EVEN_IN + 2560 + 4 * (q & 3)); }
#pragma unroll
      for (int j = 0; j < 8; ++j) { const int q = tid + NTHR * j; *(f32x4*)(wl + kpos(q >> 2) * 20 + 4 * (q & 3)) = w4[j]; } }
    __syncthreads();
    { float* DT = wsp<float>(p, OFF_DT); unsigned* XB = wsp<unsigned>(p, R_XBZ);
      const int hsel = tred_idx<16>(lane); const float dtb = p.ev_dt_bias[hsel];
      f32x2 xnx[8];
      { const int t0 = bid * 8 + wid; if (t0 < T) {
#pragma unroll
          for (int i = 0; i < 8; ++i) xnx[i] = ((const f32x2*)(p.x + (size_t)t0 * D))[lane + 64 * i]; } }
      for (int t = bid * 8 + wid; t < T; t += nblk * 8) {
          asm volatile("" ::: "memory");
          f32x2 xv[8];
#pragma unroll
          for (int i = 0; i < 8; ++i) xv[i] = xnx[i];
          { const int tn = t + nblk * 8; if (tn < T) {
#pragma unroll
              for (int i = 0; i < 8; ++i) xnx[i] = ((const f32x2*)(p.x + (size_t)tn * D))[lane + 64 * i]; } }
#pragma unroll
          for (int i = 0; i < 8; ++i) XB[(size_t)t * 512 + lane + 64 * i] = pk_bf16(xv[i][0], xv[i][1]);
          f32x2 accv[8];
#pragma unroll
          for (int h = 0; h < 8; ++h) accv[h] = (f32x2){0.f, 0.f};
#pragma unroll
          for (int i = 0; i < 8; ++i)
#pragma unroll
              for (int c = 0; c < 2; ++c) { const float* wrow = wl + (c * 512 + 64 * i + lane) * 20; const f32x2 xx = {xv[i][c], xv[i][c]};
#pragma unroll
                  for (int h4 = 0; h4 < 4; ++h4) { const f32x4 w4 = *(const f32x4*)(wrow + 4 * h4);
                      accv[2 * h4] = __builtin_elementwise_fma(xx, (f32x2){w4[0], w4[1]}, accv[2 * h4]); accv[2 * h4 + 1] = __builtin_elementwise_fma(xx, (f32x2){w4[2], w4[3]}, accv[2 * h4 + 1]); } }
          float acc[16];
#pragma unroll
          for (int h = 0; h < 8; ++h) { acc[2 * h] = accv[h][0]; acc[2 * h + 1] = accv[h][1]; }
          const float r = tred<16>(acc, lane);
          if ((lane & 3) == 0) DT[(size_t)t * 16 + hsel] = softplus_f(r + dtb);
      } }
    __syncthreads();
    float* tile = (float*)smem;
    int toff = 0, pp = 0; TBuf tbA, tbB;
    tconv<false>(wsp<bf16_t>(p, W0M), p.ev_w_in, EVEN_IN, 1024, MapIn0{}, nullptr, 0, 1, 0, 0, tile, bid, nblk, tid, toff, tbA, tbB, pp);
    tconv<false>(wsp<bf16_t>(p, W0V), p.ev_w_in, EVEN_IN, 1024, MapOff{512, 3600}, nullptr, 0, 1, 0, 0, tile, bid, nblk, tid, toff, tbA, tbB, pp);
    tconv<true>(wsp<bf16_t>(p, W0O), p.ev_w_out, 1024, 1536, MapOff{1024, 0}, p.ev_norm_g, 1024, 1, 0, 0, tile, bid, nblk, tid, toff, tbA, tbB, pp);
    tconv<false>(wsp<bf16_t>(p, W1M), p.od_w_in, ODD_IN, 1024, MapIn1{}, nullptr, 0, 1, 0, 0, tile, bid, nblk, tid, toff, tbA, tbB, pp);
    tconv<false>(wsp<bf16_t>(p, W1V), p.od_w_in, ODD_IN, 1024, MapOff{512, 1440}, nullptr, 0, 1, 0, 0, tile, bid, nblk, tid, toff, tbA, tbB, pp);
    tconv<true>(wsp<bf16_t>(p, W1Q), p.od_w_q_up, 768, 256, MapQup{}, p.od_q_norm_g, 256, 1, 0, 0, tile, bid, nblk, tid, toff, tbA, tbB, pp);
    tconv<true>(wsp<bf16_t>(p, W1K), p.od_w_kv_up, 1024, 128, MapKV{0}, p.od_kv_norm_g, 128, 1, 0, 0, tile, bid, nblk, tid, toff, tbA, tbB, pp);
    tconv<true>(wsp<bf16_t>(p, W1VV), p.od_w_kv_up, 1024, 128, MapKV{64}, p.od_kv_norm_g, 128, 1, 0, 0, tile, bid, nblk, tid, toff, tbA, tbB, pp);
    tconv<false>(wsp<bf16_t>(p, W1O), p.od_w_out, 1024, 1024, MapOff{1024, 0}, nullptr, 0, 1, 0, 0, tile, bid, nblk, tid, toff, tbA, tbB, pp);
    tconv<false>(wsp<bf16_t>(p, WGU), p.moe_w_gate, 256, 1024, MapGU{0}, nullptr, 0, 32, (size_t)512 * 1024, (size_t)1024 * 256, tile, bid, nblk, tid, toff, tbA, tbB, pp);
    tconv<false>(wsp<bf16_t>(p, WGU), p.moe_w_up, 256, 1024, MapGU{1}, nullptr, 0, 32, (size_t)512 * 1024, (size_t)1024 * 256, tile, bid, nblk, tid, toff, tbA, tbB, pp);
    tconv<false>(wsp<bf16_t>(p, WDN), p.moe_w_down, 1024, 256, MapOff{1024, 0}, nullptr, 0, 32, (size_t)1024 * 256, (size_t)256 * 1024, tile, bid, nblk, tid, toff, tbA, tbB, pp);
    if (pp == 1) tconv_finish(tbA, tile, tid); else if (pp == 2) tconv_finish(tbB, tile, tid);
    { const size_t gtid = (size_t)bid * NTHR + tid, gstride = (size_t)nblk * NTHR; float* tab = wsp<float>(p, OFF_TAB);
      for (size_t i = gtid; i < (size_t)S * 16; i += gstride) { const int s = (int)(i >> 4), f = (int)(i & 15);
        double inv = 1.0; for (int k = 0; k < f; ++k) inv *= 0.56234132519034908;
        const double rev = (double)s * inv * 0.15915494309189535; const double fr = rev - floor(rev);
        const double x = fr * 4.0; const double qd = floor(x + 0.5); const int qi = (int)qd & 3;
        const double y = (x - qd) * 1.5707963267948966, y2 = y * y;
        const double sy = y * (1.0 + y2 * (-1.0 / 6 + y2 * (1.0 / 120 + y2 * (-1.0 / 5040 + y2 * (1.0 / 362880 + y2 * (-1.0 / 39916800 + y2 * (1.0 / 6227020800.0)))))));
        const double cy = 1.0 + y2 * (-0.5 + y2 * (1.0 / 24 + y2 * (-1.0 / 720 + y2 * (1.0 / 40320 + y2 * (-1.0 / 3628800 + y2 * (1.0 / 479001600.0 + y2 * (-1.0 / 87178291200.0)))))));
        const double cv = (qi == 0) ? cy : (qi == 1) ? -sy : (qi == 2) ? -cy : sy;
        const double sv = (qi == 0) ? sy : (qi == 1) ? cy : (qi == 2) ? -sy : -cy;
        tab[i] = (float)cv; tab[S * 16 + i] = (float)sv; } }
}

__device__ __forceinline__ void ln_row2(f32x2 (&v)[8], const f32x2 (&g)[8], const f32x2 (&bt)[8]) {
    float s = 0.f;
#pragma unroll
    for (int i = 0; i < 8; ++i) s += v[i][0] + v[i][1];
    const float mu = wave_sum(s) * (1.0f / 1024.0f);
    float q = 0.f;
#pragma unroll
    for (int i = 0; i < 8; ++i) { const f32x2 d = v[i] - mu; q += d[0] * d[0] + d[1] * d[1]; }
    const float rstd = rsqrtf(wave_sum(q) * (1.0f / 1024.0f) + 1e-5f);
#pragma unroll
    for (int i = 0; i < 8; ++i) v[i] = (v[i] - mu) * rstd * g[i] + bt[i];
}
__device__ __forceinline__ void ph_ln1_router2(const P& p, int l, unsigned char* smem, int bid, int nblk, int tid_) {
    int tid = tid_; asm volatile("" : "+v"(tid));
    const int lane = tid & 63, wid = tid >> 6;
    const unsigned* MIX = wsp<unsigned>(p, R_XBZ); unsigned* X1B = wsp<unsigned>(p, R_XQ + 128 * MiB);
    const float* XIN = p.x;
    float* TOKW = wsp<float>(p, OFF_ROUTE + 256 * 1024); int* LIST = wsp<int>(p, OFF_LIST);
    unsigned* CNT = wsp<unsigned>(p, OFF_CTRL) + 64 * l;
    float* wl = (float*)smem;
    float* lgs = wl + 1024 * 20;
    int* ent = (int*)(lgs + 8 * 256);
    int* lcnt = ent + 256;
    int* lbase = lcnt + 32;
    { const f32x4* wgp = (const f32x4*)(p.moe_w_group + (size_t)l * 1024 * 4); const f32x4* wep = (const f32x4*)(p.moe_w_expert + (size_t)l * 1024 * 16);
      f32x4 wg4[2], we4[8];
#pragma unroll
      for (int j = 0; j < 2; ++j) wg4[j] = wgp[tid + NTHR * j];
#pragma unroll
      for (int j = 0; j < 8; ++j) we4[j] = wep[tid + NTHR * j];
#pragma unroll
      for (int j = 0; j < 2; ++j) *(f32x4*)(wl + kpos(tid + NTHR * j) * 20) = wg4[j];
#pragma unroll
      for (int j = 0; j < 8; ++j) { const int q = tid + NTHR * j; *(f32x4*)(wl + kpos(q >> 2) * 20 + 4 + 4 * (q & 3)) = we4[j]; } }
    f32x2 g[8], bt[8];
#pragma unroll
    for (int i = 0; i < 8; ++i) { g[i] = ((const f32x2*)(p.ln1_g + l * 1024))[lane + 64 * i]; bt[i] = ((const f32x2*)(p.ln1_b + l * 1024))[lane + 64 * i]; }
    const int gsel = tred_idx<4>(lane);
    for (int ch = bid; ch < T / 128; ch += nblk) {
        if (tid < 32) lcnt[tid] = 0;
        __syncthreads();
        f32x2 xn[8]; unsigned mn[8];
#pragma unroll
        for (int i = 0; i < 8; ++i) { const size_t o = (size_t)(ch * 128 + wid * 16) * 512 + lane + 64 * i; mn[i] = MIX[o];
            if (l == 0) xn[i] = ((const f32x2*)XIN)[o]; else { const unsigned xb = X1B[o]; xn[i] = (f32x2){bflo(xb), bfhi(xb)}; } }
        for (int r = 0; r < 16; ++r) {
            const int lr = wid * 16 + r, t = ch * 128 + lr;
            f32x2 v[8];
#pragma unroll
            for (int i = 0; i < 8; ++i) v[i] = xn[i] * ALPHA + (f32x2){bflo(mn[i]), bfhi(mn[i])};
            if (r + 1 < 16) {
#pragma unroll
                for (int i = 0; i < 8; ++i) { const size_t o = (size_t)(t + 1) * 512 + lane + 64 * i; mn[i] = MIX[o];
                    if (l == 0) xn[i] = ((const f32x2*)XIN)[o]; else { const unsigned xb = X1B[o]; xn[i] = (f32x2){bflo(xb), bfhi(xb)}; } } }
            ln_row2(v, g, bt);
#pragma unroll
            for (int i = 0; i < 8; ++i) X1B[(size_t)t * 512 + lane + 64 * i] = pk_bf16(v[i][0], v[i][1]);
            f32x2 agv[2];
#pragma unroll
            for (int e = 0; e < 2; ++e) agv[e] = (f32x2){0.f, 0.f};
#pragma unroll
            for (int i = 0; i < 8; ++i)
#pragma unroll
                for (int c = 0; c < 2; ++c) { const float* wrow = wl + (c * 512 + 64 * i + lane) * 20; const f32x2 xx = {v[i][c], v[i][c]};
                    const f32x4 w0 = *(const f32x4*)wrow;
                    agv[0] = __builtin_elementwise_fma(xx, (f32x2){w0[0], w0[1]}, agv[0]); agv[1] = __builtin_elementwise_fma(xx, (f32x2){w0[2], w0[3]}, agv[1]); }
            float ag[4];
#pragma unroll
            for (int e = 0; e < 2; ++e) { ag[2 * e] = agv[e][0]; ag[2 * e + 1] = agv[e][1]; }
            const float rg = tred<4>(ag, lane);
            float gl[4]; float gm = -INFINITY; int gs = 0;
#pragma unroll
            for (int e = 0; e < 4; ++e) { gl[e] = __int_as_float(__builtin_amdgcn_readlane(__float_as_int(rg), 16 * e)) + p.moe_b_group[l * 4 + e]; if (gl[e] > gm) { gm = gl[e]; gs = e; } }
            f32x2 aev[2];
#pragma unroll
            for (int e = 0; e < 2; ++e) aev[e] = (f32x2){0.f, 0.f};
#pragma unroll
            for (int i = 0; i < 8; ++i)
#pragma unroll
                for (int c = 0; c < 2; ++c) { const float* wrow = wl + (c * 512 + 64 * i + lane) * 20 + 4 + 4 * gs; const f32x2 xx = {v[i][c], v[i][c]};
                    const f32x4 w4 = *(const f32x4*)wrow;
                    aev[0] = __builtin_elementwise_fma(xx, (f32x2){w4[0], w4[1]}, aev[0]); aev[1] = __builtin_elementwise_fma(xx, (f32x2){w4[2], w4[3]}, aev[1]); }
            float ae[4];
#pragma unroll
            for (int e = 0; e < 2; ++e) { ae[2 * e] = aev[e][0]; ae[2 * e + 1] = aev[e][1]; }
            const float re = tred<4>(ae, lane);
            float* lw = lgs + wid * 256 + r * 16;
            if ((lane & 15) == 0) { lw[gsel] = rg + p.moe_b_group[l * 4 + gsel]; lw[4 + gsel] = re; }
            if (lane == 0) lw[8] = __int_as_float(gs);
        }
        __builtin_amdgcn_wave_barrier();
        if (lane < 16) {
            const int lr = wid * 16 + lane, t = ch * 128 + lr; const float* lw = lgs + wid * 256 + lane * 16;
            float gl[4]; float gm = -INFINITY;
#pragma unroll
            for (int e = 0; e < 4; ++e) { gl[e] = lw[e]; gm = fmaxf(gm, gl[e]); }
            const int gs = __float_as_int(lw[8]);
            float gsum = 0.f;
#pragma unroll
            for (int e = 0; e < 4; ++e) gsum += expf(gl[e] - gm);
            const float gp = 1.0f / gsum;
            float el[4]; float em = -INFINITY;
#pragma unroll
            for (int e = 0; e < 4; ++e) { el[e] = lw[4 + e] + p.moe_b_expert[l * 16 + gs * 4 + e]; em = fmaxf(em, el[e]); }
            int i0 = 0; float b0 = el[0];
#pragma unroll
            for (int e = 1; e < 4; ++e) if (el[e] > b0) { b0 = el[e]; i0 = e; }
            int i1 = 0; float b1 = -INFINITY;
#pragma unroll
            for (int e = 0; e < 4; ++e) if (e != i0 && el[e] > b1) { b1 = el[e]; i1 = e; }
            const float p0 = expf(b0 - em), p1 = expf(b1 - em);
            const float w0 = gp * p0 / (p0 + p1), w1 = gp * p1 / (p0 + p1);
            if (i1 == i0) i1 = (i0 + 1) & 3;
            const int lo = i0 < i1 ? i0 : i1, hi = i0 < i1 ? i1 : i0;
            const int lid = gs * 6 + (lo == 0 ? hi - 1 : (lo == 1 ? hi + 1 : 5));
            TOKW[t * 2] = i0 < i1 ? w0 : w1; TOKW[t * 2 + 1] = i0 < i1 ? w1 : w0;
            const int s0 = atomicAdd(&lcnt[lid], 1);
            ent[lr] = (lid << 16) | s0;
        }
        __syncthreads();
        if (tid < NLIST) lbase[tid] = (int)atomicAdd(&CNT[tid], (unsigned)lcnt[tid]);
        __syncthreads();
        if (tid < 128) { const int pe = ent[tid], e = pe >> 16, sl = pe & 0xffff; LIST[(size_t)e * T + lbase[e] + sl] = ch * 128 + tid; }
        __syncthreads();
    }
}
__device__ __forceinline__ void ph_ln2_2(const P& p, int l, unsigned char* smem, int bid, int nblk, int tid_) {
    int tid = tid_; asm volatile("" : "+v"(tid));
    const int lane = tid & 63, wid = tid >> 6;
    unsigned* X1B = wsp<unsigned>(p, R_XQ + 128 * MiB); const unsigned* Y = wsp<unsigned>(p, R_XBZ);
    float* LOGF = wsp<float>(p, OFF_DT);
    float* wl = (float*)smem;
    if (l == 0) { f32x4 w4[4];
#pragma unroll
        for (int j = 0; j < 4; ++j) { const int q = tid + NTHR * j; w4[j] = *(const f32x4*)(p.od_w_in + (size_t)(q >> 1) * ODD_IN + 1952 + 4 * (q & 1)); }
#pragma unroll
        for (int j = 0; j < 4; ++j) { const int q = tid + NTHR * j; *(f32x4*)(wl + kpos(q >> 1) * 12 + 4 * (q & 1)) = w4[j]; }
        __syncthreads(); }
    f32x2 g[8], bt[8];
#pragma unroll
    for (int i = 0; i < 8; ++i) { g[i] = ((const f32x2*)(p.ln2_g + l * 1024))[lane + 64 * i]; bt[i] = ((const f32x2*)(p.ln2_b + l * 1024))[lane + 64 * i]; }
    const int fsel = tred_idx<8>(lane); const float fb = p.od_f_bias[fsel];
    unsigned xn[8], ya[8];
    { const int t0 = bid * 8 + wid; if (t0 < T) {
#pragma unroll
        for (int i = 0; i < 8; ++i) { const size_t o = (size_t)t0 * 512 + lane + 64 * i; xn[i] = X1B[o]; ya[i] = Y[o]; } } }
    for (int t = bid * 8 + wid; t < T; t += nblk * 8) {
        f32x2 v[8];
#pragma unroll
        for (int i = 0; i < 8; ++i) v[i] = (f32x2){bflo(xn[i]), bfhi(xn[i])} * ALPHA + (f32x2){bflo(ya[i]), bfhi(ya[i])};
        { const int tn = t + nblk * 8; if (tn < T) {
#pragma unroll
            for (int i = 0; i < 8; ++i) { const size_t o = (size_t)tn * 512 + lane + 64 * i; xn[i] = X1B[o]; ya[i] = Y[o]; } } }
        ln_row2(v, g, bt);
        if (l == 1) {
#pragma unroll
            for (int i = 0; i < 8; ++i) ((f32x2*)(p.out + (size_t)t * 1024))[lane + 64 * i] = v[i];
        } else {
#pragma unroll
            for (int i = 0; i < 8; ++i) X1B[(size_t)t * 512 + lane + 64 * i] = pk_bf16(v[i][0], v[i][1]);
            f32x2 afv[4];
#pragma unroll
            for (int e = 0; e < 4; ++e) afv[e] = (f32x2){0.f, 0.f};
#pragma unroll
            for (int i = 0; i < 8; ++i)
#pragma unroll
                for (int c = 0; c < 2; ++c) { const float* wrow = wl + (c * 512 + 64 * i + lane) * 12; const f32x2 xx = {v[i][c], v[i][c]};
                    const f32x4 w0 = *(const f32x4*)wrow, w1 = *(const f32x4*)(wrow + 4);
                    afv[0] = __builtin_elementwise_fma(xx, (f32x2){w0[0], w0[1]}, afv[0]); afv[1] = __builtin_elementwise_fma(xx, (f32x2){w0[2], w0[3]}, afv[1]);
                    afv[2] = __builtin_elementwise_fma(xx, (f32x2){w1[0], w1[1]}, afv[2]); afv[3] = __builtin_elementwise_fma(xx, (f32x2){w1[2], w1[3]}, afv[3]); }
            float af[8];
#pragma unroll
            for (int e = 0; e < 4; ++e) { af[2 * e] = afv[e][0]; af[2 * e + 1] = afv[e][1]; }
            const float r = tred<8>(af, lane);
            if ((lane & 7) == 0) LOGF[(size_t)t * 8 + fsel] = logsigmoid_f(r + fb);
        }
    }
}

#ifndef USE_MF
#define USE_MF 1
#endif
#ifndef USE_ATT
#define USE_ATT 3
#endif
#ifndef USE_THIN
#define USE_THIN 1
#endif
#ifndef USE_SSD
#define USE_SSD 1
#endif
#ifndef REP_MASK
#define REP_MASK 0
#endif
#ifndef REP_SSD
#define REP_SSD 0
#endif
#ifndef REP_SB
#define REP_SB 0
#endif
constexpr int LDS_BYTES = LDS_STAGE + LDS_TAB_BYTES;
constexpr int NPH = 17;
template <int PH> __device__ __forceinline__ void run_phase(const P& p, unsigned char* smem, int bid, int nblk, int tid_) {
    float* lds = (float*)smem;
    if constexpr (PH == 0) { if (USE_THIN) ph_prologue2(p, smem, bid, nblk, tid_); else ph_prologue(p, bid, nblk, tid_); }
    if constexpr (PH == 1) { if (USE_MF) ph_inproj0_mf(p, smem, bid, nblk, tid_); else ph_inproj0(p, lds, bid, nblk, tid_); }
    if constexpr (PH == 2) { if (USE_SSD) ph_conv2(p, smem, bid, nblk, tid_); else ph_conv(p, bid, nblk, tid_); }
    if constexpr (PH == 3) { if (USE_SSD) ph_ssd_mf(p, smem, bid, nblk, tid_); else ph_ssd_naive(p, lds, bid, nblk, tid_); if (REP_SSD) ph_ssd_mf(p, smem, bid, nblk, tid_);
        if (USE_ATT & 1) ph_sb_mf(p, smem, bid, nblk, tid_); else ph_sb_naive(p, bid, nblk, tid_);
        if (REP_SB) ph_sb_mf(p, smem, bid, nblk, tid_); }
    if constexpr (PH == 4) { if (USE_MF) ph_outproj0_mf(p, smem, bid, nblk, tid_); else ph_outproj0(p, lds, bid, nblk, tid_); }
    if constexpr (PH == 5) { if (USE_THIN) ph_ln1_router2(p, 0, smem, bid, nblk, tid_); else ph_ln1_router(p, 0, bid, nblk, tid_); }
    if constexpr (PH == 6) { ph_moe1_mf(p, 0, smem, bid, nblk, tid_); __syncthreads(); ph_moe2_mf(p, 0, smem, bid, nblk, tid_); }
    if constexpr (PH == 8) { if (USE_THIN) ph_ln2_2(p, 0, smem, bid, nblk, tid_); else ph_ln2(p, 0, bid, nblk, tid_); }
    if constexpr (PH == 9) { if (USE_MF) ph_inproj1_mf(p, smem, bid, nblk, tid_); else ph_inproj1(p, lds, bid, nblk, tid_); }
    if constexpr (PH == 10) { if (USE_MF) ph_upproj_mf(p, smem, bid, nblk, tid_); else ph_upproj(p, lds, bid, nblk, tid_); }
    if constexpr (PH == 11) { if (USE_ATT & 2) ph_attn1_mf(p, smem, bid, nblk, tid_); else ph_attn1_naive(p, bid, nblk, tid_); }
    if constexpr (PH == 12) { if (USE_MF) ph_outproj1_mf(p, smem, bid, nblk, tid_); else ph_outproj1(p, lds, bid, nblk, tid_); }
    if constexpr (PH == 13) { if (USE_THIN) ph_ln1_router2(p, 1, smem, bid, nblk, tid_); else ph_ln1_router(p, 1, bid, nblk, tid_); }
    if constexpr (PH == 14) { ph_moe1_mf(p, 1, smem, bid, nblk, tid_); __syncthreads(); ph_moe2_mf(p, 1, smem, bid, nblk, tid_); }
    if constexpr (PH == 16) { if (USE_THIN) ph_ln2_2(p, 1, smem, bid, nblk, tid_); else ph_ln2(p, 1, bid, nblk, tid_); }
}

__device__ __forceinline__ void load_kargs(P& pl) {
#if defined(__HIP_DEVICE_COMPILE__)
    typedef __attribute__((address_space(4))) const P* kargp_t;
    kargp_t kp = (kargp_t)__builtin_amdgcn_kernarg_segment_ptr(); asm volatile("" : "+s"(kp));
    pl.x = kp->x; pl.ev_w_in = kp->ev_w_in; pl.ev_conv_w = kp->ev_conv_w; pl.ev_conv_b = kp->ev_conv_b; pl.ev_dt_bias = kp->ev_dt_bias; pl.ev_a_log = kp->ev_a_log; pl.ev_d_skip = kp->ev_d_skip; pl.ev_norm_g = kp->ev_norm_g; pl.ev_w_out = kp->ev_w_out; pl.od_w_in = kp->od_w_in; pl.od_q_norm_g = kp->od_q_norm_g; pl.od_w_q_up = kp->od_w_q_up; pl.od_kv_norm_g = kp->od_kv_norm_g; pl.od_w_kv_up = kp->od_w_kv_up; pl.od_f_bias = kp->od_f_bias; pl.od_w_out = kp->od_w_out; pl.ln1_g = kp->ln1_g; pl.ln1_b = kp->ln1_b; pl.ln2_g = kp->ln2_g; pl.ln2_b = kp->ln2_b; pl.moe_w_group = kp->moe_w_group; pl.moe_b_group = kp->moe_b_group; pl.moe_w_expert = kp->moe_w_expert; pl.moe_b_expert = kp->moe_b_expert; pl.moe_w_gate = kp->moe_w_gate; pl.moe_w_up = kp->moe_w_up; pl.moe_w_down = kp->moe_w_down; pl.out = kp->out; pl.ws = kp->ws;
#else
    (void)pl;
#endif
}
#if MK_MULTI
template <int PH> __global__ void __launch_bounds__(NTHR, 2) k_phase(P p) {
    extern __shared__ __attribute__((aligned(16))) unsigned char smem[];
    run_phase<PH>(p, smem, blockIdx.x, gridDim.x, threadIdx.x);
}
template <int PH> static void launch_phases(const P& p, int grid, hipStream_t stream) {
    if constexpr (PH < NPH) {
        (void)hipFuncSetAttribute((const void*)k_phase<PH>, hipFuncAttributeMaxDynamicSharedMemorySize, LDS_BYTES);
        hipLaunchKernelGGL(k_phase<PH>, dim3(grid), dim3(NTHR), LDS_BYTES, stream, p);
        launch_phases<PH + 1>(p, grid, stream);
    }
}
#else
template <int PH> __device__ __forceinline__ void run_all(unsigned char* smem, const XcdBarrier& bar, int wave_s) {
    if constexpr (PH < NPH) {
        asm volatile("; PHASE_MARK %0" :: "n"(PH));
#define RUN_ONE_PHASE() do { int bid_ = blockIdx.x, nblk_ = gridDim.x, w_ = wave_s; asm volatile("" : "+s"(bid_), "+s"(nblk_), "+s"(w_)); \
        int tid_ = (w_ << 6) | lane_id(); asm volatile("" : "+v"(tid_)); P pl; load_kargs(pl); run_phase<PH>(pl, smem, bid_, nblk_, tid_); } while (0)
        RUN_ONE_PHASE();
        if constexpr ((REP_MASK >> PH) & 1) { xcd_barrier(bar); RUN_ONE_PHASE(); }
#undef RUN_ONE_PHASE
        if constexpr (PH < NPH - 1 && PH != 7 && PH != 15) xcd_barrier(bar);
        run_all<PH + 1>(smem, bar, wave_s);
    }
}
__global__ void __launch_bounds__(NTHR, 2) k_all(P p) {
    extern __shared__ __attribute__((aligned(16))) unsigned char smem[];
    volatile LAS unsigned* st = (volatile LAS unsigned*)(smem + LDS_BYTES);
    if (threadIdx.x == 0) { st[0] = 0u; st[1] = 0u; st[2] = 0u; st[3] = 0u; }
    __syncthreads();
    XcdBarrier bar = xcd_barrier_post((unsigned*)(p.ws + OFF_BAR), st);
    const int wave_s = __builtin_amdgcn_readfirstlane(threadIdx.x >> 6);
    run_all<0>(smem, bar, wave_s);
}
#endif

extern "C" void kernel_launch(void* const* d_in, const int* in_sizes, int n_in, void* d_out, int out_size, void* d_ws, size_t ws_size, hipStream_t stream) {
    (void)in_sizes; (void)n_in; (void)out_size;
    if (ws_size < WS_NEED) { fprintf(stderr, "workspace too small: %zu < %zu\n", ws_size, WS_NEED); return; }
    P p{};
    const float** f = (const float**)&p;
    for (int i = 0; i < 27; ++i) f[i] = (const float*)d_in[i];
    p.out = (float*)d_out; p.ws = (unsigned char*)d_ws;
    (void)hipMemsetAsync(d_ws, 0, OFF_CTRL + CTRL_BYTES, stream);
#if MK_MULTI
    launch_phases<0>(p, 256, stream);
#else
    static int grid = 0;
    if (!grid) {
        int dev = 0, cus = 0, per_cu = 0;
        hipGetDevice(&dev);
        hipDeviceGetAttribute(&cus, hipDeviceAttributeMultiprocessorCount, dev);
        (void)hipFuncSetAttribute((const void*)k_all, hipFuncAttributeMaxDynamicSharedMemorySize, LDS_BYTES + 16);
        (void)hipOccupancyMaxActiveBlocksPerMultiprocessor(&per_cu, k_all, NTHR, LDS_BYTES + 16);
        grid = cus * (per_cu < 1 ? per_cu : 1);
        if (grid <= 0) grid = cus;
    }
    hipLaunchKernelGGL(k_all, dim3(grid), dim3(NTHR), LDS_BYTES + 16, stream, p);
#endif
}
```

```cpp
#include <hip/hip_runtime.h>
#include <stdint.h>
#include <stdio.h>

#ifndef MK_MULTI
#define MK_MULTI 0
#endif

#ifndef USE_SSD
#define USE_SSD 1
#endif
typedef unsigned short bf16_t;
typedef float f32x4 __attribute__((ext_vector_type(4)));
typedef float f32x2 __attribute__((ext_vector_type(2)));
typedef unsigned u32x4 __attribute__((ext_vector_type(4)));
typedef unsigned u32x2 __attribute__((ext_vector_type(2)));

constexpr int NB = 16, S = 2048, T = NB * S, D = 1024;
constexpr int EVEN_IN = 4112, ODD_IN = 1960;
constexpr float ALPHA = 1.4142135623730951f;
constexpr float LOG2E = 1.4426950408889634f;
constexpr float C2_64 = 0.125f * LOG2E;
constexpr float C2_96 = 0.10206207261596577f * LOG2E;
constexpr int NTHR = 512;

constexpr size_t MiB = 1024 * 1024;
constexpr size_t OFF_BAR = 0;
constexpr size_t OFF_CTRL = 16 * 1024;
constexpr size_t CTRL_BYTES = 16 * 1024;
constexpr size_t OFF_TAB = 64 * 1024;
constexpr size_t OFF_DT = 1 * MiB;
constexpr size_t OFF_SSQ = 3 * MiB;
constexpr size_t OFF_ROUTE = 5 * MiB;
constexpr size_t OFF_W = 8 * MiB;
constexpr size_t W0M = OFF_W;
constexpr size_t W0V = W0M + (size_t)3584 * 1024 * 2;
constexpr size_t W0O = W0V + (size_t)512 * 1024 * 2;
constexpr size_t W1M = W0O + (size_t)1024 * 1536 * 2;
constexpr size_t W1V = W1M + (size_t)1536 * 1024 * 2;
constexpr size_t W1Q = W1V + (size_t)512 * 1024 * 2;
constexpr size_t W1K = W1Q + (size_t)768 * 256 * 2;
constexpr size_t W1VV = W1K + (size_t)512 * 128 * 2;
constexpr size_t W1O = W1VV + (size_t)512 * 128 * 2;
constexpr size_t WGU = W1O + (size_t)1024 * 1024 * 2;
constexpr size_t WDN = WGU + (size_t)2 * 16 * 512 * 1024 * 2;
constexpr size_t W_END = WDN + (size_t)2 * 16 * 1024 * 256 * 2;
static_assert(W_END <= 76 * MiB, "weights region");
constexpr size_t R_XBZ = 76 * MiB;
constexpr size_t R_XQ = 204 * MiB;
constexpr size_t R_A2 = 396 * MiB;
constexpr size_t WS_NEED = 512 * MiB;

struct P {
    const float* x; const float* ev_w_in; const float* ev_conv_w; const float* ev_conv_b; const float* ev_dt_bias; const float* ev_a_log;
    const float* ev_d_skip; const float* ev_norm_g; const float* ev_w_out; const float* od_w_in; const float* od_q_norm_g; const float* od_w_q_up;
    const float* od_kv_norm_g; const float* od_w_kv_up; const float* od_f_bias; const float* od_w_out; const float* ln1_g; const float* ln1_b;
    const float* ln2_g; const float* ln2_b; const float* moe_w_group; const float* moe_b_group; const float* moe_w_expert; const float* moe_b_expert;
    const float* moe_w_gate; const float* moe_w_up; const float* moe_w_down;
    float* out; unsigned char* ws;
};

__device__ __forceinline__ float bf2f(bf16_t v) { return __uint_as_float(((unsigned)v) << 16); }
__device__ __forceinline__ unsigned pk_bf16(float lo, float hi) {
    typedef __bf16 b2 __attribute__((ext_vector_type(2)));
    f32x2 v = {lo, hi}; b2 b = __builtin_convertvector(v, b2); return __builtin_bit_cast(unsigned, b);
}
__device__ __forceinline__ bf16_t f2bf(float f) { return (bf16_t)(pk_bf16(f, 0.f) & 0xffffu); }
__device__ __forceinline__ float bflo(unsigned w) { return __uint_as_float(w << 16); }
__device__ __forceinline__ float bfhi(unsigned w) { return __uint_as_float(w & 0xffff0000u); }
__device__ __forceinline__ float silu_f(float x) { return x * __builtin_amdgcn_rcpf(1.0f + __builtin_amdgcn_exp2f(-1.4426950408889634f * x)); }
__device__ __forceinline__ float softplus_f(float x) { return x > 20.f ? x : log1pf(expf(x)); }
__device__ __forceinline__ float logsigmoid_f(float x) { return fminf(x, 0.f) - log1pf(expf(-fabsf(x))); }
template <int CTRL> __device__ __forceinline__ float dpp_f(float x) { return __int_as_float(__builtin_amdgcn_update_dpp(0, __float_as_int(x), CTRL, 0xF, 0xF, true)); }
template <int G> __device__ __forceinline__ float group_sum(float r) {
    if constexpr (G >= 16) r += dpp_f<0x140>(r);
    if constexpr (G >= 8) r += dpp_f<0x141>(r);
    r += dpp_f<0x4E>(r);
    r += dpp_f<0xB1>(r);
    return r;
}
__device__ __forceinline__ float other16(float x, bool odd) { auto rr = __builtin_amdgcn_permlane16_swap(__float_as_uint(x), __float_as_uint(x), false, false); return __uint_as_float(odd ? rr[0] : rr[1]); }
__device__ __forceinline__ float other32(float x, bool hi) { auto rr = __builtin_amdgcn_permlane32_swap(__float_as_uint(x), __float_as_uint(x), false, false); return __uint_as_float(hi ? rr[0] : rr[1]); }
__device__ __forceinline__ float wave_sum(float v) {
    v = group_sum<16>(v);
    { auto rr = __builtin_amdgcn_permlane16_swap(__float_as_uint(v), __float_as_uint(v), false, false); v = __uint_as_float(rr[0]) + __uint_as_float(rr[1]); }
    { auto rr = __builtin_amdgcn_permlane32_swap(__float_as_uint(v), __float_as_uint(v), false, false); v = __uint_as_float(rr[0]) + __uint_as_float(rr[1]); }
    return v;
}
__device__ __forceinline__ int lane_id() { unsigned z = 0u; asm volatile("" : "+v"(z)); return (int)__builtin_amdgcn_mbcnt_hi(~0u, __builtin_amdgcn_mbcnt_lo(~0u, z)); }
#define LDS_BARRIER() do { asm volatile("s_waitcnt lgkmcnt(0)" ::: "memory"); __builtin_amdgcn_s_barrier(); asm volatile("" ::: "memory"); } while (0)
template <class T_> __device__ __forceinline__ T_* wsp(const P& p, size_t off) { return (T_*)(p.ws + off); }

#define XB_TMO      128
#define XB_XCNT(j)  (256  + 64 * (j))
#define XB_XSUB(j)  (1280 + 64 * (j))
#define XB_XGEN(j)  (2304 + 64 * (j))
#define XB_TOP      3328
#define XB_TOPGEN   3392
#define XCD_BAR_WORDS 3456
#define XB_SPIN_CAP (1u << 18)
#define LAS __attribute__((address_space(3)))

__device__ __forceinline__ unsigned xb_ld(unsigned* p)              { return __hip_atomic_load(p, __ATOMIC_RELAXED, __HIP_MEMORY_SCOPE_AGENT); }
__device__ __forceinline__ unsigned xb_add(unsigned* p, unsigned v) { return __hip_atomic_fetch_add(p, v, __ATOMIC_RELAXED, __HIP_MEMORY_SCOPE_AGENT); }
__device__ __forceinline__ unsigned xb_xcc_id() { return (unsigned)__builtin_amdgcn_s_getreg((3 << 11) | 20) & 0xFu; }
#define XB_SPIN(cond, bar) do { unsigned _sp = 0; while (cond) { __builtin_amdgcn_s_sleep(1); \
    if ((++_sp & 255u) == 0u) { if (xb_ld(&(bar)[XB_TMO])) break; if (_sp > XB_SPIN_CAP) { atomicAdd(&(bar)[XB_TMO], 1u); break; } } } } while (0)

struct XcdBarrier { unsigned* bar; unsigned x; volatile LAS unsigned* st; };

__device__ __forceinline__ XcdBarrier xcd_barrier_post(unsigned* bar, volatile LAS unsigned* st) {
    XcdBarrier b; b.bar = bar; b.x = xb_xcc_id(); b.st = st;
    if (threadIdx.x == 0) (void)xb_add(&bar[XB_XCNT(b.x)], 1u);
    return b;
}
__device__ __forceinline__ void xcd_barrier_complete(unsigned* bar, unsigned x, unsigned& nloc, unsigned& nx) {
    const unsigned G = gridDim.x * gridDim.y * gridDim.z;
    unsigned sum, cnt, mine, sp = 0u;
    for (;;) {
        sum = 0u; cnt = 0u; mine = 0u;
#pragma unroll
        for (unsigned j = 0; j < 16; ++j) { const unsigned c = xb_ld(&bar[XB_XCNT(j)]); sum += c; cnt += (c > 0u) ? 1u : 0u; mine = (j == x) ? c : mine; }
        if (sum == G) break;
        __builtin_amdgcn_s_sleep(1);
        if ((++sp & 255u) == 0u) { if (xb_ld(&bar[XB_TMO])) break; if (sp > XB_SPIN_CAP) { atomicAdd(&bar[XB_TMO], 1u); break; } }
    }
    nloc = mine > 0u ? mine : 1u; nx = cnt > 0u ? cnt : 1u;
}
__device__ __forceinline__ void xcd_barrier(const XcdBarrier& b) {
    asm volatile("s_waitcnt vmcnt(0)" ::: "memory");
    __syncthreads();
    if (threadIdx.x == 0) {
        unsigned* bar = b.bar;
        __builtin_amdgcn_s_waitcnt(0);
        unsigned nloc = b.st[0], nx = b.st[1];
        if (nloc == 0u) { xcd_barrier_complete(bar, b.x, nloc, nx); b.st[0] = nloc; b.st[1] = nx; }
        const unsigned old = xb_add(&bar[XB_XSUB(b.x)], 1u);
        const unsigned gen = old / nloc;
        if (old + 1u == (gen + 1u) * nloc) {
            __builtin_amdgcn_fence(__ATOMIC_RELEASE, "agent");
            asm volatile("s_waitcnt vmcnt(0)" ::: "memory");
            const unsigned og = xb_add(&bar[XB_TOP], 1u);
            const unsigned tg = og / nx;
            if (og + 1u == (tg + 1u) * nx) xb_add(&bar[XB_TOPGEN], 1u);
            else XB_SPIN(xb_ld(&bar[XB_TOPGEN]) == tg, bar);
            __builtin_amdgcn_fence(__ATOMIC_ACQUIRE, "agent");
            xb_add(&bar[XB_XGEN(b.x)], 1u);
            asm volatile("s_waitcnt vmcnt(0)" ::: "memory");
        } else {
            XB_SPIN(xb_ld(&bar[XB_XGEN(b.x)]) == gen, bar);
            __builtin_amdgcn_fence(__ATOMIC_ACQUIRE, "agent");
            asm volatile("s_waitcnt vmcnt(0)" ::: "memory");
        }
    }
    __syncthreads();
}

struct NoMid { static constexpr int ksplit = -1; __device__ __forceinline__ float scale(int) const { return 1.f; } };
template <bool DUAL, class Epi, class Mid> __attribute__((always_inline))
__device__ void gemm_naive(const bf16_t* __restrict__ A, int lda, const int* __restrict__ gidx, const bf16_t* __restrict__ Bt, int ldb,
                           int M, int N, int K, const Epi& epi, const Mid& mid, float* lds, int bid, int nblk, int tid_) {
    float* As = lds;
    float* Bs = lds + 32 * 132;
    float* Bs2 = Bs + 32 * 68;
    const int tid = tid_, ty = tid >> 4, tx = tid & 15;
    const int ntn = N / 64, ntiles = (M / 128) * ntn;
    for (int tile = bid; tile < ntiles; tile += nblk) {
        const int tm = tile / ntn, tn = tile % ntn;
        float acc[4][4], acc2[4][4];
#pragma unroll
        for (int i = 0; i < 4; ++i)
#pragma unroll
            for (int j = 0; j < 4; ++j) { acc[i][j] = 0.f; acc2[i][j] = 0.f; }
        const int lrow = tid >> 2, kc = (tid & 3) * 8;
        long arow = tm * 128 + lrow;
        if (gidx) { const int e = gidx[arow]; arow = e < 0 ? -1 : (e >> 1); }
        int brow = tn * 64 + (lrow & 63);
        if (DUAL) brow = (tn >> 1) * 256 + (tn & 1) * 64 + (lrow & 63);
        for (int k0 = 0; k0 < K; k0 += 32) {
            if (k0 == Mid::ksplit) {
#pragma unroll
                for (int i = 0; i < 4; ++i) { const float s = mid.scale(tm * 128 + ty * 4 + i);
#pragma unroll
                    for (int j = 0; j < 4; ++j) acc[i][j] *= s; }
            }
            u32x4 va = {0u, 0u, 0u, 0u};
            if (arow >= 0) va = *(const u32x4*)(A + (size_t)arow * lda + k0 + kc);
#pragma unroll
            for (int j = 0; j < 4; ++j) { As[(kc + 2 * j) * 132 + lrow] = bflo(va[j]); As[(kc + 2 * j + 1) * 132 + lrow] = bfhi(va[j]); }
            if (tid < 256) {
                const u32x4 vb = *(const u32x4*)(Bt + (size_t)brow * ldb + k0 + kc);
#pragma unroll
                for (int j = 0; j < 4; ++j) { Bs[(kc + 2 * j) * 68 + lrow] = bflo(vb[j]); Bs[(kc + 2 * j + 1) * 68 + lrow] = bfhi(vb[j]); }
            } else if (DUAL) {
                const u32x4 vb = *(const u32x4*)(Bt + (size_t)(brow + 128) * ldb + k0 + kc);
#pragma unroll
                for (int j = 0; j < 4; ++j) { Bs2[(kc + 2 * j) * 68 + (lrow & 63)] = bflo(vb[j]); Bs2[(kc + 2 * j + 1) * 68 + (lrow & 63)] = bfhi(vb[j]); }
            }
            __syncthreads();
#pragma unroll 8
            for (int k = 0; k < 32; ++k) {
                const f32x4 a = *(const f32x4*)(As + k * 132 + ty * 4);
                const f32x4 b = *(const f32x4*)(Bs + k * 68 + tx * 4);
#pragma unroll
                for (int i = 0; i < 4; ++i)
#pragma unroll
                    for (int j = 0; j < 4; ++j) acc[i][j] += a[i] * b[j];
                if (DUAL) {
                    const f32x4 b2 = *(const f32x4*)(Bs2 + k * 68 + tx * 4);
#pragma unroll
                    for (int i = 0; i < 4; ++i)
#pragma unroll
                        for (int j = 0; j < 4; ++j) acc2[i][j] += a[i] * b2[j];
                }
            }
            __syncthreads();
        }
#pragma unroll
        for (int i = 0; i < 4; ++i) {
            f32x4 v = {acc[i][0], acc[i][1], acc[i][2], acc[i][3]};
            if (DUAL) {
#pragma unroll
                for (int j = 0; j < 4; ++j) v[j] = silu_f(acc[i][j]) * acc2[i][j];
            }
            epi(tm * 128 + ty * 4 + i, tn * 64 + tx * 4, v);
        }
    }
}

__device__ __forceinline__ void st_bf16x4(bf16_t* p, f32x4 v) { u32x2 w; w.x = pk_bf16(v[0], v[1]); w.y = pk_bf16(v[2], v[3]); *(u32x2*)p = w; }

namespace pg8 {
#define PG8_LAS __attribute__((address_space(3)))
typedef short bf16x8 __attribute__((ext_vector_type(8)));
constexpr int BM = 256, BK = 64, HALF = 128, HTB = HALF * BK * 2, STAGE_BYTES = 8 * HTB, NXCD = 8, WGM = 4;
__host__ __device__ __forceinline__ int lds_byte(int r, int c) { const int st = (r >> 4) * 2 + (c >> 5), rr = r & 15, cc = c & 31, ob = rr * 64 + cc * 2; return st * 1024 + (ob ^ (((ob >> 9) & 1) << 5)); }
__host__ __device__ __forceinline__ void stage_rc(int b, int& R, int& C) { const int st = b / 1024, sb = b % 1024, swz = sb ^ (((sb >> 9) & 1) << 5); R = (st >> 1) * 16 + swz / 64; C = (st & 1) * 32 + (swz % 64) / 2; }

struct Unit { int pm, pn, e, g0; size_t aoff, boff, boff2; };
struct Gemm { const bf16_t* A; const bf16_t* Bt; int lda, ldb, K; const PG8_LAS int* gl; };

struct DenseOrder {
    static constexpr bool HOOK = false; static constexpr int BSEAM = 0;
    int nM, nN, nwg, G, c, lda, ldb;
    __device__ __forceinline__ void init(int M, int N, int lda_, int ldb_, int G_, int c_) { nM = M / BM; nN = N / BM; nwg = nM * nN; G = G_; c = c_; lda = lda_; ldb = ldb_; }
    __device__ __forceinline__ bool next(int i, Unit& u) const { return at((long)i * G + c, u); }
    __device__ __forceinline__ bool at(long L, Unit& u) const {
        if (L >= nwg) return false;
        int wgid = (int)L; { const int q = nwg / NXCD, r = nwg % NXCD, xcd = wgid % NXCD, off = wgid / NXCD; wgid = (xcd < r ? xcd * (q + 1) : r * (q + 1) + (xcd - r) * q) + off; }
        const int nig = WGM * nN, gid = wgid / nig, fm = gid * WGM, gsz = (nM - fm) < WGM ? (nM - fm) : WGM;
        u.pm = fm + ((wgid % nig) % gsz); u.pn = (wgid % nig) / gsz; u.e = 0; u.g0 = 0;
        u.aoff = (size_t)u.pm * BM * lda * 2; u.boff = (size_t)u.pn * BM * ldb * 2; u.boff2 = u.boff; return true;
    }
};
struct DualOrder {
    static constexpr bool HOOK = false; static constexpr int BSEAM = 0;
    DenseOrder s1, s2; long a2off, b2off;
    __device__ __forceinline__ bool next(int i, Unit& u) const {
        const long L = (long)i * s1.G + s1.c;
        if (L < s1.nwg) return s1.at(L, u);
        if (!s2.at(L - s1.nwg, u)) return false;
        u.e = 1; u.aoff = (size_t)((long)u.aoff + a2off); u.boff = (size_t)((long)u.boff + b2off); u.boff2 = u.boff; return true; }
};
struct NoMidK { static constexpr int ktile = -1; __device__ __forceinline__ void apply(f32x4 (&)[2][2][4][2], int, int, int) const {} };

__host__ __device__ __forceinline__ int perm32(int rho) { const int n = rho >> 4, i = rho & 15; return 8 * (i >> 2) + 4 * n + (i & 3); }
template <class Epi, class Sched, class MidK, bool GATHER, bool PERM = false>
__device__ __forceinline__ void gemm_phase(PG8_LAS unsigned char* lds, const Gemm g, const Sched& S, const Epi& E, const MidK& mid, int tid_) {
    int tid = tid_; asm volatile("" : "+v"(tid));
    const int wid = __builtin_amdgcn_readfirstlane(tid >> 6), lane = tid & 63, wr = wid >> 2, wc = wid & 3, fr = lane & 15, fq = lane >> 4;
    const int K = g.K, nt = K / BK;
    int R_[2], C_[2];
#pragma unroll
    for (int i = 0; i < 2; ++i) stage_rc(tid * 16 + i * 8192, R_[i], C_[i]);
    unsigned vB[2], vAd[2], vAc[2][2], vAn[2][2];
#pragma unroll
    for (int i = 0; i < 2; ++i) { const int Rb = PERM ? ((R_[i] & ~31) + perm32(R_[i] & 31)) : R_[i]; vB[i] = (unsigned)(Rb * g.ldb + C_[i]) * 2u; vAd[i] = (unsigned)(R_[i] * g.lda + C_[i]) * 2u; }
#pragma unroll
    for (int h = 0; h < 2; ++h)
#pragma unroll
        for (int i = 0; i < 2; ++i) { vAc[h][i] = 0u; vAn[h][i] = 0u; }
    const size_t hstepA = GATHER ? (size_t)0 : (size_t)HALF * g.lda * 2, hstepB = (size_t)HALF * g.ldb * 2;
#define PG8_GATHER_SET(v, ui_) do { if constexpr (GATHER) { _Pragma("unroll") for (int h_ = 0; h_ < 2; ++h_) _Pragma("unroll") for (int i_ = 0; i_ < 2; ++i_) \
        v[h_][i_] = (unsigned)(g.gl[(ui_) * 256 + h_ * HALF + R_[i_]] * g.lda + C_[i_]) * 2u; } } while (0)
    const size_t kstep = (size_t)(BK * 2);
    const unsigned ldsw = (unsigned)wid * 1024u;
    const int aoff = lds_byte(wr * 64 + fr, fq * 8), boff = lds_byte(wc * 32 + fr, fq * 8);
#define PG8_SA(b, h) (((b) * 2 + (h)) * HTB)
#define PG8_SB(b, h) ((4 + (b) * 2 + (h)) * HTB)
#define PG8_STAGE(bufoff, gbase, voff) do { _Pragma("unroll") for (int _i = 0; _i < 2; ++_i) \
        __builtin_amdgcn_global_load_lds((const unsigned*)((const char*)(gbase) + (voff)[_i]), (PG8_LAS unsigned*)(lds + (bufoff) + ldsw + _i * 8192), 16, 0, 0); } while (0)
#define PG8_STB(bufoff, gbase, h) PG8_STAGE(bufoff, (gbase) + (h) * hstepB, vB)
#define PG8_STA(bufoff, gbase, h, VG) do { if constexpr (GATHER) { PG8_STAGE(bufoff, gbase, VG[h]); } else { PG8_STAGE(bufoff, (gbase) + (h) * hstepA, vAd); } } while (0)
#define PG8_LDA(dst, b, h) do { _Pragma("unroll") for (int m = 0; m < 4; ++m) _Pragma("unroll") for (int k = 0; k < 2; ++k) dst[m][k] = *(const PG8_LAS bf16x8*)(lds + PG8_SA(b, h) + aoff + m * 2048 + k * 1024); } while (0)
#define PG8_LDB(dst, b, h) do { _Pragma("unroll") for (int n = 0; n < 2; ++n) _Pragma("unroll") for (int k = 0; k < 2; ++k) dst[n][k] = *(const PG8_LAS bf16x8*)(lds + PG8_SB(b, h) + boff + n * 2048 + k * 1024); } while (0)
#define PG8_MMA(ai, bj, At, Bt) do { __builtin_amdgcn_s_setprio(1); _Pragma("unroll") for (int m = 0; m < 4; ++m) _Pragma("unroll") for (int n = 0; n < 2; ++n) _Pragma("unroll") for (int k = 0; k < 2; ++k) \
        acc[ai][bj][m][n] = __builtin_amdgcn_mfma_f32_16x16x32_bf16(Bt[n][k], At[m][k], acc[ai][bj][m][n], 0, 0, 0); __builtin_amdgcn_s_setprio(0); } while (0)
#define PG8_WAIT_V(n) asm volatile("s_waitcnt vmcnt(" #n ")" ::: "memory")
#define PG8_WAIT_L(n) asm volatile("s_waitcnt lgkmcnt(" #n ")" ::: "memory")
#define PG8_BAR __builtin_amdgcn_s_barrier()
#define PG8_SCHED __builtin_amdgcn_sched_barrier(0)
    Unit cur, nxt; int ui = 0;
    if (!S.next(0, cur)) return;
    f32x4 acc[2][2][4][2];
#pragma unroll
    for (int a = 0; a < 2; ++a)
#pragma unroll
        for (int b = 0; b < 2; ++b)
#pragma unroll
            for (int m = 0; m < 4; ++m)
#pragma unroll
                for (int n = 0; n < 2; ++n) acc[a][b][m][n] = (f32x4){0.f, 0.f, 0.f, 0.f};
    bf16x8 At[4][2], B0[2][2], B1[2][2];
    const char* cA = (const char*)g.A + cur.aoff; const char* cB = (const char*)g.Bt + cur.boff; const char* cB2 = (const char*)g.Bt + cur.boff2;
    if constexpr (Sched::HOOK) S.a_ready(cur, wid);
    PG8_GATHER_SET(vAc, 0);
    if constexpr (GATHER) PG8_WAIT_L(0);
    PG8_STB(PG8_SB(0, 0), cB, 0); PG8_STB(PG8_SB(0, 1), cB, 1); PG8_STA(PG8_SA(0, 0), cA, 0, vAc); PG8_STA(PG8_SA(0, 1), cA, 1, vAc);
    if (wr == 1) PG8_BAR;
    PG8_WAIT_V(2); PG8_BAR;
    PG8_STB(PG8_SB(1, 0), cB + kstep, 0); PG8_STA(PG8_SA(1, 0), cA + kstep, 0, vAc); PG8_STB(PG8_SB(1, 1), cB + kstep, 1);
    PG8_WAIT_V(6); PG8_BAR;
    for (;;) {
        const bool has_next = S.next(ui + 1, nxt);
        const char* nA = has_next ? (const char*)g.A + nxt.aoff : cA; const char* nB = has_next ? (const char*)g.Bt + nxt.boff : cB; const char* nB2 = has_next ? (const char*)g.Bt + nxt.boff2 : cB2;
        if constexpr (GATHER) { if (has_next) { PG8_GATHER_SET(vAn, ui + 1); } else {
#pragma unroll
            for (int h = 0; h < 2; ++h)
#pragma unroll
                for (int i = 0; i < 2; ++i) vAn[h][i] = vAc[h][i]; } }
#pragma unroll 1
        for (int t = 0; t < nt; t += 2) {
            const bool last = (t == nt - 2);
            if constexpr (Sched::HOOK) { if (last && has_next) S.a_ready(nxt, wid); }
            if constexpr (MidK::ktile >= 0) { if (t == MidK::ktile) mid.apply(acc, ui, wr, fr); }
            const char* a1 = cA + (size_t)(t + 1) * kstep;
            const char* cBs = (Sched::BSEAM > 0 && t + 2 >= Sched::BSEAM) ? cB2 : cB;
            const char* a2 = last ? nA : cA + (size_t)(t + 2) * kstep; const char* b2 = last ? nB : cBs + (size_t)(t + 2) * kstep;
            const char* a3 = a2 + kstep; const char* b3 = b2 + kstep;
            unsigned vA2[2][2];
#pragma unroll
            for (int h = 0; h < 2; ++h)
#pragma unroll
                for (int i = 0; i < 2; ++i) vA2[h][i] = (GATHER && last) ? vAn[h][i] : vAc[h][i];
            PG8_LDB(B0, 0, 0); PG8_LDB(B1, 0, 1); PG8_SCHED; PG8_LDA(At, 0, 0); PG8_STA(PG8_SA(1, 1), a1, 1, vAc);
            PG8_WAIT_V(8); PG8_WAIT_L(0); PG8_BAR; PG8_MMA(0, 0, At, B0); PG8_MMA(0, 1, At, B1); PG8_BAR; PG8_SCHED;
            PG8_LDA(At, 0, 1); PG8_STB(PG8_SB(0, 0), b2, 0); PG8_STB(PG8_SB(0, 1), b2, 1); PG8_STA(PG8_SA(0, 0), a2, 0, vA2);
            PG8_WAIT_V(8); PG8_WAIT_L(0); PG8_BAR; PG8_MMA(1, 0, At, B0); PG8_MMA(1, 1, At, B1); PG8_BAR; PG8_SCHED;
            PG8_LDB(B0, 1, 0); PG8_LDB(B1, 1, 1); PG8_SCHED; PG8_LDA(At, 1, 0); PG8_STA(PG8_SA(0, 1), a2, 1, vA2);
            PG8_WAIT_V(8); PG8_WAIT_L(0); PG8_BAR; PG8_MMA(0, 0, At, B0); PG8_MMA(0, 1, At, B1); PG8_BAR; PG8_SCHED;
            PG8_LDA(At, 1, 1); PG8_STB(PG8_SB(1, 0), b3, 0); PG8_STB(PG8_SB(1, 1), b3, 1); PG8_STA(PG8_SA(1, 0), a3, 0, vA2);
            PG8_WAIT_V(8); PG8_WAIT_L(0); PG8_BAR; PG8_MMA(1, 0, At, B0); PG8_MMA(1, 1, At, B1); PG8_BAR; PG8_SCHED;
        }
        if (wr == 0) PG8_BAR;
        { int le = lane_id(); asm volatile("" : "+v"(le)); E(acc, cur, ui, wr, wc, le & 15, le >> 4); }
        if (!has_next) break;
#pragma unroll
        for (int a = 0; a < 2; ++a)
#pragma unroll
            for (int b = 0; b < 2; ++b)
#pragma unroll
                for (int m = 0; m < 4; ++m)
#pragma unroll
                    for (int n = 0; n < 2; ++n) acc[a][b][m][n] = (f32x4){0.f, 0.f, 0.f, 0.f};
        cur = nxt; cA = nA; cB = nB; cB2 = nB2; ++ui;
        if constexpr (GATHER) {
#pragma unroll
            for (int h = 0; h < 2; ++h)
#pragma unroll
                for (int i = 0; i < 2; ++i) vAc[h][i] = vAn[h][i]; }
        if (wr == 1) PG8_BAR;
    }
    PG8_WAIT_V(0);
    PG8_BAR;
#undef PG8_GATHER_SET
#undef PG8_SA
#undef PG8_SB
#undef PG8_STAGE
#undef PG8_STA
#undef PG8_STB
#undef PG8_LDA
#undef PG8_LDB
#undef PG8_MMA
#undef PG8_WAIT_V
#undef PG8_WAIT_L
#undef PG8_BAR
#undef PG8_SCHED
}
template <class F> __device__ __forceinline__ void epi_each(const f32x4 (&acc)[2][2][4][2], const Unit& u, int wr, int wc, int fr, int fq, const F& f) {
#pragma unroll
    for (int ai = 0; ai < 2; ++ai)
#pragma unroll
        for (int m = 0; m < 4; ++m) { const int row = u.pm * BM + ai * HALF + wr * 64 + m * 16 + fr;
#pragma unroll
            for (int bj = 0; bj < 2; ++bj)
#pragma unroll
                for (int n = 0; n < 2; ++n) f(row, u.pn * BM + bj * HALF + wc * 32 + n * 16 + fq * 4, acc[ai][bj][m][n]); }
}
template <class F> struct EpiWrap { F f; __device__ __forceinline__ void operator()(const f32x4 (&acc)[2][2][4][2], const Unit& u, int, int wr, int wc, int fr, int fq) const { epi_each(acc, u, wr, wc, fr, fq, f); } };
}

template <class F> __device__ __forceinline__ void conv_rows(bf16_t* dst, int nrows, int K, F f, size_t gtid, size_t gstride) {
    const size_t n_el = (size_t)nrows * K;
    for (size_t i = gtid; i < n_el; i += gstride) { const int n = (int)(i / K), k = (int)(i % K); dst[i] = f2bf(f(n, k)); }
}
__device__ __forceinline__ void ph_prologue(const P& p, int bid, int nblk, int tid_) {
    const size_t gtid = (size_t)bid * NTHR + tid_, gstride = (size_t)nblk * NTHR;
    { const f32x4* src = (const f32x4*)p.x; u32x2* dst = wsp<u32x2>(p, R_XBZ);
      for (size_t i = gtid; i < (size_t)T * D / 4; i += gstride) { const f32x4 v = src[i]; u32x2 o; o.x = pk_bf16(v[0], v[1]); o.y = pk_bf16(v[2], v[3]); dst[i] = o; } }
    { float* DT = wsp<float>(p, OFF_DT);
      for (size_t i = gtid; i < (size_t)T * 16; i += gstride) { const int t = (int)(i >> 4), h = (int)(i & 15); const float* xr = p.x + (size_t)t * D; const float* w = p.ev_w_in + 2560 + h;
        float a = 0.f; for (int k = 0; k < D; ++k) a += xr[k] * w[(size_t)k * EVEN_IN]; DT[i] = softplus_f(a + p.ev_dt_bias[h]); } }
    { const float* w = p.ev_w_in;
      conv_rows(wsp<bf16_t>(p, W0M), 3584, 1024, [=](int n, int k) { const int c = n < 2560 ? n : (n < 3072 ? 2576 + (n - 2560) : 3088 + (n - 3072)); return w[(size_t)k * EVEN_IN + c]; }, gtid, gstride);
      conv_rows(wsp<bf16_t>(p, W0V), 512, 1024, [=](int n, int k) { return w[(size_t)k * EVEN_IN + 3600 + n]; }, gtid, gstride); }
    { const float* w = p.ev_w_out; const float* g = p.ev_norm_g;
      conv_rows(wsp<bf16_t>(p, W0O), 1024, 1536, [=](int n, int k) { return w[(size_t)k * 1024 + n] * (k < 1024 ? g[k] : 1.f); }, gtid, gstride); }
    { const float* w = p.od_w_in;
      conv_rows(wsp<bf16_t>(p, W1M), 1536, 1024, [=](int n, int k) {
          int c;
          if (n < 384) c = n;
          else if (n < 416) { const int j = n - 384, i = j >> 1; c = 384 + ((j & 1) ? i + 16 : i); }
          else if (n < 512) return 0.f;
          else if (n < 1024) c = 416 + (n - 512);
          else c = 928 + (n - 1024);
          return w[(size_t)k * ODD_IN + c]; }, gtid, gstride);
      conv_rows(wsp<bf16_t>(p, W1V), 512, 1024, [=](int n, int k) { return w[(size_t)k * ODD_IN + 1440 + n]; }, gtid, gstride); }
    { const float* w = p.od_w_q_up; const float* g = p.od_q_norm_g;
      conv_rows(wsp<bf16_t>(p, W1Q), 768, 256, [=](int n, int k) { const int h = n / 96, j = n % 96; int c = n;
          if (j >= 64) { const int jj = j - 64, i = jj >> 1; c = 96 * h + 64 + ((jj & 1) ? i + 16 : i); }
          return w[(size_t)k * 768 + c] * g[k]; }, gtid, gstride); }
    { const float* w = p.od_w_kv_up; const float* g = p.od_kv_norm_g;
      conv_rows(wsp<bf16_t>(p, W1K), 512, 128, [=](int n, int k) { const int h = n >> 6, d = n & 63; return w[(size_t)k * 1024 + 128 * h + d] * g[k]; }, gtid, gstride);
      conv_rows(wsp<bf16_t>(p, W1VV), 512, 128, [=](int n, int k) { const int h = n >> 6, d = n & 63; return w[(size_t)k * 1024 + 128 * h + 64 + d] * g[k]; }, gtid, gstride); }
    { const float* w = p.od_w_out;
      conv_rows(wsp<bf16_t>(p, W1O), 1024, 1024, [=](int n, int k) { return w[(size_t)k * 1024 + n]; }, gtid, gstride); }
    { const float* wg = p.moe_w_gate; const float* wu = p.moe_w_up; const float* wd = p.moe_w_down;
      { bf16_t* dst = wsp<bf16_t>(p, WGU);
        for (size_t i = gtid; i < (size_t)32 * 256 * 1024; i += gstride) { const int k = (int)(i & 1023), n = (int)(i >> 10), le = n >> 8, c = n & 255, j = c >> 7, r = c & 127;
          const size_t row = (size_t)le * 512 + j * 256 + r, si = ((size_t)le * 1024 + k) * 256 + c;
          dst[row * 1024 + k] = f2bf(wg[si]); dst[(row + 128) * 1024 + k] = f2bf(wu[si]); } }
      conv_rows(wsp<bf16_t>(p, WDN), 32 * 1024, 256, [=](int n, int k) { const int le = n >> 10, c = n & 1023; return wd[((size_t)le * 256 + k) * 1024 + c]; }, gtid, gstride); }
    { float* tab = wsp<float>(p, OFF_TAB);
      for (size_t i = gtid; i < (size_t)S * 16; i += gstride) { const int s = (int)(i >> 4), f = (int)(i & 15);
        double inv = 1.0; for (int k = 0; k < f; ++k) inv *= 0.56234132519034908;
        const double rev = (double)s * inv * 0.15915494309189535; const double fr = rev - floor(rev);
        const double x = fr * 4.0; const double qd = floor(x + 0.5); const int qi = (int)qd & 3;
        const double y = (x - qd) * 1.5707963267948966, y2 = y * y;
        const double sy = y * (1.0 + y2 * (-1.0 / 6 + y2 * (1.0 / 120 + y2 * (-1.0 / 5040 + y2 * (1.0 / 362880 + y2 * (-1.0 / 39916800 + y2 * (1.0 / 6227020800.0)))))));
        const double cy = 1.0 + y2 * (-0.5 + y2 * (1.0 / 24 + y2 * (-1.0 / 720 + y2 * (1.0 / 40320 + y2 * (-1.0 / 3628800 + y2 * (1.0 / 479001600.0 + y2 * (-1.0 / 87178291200.0)))))));
        const double cv = (qi == 0) ? cy : (qi == 1) ? -sy : (qi == 2) ? -cy : sy;
        const double sv = (qi == 0) ? sy : (qi == 1) ? cy : (qi == 2) ? -sy : -cy;
        tab[i] = (float)cv; tab[S * 16 + i] = (float)sv; } }
}

struct EpiIn0 {
    bf16_t* Z; bf16_t* XBCR; bf16_t* Q; bf16_t* K;
    __device__ __forceinline__ void operator()(int row, int col, f32x4 v) const {
        if (col < 1024) st_bf16x4(Z + (size_t)row * 1024 + col, v);
        else if (col < 2560) st_bf16x4(XBCR + (size_t)row * 1536 + (col - 1024), v);
        else if (col < 3072) st_bf16x4(Q + (size_t)row * 512 + (col - 2560), v * C2_64);
        else st_bf16x4(K + (size_t)row * 512 + (col - 3072), v);
    }
};
struct EpiVt { bf16_t* Vt; __device__ __forceinline__ void operator()(int row, int col, f32x4 v) const { st_bf16x4(Vt + (size_t)row * T + col, v); } };

__device__ __forceinline__ void ph_inproj0(const P& p, float* lds, int bid, int nblk, int tid_) {
    const bf16_t* XB = wsp<bf16_t>(p, R_XBZ);
    EpiIn0 e{wsp<bf16_t>(p, R_XBZ + 64 * MiB), wsp<bf16_t>(p, R_A2), wsp<bf16_t>(p, R_XQ + 96 * MiB), wsp<bf16_t>(p, R_XQ + 128 * MiB)};
    gemm_naive<false>(XB, 1024, nullptr, wsp<bf16_t>(p, W0M), 1024, T, 3584, 1024, e, NoMid{}, lds, bid, nblk, tid_);
    EpiVt ev{wsp<bf16_t>(p, R_XQ + 160 * MiB)};
    gemm_naive<false>(wsp<bf16_t>(p, W0V), 1024, nullptr, XB, 1024, 512, T, 1024, ev, NoMid{}, lds, bid, nblk, tid_);
}
__device__ __forceinline__ void ph_conv(const P& p, int bid, int nblk, int tid_) {
    const bf16_t* XR = wsp<bf16_t>(p, R_A2); bf16_t* XC = wsp<bf16_t>(p, R_XQ);
    const size_t gtid = (size_t)bid * NTHR + tid_, gstride = (size_t)nblk * NTHR;
    for (size_t i = gtid; i < (size_t)T * 1536; i += gstride) {
        const int t = (int)(i / 1536), c = (int)(i % 1536), s = t & (S - 1);
        float a = p.ev_conv_b[c];
#pragma unroll
        for (int k = 0; k < 4; ++k) { const int ss = s - 3 + k; if (ss >= 0) a += p.ev_conv_w[k * 1536 + c] * bf2f(XR[(size_t)(t - 3 + k) * 1536 + c]); }
        XC[i] = f2bf(silu_f(a));
    }
}
__device__ __forceinline__ void ph_ssd_naive(const P& p, float* lds, int bid, int nblk, int tid_) {
    const bf16_t* XC = wsp<bf16_t>(p, R_XQ); const bf16_t* Z = wsp<bf16_t>(p, R_XBZ + 64 * MiB); const float* DT = wsp<float>(p, OFF_DT);
    bf16_t* A2 = wsp<bf16_t>(p, R_A2); float* SSQ = wsp<float>(p, OFF_SSQ);
    float* Bs = lds; float* Cs = Bs + 16 * 128; float* xs = Cs + 16 * 128; float* dts = xs + 16 * 64; float* yp = dts + 16;
    const int tid = tid_, pp = tid & 63, nq = tid >> 6, lane = tid & 63;
    for (int u = bid; u < NB * 16; u += nblk) {
        const int b = u >> 4, h = u & 15, g = h >> 3;
        const float a = -expf(p.ev_a_log[h]), dsk = p.ev_d_skip[h];
        float st[16];
#pragma unroll
        for (int n = 0; n < 16; ++n) st[n] = 0.f;
        for (int c0 = 0; c0 < S; c0 += 16) {
            const size_t r0 = (size_t)b * S + c0;
            for (int idx = tid; idx < 16 * 128; idx += NTHR) { const int i = idx >> 7, n = idx & 127; const bf16_t* r = XC + (r0 + i) * 1536;
                Bs[idx] = bf2f(r[1024 + g * 128 + n]); Cs[idx] = bf2f(r[1280 + g * 128 + n]); }
            for (int idx = tid; idx < 16 * 64; idx += NTHR) { const int i = idx >> 6, q = idx & 63; xs[idx] = bf2f(XC[(r0 + i) * 1536 + h * 64 + q]); }
            if (tid < 16) dts[tid] = DT[(r0 + tid) * 16 + h];
            __syncthreads();
            for (int i = 0; i < 16; ++i) {
                const float dt = dts[i], dA = expf(dt * a), dtx = dt * xs[i * 64 + pp];
                float y = 0.f;
#pragma unroll
                for (int n = 0; n < 16; ++n) { st[n] = st[n] * dA + dtx * Bs[i * 128 + nq * 16 + n]; y += Cs[i * 128 + nq * 16 + n] * st[n]; }
                yp[(nq * 16 + i) * 64 + pp] = y;
            }
            __syncthreads();
            for (int idx = tid; idx < 16 * 64; idx += NTHR) {
                const int i = idx >> 6, q = idx & 63; float y = 0.f;
#pragma unroll
                for (int w = 0; w < 8; ++w) y += yp[(w * 16 + i) * 64 + q];
                y += dsk * xs[idx];
                const float z = bf2f(Z[(r0 + i) * 1024 + h * 64 + q]);
                const float uu = y * silu_f(z);
                A2[(r0 + i) * 1536 + h * 64 + q] = f2bf(uu);
                const float ss = wave_sum(uu * uu);
                if (lane == 0) SSQ[(r0 + i) * 16 + h] = ss;
            }
            __syncthreads();
        }
    }
}
__device__ __forceinline__ void ph_sb_naive(const P& p, int bid, int nblk, int tid_) {
    const bf16_t* Q = wsp<bf16_t>(p, R_XQ + 96 * MiB); const bf16_t* K = wsp<bf16_t>(p, R_XQ + 128 * MiB); const bf16_t* Vt = wsp<bf16_t>(p, R_XQ + 160 * MiB);
    bf16_t* A2 = wsp<bf16_t>(p, R_A2);
    const int lane = tid_ & 63, wid = tid_ >> 6;
    const int nunits = NB * 8 * (S / 64);
    for (int u = bid * 8 + wid; u < nunits; u += nblk * 8) {
        const int tb = (S / 64 - 1) - (u % (S / 64)), bh = u / (S / 64), b = bh >> 3, h = bh & 7;
        const int t0 = tb * 64, t = t0 + lane; const size_t row = (size_t)b * S + t;
        unsigned qp[32]; float o[64];
#pragma unroll
        for (int d = 0; d < 64; d += 8) { const u32x4 v = *(const u32x4*)(Q + row * 512 + h * 64 + d);
#pragma unroll
            for (int j = 0; j < 4; ++j) qp[d / 2 + j] = v[j]; }
#pragma unroll
        for (int d = 0; d < 64; ++d) o[d] = 0.f;
        float csum = 0.f;
        for (int s = t0 + 62; s >= 0; --s) {
            const bf16_t* kr = K + ((size_t)b * S + s) * 512 + h * 64;
            float z = 0.f;
#pragma unroll
            for (int d = 0; d < 64; d += 8) { const u32x4 v = *(const u32x4*)(kr + d);
#pragma unroll
                for (int j = 0; j < 4; ++j) { z += bflo(qp[d / 2 + j]) * bflo(v[j]); z += bfhi(qp[d / 2 + j]) * bfhi(v[j]); } }
            float w = 0.f;
            if (s < t) { const float l = fmaxf(z, 0.f) + log2f(1.f + exp2f(-fabsf(z))); csum += l; w = exp2f(z - csum); }
            const bf16_t* vc = Vt + (size_t)(h * 64) * T + (size_t)b * S + s;
#pragma unroll
            for (int d = 0; d < 64; ++d) o[d] += w * bf2f(vc[(size_t)d * T]);
        }
#pragma unroll
        for (int d = 0; d < 64; d += 4) st_bf16x4(A2 + row * 1536 + 1024 + h * 64 + d, (f32x4){o[d], o[d + 1], o[d + 2], o[d + 3]});
    }
}
struct MidRms0 { static constexpr int ksplit = 1024; const float* SSQ;
    __device__ __forceinline__ float scale(int row) const { float s = 0.f;
#pragma unroll
        for (int h = 0; h < 16; ++h) s += SSQ[(size_t)row * 16 + h];
        return rsqrtf(s * (1.0f / 1024.0f) + 1e-6f); } };
struct EpiRes { const float* X; float* PRE; __device__ __forceinline__ void operator()(int row, int col, f32x4 v) const {
        const f32x4 xr = *(const f32x4*)(X + (size_t)row * 1024 + col); *(f32x4*)(PRE + (size_t)row * 1024 + col) = xr * ALPHA + v; } };
struct EpiMixMf { bf16_t* MIX; __device__ __forceinline__ void operator()(const f32x4 (&acc)[2][2][4][2], const pg8::Unit& u, int, int wr, int wc, int fr, int fq) const; };
__device__ __forceinline__ void ph_outproj0(const P& p, float* lds, int bid, int nblk, int tid_) {
    MidRms0 mid{wsp<float>(p, OFF_SSQ)}; EpiRes e{p.x, wsp<float>(p, R_XBZ)};
    gemm_naive<false>(wsp<bf16_t>(p, R_A2), 1536, nullptr, wsp<bf16_t>(p, W0O), 1536, T, 1024, 1536, e, mid, lds, bid, nblk, tid_);
}

__device__ __forceinline__ void ln_row(f32x4 (&v)[4], const float* g, const float* bta, int lane) {
    float s = 0.f;
#pragma unroll
    for (int j = 0; j < 4; ++j) s += (v[j][0] + v[j][1]) + (v[j][2] + v[j][3]);
    const float mu = wave_sum(s) * (1.0f / 1024.0f);
    float q = 0.f;
#pragma unroll
    for (int j = 0; j < 4; ++j) { const f32x4 d = v[j] - mu; q += (d[0] * d[0] + d[1] * d[1]) + (d[2] * d[2] + d[3] * d[3]); }
    const float rstd = rsqrtf(wave_sum(q) * (1.0f / 1024.0f) + 1e-5f);
#pragma unroll
    for (int j = 0; j < 4; ++j) { const f32x4 gg = *(const f32x4*)(g + j * 256 + lane * 4), bb = *(const f32x4*)(bta + j * 256 + lane * 4); v[j] = (v[j] - mu) * rstd * gg + bb; }
}
__device__ __forceinline__ void ph_ln1_router(const P& p, int l, int bid, int nblk, int tid_) {
    const float* PRE = wsp<float>(p, R_XBZ); float* X1F = wsp<float>(p, R_XQ); bf16_t* X1B = wsp<bf16_t>(p, R_XQ + 128 * MiB);
    int* TOKE = wsp<int>(p, OFF_ROUTE); float* TOKW = wsp<float>(p, OFF_ROUTE + 256 * 1024); int* LIST = wsp<int>(p, OFF_ROUTE + 512 * 1024);
    unsigned* CNT = wsp<unsigned>(p, OFF_CTRL) + 64 * l;
    const float* g = p.ln1_g + l * 1024; const float* bta = p.ln1_b + l * 1024;
    const float* wgp = p.moe_w_group + (size_t)l * 1024 * 4; const float* wep = p.moe_w_expert + (size_t)l * 1024 * 16;
    const int lane = tid_ & 63, wid = tid_ >> 6;
    for (int t = bid * 8 + wid; t < T; t += nblk * 8) {
        f32x4 v[4];
#pragma unroll
        for (int j = 0; j < 4; ++j) v[j] = *(const f32x4*)(PRE + (size_t)t * 1024 + j * 256 + lane * 4);
        ln_row(v, g, bta, lane);
#pragma unroll
        for (int j = 0; j < 4; ++j) { *(f32x4*)(X1F + (size_t)t * 1024 + j * 256 + lane * 4) = v[j]; st_bf16x4(X1B + (size_t)t * 1024 + j * 256 + lane * 4, v[j]); }
        float lg[20];
#pragma unroll
        for (int e = 0; e < 20; ++e) lg[e] = 0.f;
#pragma unroll
        for (int j = 0; j < 4; ++j)
#pragma unroll
            for (int i = 0; i < 4; ++i) { const int k = j * 256 + lane * 4 + i; const float xv = v[j][i];
                const f32x4 wg4 = *(const f32x4*)(wgp + (size_t)k * 4);
#pragma unroll
                for (int e = 0; e < 4; ++e) lg[e] += xv * wg4[e];
#pragma unroll
                for (int e4 = 0; e4 < 4; ++e4) { const f32x4 we4 = *(const f32x4*)(wep + (size_t)k * 16 + e4 * 4);
#pragma unroll
                    for (int e = 0; e < 4; ++e) lg[4 + e4 * 4 + e] += xv * we4[e]; } }
#pragma unroll
        for (int e = 0; e < 20; ++e) lg[e] = wave_sum(lg[e]);
        if (lane == 0) {
            float gl[4]; float gm = -INFINITY; int gs = 0;
#pragma unroll
            for (int e = 0; e < 4; ++e) { gl[e] = lg[e] + p.moe_b_group[l * 4 + e]; if (gl[e] > gm) { gm = gl[e]; gs = e; } }
            float gsum = 0.f;
#pragma unroll
            for (int e = 0; e < 4; ++e) gsum += expf(gl[e] - gm);
            const float gp = 1.0f / gsum;
            float el[4]; float em = -INFINITY;
#pragma unroll
            for (int e = 0; e < 4; ++e) { float vv = 0.f;
#pragma unroll
                for (int gg = 0; gg < 4; ++gg) vv = (gg == gs) ? lg[4 + gg * 4 + e] : vv;
                el[e] = vv + p.moe_b_expert[l * 16 + gs * 4 + e]; em = fmaxf(em, el[e]); }
            int i0 = 0; float b0 = el[0];
#pragma unroll
            for (int e = 1; e < 4; ++e) if (el[e] > b0) { b0 = el[e]; i0 = e; }
            int i1 = 0; float b1 = -INFINITY;
#pragma unroll
            for (int e = 0; e < 4; ++e) if (e != i0 && el[e] > b1) { b1 = el[e]; i1 = e; }
            const float p0 = expf(b0 - em), p1 = expf(b1 - em);
            const float w0 = gp * p0 / (p0 + p1), w1 = gp * p1 / (p0 + p1);
            const int e0 = gs * 4 + i0, e1 = gs * 4 + i1;
            TOKE[t * 2] = e0; TOKE[t * 2 + 1] = e1; TOKW[t * 2] = w0; TOKW[t * 2 + 1] = w1;
            const unsigned s0 = atomicAdd(&CNT[e0], 1u); LIST[(size_t)e0 * T + s0] = t * 2;
            const unsigned s1 = atomicAdd(&CNT[e1], 1u); LIST[(size_t)e1 * T + s1] = t * 2 + 1;
        }
    }
}
struct EpiHid { bf16_t* HID; __device__ __forceinline__ void operator()(int row, int col, f32x4 v) const { st_bf16x4(HID + (size_t)row * 256 + col, v); } };
struct EpiDown { bf16_t* Y; const int* gidx; const float* TOKW;
    __device__ __forceinline__ void operator()(int row, int col, f32x4 v) const { const int e = gidx[row]; if (e < 0) return; const float w = TOKW[e];
        st_bf16x4(Y + ((size_t)(e & 1) * T + (e >> 1)) * 1024 + col, v * w); } };
__device__ __forceinline__ void moe_range(const unsigned* CNT, int e, int& off_e, int& rows) {
    int o = 0; off_e = 0; rows = 0;
#pragma unroll
    for (int k = 0; k < 16; ++k) { const int r = ((int)CNT[k] + 255) & ~255; if (k == e) { off_e = o; rows = r; } o += r; }
}
__device__ __forceinline__ void ph_moe_index(const P& p, int l, int bid, int nblk, int tid_) {
    const unsigned* CNT = wsp<unsigned>(p, OFF_CTRL) + 64 * l; const int* LIST = wsp<int>(p, OFF_ROUTE + 512 * 1024); int* GIDX = wsp<int>(p, OFF_ROUTE + 512 * 1024 + 2 * MiB);
    int total = 0;
#pragma unroll
    for (int k = 0; k < 16; ++k) total += ((int)CNT[k] + 255) & ~255;
    const size_t gtid = (size_t)bid * NTHR + tid_, gstride = (size_t)nblk * NTHR;
    for (size_t i = gtid; i < (size_t)total; i += gstride) {
        int o = 0, e_off = 0, e_n = 0, e_id = 0;
#pragma unroll
        for (int k = 0; k < 16; ++k) { const int nk = (int)CNT[k], r = (nk + 255) & ~255; if ((int)i >= o && (int)i < o + r) { e_off = o; e_n = nk; e_id = k; } o += r; }
        const int r = (int)i - e_off; GIDX[i] = r < e_n ? LIST[(size_t)e_id * T + r] : -1;
    }
}
__device__ __forceinline__ void ph_moe1(const P& p, int l, float* lds, int bid, int nblk, int tid_) {
    const unsigned* CNT = wsp<unsigned>(p, OFF_CTRL) + 64 * l; const int* GIDX = wsp<int>(p, OFF_ROUTE + 512 * 1024 + 2 * MiB);
    const bf16_t* X1B = wsp<bf16_t>(p, R_XQ + 128 * MiB);
    for (int e = 0; e < 16; ++e) {
        int off_e, rows; moe_range(CNT, e, off_e, rows); if (rows == 0) continue;
        EpiHid ep{wsp<bf16_t>(p, R_A2) + (size_t)off_e * 256};
        gemm_naive<true>(X1B, 1024, GIDX + off_e, wsp<bf16_t>(p, WGU) + (size_t)(l * 16 + e) * 512 * 1024, 1024, rows, 256, 1024, ep, NoMid{}, lds, bid, nblk, tid_);
    }
}
__device__ __forceinline__ void ph_moe2(const P& p, int l, float* lds, int bid, int nblk, int tid_) {
    const unsigned* CNT = wsp<unsigned>(p, OFF_CTRL) + 64 * l; const int* GIDX = wsp<int>(p, OFF_ROUTE + 512 * 1024 + 2 * MiB);
    for (int e = 0; e < 16; ++e) {
        int off_e, rows; moe_range(CNT, e, off_e, rows); if (rows == 0) continue;
        EpiDown ep{wsp<bf16_t>(p, R_XBZ), GIDX + off_e, wsp<float>(p, OFF_ROUTE + 256 * 1024)};
        gemm_naive<false>(wsp<bf16_t>(p, R_A2) + (size_t)off_e * 256, 256, nullptr, wsp<bf16_t>(p, WDN) + (size_t)(l * 16 + e) * 1024 * 256, 256, rows, 1024, 256, ep, NoMid{}, lds, bid, nblk, tid_);
    }
}
__device__ __forceinline__ void ph_ln2(const P& p, int l, int bid, int nblk, int tid_) {
    float* X1F = wsp<float>(p, R_XQ); bf16_t* X1B = wsp<bf16_t>(p, R_XQ + 128 * MiB); const bf16_t* Y = wsp<bf16_t>(p, R_XBZ);
    float* LOGF = wsp<float>(p, OFF_DT);
    const float* g = p.ln2_g + l * 1024; const float* bta = p.ln2_b + l * 1024;
    const int lane = tid_ & 63, wid = tid_ >> 6;
    for (int t = bid * 8 + wid; t < T; t += nblk * 8) {
        f32x4 v[4];
#pragma unroll
        for (int j = 0; j < 4; ++j) { const size_t o = (size_t)t * 1024 + j * 256 + lane * 4; const f32x4 xv = *(const f32x4*)(X1F + o);
            const u32x2 a = *(const u32x2*)(Y + o), b = *(const u32x2*)(Y + (size_t)T * 1024 + o);
            v[j] = xv * ALPHA + (f32x4){bflo(a.x) + bflo(b.x), bfhi(a.x) + bfhi(b.x), bflo(a.y) + bflo(b.y), bfhi(a.y) + bfhi(b.y)}; }
        ln_row(v, g, bta, lane);
        if (l == 1) {
#pragma unroll
            for (int j = 0; j < 4; ++j) *(f32x4*)(p.out + (size_t)t * 1024 + j * 256 + lane * 4) = v[j];
        } else {
#pragma unroll
            for (int j = 0; j < 4; ++j) { *(f32x4*)(X1F + (size_t)t * 1024 + j * 256 + lane * 4) = v[j]; st_bf16x4(X1B + (size_t)t * 1024 + j * 256 + lane * 4, v[j]); }
            float f[8];
#pragma unroll
            for (int e = 0; e < 8; ++e) f[e] = 0.f;
#pragma unroll
            for (int j = 0; j < 4; ++j)
#pragma unroll
                for (int i = 0; i < 4; ++i) { const int k = j * 256 + lane * 4 + i; const float* w = p.od_w_in + (size_t)k * ODD_IN + 1952;
#pragma unroll
                    for (int e = 0; e < 8; ++e) f[e] += v[j][i] * w[e]; }
#pragma unroll
            for (int e = 0; e < 8; ++e) f[e] = wave_sum(f[e]);
            if (lane < 8) { float fv = 0.f;
#pragma unroll
                for (int e = 0; e < 8; ++e) fv = (e == lane) ? f[e] : fv;
                LOGF[(size_t)t * 8 + lane] = logsigmoid_f(fv + p.od_f_bias[lane]); }
        }
    }
}

struct EpiIn1 {
    bf16_t* CQ; bf16_t* CKV; bf16_t* Q; bf16_t* K; float* SSQQ; float* SSQK; const float* tab;
    __device__ __forceinline__ void operator()(int row, int col, f32x4 v) const {
        const int tx = lane_id() & 15;
        if (col < 512) {
            const bool isq = col < 256; const bool iskv = (col >= 256 && col < 384);
            float s = (isq || iskv) ? (v[0] * v[0] + v[1] * v[1]) + (v[2] * v[2] + v[3] * v[3]) : 0.f;
            s += __shfl_xor(s, 1); s += __shfl_xor(s, 2); s += __shfl_xor(s, 4); s += __shfl_xor(s, 8);
            if (tx == 0) { if (isq) SSQQ[(size_t)row * 4 + (col >> 6)] = s; else SSQK[(size_t)row * 4 + ((col - 256) >> 6)] = s; }
            if (isq) st_bf16x4(CQ + (size_t)row * 256 + col, v);
            else {
                if (col >= 384 && col < 416) { const int sp = row & (S - 1), i0 = (col - 384) >> 1;
                    const float c0 = tab[sp * 16 + i0], s0 = tab[S * 16 + sp * 16 + i0], c1 = tab[sp * 16 + i0 + 1], s1 = tab[S * 16 + sp * 16 + i0 + 1];
                    v = (f32x4){v[0] * c0 - v[1] * s0, v[1] * c0 + v[0] * s0, v[2] * c1 - v[3] * s1, v[3] * c1 + v[2] * s1}; }
                st_bf16x4(CKV + (size_t)row * 256 + (col - 256), v);
            }
        } else if (col < 1024) st_bf16x4(Q + (size_t)row * 512 + (col - 512), v * C2_64);
        else st_bf16x4(K + (size_t)row * 512 + (col - 1024), v);
    }
};
__device__ __forceinline__ void ph_inproj1(const P& p, float* lds, int bid, int nblk, int tid_) {
    const bf16_t* XB = wsp<bf16_t>(p, R_XQ + 128 * MiB);
    EpiIn1 e{wsp<bf16_t>(p, R_XBZ), wsp<bf16_t>(p, R_XBZ + 16 * MiB), wsp<bf16_t>(p, R_XBZ + 32 * MiB), wsp<bf16_t>(p, R_XBZ + 64 * MiB),
             wsp<float>(p, OFF_SSQ), wsp<float>(p, OFF_SSQ + 512 * 1024), wsp<float>(p, OFF_TAB)};
    gemm_naive<false>(XB, 1024, nullptr, wsp<bf16_t>(p, W1M), 1024, T, 1536, 1024, e, NoMid{}, lds, bid, nblk, tid_);
    EpiVt ev{wsp<bf16_t>(p, R_XBZ + 96 * MiB)};
    gemm_naive<false>(wsp<bf16_t>(p, W1V), 1024, nullptr, XB, 1024, 512, T, 1024, ev, NoMid{}, lds, bid, nblk, tid_);
}
__device__ __forceinline__ float rs4(const float* s, int row, float inv_n) { const f32x4 v = *(const f32x4*)(s + (size_t)row * 4); return rsqrtf(((v[0] + v[1]) + (v[2] + v[3])) * inv_n + 1e-6f); }
struct EpiQup { bf16_t* QM; const float* SSQQ; const float* tab;
    __device__ __forceinline__ void operator()(int row, int col, f32x4 v) const {
        v = v * rs4(SSQQ, row, 1.0f / 256.0f);
        const int j = col % 96;
        if (j >= 64) { const int sp = row & (S - 1), i0 = (j - 64) >> 1;
            const float c0 = tab[sp * 16 + i0], s0 = tab[S * 16 + sp * 16 + i0], c1 = tab[sp * 16 + i0 + 1], s1 = tab[S * 16 + sp * 16 + i0 + 1];
            v = (f32x4){v[0] * c0 - v[1] * s0, v[1] * c0 + v[0] * s0, v[2] * c1 - v[3] * s1, v[3] * c1 + v[2] * s1}; }
        st_bf16x4(QM + (size_t)row * 768 + col, v * C2_96);
    } };
struct EpiKup { bf16_t* KN; const float* SSQK; __device__ __forceinline__ void operator()(int row, int col, f32x4 v) const { st_bf16x4(KN + (size_t)row * 512 + col, v * rs4(SSQK, row, 1.0f / 128.0f)); } };
struct EpiVup { bf16_t* VtM; const float* SSQK; __device__ __forceinline__ void operator()(int row, int col, f32x4 v) const {
        v = (f32x4){v[0] * rs4(SSQK, col, 1.0f / 128.0f), v[1] * rs4(SSQK, col + 1, 1.0f / 128.0f), v[2] * rs4(SSQK, col + 2, 1.0f / 128.0f), v[3] * rs4(SSQK, col + 3, 1.0f / 128.0f)};
        st_bf16x4(VtM + (size_t)row * T + col, v); } };
__device__ __forceinline__ void ph_upproj(const P& p, float* lds, int bid, int nblk, int tid_) {
    const bf16_t* CQ = wsp<bf16_t>(p, R_XBZ); const bf16_t* CKV = wsp<bf16_t>(p, R_XBZ + 16 * MiB);
    const float* SSQQ = wsp<float>(p, OFF_SSQ); const float* SSQK = wsp<float>(p, OFF_SSQ + 512 * 1024);
    EpiQup eq{wsp<bf16_t>(p, R_A2), SSQQ, wsp<float>(p, OFF_TAB)};
    gemm_naive<false>(CQ, 256, nullptr, wsp<bf16_t>(p, W1Q), 256, T, 768, 256, eq, NoMid{}, lds, bid, nblk, tid_);
    EpiKup ek{wsp<bf16_t>(p, R_A2 + 48 * MiB), SSQK};
    gemm_naive<false>(CKV, 256, nullptr, wsp<bf16_t>(p, W1K), 128, T, 512, 128, ek, NoMid{}, lds, bid, nblk, tid_);
    EpiVup ev{wsp<bf16_t>(p, R_A2 + 80 * MiB), SSQK};
    gemm_naive<false>(wsp<bf16_t>(p, W1VV), 128, nullptr, CKV, 256, 512, T, 128, ev, NoMid{}, lds, bid, nblk, tid_);
    const float* LOGF = wsp<float>(p, OFF_DT); float* FH2 = wsp<float>(p, OFF_DT + 1 * MiB);
    const int lane = tid_ & 63, wid = tid_ >> 6;
    for (int u = bid * 8 + wid; u < NB * 8; u += nblk * 8) {
        const int b = u >> 3, h = u & 7;
        float loc[32]; float run = 0.f;
#pragma unroll
        for (int i = 0; i < 32; ++i) { run += LOGF[((size_t)b * S + lane * 32 + i) * 8 + h]; loc[i] = run; }
        float incl = run;
#pragma unroll
        for (int o = 1; o < 64; o <<= 1) { const float nb = __shfl_up(incl, o); if (lane >= o) incl += nb; }
        const float excl = incl - run;
#pragma unroll
        for (int i = 0; i < 32; ++i) FH2[(size_t)u * S + lane * 32 + i] = (excl + loc[i]) * LOG2E;
    }
}
__device__ __forceinline__ void ph_attn1_naive(const P& p, int bid, int nblk, int tid_) {
    const bf16_t* QM = wsp<bf16_t>(p, R_A2); const bf16_t* KN = wsp<bf16_t>(p, R_A2 + 48 * MiB); const bf16_t* VtM = wsp<bf16_t>(p, R_A2 + 80 * MiB);
    const bf16_t* CKV = wsp<bf16_t>(p, R_XBZ + 16 * MiB);
    const bf16_t* Qf = wsp<bf16_t>(p, R_XBZ + 32 * MiB); const bf16_t* Kf = wsp<bf16_t>(p, R_XBZ + 64 * MiB); const bf16_t* Vtf = wsp<bf16_t>(p, R_XBZ + 96 * MiB);
    const float* FH2 = wsp<float>(p, OFF_DT + 1 * MiB);
    bf16_t* A2 = wsp<bf16_t>(p, R_XQ + 128 * MiB);
    const int lane = tid_ & 63, wid = tid_ >> 6;
    const int nper = NB * 8 * (S / 64);
    for (int u = bid * 8 + wid; u < 2 * nper; u += nblk * 8) {
        const bool fox = u >= nper; const int uu = fox ? u - nper : u;
        const int tb = (S / 64 - 1) - (uu % (S / 64)), bh = uu / (S / 64), b = bh >> 3, h = bh & 7;
        const int t0 = tb * 64, t = t0 + lane; const size_t row = (size_t)b * S + t;
        float o[64];
#pragma unroll
        for (int d = 0; d < 64; ++d) o[d] = 0.f;
        float m = -INFINITY, lsum = 0.f;
        if (!fox) {
            unsigned qp[48];
#pragma unroll
            for (int d = 0; d < 96; d += 8) { const u32x4 v = *(const u32x4*)(QM + row * 768 + h * 96 + d);
#pragma unroll
                for (int j = 0; j < 4; ++j) qp[d / 2 + j] = v[j]; }
            for (int s = 0; s < t0 + 64; ++s) {
                const size_t kr = (size_t)b * S + s; float z = 0.f;
#pragma unroll
                for (int d = 0; d < 64; d += 8) { const u32x4 v = *(const u32x4*)(KN + kr * 512 + h * 64 + d);
#pragma unroll
                    for (int j = 0; j < 4; ++j) { z += bflo(qp[d / 2 + j]) * bflo(v[j]); z += bfhi(qp[d / 2 + j]) * bfhi(v[j]); } }
#pragma unroll
                for (int d = 0; d < 32; d += 8) { const u32x4 v = *(const u32x4*)(CKV + kr * 256 + 128 + d);
#pragma unroll
                    for (int j = 0; j < 4; ++j) { z += bflo(qp[32 + d / 2 + j]) * bflo(v[j]); z += bfhi(qp[32 + d / 2 + j]) * bfhi(v[j]); } }
                const float mn = fmaxf(m, z), corr = exp2f(m - mn), pw = exp2f(z - mn); m = mn; lsum = lsum * corr + pw;
                const bf16_t* vc = VtM + (size_t)(h * 64) * T + kr;
#pragma unroll
                for (int d = 0; d < 64; ++d) o[d] = o[d] * corr + pw * bf2f(vc[(size_t)d * T]);
            }
        } else {
            unsigned qp[32];
#pragma unroll
            for (int d = 0; d < 64; d += 8) { const u32x4 v = *(const u32x4*)(Qf + row * 512 + h * 64 + d);
#pragma unroll
                for (int j = 0; j < 4; ++j) qp[d / 2 + j] = v[j]; }
            const float fht = FH2[(size_t)bh * S + t];
            for (int s = 0; s < t0 + 64; ++s) {
                const size_t kr = (size_t)b * S + s; float z = 0.f;
#pragma unroll
                for (int d = 0; d < 64; d += 8) { const u32x4 v = *(const u32x4*)(Kf + kr * 512 + h * 64 + d);
#pragma unroll
                    for (int j = 0; j < 4; ++j) { z += bflo(qp[d / 2 + j]) * bflo(v[j]); z += bfhi(qp[d / 2 + j]) * bfhi(v[j]); } }
                z += fht - FH2[(size_t)bh * S + s];
                if (s <= t) {
                    const float mn = fmaxf(m, z), corr = exp2f(m - mn), pw = exp2f(z - mn); m = mn; lsum = lsum * corr + pw;
                    const bf16_t* vc = Vtf + (size_t)(h * 64) * T + kr;
#pragma unroll
                    for (int d = 0; d < 64; ++d) o[d] = o[d] * corr + pw * bf2f(vc[(size_t)d * T]);
                }
            }
        }
        const float inv = 1.0f / lsum;
#pragma unroll
        for (int d = 0; d < 64; d += 4) st_bf16x4(A2 + row * 1024 + (fox ? 512 : 0) + h * 64 + d, (f32x4){o[d] * inv, o[d + 1] * inv, o[d + 2] * inv, o[d + 3] * inv});
    }
}
__device__ __forceinline__ void ph_outproj1(const P& p, float* lds, int bid, int nblk, int tid_) {
    EpiRes e{wsp<float>(p, R_XQ), wsp<float>(p, R_XBZ)};
    gemm_naive<false>(wsp<bf16_t>(p, R_XQ + 128 * MiB), 1024, nullptr, wsp<bf16_t>(p, W1O), 1024, T, 1024, 1024, e, NoMid{}, lds, bid, nblk, tid_);
}

constexpr int LDS_STAGE = pg8::STAGE_BYTES;
constexpr int LDS_TAB_OFF = LDS_STAGE;
constexpr int LDS_TAB_BYTES = 16 * 1024;
#define LDSP(smem) ((PG8_LAS unsigned char*)(smem))

__device__ __forceinline__ void st_bf16x8(bf16_t* p, f32x4 a, f32x4 b) { u32x4 w; w[0] = pk_bf16(a[0], a[1]); w[1] = pk_bf16(a[2], a[3]); w[2] = pk_bf16(b[0], b[1]); w[3] = pk_bf16(b[2], b[3]); *(u32x4*)p = w; }
__device__ __forceinline__ void epi_store_bf16p(const f32x4 (&acc)[2][2][4][2], const pg8::Unit& u, int wr, int wc, int fr, int fq, bf16_t* base, int ld, int c0, float sc) {
#pragma unroll
    for (int ai = 0; ai < 2; ++ai)
#pragma unroll
        for (int m = 0; m < 4; ++m) { bf16_t* rp = base + (size_t)(u.pm * 256 + ai * 128 + wr * 64 + m * 16 + fr) * ld + c0 + wc * 32 + fq * 8;
#pragma unroll
            for (int bj = 0; bj < 2; ++bj) st_bf16x8(rp + bj * 128, acc[ai][bj][m][0] * sc, acc[ai][bj][m][1] * sc); }
}
__device__ __forceinline__ void epi_store_bf16(const f32x4 (&acc)[2][2][4][2], const pg8::Unit& u, int wr, int wc, int fr, int fq, bf16_t* base, int ld, int c0, float sc) {
#pragma unroll
    for (int ai = 0; ai < 2; ++ai)
#pragma unroll
        for (int m = 0; m < 4; ++m) { bf16_t* rp = base + (size_t)(u.pm * 256 + ai * 128 + wr * 64 + m * 16 + fr) * ld + c0 + wc * 32 + fq * 4;
#pragma unroll
            for (int bj = 0; bj < 2; ++bj)
#pragma unroll
                for (int n = 0; n < 2; ++n) st_bf16x4(rp + bj * 128 + n * 16, acc[ai][bj][m][n] * sc); }
}
__device__ __forceinline__ void EpiMixMf::operator()(const f32x4 (&acc)[2][2][4][2], const pg8::Unit& u, int, int wr, int wc, int fr, int fq) const { epi_store_bf16p(acc, u, wr, wc, fr, fq, MIX, 1024, u.pn * 256, 1.f); }
struct EpiIn0Mf { bf16_t* Z; bf16_t* XBCR; bf16_t* Q; bf16_t* K;
    __device__ __forceinline__ void operator()(const f32x4 (&acc)[2][2][4][2], const pg8::Unit& u, int, int wr, int wc, int fr, int fq) const {
        bf16_t* base; int ld, c0; float sc = 1.f;
        if (u.pn < 4) { base = Z; ld = 1024; c0 = u.pn * 256; }
        else if (u.pn < 10) { base = XBCR; ld = 1536; c0 = (u.pn - 4) * 256; }
        else if (u.pn < 12) { base = Q; ld = 512; c0 = (u.pn - 10) * 256; sc = C2_64; }
        else { base = K; ld = 512; c0 = (u.pn - 12) * 256; }
        epi_store_bf16p(acc, u, wr, wc, fr, fq, base, ld, c0, sc); } };
struct EpiVtMf { bf16_t* Vt; __device__ __forceinline__ void operator()(const f32x4 (&acc)[2][2][4][2], const pg8::Unit& u, int, int wr, int wc, int fr, int fq) const {
        epi_store_bf16p(acc, u, wr, wc, fr, fq, Vt, T, u.pn * 256, 1.f); } };
template <class E1, class E2> struct EpiDual { E1 e1; E2 e2;
    __device__ __forceinline__ void operator()(const f32x4 (&acc)[2][2][4][2], const pg8::Unit& u, int ui, int wr, int wc, int fr, int fq) const {
        if (u.e == 0) e1(acc, u, ui, wr, wc, fr, fq); else e2(acc, u, ui, wr, wc, fr, fq); } };
template <class F> __device__ __forceinline__ void mf_dense(unsigned char* smem, const bf16_t* A, int lda, const bf16_t* Bt, int ldb, int M, int N, int K, const F& f, int bid, int nblk, int tid_) {
    pg8::Gemm g{A, Bt, lda, ldb, K, nullptr}; pg8::DenseOrder S; S.init(M, N, lda, ldb, nblk, bid);
    pg8::EpiWrap<F> E{f};
    pg8::gemm_phase<pg8::EpiWrap<F>, pg8::DenseOrder, pg8::NoMidK, false>(LDSP(smem), g, S, E, pg8::NoMidK{}, tid_);
}
template <bool PERM, class E_> __device__ __forceinline__ void mf_dense_e(unsigned char* smem, const bf16_t* A, int lda, const bf16_t* Bt, int ldb, int M, int N, int K, const E_& E, int bid, int nblk, int tid_) {
    pg8::Gemm g{A, Bt, lda, ldb, K, nullptr}; pg8::DenseOrder S; S.init(M, N, lda, ldb, nblk, bid);
    pg8::gemm_phase<E_, pg8::DenseOrder, pg8::NoMidK, false, PERM>(LDSP(smem), g, S, E, pg8::NoMidK{}, tid_);
}
__device__ __forceinline__ void ph_inproj0_mf(const P& p, unsigned char* smem, int bid, int nblk, int tid_) {
    const bf16_t* XB = wsp<bf16_t>(p, R_XBZ);
    EpiIn0Mf e{wsp<bf16_t>(p, R_XBZ + 64 * MiB), wsp<bf16_t>(p, R_A2), wsp<bf16_t>(p, R_XQ + 96 * MiB), wsp<bf16_t>(p, R_XQ + 128 * MiB)};
    EpiVtMf ev{wsp<bf16_t>(p, R_XQ + 160 * MiB)};
    const bf16_t* W0Mp = wsp<bf16_t>(p, W0M); const bf16_t* W0Vp = wsp<bf16_t>(p, W0V);
    pg8::DualOrder S; S.s1.init(T, 3584, 1024, 1024, nblk, bid); S.s2.init(512, T, 1024, 1024, nblk, bid);
    S.a2off = (const char*)W0Vp - (const char*)XB; S.b2off = (const char*)XB - (const char*)W0Mp;
    EpiDual<EpiIn0Mf, EpiVtMf> E{e, ev};
    pg8::Gemm g{XB, W0Mp, 1024, 1024, 1024, nullptr};
    pg8::gemm_phase<EpiDual<EpiIn0Mf, EpiVtMf>, pg8::DualOrder, pg8::NoMidK, false, true>(LDSP(smem), g, S, E, pg8::NoMidK{}, tid_);
}
struct MidRmsK { static constexpr int ktile = 16; const PG8_LAS float* rs;
    __device__ __forceinline__ void apply(f32x4 (&acc)[2][2][4][2], int ui, int wr, int fr) const {
#pragma unroll
        for (int ai = 0; ai < 2; ++ai)
#pragma unroll
            for (int m = 0; m < 4; ++m) { const float s = rs[ui * 256 + ai * 128 + wr * 64 + m * 16 + fr];
#pragma unroll
                for (int bj = 0; bj < 2; ++bj)
#pragma unroll
                    for (int n = 0; n < 2; ++n) acc[ai][bj][m][n] *= s; } } };
constexpr int NSSQ = USE_SSD ? 32 : 16;
__device__ __forceinline__ void ph_outproj0_mf(const P& p, unsigned char* smem, int bid, int nblk, int tid_) {
    const float* SSQ = wsp<float>(p, OFF_SSQ);
    PG8_LAS float* rs = (PG8_LAS float*)(LDSP(smem) + LDS_TAB_OFF);
    pg8::Gemm g{wsp<bf16_t>(p, R_A2), wsp<bf16_t>(p, W0O), 1536, 1536, 1536, nullptr}; pg8::DenseOrder S; S.init(T, 1024, 1536, 1536, nblk, bid);
    for (int idx = tid_; idx < 8 * 256; idx += NTHR) { pg8::Unit u; const int ui = idx >> 8, r = idx & 255;
        if (S.next(ui, u)) { const int row = u.pm * 256 + r; float s = 0.f;
#pragma unroll
            for (int h = 0; h < NSSQ; h += 4) { const f32x4 v = *(const f32x4*)(SSQ + (size_t)row * NSSQ + h); s += (v[0] + v[1]) + (v[2] + v[3]); }
            rs[idx] = rsqrtf(s * (1.0f / 1024.0f) + 1e-6f); } }
    __syncthreads();
    EpiMixMf E{wsp<bf16_t>(p, R_XBZ)}; MidRmsK mid{rs};
    pg8::gemm_phase<EpiMixMf, pg8::DenseOrder, MidRmsK, false, true>(LDSP(smem), g, S, E, mid, tid_);
}
constexpr size_t OFF_DONE = OFF_CTRL + 4096;
constexpr size_t OFF_LIST = R_A2 + 100 * MiB;
constexpr int NLIST = 24;
__device__ __forceinline__ void pair_experts(int lid, int& elo, int& ehi) { const int gs = lid / 6, pid = lid % 6;
    const int lo = pid < 3 ? 0 : (pid < 5 ? 1 : 2), hi = pid < 3 ? pid + 1 : (pid < 5 ? pid - 1 : 3); elo = gs * 4 + lo; ehi = gs * 4 + hi; }
template <int PHASE> struct MoeOrder {
    static constexpr int NPN = 4;
    static constexpr bool HOOK = PHASE == 2;
    static constexpr int BSEAM = PHASE == 2 ? 4 : 0;
    int cnt[NLIST]; int G, c; unsigned* done; int nA, nB, qlo, NBtot, N2;
    __device__ __forceinline__ void init(const unsigned* CNT, unsigned* done_, int G_, int c_) {
        int tiles = 0;
#pragma unroll
        for (int k = 0; k < NLIST; ++k) { cnt[k] = (int)CNT[k]; tiles += (cnt[k] + 255) >> 8; }
        G = G_; c = c_; done = done_;
        const int n1 = tiles * 4; N2 = tiles * 4; nA = n1 % G; nB = G - nA;
        int q = (N2 + G - 1) / G;
        while (nB * q + nA * (q > 2 ? q - 2 : 0) < N2) ++q;
        qlo = q > 2 ? q - 2 : 0; NBtot = N2 - nA * qlo; if (NBtot < 0) NBtot = 0; }
    __device__ __forceinline__ bool next(int i, pg8::Unit& u) const {
        int L;
        if (PHASE == 1) L = i * G + c;
        else if (c >= nA) { L = i * nB + (c - nA); if (L >= NBtot) L = 1 << 30; }
        else { L = NBtot + i * nA + c; if (i >= qlo) L = 1 << 30; }
        int base = 0, off = 0; bool found = false;
        u.pm = 0; u.pn = 0; u.e = 0; u.g0 = 0;
#pragma unroll
        for (int k = 0; k < NLIST; ++k) { const int te = (cnt[k] + 255) >> 8, nu = te * NPN;
            if (!found && L < base + nu) { const int loc = L - base; u.e = k; u.pm = loc / NPN; u.pn = loc % NPN; u.g0 = off + u.pm * 256; found = true; }
            base += nu; off += te * 256; }
        int elo, ehi; pair_experts(u.e, elo, ehi);
        if (PHASE == 1) { u.aoff = 0; u.boff = ((size_t)((u.pn >> 1) ? ehi : elo) * 512 + (u.pn & 1) * 256) * 1024 * 2; u.boff2 = u.boff; }
        else { u.aoff = (size_t)u.g0 * 512 * 2; u.boff = ((size_t)elo * 1024 + u.pn * 256) * 256 * 2; u.boff2 = ((size_t)ehi * 1024 + u.pn * 256) * 256 * 2 - (size_t)BSEAM * 128; }
        return found; }
    __device__ __forceinline__ int count(int e) const { int r = 0;
#pragma unroll
        for (int k = 0; k < NLIST; ++k) r = (k == e) ? cnt[k] : r;
        return r; }
    __device__ __forceinline__ void a_ready(const pg8::Unit& u, int wid) const {
        if (wid == 0) { unsigned* w = done + (u.g0 >> 8); unsigned sp = 0;
            while (__hip_atomic_load(w, __ATOMIC_RELAXED, __HIP_MEMORY_SCOPE_AGENT) < 32u) { __builtin_amdgcn_s_sleep(2); if (++sp > (1u << 22)) break; }
            __builtin_amdgcn_fence(__ATOMIC_ACQUIRE, "agent"); asm volatile("s_waitcnt vmcnt(0)" ::: "memory"); }
        __builtin_amdgcn_s_barrier(); asm volatile("" ::: "memory"); }
};
__device__ __forceinline__ void st16_sc1(void* p, u32x4 v) { asm volatile("global_store_dwordx4 %0, %1, off sc1" :: "v"(p), "v"(v) : "memory"); }
struct EpiHidMf { bf16_t* HID; unsigned* done; const PG8_LAS int* gl; const float* TOKW;
    __device__ __forceinline__ void operator()(const f32x4 (&acc)[2][2][4][2], const pg8::Unit& u, int ui, int wr, int wc, int fr, int fq) const {
        const int hi = u.pn >> 1;
#pragma unroll
        for (int ai = 0; ai < 2; ++ai)
#pragma unroll
            for (int m = 0; m < 4; ++m) { const int rl = ai * 128 + wr * 64 + m * 16 + fr; const size_t hrow = (size_t)u.g0 + rl; u32x4 w;
                const float tw = TOKW[gl[ui * 256 + rl] * 2 + hi];
#pragma unroll
                for (int n = 0; n < 2; ++n) { const f32x4 gt = acc[ai][0][m][n], up = acc[ai][1][m][n] * tw;
                    w[2 * n] = pk_bf16(silu_f(gt[0]) * up[0], silu_f(gt[1]) * up[1]); w[2 * n + 1] = pk_bf16(silu_f(gt[2]) * up[2], silu_f(gt[3]) * up[3]); }
                st16_sc1(HID + hrow * 512 + hi * 256 + (u.pn & 1) * 128 + wc * 32 + fq * 8, w); }
        asm volatile("s_waitcnt vmcnt(0)" ::: "memory");
        if (fr == 0 && fq == 0) __hip_atomic_fetch_add(done + (u.g0 >> 8), 1u, __ATOMIC_RELAXED, __HIP_MEMORY_SCOPE_AGENT); } };
__device__ __forceinline__ void ph_moe1_mf(const P& p, int l, unsigned char* smem, int bid, int nblk, int tid_) {
    const unsigned* CNT = wsp<unsigned>(p, OFF_CTRL) + 64 * l; const int* LIST = wsp<int>(p, OFF_LIST);
    PG8_LAS int* gl = (PG8_LAS int*)(LDSP(smem) + LDS_TAB_OFF);
    unsigned* done = wsp<unsigned>(p, OFF_DONE) + 512 * l;
    MoeOrder<1> S; S.init(CNT, done, nblk, bid);
    for (int idx = tid_; idx < 8 * 256; idx += NTHR) { pg8::Unit u; const int ui = idx >> 8, r = idx & 255;
        if (S.next(ui, u)) { const int li = u.pm * 256 + r; gl[idx] = (li < S.count(u.e)) ? LIST[(size_t)u.e * T + li] : 0; } }
    __syncthreads();
    pg8::Gemm g{wsp<bf16_t>(p, R_XQ + 128 * MiB), wsp<bf16_t>(p, WGU) + (size_t)l * 16 * 512 * 1024, 1024, 1024, 1024, gl};
    EpiHidMf E{wsp<bf16_t>(p, R_A2), done, gl, wsp<float>(p, OFF_ROUTE + 256 * 1024)};
    pg8::gemm_phase<EpiHidMf, MoeOrder<1>, pg8::NoMidK, true, true>(LDSP(smem), g, S, E, pg8::NoMidK{}, tid_);
}
struct EpiDownMf { bf16_t* Y; const PG8_LAS int* ent;
    __device__ __forceinline__ void operator()(const f32x4 (&acc)[2][2][4][2], const pg8::Unit& u, int ui, int wr, int wc, int fr, int fq) const {
#pragma unroll
        for (int ai = 0; ai < 2; ++ai)
#pragma unroll
            for (int m = 0; m < 4; ++m) { const int r = ui * 256 + ai * 128 + wr * 64 + m * 16 + fr; const int en = ent[r];
                if (en >= 0) { bf16_t* yr = Y + (size_t)en * 1024 + u.pn * 256 + wc * 32 + fq * 8;
#pragma unroll
                    for (int bj = 0; bj < 2; ++bj) st_bf16x8(yr + bj * 128, acc[ai][bj][m][0], acc[ai][bj][m][1]); } } } };
__device__ __forceinline__ void ph_moe2_mf(const P& p, int l, unsigned char* smem, int bid, int nblk, int tid_) {
    const unsigned* CNT = wsp<unsigned>(p, OFF_CTRL) + 64 * l; const int* LIST = wsp<int>(p, OFF_LIST);
    PG8_LAS int* ent = (PG8_LAS int*)(LDSP(smem) + LDS_TAB_OFF);
    MoeOrder<2> S; S.init(CNT, wsp<unsigned>(p, OFF_DONE) + 512 * l, nblk, bid);
    for (int idx = tid_; idx < 8 * 256; idx += NTHR) { pg8::Unit u; const int ui = idx >> 8, r = idx & 255;
        if (S.next(ui, u)) { const int li = u.pm * 256 + r; ent[idx] = (li < S.count(u.e)) ? LIST[(size_t)u.e * T + li] : -1; } }
    __syncthreads();
    pg8::Gemm g{wsp<bf16_t>(p, R_A2), wsp<bf16_t>(p, WDN) + (size_t)l * 16 * 1024 * 256, 512, 256, 512, nullptr};
    EpiDownMf E{wsp<bf16_t>(p, R_XBZ), ent};
    pg8::gemm_phase<EpiDownMf, MoeOrder<2>, pg8::NoMidK, false, true>(LDSP(smem), g, S, E, pg8::NoMidK{}, tid_);
}
struct EpiIn1Mf { bf16_t* CQ; bf16_t* CKV; bf16_t* Q; bf16_t* K; float* SSQQ; float* SSQK; const float* tab;
    __device__ __forceinline__ void operator()(const f32x4 (&acc)[2][2][4][2], const pg8::Unit& u, int, int wr, int wc, int fr, int fq) const {
        if (u.pn == 0) {
#pragma unroll
            for (int ai = 0; ai < 2; ++ai)
#pragma unroll
                for (int m = 0; m < 4; ++m) { const size_t row = (size_t)u.pm * 256 + ai * 128 + wr * 64 + m * 16 + fr; float s = 0.f;
#pragma unroll
                    for (int bj = 0; bj < 2; ++bj) {
#pragma unroll
                        for (int n = 0; n < 2; ++n) { const f32x4 v = acc[ai][bj][m][n]; s += (v[0] * v[0] + v[1] * v[1]) + (v[2] * v[2] + v[3] * v[3]); }
                        st_bf16x8(CQ + row * 256 + bj * 128 + wc * 32 + fq * 8, acc[ai][bj][m][0], acc[ai][bj][m][1]); }
                    s += __shfl_xor(s, 16); s += __shfl_xor(s, 32);
                    if (fq == 0) SSQQ[row * 4 + wc] = s; }
        } else if (u.pn == 1) {
#pragma unroll
            for (int ai = 0; ai < 2; ++ai)
#pragma unroll
                for (int m = 0; m < 4; ++m) { const size_t row = (size_t)u.pm * 256 + ai * 128 + wr * 64 + m * 16 + fr; float s = 0.f;
#pragma unroll
                    for (int n = 0; n < 2; ++n) { const f32x4 v = acc[ai][0][m][n]; s += (v[0] * v[0] + v[1] * v[1]) + (v[2] * v[2] + v[3] * v[3]); }
                    st_bf16x8(CKV + row * 256 + wc * 32 + fq * 8, acc[ai][0][m][0], acc[ai][0][m][1]);
                    s += __shfl_xor(s, 16); s += __shfl_xor(s, 32);
                    if (fq == 0) SSQK[row * 4 + wc] = s;
                    if (wc == 0) { const int sp = (int)(row & (S - 1)); f32x4 vv[2];
#pragma unroll
                        for (int n = 0; n < 2; ++n) { f32x4 v = acc[ai][1][m][n]; const int cp = fq * 8 + n * 4, i0 = cp >> 1;
                            const float c0 = tab[sp * 16 + i0], s0 = tab[S * 16 + sp * 16 + i0], c1 = tab[sp * 16 + i0 + 1], s1 = tab[S * 16 + sp * 16 + i0 + 1];
                            vv[n] = (f32x4){v[0] * c0 - v[1] * s0, v[1] * c0 + v[0] * s0, v[2] * c1 - v[3] * s1, v[3] * c1 + v[2] * s1}; }
                        st_bf16x8(CKV + row * 256 + 128 + fq * 8, vv[0], vv[1]); } }
        } else {
            const bool isq = u.pn < 4;
            epi_store_bf16p(acc, u, wr, wc, fr, fq, isq ? Q : K, 512, (isq ? u.pn - 2 : u.pn - 4) * 256, isq ? C2_64 : 1.f);
        } } };
__device__ __forceinline__ void ph_inproj1_mf(const P& p, unsigned char* smem, int bid, int nblk, int tid_) {
    const bf16_t* XB = wsp<bf16_t>(p, R_XQ + 128 * MiB);
    EpiIn1Mf E{wsp<bf16_t>(p, R_XBZ), wsp<bf16_t>(p, R_XBZ + 16 * MiB), wsp<bf16_t>(p, R_XBZ + 32 * MiB), wsp<bf16_t>(p, R_XBZ + 64 * MiB),
               wsp<float>(p, OFF_SSQ), wsp<float>(p, OFF_SSQ + 512 * 1024), wsp<float>(p, OFF_TAB)};
    EpiVtMf ev{wsp<bf16_t>(p, R_XBZ + 96 * MiB)};
    const bf16_t* W1Mp = wsp<bf16_t>(p, W1M); const bf16_t* W1Vp = wsp<bf16_t>(p, W1V);
    pg8::DualOrder S; S.s1.init(T, 1536, 1024, 1024, nblk, bid); S.s2.init(512, T, 1024, 1024, nblk, bid);
    S.a2off = (const char*)W1Vp - (const char*)XB; S.b2off = (const char*)XB - (const char*)W1Mp;
    EpiDual<EpiIn1Mf, EpiVtMf> E2{E, ev};
    pg8::Gemm g{XB, W1Mp, 1024, 1024, 1024, nullptr};
    pg8::gemm_phase<EpiDual<EpiIn1Mf, EpiVtMf>, pg8::DualOrder, pg8::NoMidK, false, true>(LDSP(smem), g, S, E2, pg8::NoMidK{}, tid_);
}
__device__ __forceinline__ void ph_fh_cumsum(const P& p, int bid, int nblk, int tid_) {
    const float* LOGF = wsp<float>(p, OFF_DT); float* FH2 = wsp<float>(p, OFF_DT + 1 * MiB);
    const int lane = tid_ & 63, wid = tid_ >> 6;
    for (int u = bid * 8 + wid; u < NB * 8; u += nblk * 8) {
        const int b = u >> 3, h = u & 7;
        float loc[32]; float run = 0.f;
#pragma unroll
        for (int i = 0; i < 32; ++i) { run += LOGF[((size_t)b * S + lane * 32 + i) * 8 + h]; loc[i] = run; }
        float incl = run;
#pragma unroll
        for (int o = 1; o < 64; o <<= 1) { const float nb = __shfl_up(incl, o); if (lane >= o) incl += nb; }
        const float excl = incl - run;
#pragma unroll
        for (int i = 0; i < 32; ++i) FH2[(size_t)u * S + lane * 32 + i] = (excl + loc[i]) * LOG2E;
    }
}
template <bool BYCOL> __device__ __forceinline__ void fill_scale(const pg8::DenseOrder& S, PG8_LAS float* tab, const float* SSQ, float inv_n, int tid_) {
    for (int idx = tid_; idx < 8 * 256; idx += NTHR) { pg8::Unit u; const int ui = idx >> 8, r = idx & 255;
        if (S.next(ui, u)) tab[idx] = rs4(SSQ, (BYCOL ? u.pn : u.pm) * 256 + r, inv_n); }
    __syncthreads();
}
struct EpiQupMf { bf16_t* QM; const PG8_LAS float* rs; const float* tab;
    __device__ __forceinline__ void operator()(const f32x4 (&acc)[2][2][4][2], const pg8::Unit& u, int ui, int wr, int wc, int fr, int fq) const {
#pragma unroll
        for (int ai = 0; ai < 2; ++ai)
#pragma unroll
            for (int m = 0; m < 4; ++m) { const int r = ai * 128 + wr * 64 + m * 16 + fr; const size_t row = (size_t)u.pm * 256 + r; const float sc = rs[ui * 256 + r] * C2_96; const int sp = (int)(row & (S - 1));
#pragma unroll
                for (int bj = 0; bj < 2; ++bj) { f32x4 vv[2]; const int col8 = u.pn * 256 + bj * 128 + wc * 32 + fq * 8;
#pragma unroll
                    for (int n = 0; n < 2; ++n) { const int col = col8 + 4 * n; f32x4 v = acc[ai][bj][m][n] * sc; const int j = col % 96;
                        if (j >= 64) { const int i0 = (j - 64) >> 1;
                            const float c0 = tab[sp * 16 + i0], s0 = tab[S * 16 + sp * 16 + i0], c1 = tab[sp * 16 + i0 + 1], s1 = tab[S * 16 + sp * 16 + i0 + 1];
                            v = (f32x4){v[0] * c0 - v[1] * s0, v[1] * c0 + v[0] * s0, v[2] * c1 - v[3] * s1, v[3] * c1 + v[2] * s1}; }
                        vv[n] = v; }
                    st_bf16x8(QM + row * 768 + col8, vv[0], vv[1]); }
                asm volatile("" ::: "memory"); } } };
struct EpiKupMf { bf16_t* KN; const PG8_LAS float* rs;
    __device__ __forceinline__ void operator()(const f32x4 (&acc)[2][2][4][2], const pg8::Unit& u, int ui, int wr, int wc, int fr, int fq) const {
#pragma unroll
        for (int ai = 0; ai < 2; ++ai)
#pragma unroll
            for (int m = 0; m < 4; ++m) { const int r = ai * 128 + wr * 64 + m * 16 + fr; const size_t row = (size_t)u.pm * 256 + r; const float sc = rs[ui * 256 + r];
#pragma unroll
                for (int bj = 0; bj < 2; ++bj) st_bf16x8(KN + row * 512 + u.pn * 256 + bj * 128 + wc * 32 + fq * 8, acc[ai][bj][m][0] * sc, acc[ai][bj][m][1] * sc); } } };
struct EpiVupMf { bf16_t* VtM; const PG8_LAS float* cs;
    __device__ __forceinline__ void operator()(const f32x4 (&acc)[2][2][4][2], const pg8::Unit& u, int ui, int wr, int wc, int fr, int fq) const {
        f32x4 sc[2][2];
#pragma unroll
        for (int bj = 0; bj < 2; ++bj)
#pragma unroll
            for (int n = 0; n < 2; ++n) sc[bj][n] = *(const PG8_LAS f32x4*)(cs + ui * 256 + bj * 128 + wc * 32 + fq * 8 + n * 4);
#pragma unroll
        for (int ai = 0; ai < 2; ++ai)
#pragma unroll
            for (int m = 0; m < 4; ++m) { const size_t row = (size_t)u.pm * 256 + ai * 128 + wr * 64 + m * 16 + fr;
#pragma unroll
                for (int bj = 0; bj < 2; ++bj) st_bf16x8(VtM + row * T + u.pn * 256 + bj * 128 + wc * 32 + fq * 8, acc[ai][bj][m][0] * sc[bj][0], acc[ai][bj][m][1] * sc[bj][1]); } } };
__device__ __forceinline__ void ph_knorm(const P& p, int bid, int nblk, int tid_) {
    const bf16_t* Kf = wsp<bf16_t>(p, R_XBZ + 64 * MiB); float* KMAXT = wsp<float>(p, OFF_SSQ + 1 * MiB);
    const int lane = tid_ & 63, wid = tid_ >> 6;
    for (int it = bid * 8 + wid; it < 128 * 32; it += nblk * 8) {
        const int bh = it >> 5, tile = it & 31, b = bh >> 3, h = bh & 7;
        const bf16_t* kr = Kf + ((size_t)b * S + tile * 64 + lane) * 512 + h * 64; float s2 = 0.f;
#pragma unroll
        for (int c = 0; c < 8; ++c) { const u32x4 v = *(const u32x4*)(kr + c * 8);
#pragma unroll
            for (int j = 0; j < 4; ++j) { const float lo = bflo(v[j]), hi_ = bfhi(v[j]); s2 += lo * lo + hi_ * hi_; } }
        float m = sqrtf(s2);
#pragma unroll
        for (int o = 32; o >= 1; o >>= 1) m = fmaxf(m, __shfl_xor(m, o));
        if (lane == 0) KMAXT[it] = m;
    }
}
__device__ __forceinline__ void ph_upproj_mf(const P& p, unsigned char* smem, int bid, int nblk, int tid_) {
    const bf16_t* CQ = wsp<bf16_t>(p, R_XBZ); const bf16_t* CKV = wsp<bf16_t>(p, R_XBZ + 16 * MiB);
    const float* SSQQ = wsp<float>(p, OFF_SSQ); const float* SSQK = wsp<float>(p, OFF_SSQ + 512 * 1024);
    PG8_LAS float* tabl = (PG8_LAS float*)(LDSP(smem) + LDS_TAB_OFF);
    { pg8::Gemm g{CQ, wsp<bf16_t>(p, W1Q), 256, 256, 256, nullptr}; pg8::DenseOrder S; S.init(T, 768, 256, 256, nblk, bid);
      fill_scale<false>(S, tabl, SSQQ, 1.0f / 256.0f, tid_);
      EpiQupMf E{wsp<bf16_t>(p, R_A2), tabl, wsp<float>(p, OFF_TAB)};
      pg8::gemm_phase<EpiQupMf, pg8::DenseOrder, pg8::NoMidK, false, true>(LDSP(smem), g, S, E, pg8::NoMidK{}, tid_); }
    { pg8::Gemm g{CKV, wsp<bf16_t>(p, W1K), 256, 128, 128, nullptr}; pg8::DenseOrder S; S.init(T, 512, 256, 128, nblk, bid);
      fill_scale<false>(S, tabl, SSQK, 1.0f / 128.0f, tid_);
      EpiKupMf E{wsp<bf16_t>(p, R_A2 + 48 * MiB), tabl};
      pg8::gemm_phase<EpiKupMf, pg8::DenseOrder, pg8::NoMidK, false, true>(LDSP(smem), g, S, E, pg8::NoMidK{}, tid_); }
    { pg8::Gemm g{wsp<bf16_t>(p, W1VV), CKV, 128, 256, 128, nullptr}; pg8::DenseOrder S; S.init(512, T, 128, 256, nblk, bid);
      fill_scale<true>(S, tabl, SSQK, 1.0f / 128.0f, tid_);
      EpiVupMf E{wsp<bf16_t>(p, R_A2 + 80 * MiB), tabl};
      pg8::gemm_phase<EpiVupMf, pg8::DenseOrder, pg8::NoMidK, false, true>(LDSP(smem), g, S, E, pg8::NoMidK{}, tid_); }
    ph_fh_cumsum(p, bid, nblk, tid_);
    ph_knorm(p, bid, nblk, tid_);
}
__device__ __forceinline__ void ph_outproj1_mf(const P& p, unsigned char* smem, int bid, int nblk, int tid_) {
    EpiMixMf E{wsp<bf16_t>(p, R_XBZ)};
    mf_dense_e<true>(smem, wsp<bf16_t>(p, R_XQ), 1024, wsp<bf16_t>(p, W1O), 1024, T, 1024, 1024, E, bid, nblk, tid_);
}

namespace att {
typedef short bf16x8 __attribute__((ext_vector_type(8)));
typedef float f32x16 __attribute__((ext_vector_type(16)));
struct Args { const bf16_t* Q; int ldq; const bf16_t* K; int ldk; const bf16_t* K2; const bf16_t* Vt; bf16_t* O; int ldo; const float* FH2; const float* KMAXT; };
template <int MODE> struct Cfg { static constexpr int DK = MODE == 2 ? 96 : 64, DKX = DK + (MODE == 1 ? 16 : 0), KROW = DKX * 2 + 16, VROW = 144, K_BYTES = 64 * KROW, V_BYTES = 64 * VROW, TILE = K_BYTES + V_BYTES + 256; };
__device__ __forceinline__ float swap_sum(float x) { auto rr = __builtin_amdgcn_permlane32_swap(__float_as_uint(x), __float_as_uint(x), false, false); return __uint_as_float(rr[0]) + __uint_as_float(rr[1]); }
__device__ __forceinline__ float swap_max(float x) { auto rr = __builtin_amdgcn_permlane32_swap(__float_as_uint(x), __float_as_uint(x), false, false); return fmaxf(__uint_as_float(rr[0]), __uint_as_float(rr[1])); }
__device__ __forceinline__ float swap_other(float x, int hi) { auto rr = __builtin_amdgcn_permlane32_swap(__float_as_uint(x), __float_as_uint(x), false, false); return __uint_as_float(hi ? rr[0] : rr[1]); }

template <int MODE, int HP = 1>
__device__ __forceinline__ void attn_unit(const Args& a, int b, int h0, int qb, unsigned char* smem, int tid_) {
    typedef Cfg<MODE> C;
    constexpr int BUF = HP * C::TILE, QROWS = 256 / HP;
    constexpr int NKS = C::DK / 16, NKX = C::DKX / 16;
    int tid = tid_; asm volatile("" : "+v"(tid));
    const int lane = tid & 63, wid = __builtin_amdgcn_readfirstlane(tid >> 6), r32 = lane & 31, hi = lane >> 5;
    PG8_LAS unsigned char* lds = (PG8_LAS unsigned char*)smem;
    const int hsw = (HP == 2) ? (wid >> 2) : 0, h = h0 + hsw, wq = (HP == 2) ? (wid & 3) : wid;
    const int q0 = qb * QROWS, qw = q0 + wq * 32;
    const size_t rowb = (size_t)b * S;
    const int jmax = q0 / 64 + QROWS / 64 - 1;
    const int hoff = hsw * C::TILE;
    const int jw = (MODE == 2) ? (qw >> 6) : ((qw + 31) >> 6);
    bf16x8 qf[NKX];
    { const bf16_t* qp = a.Q + (rowb + qw + r32) * a.ldq + h * C::DK + hi * 8;
#pragma unroll
      for (int ks = 0; ks < NKS; ++ks) qf[ks] = *(const bf16x8*)(qp + ks * 16);
      if (MODE == 1) { const u32x4 m1 = {hi ? 0u : 0xBF80BF80u, hi ? 0u : 0x0000BF80u, 0u, 0u}; qf[NKX - 1] = __builtin_bit_cast(bf16x8, m1); } }
    const u32x4 ones_u = {0x3F803F80u, 0x3F803F80u, 0x3F803F80u, 0x3F803F80u}; const bf16x8 ones8 = __builtin_bit_cast(bf16x8, ones_u);
    float qn = 0.f;
    if (MODE == 1) {
#pragma unroll
        for (int ks = 0; ks < NKS; ++ks)
#pragma unroll
            for (int e = 0; e < 8; ++e) { const float qv = __uint_as_float(((unsigned)(unsigned short)qf[ks][e]) << 16); qn += qv * qv; }
        qn = sqrtf(swap_sum(qn)) * 1.001f; }
    const int kkey = tid >> 3, kch = tid & 7;
    const bf16_t* kg = a.K + (rowb + kkey) * a.ldk + h0 * 64 + kch * 8;
    const bf16_t* k2g = a.K2 + (rowb + (tid >> 2)) * 256 + 128 + (tid & 3) * 8;
    const bf16_t* vg = a.Vt + (size_t)(h0 * 64 + kkey) * T + rowb + kch * 8;
    const float* fg0 = a.FH2 + (size_t)(b * 8 + h0) * S;
    const float* fg = fg0 + (size_t)hsw * S;
    const int k_l = kkey * C::KROW + kch * 16, k2_l = (tid >> 2) * C::KROW + 128 + (tid & 3) * 16, v_l = C::K_BYTES + kkey * C::VROW + (kch >> 1) * 32 + (kch & 1) * 8, f_l = C::K_BYTES + C::V_BYTES + tid * 4;
    u32x4 sk[HP], sv[HP], sk2; float sf[HP];
#pragma unroll
    for (int hs = 0; hs < HP; ++hs) sf[hs] = 0.f;
#define ATT_LOAD(j) do { _Pragma("unroll") for (int hs_ = 0; hs_ < HP; ++hs_) { sk[hs_] = *(const u32x4*)(kg + (size_t)(j) * 64 * a.ldk + hs_ * 64); sv[hs_] = *(const u32x4*)(vg + (size_t)hs_ * 64 * T + (j) * 64); \
            if (MODE == 1) { if (tid < 64) sf[hs_] = fg0[(size_t)hs_ * S + (j) * 64 + tid]; } } \
        if (MODE == 2) { if (tid < 256) sk2 = *(const u32x4*)(k2g + (size_t)(j) * 64 * 256); } } while (0)
#define ATT_STORE(bufo) do { _Pragma("unroll") for (int hs_ = 0; hs_ < HP; ++hs_) { const int bo_ = (bufo) + hs_ * C::TILE; *(PG8_LAS u32x4*)(lds + bo_ + k_l) = sk[hs_]; \
            *(PG8_LAS u32x2*)(lds + bo_ + v_l) = (u32x2){sv[hs_][0], sv[hs_][1]}; *(PG8_LAS u32x2*)(lds + bo_ + v_l + 16) = (u32x2){sv[hs_][2], sv[hs_][3]}; \
            if (MODE == 1) { if (tid < 64) { const float f_ = sf[hs_]; const unsigned h1_ = pk_bf16(f_, 0.f) & 0xffffu; const float r1_ = f_ - bflo(h1_); const unsigned h2_ = pk_bf16(r1_, 0.f) & 0xffffu; const float r2_ = r1_ - bflo(h2_); const unsigned h3_ = pk_bf16(r2_, 0.f) & 0xffffu; \
                *(PG8_LAS u32x4*)(lds + bo_ + tid * C::KROW + 128) = (u32x4){h1_ | (h2_ << 16), h3_, 0u, 0u}; *(PG8_LAS u32x4*)(lds + bo_ + tid * C::KROW + 144) = (u32x4){0u, 0u, 0u, 0u}; } } } \
        if (MODE == 2) { if (tid < 256) *(PG8_LAS u32x4*)(lds + (bufo) + k2_l) = sk2; } } while (0)
    f32x16 o[2];
#pragma unroll
    for (int i = 0; i < 16; ++i) { o[0][i] = 0.f; o[1][i] = 0.f; }
    float R = 0.f; bool first = true;
    f32x16 lacc;
#pragma unroll
    for (int i = 0; i < 16; ++i) lacc[i] = 0.f;
    float fht = 0.f; if (MODE == 1) fht = fg[qw + r32];
    f32x16 negm;
#pragma unroll
    for (int i = 0; i < 16; ++i) negm[i] = (MODE == 0) ? 0.f : fht;
    const int qi = qw + r32;
    const int nt = jmax + 1;
    PG8_LAS int* dflag = (PG8_LAS int*)(lds + 2 * BUF);
    PG8_LAS float* kpm0 = (PG8_LAS float*)(lds + 2 * BUF + 64);
    PG8_LAS float* kpm = kpm0 + hsw * 64;
    PG8_LAS float* fedge = kpm + 32;
    if (MODE != 2) { if (tid < 8) dflag[tid] = 0; }
    if (MODE == 1) { if (tid < 32 * HP) { const int hs = tid >> 5, ti = tid & 31; float v = a.KMAXT[(b * 8 + h0 + hs) * 32 + ti];
#pragma unroll
            for (int o = 1; o < 32; o <<= 1) { const float u_ = __shfl_up(v, o, 32); if (ti >= o) v = fmaxf(v, u_); }
            kpm0[hs * 64 + ti] = v; kpm0[hs * 64 + 32 + ti] = fg0[(size_t)hs * S + 64 * (ti + 1) - 1]; } }
    { const int j0 = (MODE != 2) ? jmax : 0; ATT_LOAD(j0); ATT_STORE(0); }
    __syncthreads();
    for (int it = 0; it < nt; ++it) {
        const int j = (MODE != 2) ? (jmax - it) : it;
        const int bufo = (it & 1) * BUF, nbufo = ((it + 1) & 1) * BUF;
        const bool more = (it + 1 < nt);
        if (more) { const int jn = (MODE != 2) ? (j - 1) : (j + 1); ATT_LOAD(jn); }
        if (j <= jw) {
            f32x16 p0 = negm, p1 = negm;
            { const PG8_LAS unsigned char* kb = lds + bufo + hoff + r32 * C::KROW + hi * 16;
              __builtin_amdgcn_s_setprio(1);
#pragma unroll
              for (int ks = 0; ks < NKX; ++ks) {
                  const bf16x8 a0 = *(const PG8_LAS bf16x8*)(kb + ks * 32), a1 = *(const PG8_LAS bf16x8*)(kb + 32 * C::KROW + ks * 32);
                  p0 = __builtin_amdgcn_mfma_f32_32x32x16_bf16(a0, qf[ks], p0, 0, 0, 0);
                  p1 = __builtin_amdgcn_mfma_f32_32x32x16_bf16(a1, qf[ks], p1, 0, 0, 0); }
              __builtin_amdgcn_s_setprio(0); }
            const int kbase = j * 64 + 4 * hi;
            if (MODE != 0) {
                if (MODE == 1 && j == jw) {
#pragma unroll
                    for (int i = 0; i < 16; ++i) { const int kp = kbase + 8 * (i >> 2) + (i & 3); if (kp > qi) p0[i] = -INFINITY; if (kp + 32 > qi) p1[i] = -INFINITY; }
                }
                float mx = __builtin_fmaxf(__builtin_fmaxf(p0[0], p0[1]), p1[0]), mx2 = __builtin_fmaxf(__builtin_fmaxf(p0[2], p0[3]), p1[1]);
                mx = __builtin_fmaxf(__builtin_fmaxf(mx, p1[2]), p1[3]);
#pragma unroll
                for (int i = 4; i < 16; i += 4) { mx = __builtin_fmaxf(__builtin_fmaxf(mx, p0[i]), p0[i + 1]); mx2 = __builtin_fmaxf(__builtin_fmaxf(mx2, p0[i + 2]), p0[i + 3]);
                    mx = __builtin_fmaxf(__builtin_fmaxf(mx, p1[i]), p1[i + 1]); mx2 = __builtin_fmaxf(__builtin_fmaxf(mx2, p1[i + 2]), p1[i + 3]); }
                mx = swap_max(__builtin_fmaxf(mx, mx2));
                if (first || __any(mx > 8.0f)) {
                    const float dl = first ? mx : __builtin_fmaxf(mx, 0.f);
                    const float alpha = first ? 0.f : __builtin_amdgcn_exp2f(-dl);
#pragma unroll
                    for (int i = 0; i < 16; ++i) { p0[i] -= dl; p1[i] -= dl; negm[i] -= dl; o[0][i] *= alpha; o[1][i] *= alpha; lacc[i] *= alpha; }
                    first = false;
                }
#pragma unroll
                for (int i = 0; i < 16; ++i) { p0[i] = __builtin_amdgcn_exp2f(p0[i]); p1[i] = __builtin_amdgcn_exp2f(p1[i]); }
            } else {
                const bool diag = (j == jw);
#pragma unroll
                for (int blk = 1; blk >= 0; --blk) {
                    f32x16& pz = blk ? p1 : p0;
                    float L[16];
#pragma unroll
                    for (int i = 0; i < 16; ++i) { const float z = pz[i]; float l = fmaxf(z, 0.f) + __builtin_amdgcn_logf(1.f + __builtin_amdgcn_exp2f(-fabsf(z)));
                        if (diag) { const int kp = kbase + 32 * blk + 8 * (i >> 2) + (i & 3); if (kp >= qi) l = 0.f; }
                        L[i] = l; }
                    float tail = R;
#pragma unroll
                    for (int g = 3; g >= 0; --g) {
                        const float s3 = L[4 * g + 3], s2 = s3 + L[4 * g + 2], s1 = s2 + L[4 * g + 1], s0 = s1 + L[4 * g];
                        const float gp = swap_other(s0, hi);
                        const float base = tail + (hi ? 0.f : gp);
                        tail += s0 + gp;
                        const float c0 = base + s0, c1 = base + s1, c2 = base + s2, c3 = base + s3;
                        pz[4 * g] = __builtin_amdgcn_exp2f(pz[4 * g] - c0); pz[4 * g + 1] = __builtin_amdgcn_exp2f(pz[4 * g + 1] - c1);
                        pz[4 * g + 2] = __builtin_amdgcn_exp2f(pz[4 * g + 2] - c2); pz[4 * g + 3] = __builtin_amdgcn_exp2f(pz[4 * g + 3] - c3);
                    }
                    R = tail;
                    if (diag) {
#pragma unroll
                        for (int i = 0; i < 16; ++i) { const int kp = kbase + 32 * blk + 8 * (i >> 2) + (i & 3); if (kp >= qi) pz[i] = 0.f; }
                    }
                }
            }
            bf16x8 pf[4];
#pragma unroll
            for (int s = 0; s < 4; ++s) { const f32x16& pp = (s < 2) ? p0 : p1; const int o8 = (s & 1) * 8; u32x4 w;
                w[0] = pk_bf16(pp[o8], pp[o8 + 1]); w[1] = pk_bf16(pp[o8 + 2], pp[o8 + 3]); w[2] = pk_bf16(pp[o8 + 4], pp[o8 + 5]); w[3] = pk_bf16(pp[o8 + 6], pp[o8 + 7]);
                pf[s] = __builtin_bit_cast(bf16x8, w); }
            __builtin_amdgcn_s_setprio(1);
            if (MODE != 0) {
#pragma unroll
                for (int s = 0; s < 4; ++s) lacc = __builtin_amdgcn_mfma_f32_32x32x16_bf16(ones8, pf[s], lacc, 0, 0, 0); }
            { const PG8_LAS unsigned char* vb = lds + bufo + hoff + C::K_BYTES + r32 * C::VROW + hi * 16;
#pragma unroll
              for (int db = 0; db < 2; ++db)
#pragma unroll
                  for (int s = 0; s < 4; ++s) o[db] = __builtin_amdgcn_mfma_f32_32x32x16_bf16(*(const PG8_LAS bf16x8*)(vb + db * 32 * C::VROW + s * 32), pf[s], o[db], 0, 0, 0); }
            __builtin_amdgcn_s_setprio(0);
        }
        if (more) ATT_STORE(nbufo);
        if (MODE == 0) {
            if (j <= jw) { const bool dn = __all(R >= 150.f) != 0; if (lane == 0) dflag[wid] = dn ? 1 : 0; }
        }
        if (MODE == 1) {
            if (j <= jw) { bool dn = true; if (j > 0) { const float bnd = qn * kpm[j - 1] + negm[0] - fedge[j - 1]; dn = __all(bnd < -150.f) != 0; } if (lane == 0) dflag[wid] = dn ? 1 : 0; }
        }
        LDS_BARRIER();
        if (MODE != 2) { const u32x4 f0 = *(const PG8_LAS u32x4*)dflag, f1 = *(const PG8_LAS u32x4*)(dflag + 4);
            if ((f0[0] & f0[1] & f0[2] & f0[3] & f1[0] & f1[1] & f1[2] & f1[3]) != 0u) break; }
    }
    if (MODE != 2) __syncthreads();
    float inv = 1.f;
    if (MODE != 0) inv = 1.0f / lacc[0];
    { bf16_t* op = a.O + (rowb + qw + r32) * a.ldo + h * 64 + 4 * hi;
#pragma unroll
      for (int db = 0; db < 2; ++db)
#pragma unroll
          for (int g = 0; g < 4; ++g) st_bf16x4(op + db * 32 + g * 8, (f32x4){o[db][4 * g] * inv, o[db][4 * g + 1] * inv, o[db][4 * g + 2] * inv, o[db][4 * g + 3] * inv}); }
#undef ATT_LOAD
#undef ATT_STORE
}
}

constexpr size_t O_XT = R_XQ, O_BN = R_XQ + 64 * MiB, O_CN = R_XQ + 80 * MiB, O_BT = R_A2 + 96 * MiB;
__device__ __forceinline__ void ph_conv2(const P& p, unsigned char* smem, int bid, int nblk, int tid_) {
    int tid = tid_; asm volatile("" : "+v"(tid));
    const bf16_t* XR = wsp<bf16_t>(p, R_A2);
    bf16_t* tile = (bf16_t*)smem;
    const int l = tid >> 3, cg = tid & 7;
    constexpr int NH = 4;
    constexpr int NITEM = 24 * 16 * (32 / NH);
    u32x4 tap[NH][4]; f32x4 wv[4][2]; f32x4 bv[2];
#define CONV_LOAD(it_) do { const int cb_ = (it_) / (16 * (32 / NH)), bc_ = (it_) % (16 * (32 / NH)), b_ = bc_ / (32 / NH), c0_ = (bc_ % (32 / NH)) * NH, ch0_ = cb_ * 64 + cg * 8; \
        _Pragma("unroll") for (int hf = 0; hf < NH; ++hf) { const int s_ = (c0_ + hf) * 64 + l; const size_t t_ = (size_t)b_ * S + s_; \
            _Pragma("unroll") for (int k = 0; k < 4; ++k) { const bool ok_ = s_ - 3 + k >= 0; tap[hf][k] = *(const u32x4*)(XR + (ok_ ? (t_ - 3 + k) : t_) * 1536 + ch0_); } }   \
        bv[0] = *(const f32x4*)(p.ev_conv_b + ch0_); bv[1] = *(const f32x4*)(p.ev_conv_b + ch0_ + 4); \
        _Pragma("unroll") for (int k = 0; k < 4; ++k) { wv[k][0] = *(const f32x4*)(p.ev_conv_w + k * 1536 + ch0_); wv[k][1] = *(const f32x4*)(p.ev_conv_w + k * 1536 + ch0_ + 4); } } while (0)
    if (bid < NITEM) CONV_LOAD(bid);
    for (int it = bid; it < NITEM; it += nblk) {
        const int cb = it / (16 * (32 / NH)), bc = it % (16 * (32 / NH)), b = bc / (32 / NH), c0 = (bc % (32 / NH)) * NH;
        u32x4 ov[NH];
#pragma unroll
        for (int hf = 0; hf < NH; ++hf) {
            f32x2 acc2[4] = {{bv[0][0], bv[0][1]}, {bv[0][2], bv[0][3]}, {bv[1][0], bv[1][1]}, {bv[1][2], bv[1][3]}};
#pragma unroll
            for (int k = 0; k < 4; ++k) { const u32x4 v = ((c0 + hf) * 64 + l - 3 + k >= 0) ? tap[hf][k] : (u32x4){0u, 0u, 0u, 0u};
#pragma unroll
                for (int j = 0; j < 4; ++j) acc2[j] = __builtin_elementwise_fma((f32x2){wv[k][j >> 1][(j & 1) * 2], wv[k][j >> 1][(j & 1) * 2 + 1]}, (f32x2){bflo(v[j]), bfhi(v[j])}, acc2[j]); }
#pragma unroll
            for (int j = 0; j < 4; ++j) ov[hf][j] = pk_bf16(silu_f(acc2[j][0]), silu_f(acc2[j][1]));
        }
        { const int itn = it + nblk; if (itn < NITEM) CONV_LOAD(itn); }
        if (cb >= 16) { bf16_t* nat = wsp<bf16_t>(p, O_BN + (cb >= 20 ? 16 * MiB : 0));
#pragma unroll
            for (int hf = 0; hf < NH; ++hf) *(u32x4*)(nat + ((size_t)b * S + (c0 + hf) * 64 + l) * 256 + ((cb - 16) & 3) * 64 + cg * 8) = ov[hf]; }
        if (cb < 20) {
#pragma unroll
            for (int hf = 0; hf < NH; ++hf) *(u32x4*)(tile + hf * 64 * 72 + l * 72 + cg * 8) = ov[hf];
            LDS_BARRIER();
            const int r = tid >> 3, lg = tid & 7;
#pragma unroll
            for (int hf = 0; hf < NH; ++hf) { u32x4 tv; const int c = c0 + hf;
#pragma unroll
                for (int j = 0; j < 4; ++j) tv[j] = (unsigned)tile[hf * 64 * 72 + (lg * 8 + 2 * j) * 72 + r] | ((unsigned)tile[hf * 64 * 72 + (lg * 8 + 2 * j + 1) * 72 + r] << 16);
                bf16_t* dst;
                if (cb < 16) dst = wsp<bf16_t>(p, O_XT) + ((((size_t)(b * 16 + cb)) * 32 + c) * 64 + r) * 64 + lg * 8;
                else { const int g = (cb - 16) >> 1, n = ((cb - 16) & 1) * 64 + r; dst = wsp<bf16_t>(p, O_BT) + ((((size_t)(b * 2 + g)) * 32 + c) * 128 + n) * 64 + lg * 8; }
                *(u32x4*)dst = tv; }
            LDS_BARRIER();
        }
    }
}
#undef CONV_LOAD
namespace ssd {
typedef short bf16x8 __attribute__((ext_vector_type(8)));
typedef float f32x16 __attribute__((ext_vector_type(16)));
constexpr int RC = 272, RS = 144;
constexpr int O_CM = 0, O_BM = O_CM + 64 * RC, O_BMT = O_BM + 64 * RC, O_XST = O_BMT + 128 * RS, O_XDT = O_XST + 2 * 64 * RS, O_M = O_XDT + 64 * RS, O_HB = O_M + 64 * RS, O_TAB = O_HB + 64 * RC, LDS_END = O_TAB + 2 * 1024;
static_assert(LDS_END <= 128 * 1024, "ssd lds");
#define SSD_FRAG(off) (*(const PG8_LAS bf16x8*)(lds + (off)))
__device__ __forceinline__ void ssd_unit(const P& p, int b, int h, unsigned char* smem, int tid_) {
    int tid = tid_; asm volatile("" : "+v"(tid));
    const int lane = tid & 63, wid = __builtin_amdgcn_readfirstlane(tid >> 6), r32 = lane & 31, hi = lane >> 5;
    PG8_LAS unsigned char* lds = (PG8_LAS unsigned char*)smem;
    const int g = h >> 3;
    const float a = -expf(p.ev_a_log[h]), dsk = p.ev_d_skip[h];
    const bf16_t* XTu = wsp<bf16_t>(p, O_XT) + ((size_t)(b * 16 + h) * 32) * 4096 + tid * 8;
    const bf16_t* BTu = wsp<bf16_t>(p, O_BT) + ((size_t)(b * 2 + g) * 32) * 8192 + tid * 8;
    const bf16_t* BNu = wsp<bf16_t>(p, O_BN) + ((size_t)b * S + (tid >> 4)) * 256 + g * 128 + (tid & 15) * 8;
    const bf16_t* CNu = wsp<bf16_t>(p, O_CN) + ((size_t)b * S + (tid >> 4)) * 256 + g * 128 + (tid & 15) * 8;
    const float* DTu = wsp<float>(p, OFF_DT) + ((size_t)b * S + lane) * 16 + h;
    const bf16_t* Zu = wsp<bf16_t>(p, R_XBZ + 64 * MiB) + ((size_t)b * S) * 1024 + h * 64;
    bf16_t* A2u = wsp<bf16_t>(p, R_A2) + ((size_t)b * S) * 1536 + h * 64;
    float* SSQu = wsp<float>(p, OFF_SSQ) + ((size_t)b * S) * 32 + h * 2;
    u32x4 rxA, rbA[2], rbtA[2], rcA[2], rxB, rbB[2], rbtB[2], rcB[2]; float rdtA = 0.f, rdtB = 0.f;
#define SSD_LOAD(c, P) do { rx##P = *(const u32x4*)(XTu + (size_t)(c) * 4096); \
        rbt##P[0] = *(const u32x4*)(BTu + (size_t)(c) * 8192); rbt##P[1] = *(const u32x4*)(BTu + (size_t)(c) * 8192 + 4096); \
        rb##P[0] = *(const u32x4*)(BNu + (size_t)(c) * 64 * 256); rb##P[1] = *(const u32x4*)(BNu + ((size_t)(c) * 64 + 32) * 256); \
        rc##P[0] = *(const u32x4*)(CNu + (size_t)(c) * 64 * 256); rc##P[1] = *(const u32x4*)(CNu + ((size_t)(c) * 64 + 32) * 256); \
        if (wid == 2) rdt##P = DTu[(size_t)(c) * 64 * 16]; } while (0)
#define SSD_TABLES(par, P) do { PG8_LAS float* tb_ = (PG8_LAS float*)(lds + O_TAB + (par) * 1024); float x_ = rdt##P * a; \
        _Pragma("unroll") for (int o_ = 1; o_ < 64; o_ <<= 1) { const float y_ = __shfl_up(x_, o_); if (lane >= o_) x_ += y_; } \
        const float a63_ = __shfl(x_, 63); tb_[lane] = x_; tb_[64 + lane] = rdt##P; tb_[128 + lane] = rdt##P * __expf(a63_ - x_); tb_[192 + lane] = __expf(x_); } while (0)
#define SSD_FILL(c, P) do { const int par_ = (c) & 1; const PG8_LAS float* tw = (const PG8_LAS float*)(lds + O_TAB + par_ * 1024 + 512) + (tid & 7) * 8; \
        *(PG8_LAS u32x4*)(lds + O_XST + par_ * 64 * RS + (tid >> 3) * RS + (tid & 7) * 16) = rx##P; \
        { const f32x4 w0_ = *(const PG8_LAS f32x4*)tw, w1_ = *(const PG8_LAS f32x4*)(tw + 4); u32x4 xd_; \
          xd_[0] = pk_bf16(bflo(rx##P[0]) * w0_[0], bfhi(rx##P[0]) * w0_[1]); xd_[1] = pk_bf16(bflo(rx##P[1]) * w0_[2], bfhi(rx##P[1]) * w0_[3]); \
          xd_[2] = pk_bf16(bflo(rx##P[2]) * w1_[0], bfhi(rx##P[2]) * w1_[1]); xd_[3] = pk_bf16(bflo(rx##P[3]) * w1_[2], bfhi(rx##P[3]) * w1_[3]); \
          *(PG8_LAS u32x4*)(lds + O_XDT + (tid >> 3) * RS + (tid & 7) * 16) = xd_; } \
        *(PG8_LAS u32x4*)(lds + O_BMT + (tid >> 3) * RS + (tid & 7) * 16) = rbt##P[0]; *(PG8_LAS u32x4*)(lds + O_BMT + (64 + (tid >> 3)) * RS + (tid & 7) * 16) = rbt##P[1]; \
        *(PG8_LAS u32x4*)(lds + O_BM + (tid >> 4) * RC + (tid & 15) * 16) = rb##P[0]; *(PG8_LAS u32x4*)(lds + O_BM + (32 + (tid >> 4)) * RC + (tid & 15) * 16) = rb##P[1]; \
        *(PG8_LAS u32x4*)(lds + O_CM + (tid >> 4) * RC + (tid & 15) * 16) = rc##P[0]; *(PG8_LAS u32x4*)(lds + O_CM + (32 + (tid >> 4)) * RC + (tid & 15) * 16) = rc##P[1]; } while (0)
    for (int i = tid; i < 64 * RC / 16; i += NTHR) *(PG8_LAS u32x4*)(lds + O_HB + i * 16) = (u32x4){0u, 0u, 0u, 0u};
    f32x16 acch, accy;
#pragma unroll
    for (int i = 0; i < 16; ++i) { acch[i] = 0.f; accy[i] = 0.f; }
    const int nb = wid >> 1, pbh = wid & 1;
    const int w4 = wid & 3, t_a = w4 >> 1, t_b = w4 & 1;
#define SSD_BODY(c, P, Q) do { \
        const int par = (c) & 1; \
        if ((c) + 2 < 32) SSD_LOAD((c) + 2, P); \
        u32x2 zz[4] = {}; \
        if (wid >= 4) { \
_Pragma("unroll") \
            for (int g_ = 0; g_ < 4; ++g_) zz[g_] = *(const u32x2*)(Zu + ((size_t)(c) * 64 + 32 * t_b + r32) * 1024 + 32 * t_a + 8 * g_ + 4 * hi); } \
        LDS_BARRIER(); \
        const PG8_LAS float* tb = (const PG8_LAS float*)(lds + O_TAB + par * 1024); \
        { const float d63 = tb[192 + 63]; \
_Pragma("unroll") \
          for (int i = 0; i < 16; ++i) acch[i] *= d63; } \
        if (wid < 4) { \
            f32x16 cbt; \
_Pragma("unroll") \
            for (int i = 0; i < 16; ++i) cbt[i] = 0.f; \
            if (t_a <= t_b) { \
_Pragma("unroll") \
                for (int ks = 0; ks < 8; ++ks) { cbt = __builtin_amdgcn_mfma_f32_32x32x16_bf16(SSD_FRAG(O_BM + (32 * t_a + r32) * RC + ks * 32 + hi * 16), SSD_FRAG(O_CM + (32 * t_b + r32) * RC + ks * 32 + hi * 16), cbt, 0, 0, 0); \
                    if (ks < 4) { acch = __builtin_amdgcn_mfma_f32_32x32x16_bf16(SSD_FRAG(O_BMT + (32 * nb + r32) * RS + ks * 32 + hi * 16), SSD_FRAG(O_XDT + (32 * pbh + r32) * RS + ks * 32 + hi * 16), acch, 0, 0, 0); } } \
            } else { \
_Pragma("unroll") \
                for (int ks = 0; ks < 4; ++ks) { acch = __builtin_amdgcn_mfma_f32_32x32x16_bf16(SSD_FRAG(O_BMT + (32 * nb + r32) * RS + ks * 32 + hi * 16), SSD_FRAG(O_XDT + (32 * pbh + r32) * RS + ks * 32 + hi * 16), acch, 0, 0, 0); } \
            } \
            const int l = 32 * t_b + r32; const float Al = tb[l]; \
_Pragma("unroll") \
            for (int g_ = 0; g_ < 4; ++g_) { const int s0 = 32 * t_a + 8 * g_ + 4 * hi; \
                const f32x4 As = *(const PG8_LAS f32x4*)(tb + s0), ds = *(const PG8_LAS f32x4*)(tb + 64 + s0); \
                float m[4]; \
_Pragma("unroll") \
                for (int j = 0; j < 4; ++j) m[j] = (s0 + j <= l) ? cbt[4 * g_ + j] * __expf(Al - As[j]) * ds[j] : 0.f; \
                *(PG8_LAS u32x2*)(lds + O_M + l * RS + s0 * 2) = (u32x2){pk_bf16(m[0], m[1]), pk_bf16(m[2], m[3])}; } \
            if (wid == 2 && (c) + 1 < 32) SSD_TABLES(((c) + 1) & 1, Q); \
        } else { \
_Pragma("unroll") \
            for (int i = 0; i < 16; ++i) accy[i] = 0.f; \
_Pragma("unroll") \
            for (int ks = 0; ks < 8; ++ks) { accy = __builtin_amdgcn_mfma_f32_32x32x16_bf16(SSD_FRAG(O_HB + (32 * t_a + r32) * RC + ks * 32 + hi * 16), SSD_FRAG(O_CM + (32 * t_b + r32) * RC + ks * 32 + hi * 16), accy, 0, 0, 0); \
                if (ks < 4) { acch = __builtin_amdgcn_mfma_f32_32x32x16_bf16(SSD_FRAG(O_BMT + (32 * nb + r32) * RS + ks * 32 + hi * 16), SSD_FRAG(O_XDT + (32 * pbh + r32) * RS + ks * 32 + hi * 16), acch, 0, 0, 0); } } \
            const float eAl = tb[192 + 32 * t_b + r32]; \
_Pragma("unroll") \
            for (int i = 0; i < 16; ++i) accy[i] *= eAl; \
        } \
        LDS_BARRIER(); \
_Pragma("unroll") \
        for (int g_ = 0; g_ < 4; ++g_) *(PG8_LAS u32x2*)(lds + O_HB + (32 * pbh + r32) * RC + (32 * nb + 8 * g_ + 4 * hi) * 2) = (u32x2){pk_bf16(acch[4 * g_], acch[4 * g_ + 1]), pk_bf16(acch[4 * g_ + 2], acch[4 * g_ + 3])}; \
        if (wid >= 4) { \
            const int l = 32 * t_b + r32; const size_t trow = (size_t)(c) * 64 + l; \
_Pragma("unroll") \
            for (int ks = 0; ks < 4; ++ks) accy = __builtin_amdgcn_mfma_f32_32x32x16_bf16(SSD_FRAG(O_XST + par * 64 * RS + (32 * t_a + r32) * RS + ks * 32 + hi * 16), SSD_FRAG(O_M + (32 * t_b + r32) * RS + ks * 32 + hi * 16), accy, 0, 0, 0); \
            float ss = 0.f; \
_Pragma("unroll") \
            for (int g_ = 0; g_ < 4; ++g_) { const int p0 = 32 * t_a + 8 * g_ + 4 * hi; float u[4]; \
                const float z4[4] = {bflo(zz[g_][0]), bfhi(zz[g_][0]), bflo(zz[g_][1]), bfhi(zz[g_][1])}; \
_Pragma("unroll") \
                for (int j = 0; j < 4; ++j) { const float xs = bf2f(*(const PG8_LAS bf16_t*)(lds + O_XST + par * 64 * RS + (p0 + j) * RS + l * 2)); \
                    u[j] = (accy[4 * g_ + j] + dsk * xs) * silu_f(z4[j]); ss += u[j] * u[j]; } \
                st_bf16x4(A2u + trow * 1536 + p0, (f32x4){u[0], u[1], u[2], u[3]}); } \
            ss = att::swap_sum(ss); \
            if (hi == 0) SSQu[trow * 32 + t_a] = ss; \
        } \
        if ((c) + 1 < 32) SSD_FILL((c) + 1, Q); \
    } while (0)
    SSD_LOAD(0, A); SSD_LOAD(1, B);
    if (wid == 2) SSD_TABLES(0, A);
    __syncthreads();
    SSD_FILL(0, A);
    for (int c2 = 0; c2 < 32; c2 += 2) { SSD_BODY(c2, A, B); SSD_BODY(c2 + 1, B, A); }
    __syncthreads();
#undef SSD_LOAD
#undef SSD_BODY
#undef SSD_TABLES
#undef SSD_FILL
}
#undef SSD_FRAG
}
__device__ __forceinline__ void ph_ssd_mf(const P& p, unsigned char* smem, int bid, int nblk, int tid_) {
    for (int u = bid; u < NB * 16; u += nblk) ssd::ssd_unit(p, u >> 4, u & 15, smem, tid_);
}

__device__ __forceinline__ void hp_unit(int bid, int nblk, int i, int& b, int& h0, int& blk) {
    int pairidx;
    if (nblk == 256) { pairidx = (bid >> 4) + 16 * i; blk = ((bid & 15) + 4 * i) & 15; } else { const int u = bid + nblk * i; pairidx = u >> 4; blk = u & 15; }
    b = pairidx >> 2; h0 = (pairidx & 3) * 2;
}
__device__ __forceinline__ void ph_sb_mf(const P& p, unsigned char* smem, int bid, int nblk, int tid_) {
    att::Args a{wsp<bf16_t>(p, R_XQ + 96 * MiB), 512, wsp<bf16_t>(p, R_XQ + 128 * MiB), 512, nullptr, wsp<bf16_t>(p, R_XQ + 160 * MiB), wsp<bf16_t>(p, R_A2) + 1024, 1536, nullptr, nullptr};
    for (int i = 0; bid + nblk * i < 1024; ++i) { int b, h0, blk; hp_unit(bid, nblk, i, b, h0, blk); att::attn_unit<0, 2>(a, b, h0, blk, smem, tid_); }
}
__device__ __forceinline__ void ph_attn1_mf(const P& p, unsigned char* smem, int bid, int nblk, int tid_) {
    att::Args am{wsp<bf16_t>(p, R_A2), 768, wsp<bf16_t>(p, R_A2 + 48 * MiB), 512, wsp<bf16_t>(p, R_XBZ + 16 * MiB), wsp<bf16_t>(p, R_A2 + 80 * MiB), wsp<bf16_t>(p, R_XQ), 1024, nullptr, nullptr};
    att::Args af{wsp<bf16_t>(p, R_XBZ + 32 * MiB), 512, wsp<bf16_t>(p, R_XBZ + 64 * MiB), 512, nullptr, wsp<bf16_t>(p, R_XBZ + 96 * MiB), wsp<bf16_t>(p, R_XQ) + 512, 1024, wsp<float>(p, OFF_DT + 1 * MiB), wsp<float>(p, OFF_SSQ + 1 * MiB)};
    for (int pi = bid; pi < 512; pi += nblk) { const int bh = pi >> 2, pr = pi & 3;
        att::attn_unit<2>(am, bh >> 3, bh & 7, 7 - pr, smem, tid_); att::attn_unit<2>(am, bh >> 3, bh & 7, pr, smem, tid_); }
    for (int i = 0; bid + nblk * i < 1024; ++i) { int b, h0, blk; hp_unit(bid, nblk, i, b, h0, blk); att::attn_unit<1, 2>(af, b, h0, blk, smem, tid_); }
}
template <int N, int OFF, int NTOT> __device__ __forceinline__ void tred_rec(float (&v)[NTOT], int lane) {
    if constexpr (N > 1) {
        const bool up = (lane & OFF) != 0;
#pragma unroll
        for (int i = 0; i < N / 2; ++i) { const float keep = up ? v[i + N / 2] : v[i], send = up ? v[i] : v[i + N / 2];
            float got;
            if constexpr (OFF == 32) got = other32(send, up); else if constexpr (OFF == 16) got = other16(send, up); else if constexpr (OFF == 8) got = dpp_f<0x128>(send); else got = __shfl_xor(send, OFF);
            v[i] = keep + got; }
        tred_rec<N / 2, OFF / 2, NTOT>(v, lane);
    }
}
template <int N> __device__ __forceinline__ float tred(float (&v)[N], int lane) {
    tred_rec<N, 32, N>(v, lane);
    return group_sum<64 / N>(v[0]);
}
template <int N> __device__ __forceinline__ int tred_idx(int lane) { return lane / (64 / N); }
__device__ __forceinline__ int kpos(int k) { return (k & 1) * 512 + (k >> 1); }

struct TBuf { float v[4][8]; float g[8]; bf16_t* d; int ro[4]; int zm, gf; };
__device__ __forceinline__ void tconv_finish(const TBuf& pd, float* tile, int tid) {
    const int cq = tid & 63, rk = tid >> 6;
    const int wr_ = tid >> 3, wk = (tid & 7) * 8;
#pragma unroll
    for (int c = 0; c < 4; ++c)
#pragma unroll
        for (int i = 0; i < 8; ++i) { const float gv = pd.gf ? pd.g[i] : 1.f; tile[(rk + 8 * i) * 257 + cq + 64 * c] = ((pd.zm >> c) & 1) ? 0.f : pd.v[c][i] * gv; }
    LDS_BARRIER();
#pragma unroll
    for (int c = 0; c < 4; ++c) { u32x4 w;
#pragma unroll
      for (int j = 0; j < 4; ++j) w[j] = pk_bf16(tile[(wk + 2 * j) * 257 + wr_ + 64 * c], tile[(wk + 2 * j + 1) * 257 + wr_ + 64 * c]);
      *(u32x4*)(pd.d + pd.ro[c]) = w; }
    LDS_BARRIER();
}
template <bool GAIN, class Map> __device__ __forceinline__ void tconv(bf16_t* dst, const float* src, int src_ld, int K, const Map& map, const float* gain, int gain_n,
                                                          int nbatch, size_t dst_bstride, size_t src_bstride, float* tile, int bid, int nblk, int tid, int& toff, TBuf& A, TBuf& B, int& pp) {
    const int nkt = K / 64, nqt = map.nq / 256, per = nkt * nqt, total = per * nbatch;
    const int first = (bid - toff % nblk + nblk) % nblk;
    toff += total;
    const int cq = tid & 63, rk = tid >> 6;
    const int wr_ = tid >> 3, wk = (tid & 7) * 8;
#define TCONV_LOAD(X) do { \
        X.zm = 0; \
        _Pragma("unroll") for (int c = 0; c < 4; ++c) { const int sc = map.scol(q0 + cq + 64 * c); const int scc = sc < 0 ? 0 : sc; X.zm |= (sc < 0 ? 1 : 0) << c; \
            _Pragma("unroll") for (int i = 0; i < 8; ++i) X.v[c][i] = s[(size_t)(k0 + rk + 8 * i) * src_ld + scc]; } \
        if constexpr (GAIN) { X.gf = k0 < gain_n;             \
            _Pragma("unroll") for (int i = 0; i < 8; ++i) { const int k = k0 + rk + 8 * i; X.g[i] = gain[k < gain_n ? k : 0]; } } \
        else { X.gf = 0; _Pragma("unroll") for (int i = 0; i < 8; ++i) X.g[i] = 1.f; } \
        _Pragma("unroll") for (int c = 0; c < 4; ++c) X.ro[c] = map.drow(q0 + wr_ + 64 * c) * K + k0 + wk; \
        X.d = dst + (size_t)bt * dst_bstride; } while (0)
    for (int tI = first; tI < total; tI += nblk) {
        const int bt = tI / per, rem = tI % per, kt = rem / nqt, qt = rem % nqt, k0 = kt * 64, q0 = qt * 256;
        const float* s = src + (size_t)bt * src_bstride;
        if (pp == 1) { TCONV_LOAD(B); tconv_finish(A, tile, tid); pp = 2; }
        else { TCONV_LOAD(A); if (pp == 2) tconv_finish(B, tile, tid); pp = 1; }
    }
#undef TCONV_LOAD
}
struct MapIn0 { static constexpr int nq = 3584; __device__ __forceinline__ int drow(int q) const { return q; } __device__ __forceinline__ int scol(int q) const { return q < 2560 ? q : (q < 3072 ? 2576 + (q - 2560) : 3088 + (q - 3072)); } };
struct MapOff { int nq, off; __device__ __forceinline__ int drow(int q) const { return q; } __device__ __forceinline__ int scol(int q) const { return off + q; } };
struct MapIn1 { static constexpr int nq = 1536; __device__ __forceinline__ int drow(int q) const { return q; }
    __device__ __forceinline__ int scol(int q) const { if (q < 384) return q; if (q < 416) { const int j = q - 384, i = j >> 1; return 384 + ((j & 1) ? i + 16 : i); } if (q < 512) return -1; if (q < 1024) return 416 + (q - 512); return 928 + (q - 1024); } };
struct MapQup { static constexpr int nq = 768; __device__ __forceinline__ int drow(int q) const { return q; }
    __device__ __forceinline__ int scol(int q) const { const int h = q / 96, j = q % 96; if (j < 64) return q; const int jj = j - 64, i = jj >> 1; return 96 * h + 64 + ((jj & 1) ? i + 16 : i); } };
struct MapKV { static constexpr int nq = 512; int off; __device__ __forceinline__ int drow(int q) const { return q; } __device__ __forceinline__ int scol(int q) const { return 128 * (q >> 6) + off + (q & 63); } };
struct MapGU { static constexpr int nq = 256; int up; __device__ __forceinline__ int drow(int q) const { return 256 * (q >> 7) + 128 * up + (q & 127); } __device__ __forceinline__ int scol(int q) const { return q; } };

__device__ __forceinline__ void ph_prologue2(const P& p, unsigned char* smem, int bid, int nblk, int tid_) {
    int tid = tid_; asm volatile("" : "+v"(tid));
    const int lane = tid & 63, wid = tid >> 6;
    float* wl = (float*)smem;
    { f32x4 w4[8];
#pragma unroll
      for (int j = 0; j < 8; ++j) { const int q = tid + NTHR * j; w4[j] = *(const f32x4*)(p.ev_w_in + (size_t)(q >> 2) * EVEN_IN + 2560 + 4 * (q & 3)); }
#pragma unroll
      for (int j = 0; j < 8; ++j) { const int q = tid + NTHR * j; *(f32x4*)(wl + kpos(q >> 2) * 20 + 4 * (q & 3)) = w4[j]; } }
    __syncthreads();
    { float* DT = wsp<float>(p, OFF_DT); unsigned* XB = wsp<unsigned>(p, R_XBZ);
      const int hsel = tred_idx<16>(lane); const float dtb = p.ev_dt_bias[hsel];
      f32x2 xnx[8];
      { const int t0 = bid * 8 + wid; if (t0 < T) {
#pragma unroll
          for (int i = 0; i < 8; ++i) xnx[i] = ((const f32x2*)(p.x + (size_t)t0 * D))[lane + 64 * i]; } }
      for (int t = bid * 8 + wid; t < T; t += nblk * 8) {
          asm volatile("" ::: "memory");
          f32x2 xv[8];
#pragma unroll
          for (int i = 0; i < 8; ++i) xv[i] = xnx[i];
          { const int tn = t + nblk * 8; if (tn < T) {
#pragma unroll
              for (int i = 0; i < 8; ++i) xnx[i] = ((const f32x2*)(p.x + (size_t)tn * D))[lane + 64 * i]; } }
#pragma unroll
          for (int i = 0; i < 8; ++i) XB[(size_t)t * 512 + lane + 64 * i] = pk_bf16(xv[i][0], xv[i][1]);
          f32x2 accv[8];
#pragma unroll
          for (int h = 0; h < 8; ++h) accv[h] = (f32x2){0.f, 0.f};
#pragma unroll
          for (int i = 0; i < 8; ++i)
#pragma unroll
              for (int c = 0; c < 2; ++c) { const float* wrow = wl + (c * 512 + 64 * i + lane) * 20; const f32x2 xx = {xv[i][c], xv[i][c]};
#pragma unroll
                  for (int h4 = 0; h4 < 4; ++h4) { const f32x4 w4 = *(const f32x4*)(wrow + 4 * h4);
                      accv[2 * h4] = __builtin_elementwise_fma(xx, (f32x2){w4[0], w4[1]}, accv[2 * h4]); accv[2 * h4 + 1] = __builtin_elementwise_fma(xx, (f32x2){w4[2], w4[3]}, accv[2 * h4 + 1]); } }
          float acc[16];
#pragma unroll
          for (int h = 0; h < 8; ++h) { acc[2 * h] = accv[h][0]; acc[2 * h + 1] = accv[h][1]; }
          const float r = tred<16>(acc, lane);
          if ((lane & 3) == 0) DT[(size_t)t * 16 + hsel] = softplus_f(r + dtb);
      } }
    __syncthreads();
    float* tile = (float*)smem;
    int toff = 0, pp = 0; TBuf tbA, tbB;
    tconv<false>(wsp<bf16_t>(p, W0M), p.ev_w_in, EVEN_IN, 1024, MapIn0{}, nullptr, 0, 1, 0, 0, tile, bid, nblk, tid, toff, tbA, tbB, pp);
    tconv<false>(wsp<bf16_t>(p, W0V), p.ev_w_in, EVEN_IN, 1024, MapOff{512, 3600}, nullptr, 0, 1, 0, 0, tile, bid, nblk, tid, toff, tbA, tbB, pp);
    tconv<true>(wsp<bf16_t>(p, W0O), p.ev_w_out, 1024, 1536, MapOff{1024, 0}, p.ev_norm_g, 1024, 1, 0, 0, tile, bid, nblk, tid, toff, tbA, tbB, pp);
    tconv<false>(wsp<bf16_t>(p, W1M), p.od_w_in, ODD_IN, 1024, MapIn1{}, nullptr, 0, 1, 0, 0, tile, bid, nblk, tid, toff, tbA, tbB, pp);
    tconv<false>(wsp<bf16_t>(p, W1V), p.od_w_in, ODD_IN, 1024, MapOff{512, 1440}, nullptr, 0, 1, 0, 0, tile, bid, nblk, tid, toff, tbA, tbB, pp);
    tconv<true>(wsp<bf16_t>(p, W1Q), p.od_w_q_up, 768, 256, MapQup{}, p.od_q_norm_g, 256, 1, 0, 0, tile, bid, nblk, tid, toff, tbA, tbB, pp);
    tconv<true>(wsp<bf16_t>(p, W1K), p.od_w_kv_up, 1024, 128, MapKV{0}, p.od_kv_norm_g, 128, 1, 0, 0, tile, bid, nblk, tid, toff, tbA, tbB, pp);
    tconv<true>(wsp<bf16_t>(p, W1VV), p.od_w_kv_up, 1024, 128, MapKV{64}, p.od_kv_norm_g, 128, 1, 0, 0, tile, bid, nblk, tid, toff, tbA, tbB, pp);
    tconv<false>(wsp<bf16_t>(p, W1O), p.od_w_out, 1024, 1024, MapOff{1024, 0}, nullptr, 0, 1, 0, 0, tile, bid, nblk, tid, toff, tbA, tbB, pp);
    tconv<false>(wsp<bf16_t>(p, WGU), p.moe_w_gate, 256, 1024, MapGU{0}, nullptr, 0, 32, (size_t)512 * 1024, (size_t)1024 * 256, tile, bid, nblk, tid, toff, tbA, tbB, pp);
    tconv<false>(wsp<bf16_t>(p, WGU), p.moe_w_up, 256, 1024, MapGU{1}, nullptr, 0, 32, (size_t)512 * 1024, (size_t)1024 * 256, tile, bid, nblk, tid, toff, tbA, tbB, pp);
    tconv<false>(wsp<bf16_t>(p, WDN), p.moe_w_down, 1024, 256, MapOff{1024, 0}, nullptr, 0, 32, (size_t)1024 * 256, (size_t)256 * 1024, tile, bid, nblk, tid, toff, tbA, tbB, pp);
    if (pp == 1) tconv_finish(tbA, tile, tid); else if (pp == 2) tconv_finish(tbB, tile, tid);
    { const size_t gtid = (size_t)bid * NTHR + tid, gstride = (size_t)nblk * NTHR; float* tab = wsp<float>(p, OFF_TAB);
      for (size_t i = gtid; i < (size_t)S * 16; i += gstride) { const int s = (int)(i >> 4), f = (int)(i & 15);
        double inv = 1.0; for (int k = 0; k < f; ++k) inv *= 0.56234132519034908;
        const double rev = (double)s * inv * 0.15915494309189535; const double fr = rev - floor(rev);
        const double x = fr * 4.0; const double qd = floor(x + 0.5); const int qi = (int)qd & 3;
        const double y = (x - qd) * 1.5707963267948966, y2 = y * y;
        const double sy = y * (1.0 + y2 * (-1.0 / 6 + y2 * (1.0 / 120 + y2 * (-1.0 / 5040 + y2 * (1.0 / 362880 + y2 * (-1.0 / 39916800 + y2 * (1.0 / 6227020800.0)))))));
        const double cy = 1.0 + y2 * (-0.5 + y2 * (1.0 / 24 + y2 * (-1.0 / 720 + y2 * (1.0 / 40320 + y2 * (-1.0 / 3628800 + y2 * (1.0 / 479001600.0 + y2 * (-1.0 / 87178291200.0)))))));
        const double cv = (qi == 0) ? cy : (qi == 1) ? -sy : (qi == 2) ? -cy : sy;
        const double sv = (qi == 0) ? sy : (qi == 1) ? cy : (qi == 2) ? -sy : -cy;
        tab[i] = (float)cv; tab[S * 16 + i] = (float)sv; } }
}

__device__ __forceinline__ void ln_row2(f32x2 (&v)[8], const f32x2 (&g)[8], const f32x2 (&bt)[8]) {
    float s = 0.f;
#pragma unroll
    for (int i = 0; i < 8; ++i) s += v[i][0] + v[i][1];
    const float mu = wave_sum(s) * (1.0f / 1024.0f);
    float q = 0.f;
#pragma unroll
    for (int i = 0; i < 8; ++i) { const f32x2 d = v[i] - mu; q += d[0] * d[0] + d[1] * d[1]; }
    const float rstd = rsqrtf(wave_sum(q) * (1.0f / 1024.0f) + 1e-5f);
#pragma unroll
    for (int i = 0; i < 8; ++i) v[i] = (v[i] - mu) * rstd * g[i] + bt[i];
}
__device__ __forceinline__ void ph_ln1_router2(const P& p, int l, unsigned char* smem, int bid, int nblk, int tid_) {
    int tid = tid_; asm volatile("" : "+v"(tid));
    const int lane = tid & 63, wid = tid >> 6;
    const unsigned* MIX = wsp<unsigned>(p, R_XBZ); unsigned* X1B = wsp<unsigned>(p, R_XQ + 128 * MiB);
    const float* XIN = p.x;
    float* TOKW = wsp<float>(p, OFF_ROUTE + 256 * 1024); int* LIST = wsp<int>(p, OFF_LIST);
    unsigned* CNT = wsp<unsigned>(p, OFF_CTRL) + 64 * l;
    float* wl = (float*)smem;
    float* lgs = wl + 1024 * 20;
    int* ent = (int*)(lgs + 8 * 256);
    int* lcnt = ent + 256;
    int* lbase = lcnt + 32;
    { const f32x4* wgp = (const f32x4*)(p.moe_w_group + (size_t)l * 1024 * 4); const f32x4* wep = (const f32x4*)(p.moe_w_expert + (size_t)l * 1024 * 16);
      f32x4 wg4[2], we4[8];
#pragma unroll
      for (int j = 0; j < 2; ++j) wg4[j] = wgp[tid + NTHR * j];
#pragma unroll
      for (int j = 0; j < 8; ++j) we4[j] = wep[tid + NTHR * j];
#pragma unroll
      for (int j = 0; j < 2; ++j) *(f32x4*)(wl + kpos(tid + NTHR * j) * 20) = wg4[j];
#pragma unroll
      for (int j = 0; j < 8; ++j) { const int q = tid + NTHR * j; *(f32x4*)(wl + kpos(q >> 2) * 20 + 4 + 4 * (q & 3)) = we4[j]; } }
    f32x2 g[8], bt[8];
#pragma unroll
    for (int i = 0; i < 8; ++i) { g[i] = ((const f32x2*)(p.ln1_g + l * 1024))[lane + 64 * i]; bt[i] = ((const f32x2*)(p.ln1_b + l * 1024))[lane + 64 * i]; }
    const int gsel = tred_idx<4>(lane);
    for (int ch = bid; ch < T / 128; ch += nblk) {
        if (tid < 32) lcnt[tid] = 0;
        __syncthreads();
        f32x2 xn[8]; unsigned mn[8];
#pragma unroll
        for (int i = 0; i < 8; ++i) { const size_t o = (size_t)(ch * 128 + wid * 16) * 512 + lane + 64 * i; mn[i] = MIX[o];
            if (l == 0) xn[i] = ((const f32x2*)XIN)[o]; else { const unsigned xb = X1B[o]; xn[i] = (f32x2){bflo(xb), bfhi(xb)}; } }
        for (int r = 0; r < 16; ++r) {
            const int lr = wid * 16 + r, t = ch * 128 + lr;
            f32x2 v[8];
#pragma unroll
            for (int i = 0; i < 8; ++i) v[i] = xn[i] * ALPHA + (f32x2){bflo(mn[i]), bfhi(mn[i])};
            if (r + 1 < 16) {
#pragma unroll
                for (int i = 0; i < 8; ++i) { const size_t o = (size_t)(t + 1) * 512 + lane + 64 * i; mn[i] = MIX[o];
                    if (l == 0) xn[i] = ((const f32x2*)XIN)[o]; else { const unsigned xb = X1B[o]; xn[i] = (f32x2){bflo(xb), bfhi(xb)}; } } }
            ln_row2(v, g, bt);
#pragma unroll
            for (int i = 0; i < 8; ++i) X1B[(size_t)t * 512 + lane + 64 * i] = pk_bf16(v[i][0], v[i][1]);
            f32x2 agv[2];
#pragma unroll
            for (int e = 0; e < 2; ++e) agv[e] = (f32x2){0.f, 0.f};
#pragma unroll
            for (int i = 0; i < 8; ++i)
#pragma unroll
                for (int c = 0; c < 2; ++c) { const float* wrow = wl + (c * 512 + 64 * i + lane) * 20; const f32x2 xx = {v[i][c], v[i][c]};
                    const f32x4 w0 = *(const f32x4*)wrow;
                    agv[0] = __builtin_elementwise_fma(xx, (f32x2){w0[0], w0[1]}, agv[0]); agv[1] = __builtin_elementwise_fma(xx, (f32x2){w0[2], w0[3]}, agv[1]); }
            float ag[4];
#pragma unroll
            for (int e = 0; e < 2; ++e) { ag[2 * e] = agv[e][0]; ag[2 * e + 1] = agv[e][1]; }
            const float rg = tred<4>(ag, lane);
            float gl[4]; float gm = -INFINITY; int gs = 0;
#pragma unroll
            for (int e = 0; e < 4; ++e) { gl[e] = __int_as_float(__builtin_amdgcn_readlane(__float_as_int(rg), 16 * e)) + p.moe_b_group[l * 4 + e]; if (gl[e] > gm) { gm = gl[e]; gs = e; } }
            f32x2 aev[2];
#pragma unroll
            for (int e = 0; e < 2; ++e) aev[e] = (f32x2){0.f, 0.f};
#pragma unroll
            for (int i = 0; i < 8; ++i)
#pragma unroll
                for (int c = 0; c < 2; ++c) { const float* wrow = wl + (c * 512 + 64 * i + lane) * 20 + 4 + 4 * gs; const f32x2 xx = {v[i][c], v[i][c]};
                    const f32x4 w4 = *(const f32x4*)wrow;
                    aev[0] = __builtin_elementwise_fma(xx, (f32x2){w4[0], w4[1]}, aev[0]); aev[1] = __builtin_elementwise_fma(xx, (f32x2){w4[2], w4[3]}, aev[1]); }
            float ae[4];
#pragma unroll
            for (int e = 0; e < 2; ++e) { ae[2 * e] = aev[e][0]; ae[2 * e + 1] = aev[e][1]; }
            const float re = tred<4>(ae, lane);
            float* lw = lgs + wid * 256 + r * 16;
            if ((lane & 15) == 0) { lw[gsel] = rg + p.moe_b_group[l * 4 + gsel]; lw[4 + gsel] = re; }
            if (lane == 0) lw[8] = __int_as_float(gs);
        }
        __builtin_amdgcn_wave_barrier();
        if (lane < 16) {
            const int lr = wid * 16 + lane, t = ch * 128 + lr; const float* lw = lgs + wid * 256 + lane * 16;
            float gl[4]; float gm = -INFINITY;
#pragma unroll
            for (int e = 0; e < 4; ++e) { gl[e] = lw[e]; gm = fmaxf(gm, gl[e]); }
            const int gs = __float_as_int(lw[8]);
            float gsum = 0.f;
#pragma unroll
            for (int e = 0; e < 4; ++e) gsum += expf(gl[e] - gm);
            const float gp = 1.0f / gsum;
            float el[4]; float em = -INFINITY;
#pragma unroll
            for (int e = 0; e < 4; ++e) { el[e] = lw[4 + e] + p.moe_b_expert[l * 16 + gs * 4 + e]; em = fmaxf(em, el[e]); }
            int i0 = 0; float b0 = el[0];
#pragma unroll
            for (int e = 1; e < 4; ++e) if (el[e] > b0) { b0 = el[e]; i0 = e; }
            int i1 = 0; float b1 = -INFINITY;
#pragma unroll
            for (int e = 0; e < 4; ++e) if (e != i0 && el[e] > b1) { b1 = el[e]; i1 = e; }
            const float p0 = expf(b0 - em), p1 = expf(b1 - em);
            const float w0 = gp * p0 / (p0 + p1), w1 = gp * p1 / (p0 + p1);
            if (i1 == i0) i1 = (i0 + 1) & 3;
            const int lo = i0 < i1 ? i0 : i1, hi = i0 < i1 ? i1 : i0;
            const int lid = gs * 6 + (lo == 0 ? hi - 1 : (lo == 1 ? hi + 1 : 5));
            TOKW[t * 2] = i0 < i1 ? w0 : w1; TOKW[t * 2 + 1] = i0 < i1 ? w1 : w0;
            const int s0 = atomicAdd(&lcnt[lid], 1);
            ent[lr] = (lid << 16) | s0;
        }
        __syncthreads();
        if (tid < NLIST) lbase[tid] = (int)atomicAdd(&CNT[tid], (unsigned)lcnt[tid]);
        __syncthreads();
        if (tid < 128) { const int pe = ent[tid], e = pe >> 16, sl = pe & 0xffff; LIST[(size_t)e * T + lbase[e] + sl] = ch * 128 + tid; }
        __syncthreads();
    }
}
__device__ __forceinline__ void ph_ln2_2(const P& p, int l, unsigned char* smem, int bid, int nblk, int tid_) {
    int tid = tid_; asm volatile("" : "+v"(tid));
    const int lane = tid & 63, wid = tid >> 6;
    unsigned* X1B = wsp<unsigned>(p, R_XQ + 128 * MiB); const unsigned* Y = wsp<unsigned>(p, R_XBZ);
    float* LOGF = wsp<float>(p, OFF_DT);
    float* wl = (float*)smem;
    if (l == 0) { f32x4 w4[4];
#pragma unroll
        for (int j = 0; j < 4; ++j) { const int q = tid + NTHR * j; w4[j] = *(const f32x4*)(p.od_w_in + (size_t)(q >> 1) * ODD_IN + 1952 + 4 * (q & 1)); }
#pragma unroll
        for (int j = 0; j < 4; ++j) { const int q = tid + NTHR * j; *(f32x4*)(wl + kpos(q >> 1) * 12 + 4 * (q & 1)) = w4[j]; }
        __syncthreads(); }
    f32x2 g[8], bt[8];
#pragma unroll
    for (int i = 0; i < 8; ++i) { g[i] = ((const f32x2*)(p.ln2_g + l * 1024))[lane + 64 * i]; bt[i] = ((const f32x2*)(p.ln2_b + l * 1024))[lane + 64 * i]; }
    const int fsel = tred_idx<8>(lane); const float fb = p.od_f_bias[fsel];
    unsigned xn[8], ya[8];
    { const int t0 = bid * 8 + wid; if (t0 < T) {
#pragma unroll
        for (int i = 0; i < 8; ++i) { const size_t o = (size_t)t0 * 512 + lane + 64 * i; xn[i] = X1B[o]; ya[i] = Y[o]; } } }
    for (int t = bid * 8 + wid; t < T; t += nblk * 8) {
        f32x2 v[8];
#pragma unroll
        for (int i = 0; i < 8; ++i) v[i] = (f32x2){bflo(xn[i]), bfhi(xn[i])} * ALPHA + (f32x2){bflo(ya[i]), bfhi(ya[i])};
        { const int tn = t + nblk * 8; if (tn < T) {
#pragma unroll
            for (int i = 0; i < 8; ++i) { const size_t o = (size_t)tn * 512 + lane + 64 * i; xn[i] = X1B[o]; ya[i] = Y[o]; } } }
        ln_row2(v, g, bt);
        if (l == 1) {
#pragma unroll
            for (int i = 0; i < 8; ++i) ((f32x2*)(p.out + (size_t)t * 1024))[lane + 64 * i] = v[i];
        } else {
#pragma unroll
            for (int i = 0; i < 8; ++i) X1B[(size_t)t * 512 + lane + 64 * i] = pk_bf16(v[i][0], v[i][1]);
            f32x2 afv[4];
#pragma unroll
            for (int e = 0; e < 4; ++e) afv[e] = (f32x2){0.f, 0.f};
#pragma unroll
            for (int i = 0; i < 8; ++i)
#pragma unroll
                for (int c = 0; c < 2; ++c) { const float* wrow = wl + (c * 512 + 64 * i + lane) * 12; const f32x2 xx = {v[i][c], v[i][c]};
                    const f32x4 w0 = *(const f32x4*)wrow, w1 = *(const f32x4*)(wrow + 4);
                    afv[0] = __builtin_elementwise_fma(xx, (f32x2){w0[0], w0[1]}, afv[0]); afv[1] = __builtin_elementwise_fma(xx, (f32x2){w0[2], w0[3]}, afv[1]);
                    afv[2] = __builtin_elementwise_fma(xx, (f32x2){w1[0], w1[1]}, afv[2]); afv[3] = __builtin_elementwise_fma(xx, (f32x2){w1[2], w1[3]}, afv[3]); }
            float af[8];
#pragma unroll
            for (int e = 0; e < 4; ++e) { af[2 * e] = afv[e][0]; af[2 * e + 1] = afv[e][1]; }
            const float r = tred<8>(af, lane);
            if ((lane & 7) == 0) LOGF[(size_t)t * 8 + fsel] = logsigmoid_f(r + fb);
        }
    }
}

#ifndef USE_MF
#define USE_MF 1
#endif
#ifndef USE_ATT
#define USE_ATT 3
#endif
#ifndef USE_THIN
#define USE_THIN 1
#endif
#ifndef USE_SSD
#define USE_SSD 1
#endif
#ifndef REP_MASK
#define REP_MASK 0
#endif
#ifndef REP_SSD
#define REP_SSD 0
#endif
#ifndef REP_SB
#define REP_SB 0
#endif
constexpr int LDS_BYTES = LDS_STAGE + LDS_TAB_BYTES;
constexpr int NPH = 17;
template <int PH> __device__ __forceinline__ void run_phase(const P& p, unsigned char* smem, int bid, int nblk, int tid_) {
    float* lds = (float*)smem;
    if constexpr (PH == 0) { if (USE_THIN) ph_prologue2(p, smem, bid, nblk, tid_); else ph_prologue(p, bid, nblk, tid_); }
    if constexpr (PH == 1) { if (USE_MF) ph_inproj0_mf(p, smem, bid, nblk, tid_); else ph_inproj0(p, lds, bid, nblk, tid_); }
    if constexpr (PH == 2) { if (USE_SSD) ph_conv2(p, smem, bid, nblk, tid_); else ph_conv(p, bid, nblk, tid_); }
    if constexpr (PH == 3) { if (USE_SSD) ph_ssd_mf(p, smem, bid, nblk, tid_); else ph_ssd_naive(p, lds, bid, nblk, tid_); if (REP_SSD) ph_ssd_mf(p, smem, bid, nblk, tid_);
        if (USE_ATT & 1) ph_sb_mf(p, smem, bid, nblk, tid_); else ph_sb_naive(p, bid, nblk, tid_);
        if (REP_SB) ph_sb_mf(p, smem, bid, nblk, tid_); }
    if constexpr (PH == 4) { if (USE_MF) ph_outproj0_mf(p, smem, bid, nblk, tid_); else ph_outproj0(p, lds, bid, nblk, tid_); }
    if constexpr (PH == 5) { if (USE_THIN) ph_ln1_router2(p, 0, smem, bid, nblk, tid_); else ph_ln1_router(p, 0, bid, nblk, tid_); }
    if constexpr (PH == 6) { ph_moe1_mf(p, 0, smem, bid, nblk, tid_); __syncthreads(); ph_moe2_mf(p, 0, smem, bid, nblk, tid_); }
    if constexpr (PH == 8) { if (USE_THIN) ph_ln2_2(p, 0, smem, bid, nblk, tid_); else ph_ln2(p, 0, bid, nblk, tid_); }
    if constexpr (PH == 9) { if (USE_MF) ph_inproj1_mf(p, smem, bid, nblk, tid_); else ph_inproj1(p, lds, bid, nblk, tid_); }
    if constexpr (PH == 10) { if (USE_MF) ph_upproj_mf(p, smem, bid, nblk, tid_); else ph_upproj(p, lds, bid, nblk, tid_); }
    if constexpr (PH == 11) { if (USE_ATT & 2) ph_attn1_mf(p, smem, bid, nblk, tid_); else ph_attn1_naive(p, bid, nblk, tid_); }
    if constexpr (PH == 12) { if (USE_MF) ph_outproj1_mf(p, smem, bid, nblk, tid_); else ph_outproj1(p, lds, bid, nblk, tid_); }
    if constexpr (PH == 13) { if (USE_THIN) ph_ln1_router2(p, 1, smem, bid, nblk, tid_); else ph_ln1_router(p, 1, bid, nblk, tid_); }
    if constexpr (PH == 14) { ph_moe1_mf(p, 1, smem, bid, nblk, tid_); __syncthreads(); ph_moe2_mf(p, 1, smem, bid, nblk, tid_); }
    if constexpr (PH == 16) { if (USE_THIN) ph_ln2_2(p, 1, smem, bid, nblk, tid_); else ph_ln2(p, 1, bid, nblk, tid_); }
}

__device__ __forceinline__ void load_kargs(P& pl) {
#if defined(__HIP_DEVICE_COMPILE__)
    typedef __attribute__((address_space(4))) const P* kargp_t;
    kargp_t kp = (kargp_t)__builtin_amdgcn_kernarg_segment_ptr(); asm volatile("" : "+s"(kp));
    pl.x = kp->x; pl.ev_w_in = kp->ev_w_in; pl.ev_conv_w = kp->ev_conv_w; pl.ev_conv_b = kp->ev_conv_b; pl.ev_dt_bias = kp->ev_dt_bias; pl.ev_a_log = kp->ev_a_log; pl.ev_d_skip = kp->ev_d_skip; pl.ev_norm_g = kp->ev_norm_g; pl.ev_w_out = kp->ev_w_out; pl.od_w_in = kp->od_w_in; pl.od_q_norm_g = kp->od_q_norm_g; pl.od_w_q_up = kp->od_w_q_up; pl.od_kv_norm_g = kp->od_kv_norm_g; pl.od_w_kv_up = kp->od_w_kv_up; pl.od_f_bias = kp->od_f_bias; pl.od_w_out = kp->od_w_out; pl.ln1_g = kp->ln1_g; pl.ln1_b = kp->ln1_b; pl.ln2_g = kp->ln2_g; pl.ln2_b = kp->ln2_b; pl.moe_w_group = kp->moe_w_group; pl.moe_b_group = kp->moe_b_group; pl.moe_w_expert = kp->moe_w_expert; pl.moe_b_expert = kp->moe_b_expert; pl.moe_w_gate = kp->moe_w_gate; pl.moe_w_up = kp->moe_w_up; pl.moe_w_down = kp->moe_w_down; pl.out = kp->out; pl.ws = kp->ws;
#else
    (void)pl;
#endif
}
#if MK_MULTI
template <int PH> __global__ void __launch_bounds__(NTHR, 2) k_phase(P p) {
    extern __shared__ __attribute__((aligned(16))) unsigned char smem[];
    run_phase<PH>(p, smem, blockIdx.x, gridDim.x, threadIdx.x);
}
template <int PH> static void launch_phases(const P& p, int grid, hipStream_t stream) {
    if constexpr (PH < NPH) {
        (void)hipFuncSetAttribute((const void*)k_phase<PH>, hipFuncAttributeMaxDynamicSharedMemorySize, LDS_BYTES);
        hipLaunchKernelGGL(k_phase<PH>, dim3(grid), dim3(NTHR), LDS_BYTES, stream, p);
        launch_phases<PH + 1>(p, grid, stream);
    }
}
#else
template <int PH> __device__ __forceinline__ void run_all(unsigned char* smem, const XcdBarrier& bar, int wave_s) {
    if constexpr (PH < NPH) {
        asm volatile("; PHASE_MARK %0" :: "n"(PH));
#define RUN_ONE_PHASE() do { int bid_ = blockIdx.x, nblk_ = gridDim.x, w_ = wave_s; asm volatile("" : "+s"(bid_), "+s"(nblk_), "+s"(w_)); \
        int tid_ = (w_ << 6) | lane_id(); asm volatile("" : "+v"(tid_)); P pl; load_kargs(pl); run_phase<PH>(pl, smem, bid_, nblk_, tid_); } while (0)
        RUN_ONE_PHASE();
        if constexpr ((REP_MASK >> PH) & 1) { xcd_barrier(bar); RUN_ONE_PHASE(); }
#undef RUN_ONE_PHASE
        if constexpr (PH < NPH - 1 && PH != 7 && PH != 15) xcd_barrier(bar);
        run_all<PH + 1>(smem, bar, wave_s);
    }
}
__global__ void __launch_bounds__(NTHR, 2) k_all(P p) {
    extern __shared__ __attribute__((aligned(16))) unsigned char smem[];
    volatile LAS unsigned* st = (volatile LAS unsigned*)(smem + LDS_BYTES);
    if (threadIdx.x == 0) { st[0] = 0u; st[1] = 0u; st[2] = 0u; st[3] = 0u; }
    __syncthreads();
    XcdBarrier bar = xcd_barrier_post((unsigned*)(p.ws + OFF_BAR), st);
    const int wave_s = __builtin_amdgcn_readfirstlane(threadIdx.x >> 6);
    run_all<0>(smem, bar, wave_s);
}
#endif

extern "C" void kernel_launch(void* const* d_in, const int* in_sizes, int n_in, void* d_out, int out_size, void* d_ws, size_t ws_size, hipStream_t stream) {
    (void)in_sizes; (void)n_in; (void)out_size;
    if (ws_size < WS_NEED) { fprintf(stderr, "workspace too small: %zu < %zu\n", ws_size, WS_NEED); return; }
    P p{};
    const float** f = (const float**)&p;
    for (int i = 0; i < 27; ++i) f[i] = (const float*)d_in[i];
    p.out = (float*)d_out; p.ws = (unsigned char*)d_ws;
    (void)hipMemsetAsync(d_ws, 0, OFF_CTRL + CTRL_BYTES, stream);
#if MK_MULTI
    launch_phases<0>(p, 256, stream);
#else
    static int grid = 0;
    if (!grid) {
        int dev = 0, cus = 0, per_cu = 0;
        hipGetDevice(&dev);
        hipDeviceGetAttribute(&cus, hipDeviceAttributeMultiprocessorCount, dev);
        (void)hipFuncSetAttribute((const void*)k_all, hipFuncAttributeMaxDynamicSharedMemorySize, LDS_BYTES + 16);
        (void)hipOccupancyMaxActiveBlocksPerMultiprocessor(&per_cu, k_all, NTHR, LDS_BYTES + 16);
        grid = cus * (per_cu < 1 ? per_cu : 1);
        if (grid <= 0) grid = cus;
    }
    hipLaunchKernelGGL(k_all, dim3(grid), dim3(NTHR), LDS_BYTES + 16, stream, p);
#endif
}
```

```cpp
#include <hip/hip_runtime.h>
#include <stdint.h>
#include <stdio.h>

#ifndef MK_MULTI
#define MK_MULTI 0
#endif

#ifndef USE_SSD
#define USE_SSD 1
#endif
typedef unsigned short bf16_t;
typedef float f32x4 __attribute__((ext_vector_type(4)));
typedef float f32x2 __attribute__((ext_vector_type(2)));
typedef unsigned u32x4 __attribute__((ext_vector_type(4)));
typedef unsigned u32x2 __attribute__((ext_vector_type(2)));

constexpr int NB = 16, S = 2048, T = NB * S, D = 1024;
constexpr int EVEN_IN = 4112, ODD_IN = 1960;
constexpr float ALPHA = 1.4142135623730951f;
constexpr float LOG2E = 1.4426950408889634f;
constexpr float C2_64 = 0.125f * LOG2E;
constexpr float C2_96 = 0.10206207261596577f * LOG2E;
constexpr int NTHR = 512;

constexpr size_t MiB = 1024 * 1024;
constexpr size_t OFF_BAR = 0;
constexpr size_t OFF_CTRL = 16 * 1024;
constexpr size_t CTRL_BYTES = 16 * 1024;
constexpr size_t OFF_TAB = 64 * 1024;
constexpr size_t OFF_DT = 1 * MiB;
constexpr size_t OFF_SSQ = 3 * MiB;
constexpr size_t OFF_ROUTE = 5 * MiB;
constexpr size_t OFF_W = 8 * MiB;
constexpr size_t W0M = OFF_W;
constexpr size_t W0V = W0M + (size_t)3584 * 1024 * 2;
constexpr size_t W0O = W0V + (size_t)512 * 1024 * 2;
constexpr size_t W1M = W0O + (size_t)1024 * 1536 * 2;
constexpr size_t W1V = W1M + (size_t)1536 * 1024 * 2;
constexpr size_t W1Q = W1V + (size_t)512 * 1024 * 2;
constexpr size_t W1K = W1Q + (size_t)768 * 256 * 2;
constexpr size_t W1VV = W1K + (size_t)512 * 128 * 2;
constexpr size_t W1O = W1VV + (size_t)512 * 128 * 2;
constexpr size_t WGU = W1O + (size_t)1024 * 1024 * 2;
constexpr size_t WDN = WGU + (size_t)2 * 16 * 512 * 1024 * 2;
constexpr size_t W_END = WDN + (size_t)2 * 16 * 1024 * 256 * 2;
static_assert(W_END <= 76 * MiB, "weights region");
constexpr size_t R_XBZ = 76 * MiB;
constexpr size_t R_XQ = 204 * MiB;
constexpr size_t R_A2 = 396 * MiB;
constexpr size_t WS_NEED = 512 * MiB;

struct P {
    const float* x; const float* ev_w_in; const float* ev_conv_w; const float* ev_conv_b; const float* ev_dt_bias; const float* ev_a_log;
    const float* ev_d_skip; const float* ev_norm_g; const float* ev_w_out; const float* od_w_in; const float* od_q_norm_g; const float* od_w_q_up;
    const float* od_kv_norm_g; const float* od_w_kv_up; const float* od_f_bias; const float* od_w_out; const float* ln1_g; const float* ln1_b;
    const float* ln2_g; const float* ln2_b; const float* moe_w_group; const float* moe_b_group; const float* moe_w_expert; const float* moe_b_expert;
    const float* moe_w_gate; const float* moe_w_up; const float* moe_w_down;
    float* out; unsigned char* ws;
};

__device__ __forceinline__ float bf2f(bf16_t v) { return __uint_as_float(((unsigned)v) << 16); }
__device__ __forceinline__ unsigned pk_bf16(float lo, float hi) {
    typedef __bf16 b2 __attribute__((ext_vector_type(2)));
    f32x2 v = {lo, hi}; b2 b = __builtin_convertvector(v, b2); return __builtin_bit_cast(unsigned, b);
}
__device__ __forceinline__ bf16_t f2bf(float f) { return (bf16_t)(pk_bf16(f, 0.f) & 0xffffu); }
__device__ __forceinline__ float bflo(unsigned w) { return __uint_as_float(w << 16); }
__device__ __forceinline__ float bfhi(unsigned w) { return __uint_as_float(w & 0xffff0000u); }
__device__ __forceinline__ float silu_f(float x) { return x * __builtin_amdgcn_rcpf(1.0f + __builtin_amdgcn_exp2f(-1.4426950408889634f * x)); }
__device__ __forceinline__ float softplus_f(float x) { return x > 20.f ? x : log1pf(expf(x)); }
__device__ __forceinline__ float logsigmoid_f(float x) { return fminf(x, 0.f) - log1pf(expf(-fabsf(x))); }
template <int CTRL> __device__ __forceinline__ float dpp_f(float x) { return __int_as_float(__builtin_amdgcn_update_dpp(0, __float_as_int(x), CTRL, 0xF, 0xF, true)); }
template <int G> __device__ __forceinline__ float group_sum(float r) {
    if constexpr (G >= 16) r += dpp_f<0x140>(r);
    if constexpr (G >= 8) r += dpp_f<0x141>(r);
    r += dpp_f<0x4E>(r);
    r += dpp_f<0xB1>(r);
    return r;
}
__device__ __forceinline__ float other16(float x, bool odd) { auto rr = __builtin_amdgcn_permlane16_swap(__float_as_uint(x), __float_as_uint(x), false, false); return __uint_as_float(odd ? rr[0] : rr[1]); }
__device__ __forceinline__ float other32(float x, bool hi) { auto rr = __builtin_amdgcn_permlane32_swap(__float_as_uint(x), __float_as_uint(x), false, false); return __uint_as_float(hi ? rr[0] : rr[1]); }
__device__ __forceinline__ float wave_sum(float v) {
    v = group_sum<16>(v);
    { auto rr = __builtin_amdgcn_permlane16_swap(__float_as_uint(v), __float_as_uint(v), false, false); v = __uint_as_float(rr[0]) + __uint_as_float(rr[1]); }
    { auto rr = __builtin_amdgcn_permlane32_swap(__float_as_uint(v), __float_as_uint(v), false, false); v = __uint_as_float(rr[0]) + __uint_as_float(rr[1]); }
    return v;
}
__device__ __forceinline__ int lane_id() { unsigned z = 0u; asm volatile("" : "+v"(z)); return (int)__builtin_amdgcn_mbcnt_hi(~0u, __builtin_amdgcn_mbcnt_lo(~0u, z)); }
#define LDS_BARRIER() do { asm volatile("s_waitcnt lgkmcnt(0)" ::: "memory"); __builtin_amdgcn_s_barrier(); asm volatile("" ::: "memory"); } while (0)
template <class T_> __device__ __forceinline__ T_* wsp(const P& p, size_t off) { return (T_*)(p.ws + off); }

#define XB_TMO      128
#define XB_XCNT(j)  (256  + 64 * (j))
#define XB_XSUB(j)  (1280 + 64 * (j))
#define XB_XGEN(j)  (2304 + 64 * (j))
#define XB_TOP      3328
#define XB_TOPGEN   3392
#define XCD_BAR_WORDS 3456
#define XB_SPIN_CAP (1u << 18)
#define LAS __attribute__((address_space(3)))

__device__ __forceinline__ unsigned xb_ld(unsigned* p)              { return __hip_atomic_load(p, __ATOMIC_RELAXED, __HIP_MEMORY_SCOPE_AGENT); }
__device__ __forceinline__ unsigned xb_add(unsigned* p, unsigned v) { return __hip_atomic_fetch_add(p, v, __ATOMIC_RELAXED, __HIP_MEMORY_SCOPE_AGENT); }
__device__ __forceinline__ unsigned xb_xcc_id() { return (unsigned)__builtin_amdgcn_s_getreg((3 << 11) | 20) & 0xFu; }
#define XB_SPIN(cond, bar) do { unsigned _sp = 0; while (cond) { __builtin_amdgcn_s_sleep(1); \
    if ((++_sp & 255u) == 0u) { if (xb_ld(&(bar)[XB_TMO])) break; if (_sp > XB_SPIN_CAP) { atomicAdd(&(bar)[XB_TMO], 1u); break; } } } } while (0)

struct XcdBarrier { unsigned* bar; unsigned x; volatile LAS unsigned* st; };

__device__ __forceinline__ XcdBarrier xcd_barrier_post(unsigned* bar, volatile LAS unsigned* st) {
    XcdBarrier b; b.bar = bar; b.x = xb_xcc_id(); b.st = st;
    if (threadIdx.x == 0) (void)xb_add(&bar[XB_XCNT(b.x)], 1u);
    return b;
}
__device__ __forceinline__ void xcd_barrier_complete(unsigned* bar, unsigned x, unsigned& nloc, unsigned& nx) {
    const unsigned G = gridDim.x * gridDim.y * gridDim.z;
    unsigned sum, cnt, mine, sp = 0u;
    for (;;) {
        sum = 0u; cnt = 0u; mine = 0u;
#pragma unroll
        for (unsigned j = 0; j < 16; ++j) { const unsigned c = xb_ld(&bar[XB_XCNT(j)]); sum += c; cnt += (c > 0u) ? 1u : 0u; mine = (j == x) ? c : mine; }
        if (sum == G) break;
        __builtin_amdgcn_s_sleep(1);
        if ((++sp & 255u) == 0u) { if (xb_ld(&bar[XB_TMO])) break; if (sp > XB_SPIN_CAP) { atomicAdd(&bar[XB_TMO], 1u); break; } }
    }
    nloc = mine > 0u ? mine : 1u; nx = cnt > 0u ? cnt : 1u;
}
__device__ __forceinline__ void xcd_barrier(const XcdBarrier& b) {
    asm volatile("s_waitcnt vmcnt(0)" ::: "memory");
    __syncthreads();
    if (threadIdx.x == 0) {
        unsigned* bar = b.bar;
        __builtin_amdgcn_s_waitcnt(0);
        unsigned nloc = b.st[0], nx = b.st[1];
        if (nloc == 0u) { xcd_barrier_complete(bar, b.x, nloc, nx); b.st[0] = nloc; b.st[1] = nx; }
        const unsigned old = xb_add(&bar[XB_XSUB(b.x)], 1u);
        const unsigned gen = old / nloc;
        if (old + 1u == (gen + 1u) * nloc) {
            __builtin_amdgcn_fence(__ATOMIC_RELEASE, "agent");
            asm volatile("s_waitcnt vmcnt(0)" ::: "memory");
            const unsigned og = xb_add(&bar[XB_TOP], 1u);
            const unsigned tg = og / nx;
            if (og + 1u == (tg + 1u) * nx) xb_add(&bar[XB_TOPGEN], 1u);
            else XB_SPIN(xb_ld(&bar[XB_TOPGEN]) == tg, bar);
            __builtin_amdgcn_fence(__ATOMIC_ACQUIRE, "agent");
            xb_add(&bar[XB_XGEN(b.x)], 1u);
            asm volatile("s_waitcnt vmcnt(0)" ::: "memory");
        } else {
            XB_SPIN(xb_ld(&bar[XB_XGEN(b.x)]) == gen, bar);
            __builtin_amdgcn_fence(__ATOMIC_ACQUIRE, "agent");
            asm volatile("s_waitcnt vmcnt(0)" ::: "memory");
        }
    }
    __syncthreads();
}

struct NoMid { static constexpr int ksplit = -1; __device__ __forceinline__ float scale(int) const { return 1.f; } };
template <bool DUAL, class Epi, class Mid> __attribute__((always_inline))
__device__ void gemm_naive(const bf16_t* __restrict__ A, int lda, const int* __restrict__ gidx, const bf16_t* __restrict__ Bt, int ldb,
                           int M, int N, int K, const Epi& epi, const Mid& mid, float* lds, int bid, int nblk, int tid_) {
    float* As = lds;
    float* Bs = lds + 32 * 132;
    float* Bs2 = Bs + 32 * 68;
    const int tid = tid_, ty = tid >> 4, tx = tid & 15;
    const int ntn = N / 64, ntiles = (M / 128) * ntn;
    for (int tile = bid; tile < ntiles; tile += nblk) {
        const int tm = tile / ntn, tn = tile % ntn;
        float acc[4][4], acc2[4][4];
#pragma unroll
        for (int i = 0; i < 4; ++i)
#pragma unroll
            for (int j = 0; j < 4; ++j) { acc[i][j] = 0.f; acc2[i][j] = 0.f; }
        const int lrow = tid >> 2, kc = (tid & 3) * 8;
        long arow = tm * 128 + lrow;
        if (gidx) { const int e = gidx[arow]; arow = e < 0 ? -1 : (e >> 1); }
        int brow = tn * 64 + (lrow & 63);
        if (DUAL) brow = (tn >> 1) * 256 + (tn & 1) * 64 + (lrow & 63);
        for (int k0 = 0; k0 < K; k0 += 32) {
            if (k0 == Mid::ksplit) {
#pragma unroll
                for (int i = 0; i < 4; ++i) { const float s = mid.scale(tm * 128 + ty * 4 + i);
#pragma unroll
                    for (int j = 0; j < 4; ++j) acc[i][j] *= s; }
            }
            u32x4 va = {0u, 0u, 0u, 0u};
            if (arow >= 0) va = *(const u32x4*)(A + (size_t)arow * lda + k0 + kc);
#pragma unroll
            for (int j = 0; j < 4; ++j) { As[(kc + 2 * j) * 132 + lrow] = bflo(va[j]); As[(kc + 2 * j + 1) * 132 + lrow] = bfhi(va[j]); }
            if (tid < 256) {
                const u32x4 vb = *(const u32x4*)(Bt + (size_t)brow * ldb + k0 + kc);
#pragma unroll
                for (int j = 0; j < 4; ++j) { Bs[(kc + 2 * j) * 68 + lrow] = bflo(vb[j]); Bs[(kc + 2 * j + 1) * 68 + lrow] = bfhi(vb[j]); }
            } else if (DUAL) {
                const u32x4 vb = *(const u32x4*)(Bt + (size_t)(brow + 128) * ldb + k0 + kc);
#pragma unroll
                for (int j = 0; j < 4; ++j) { Bs2[(kc + 2 * j) * 68 + (lrow & 63)] = bflo(vb[j]); Bs2[(kc + 2 * j + 1) * 68 + (lrow & 63)] = bfhi(vb[j]); }
            }
            __syncthreads();
#pragma unroll 8
            for (int k = 0; k < 32; ++k) {
                const f32x4 a = *(const f32x4*)(As + k * 132 + ty * 4);
                const f32x4 b = *(const f32x4*)(Bs + k * 68 + tx * 4);
#pragma unroll
                for (int i = 0; i < 4; ++i)
#pragma unroll
                    for (int j = 0; j < 4; ++j) acc[i][j] += a[i] * b[j];
                if (DUAL) {
                    const f32x4 b2 = *(const f32x4*)(Bs2 + k * 68 + tx * 4);
#pragma unroll
                    for (int i = 0; i < 4; ++i)
#pragma unroll
                        for (int j = 0; j < 4; ++j) acc2[i][j] += a[i] * b2[j];
                }
            }
            __syncthreads();
        }
#pragma unroll
        for (int i = 0; i < 4; ++i) {
            f32x4 v = {acc[i][0], acc[i][1], acc[i][2], acc[i][3]};
            if (DUAL) {
#pragma unroll
                for (int j = 0; j < 4; ++j) v[j] = silu_f(acc[i][j]) * acc2[i][j];
            }
            epi(tm * 128 + ty * 4 + i, tn * 64 + tx * 4, v);
        }
    }
}

__device__ __forceinline__ void st_bf16x4(bf16_t* p, f32x4 v) { u32x2 w; w.x = pk_bf16(v[0], v[1]); w.y = pk_bf16(v[2], v[3]); *(u32x2*)p = w; }

namespace pg8 {
#define PG8_LAS __attribute__((address_space(3)))
typedef short bf16x8 __attribute__((ext_vector_type(8)));
constexpr int BM = 256, BK = 64, HALF = 128, HTB = HALF * BK * 2, STAGE_BYTES = 8 * HTB, NXCD = 8, WGM = 4;
__host__ __device__ __forceinline__ int lds_byte(int r, int c) { const int st = (r >> 4) * 2 + (c >> 5), rr = r & 15, cc = c & 31, ob = rr * 64 + cc * 2; return st * 1024 + (ob ^ (((ob >> 9) & 1) << 5)); }
__host__ __device__ __forceinline__ void stage_rc(int b, int& R, int& C) { const int st = b / 1024, sb = b % 1024, swz = sb ^ (((sb >> 9) & 1) << 5); R = (st >> 1) * 16 + swz / 64; C = (st & 1) * 32 + (swz % 64) / 2; }

struct Unit { int pm, pn, e, g0; size_t aoff, boff, boff2; };
struct Gemm { const bf16_t* A; const bf16_t* Bt; int lda, ldb, K; const PG8_LAS int* gl; };

struct DenseOrder {
    static constexpr bool HOOK = false; static constexpr int BSEAM = 0;
    int nM, nN, nwg, G, c, lda, ldb;
    __device__ __forceinline__ void init(int M, int N, int lda_, int ldb_, int G_, int c_) { nM = M / BM; nN = N / BM; nwg = nM * nN; G = G_; c = c_; lda = lda_; ldb = ldb_; }
    __device__ __forceinline__ bool next(int i, Unit& u) const { return at((long)i * G + c, u); }
    __device__ __forceinline__ bool at(long L, Unit& u) const {
        if (L >= nwg) return false;
        int wgid = (int)L; { const int q = nwg / NXCD, r = nwg % NXCD, xcd = wgid % NXCD, off = wgid / NXCD; wgid = (xcd < r ? xcd * (q + 1) : r * (q + 1) + (xcd - r) * q) + off; }
        const int nig = WGM * nN, gid = wgid / nig, fm = gid * WGM, gsz = (nM - fm) < WGM ? (nM - fm) : WGM;
        u.pm = fm + ((wgid % nig) % gsz); u.pn = (wgid % nig) / gsz; u.e = 0; u.g0 = 0;
        u.aoff = (size_t)u.pm * BM * lda * 2; u.boff = (size_t)u.pn * BM * ldb * 2; u.boff2 = u.boff; return true;
    }
};
struct DualOrder {
    static constexpr bool HOOK = false; static constexpr int BSEAM = 0;
    DenseOrder s1, s2; long a2off, b2off;
    __device__ __forceinline__ bool next(int i, Unit& u) const {
        const long L = (long)i * s1.G + s1.c;
        if (L < s1.nwg) return s1.at(L, u);
        if (!s2.at(L - s1.nwg, u)) return false;
        u.e = 1; u.aoff = (size_t)((long)u.aoff + a2off); u.boff = (size_t)((long)u.boff + b2off); u.boff2 = u.boff; return true; }
};
struct NoMidK { static constexpr int ktile = -1; __device__ __forceinline__ void apply(f32x4 (&)[2][2][4][2], int, int, int) const {} };

__host__ __device__ __forceinline__ int perm32(int rho) { const int n = rho >> 4, i = rho & 15; return 8 * (i >> 2) + 4 * n + (i & 3); }
template <class Epi, class Sched, class MidK, bool GATHER, int PERM = 0>
__device__ __forceinline__ void gemm_phase(PG8_LAS unsigned char* lds, const Gemm g, const Sched& S, const Epi& E, const MidK& mid, int tid_) {
    int tid = tid_; asm volatile("" : "+v"(tid));
    const int wid = __builtin_amdgcn_readfirstlane(tid >> 6), lane = tid & 63, wr = wid >> 2, wc = wid & 3, fr = lane & 15, fq = lane >> 4;
    const int K = g.K, nt = K / BK;
    int R_[2], C_[2];
#pragma unroll
    for (int i = 0; i < 2; ++i) stage_rc(tid * 16 + i * 8192, R_[i], C_[i]);
    unsigned vB[2], vAd[2], vAc[2][2], vAn[2][2];
#pragma unroll
    for (int i = 0; i < 2; ++i) { const int Rb = PERM == 2 ? (2 * (R_[i] & ~31) + perm32(R_[i] & 31)) : PERM == 1 ? ((R_[i] & ~31) + perm32(R_[i] & 31)) : R_[i]; vB[i] = (unsigned)(Rb * g.ldb + C_[i]) * 2u; vAd[i] = (unsigned)(R_[i] * g.lda + C_[i]) * 2u; }
#pragma unroll
    for (int h = 0; h < 2; ++h)
#pragma unroll
        for (int i = 0; i < 2; ++i) { vAc[h][i] = 0u; vAn[h][i] = 0u; }
    const size_t hstepA = GATHER ? (size_t)0 : (size_t)HALF * g.lda * 2, hstepB = (size_t)(PERM == 2 ? 32 : HALF) * g.ldb * 2;
#define PG8_GATHER_SET(v, ui_) do { if constexpr (GATHER) { _Pragma("unroll") for (int h_ = 0; h_ < 2; ++h_) _Pragma("unroll") for (int i_ = 0; i_ < 2; ++i_) \
        v[h_][i_] = (unsigned)(g.gl[(ui_) * 256 + h_ * HALF + R_[i_]] * g.lda + C_[i_]) * 2u; } } while (0)
    const size_t kstep = (size_t)(BK * 2);
    const unsigned ldsw = (unsigned)wid * 1024u;
    const int aoff = lds_byte(wr * 64 + fr, fq * 8), boff = lds_byte(wc * 32 + fr, fq * 8);
#define PG8_SA(b, h) (((b) * 2 + (h)) * HTB)
#define PG8_SB(b, h) ((4 + (b) * 2 + (h)) * HTB)
#define PG8_STAGE(bufoff, gbase, voff) do { _Pragma("unroll") for (int _i = 0; _i < 2; ++_i) \
        __builtin_amdgcn_global_load_lds((const unsigned*)((const char*)(gbase) + (voff)[_i]), (PG8_LAS unsigned*)(lds + (bufoff) + ldsw + _i * 8192), 16, 0, 0); } while (0)
#define PG8_STB(bufoff, gbase, h) PG8_STAGE(bufoff, (gbase) + (h) * hstepB, vB)
#define PG8_STA(bufoff, gbase, h, VG) do { if constexpr (GATHER) { PG8_STAGE(bufoff, gbase, VG[h]); } else { PG8_STAGE(bufoff, (gbase) + (h) * hstepA, vAd); } } while (0)
#define PG8_LDA(dst, b, h) do { _Pragma("unroll") for (int m = 0; m < 4; ++m) _Pragma("unroll") for (int k = 0; k < 2; ++k) dst[m][k] = *(const PG8_LAS bf16x8*)(lds + PG8_SA(b, h) + aoff + m * 2048 + k * 1024); } while (0)
#define PG8_LDB(dst, b, h) do { _Pragma("unroll") for (int n = 0; n < 2; ++n) _Pragma("unroll") for (int k = 0; k < 2; ++k) dst[n][k] = *(const PG8_LAS bf16x8*)(lds + PG8_SB(b, h) + boff + n * 2048 + k * 1024); } while (0)
#define PG8_MMA(ai, bj, At, Bt) do { __builtin_amdgcn_s_setprio(1); _Pragma("unroll") for (int m = 0; m < 4; ++m) _Pragma("unroll") for (int n = 0; n < 2; ++n) _Pragma("unroll") for (int k = 0; k < 2; ++k) \
        acc[ai][bj][m][n] = __builtin_amdgcn_mfma_f32_16x16x32_bf16(Bt[n][k], At[m][k], acc[ai][bj][m][n], 0, 0, 0); __builtin_amdgcn_s_setprio(0); } while (0)
#define PG8_WAIT_V(n) asm volatile("s_waitcnt vmcnt(" #n ")" ::: "memory")
#define PG8_WAIT_L(n) asm volatile("s_waitcnt lgkmcnt(" #n ")" ::: "memory")
#define PG8_BAR __builtin_amdgcn_s_barrier()
#define PG8_SCHED __builtin_amdgcn_sched_barrier(0)
    Unit cur, nxt; int ui = 0;
    if (!S.next(0, cur)) return;
    f32x4 acc[2][2][4][2];
#pragma unroll
    for (int a = 0; a < 2; ++a)
#pragma unroll
        for (int b = 0; b < 2; ++b)
#pragma unroll
            for (int m = 0; m < 4; ++m)
#pragma unroll
                for (int n = 0; n < 2; ++n) acc[a][b][m][n] = (f32x4){0.f, 0.f, 0.f, 0.f};
    bf16x8 At[4][2], B0[2][2], B1[2][2];
    const char* cA = (const char*)g.A + cur.aoff; const char* cB = (const char*)g.Bt + cur.boff; const char* cB2 = (const char*)g.Bt + cur.boff2;
    if constexpr (Sched::HOOK) S.a_ready(cur, wid);
    PG8_GATHER_SET(vAc, 0);
    if constexpr (GATHER) PG8_WAIT_L(0);
    PG8_STB(PG8_SB(0, 0), cB, 0); PG8_STB(PG8_SB(0, 1), cB, 1); PG8_STA(PG8_SA(0, 0), cA, 0, vAc); PG8_STA(PG8_SA(0, 1), cA, 1, vAc);
    if (wr == 1) PG8_BAR;
    PG8_WAIT_V(2); PG8_BAR;
    PG8_STB(PG8_SB(1, 0), cB + kstep, 0); PG8_STA(PG8_SA(1, 0), cA + kstep, 0, vAc); PG8_STB(PG8_SB(1, 1), cB + kstep, 1);
    PG8_WAIT_V(6); PG8_BAR;
    for (;;) {
        const bool has_next = S.next(ui + 1, nxt);
        const char* nA = has_next ? (const char*)g.A + nxt.aoff : cA; const char* nB = has_next ? (const char*)g.Bt + nxt.boff : cB; const char* nB2 = has_next ? (const char*)g.Bt + nxt.boff2 : cB2;
        if constexpr (GATHER) { if (has_next) { PG8_GATHER_SET(vAn, ui + 1); } else {
#pragma unroll
            for (int h = 0; h < 2; ++h)
#pragma unroll
                for (int i = 0; i < 2; ++i) vAn[h][i] = vAc[h][i]; } }
#pragma unroll 1
        for (int t = 0; t < nt; t += 2) {
            const bool last = (t == nt - 2);
            if constexpr (Sched::HOOK) { if (last && has_next) S.a_ready(nxt, wid); }
            if constexpr (MidK::ktile >= 0) { if (t == MidK::ktile) mid.apply(acc, ui, wr, fr); }
            const char* a1 = cA + (size_t)(t + 1) * kstep;
            const char* cBs = (Sched::BSEAM > 0 && t + 2 >= Sched::BSEAM) ? cB2 : cB;
            const char* a2 = last ? nA : cA + (size_t)(t + 2) * kstep; const char* b2 = last ? nB : cBs + (size_t)(t + 2) * kstep;
            const char* a3 = a2 + kstep; const char* b3 = b2 + kstep;
            unsigned vA2[2][2];
#pragma unroll
            for (int h = 0; h < 2; ++h)
#pragma unroll
                for (int i = 0; i < 2; ++i) vA2[h][i] = (GATHER && last) ? vAn[h][i] : vAc[h][i];
            PG8_LDB(B0, 0, 0); PG8_LDB(B1, 0, 1); PG8_SCHED; PG8_LDA(At, 0, 0); PG8_STA(PG8_SA(1, 1), a1, 1, vAc);
            PG8_WAIT_V(8); PG8_WAIT_L(0); PG8_BAR; PG8_MMA(0, 0, At, B0); PG8_MMA(0, 1, At, B1); PG8_BAR; PG8_SCHED;
            PG8_LDA(At, 0, 1); PG8_STB(PG8_SB(0, 0), b2, 0); PG8_STB(PG8_SB(0, 1), b2, 1); PG8_STA(PG8_SA(0, 0), a2, 0, vA2);
            PG8_WAIT_V(8); PG8_WAIT_L(0); PG8_BAR; PG8_MMA(1, 0, At, B0); PG8_MMA(1, 1, At, B1); PG8_BAR; PG8_SCHED;
            PG8_LDB(B0, 1, 0); PG8_LDB(B1, 1, 1); PG8_SCHED; PG8_LDA(At, 1, 0); PG8_STA(PG8_SA(0, 1), a2, 1, vA2);
            PG8_WAIT_V(8); PG8_WAIT_L(0); PG8_BAR; PG8_MMA(0, 0, At, B0); PG8_MMA(0, 1, At, B1); PG8_BAR; PG8_SCHED;
            PG8_LDA(At, 1, 1); PG8_STB(PG8_SB(1, 0), b3, 0); PG8_STB(PG8_SB(1, 1), b3, 1); PG8_STA(PG8_SA(1, 0), a3, 0, vA2);
            PG8_WAIT_V(8); PG8_WAIT_L(0); PG8_BAR; PG8_MMA(1, 0, At, B0); PG8_MMA(1, 1, At, B1); PG8_BAR; PG8_SCHED;
        }
        if (wr == 0) PG8_BAR;
        { int le = lane_id(); asm volatile("" : "+v"(le)); E(acc, cur, ui, wr, wc, le & 15, le >> 4); }
        if (!has_next) break;
#pragma unroll
        for (int a = 0; a < 2; ++a)
#pragma unroll
            for (int b = 0; b < 2; ++b)
#pragma unroll
                for (int m = 0; m < 4; ++m)
#pragma unroll
                    for (int n = 0; n < 2; ++n) acc[a][b][m][n] = (f32x4){0.f, 0.f, 0.f, 0.f};
        cur = nxt; cA = nA; cB = nB; cB2 = nB2; ++ui;
        if constexpr (GATHER) {
#pragma unroll
            for (int h = 0; h < 2; ++h)
#pragma unroll
                for (int i = 0; i < 2; ++i) vAc[h][i] = vAn[h][i]; }
        if (wr == 1) PG8_BAR;
    }
    PG8_WAIT_V(0);
    PG8_BAR;
#undef PG8_GATHER_SET
#undef PG8_SA
#undef PG8_SB
#undef PG8_STAGE
#undef PG8_STA
#undef PG8_STB
#undef PG8_LDA
#undef PG8_LDB
#undef PG8_MMA
#undef PG8_WAIT_V
#undef PG8_WAIT_L
#undef PG8_BAR
#undef PG8_SCHED
}
template <class F> __device__ __forceinline__ void epi_each(const f32x4 (&acc)[2][2][4][2], const Unit& u, int wr, int wc, int fr, int fq, const F& f) {
#pragma unroll
    for (int ai = 0; ai < 2; ++ai)
#pragma unroll
        for (int m = 0; m < 4; ++m) { const int row = u.pm * BM + ai * HALF + wr * 64 + m * 16 + fr;
#pragma unroll
            for (int bj = 0; bj < 2; ++bj)
#pragma unroll
                for (int n = 0; n < 2; ++n) f(row, u.pn * BM + bj * HALF + wc * 32 + n * 16 + fq * 4, acc[ai][bj][m][n]); }
}
template <class F> struct EpiWrap { F f; __device__ __forceinline__ void operator()(const f32x4 (&acc)[2][2][4][2], const Unit& u, int, int wr, int wc, int fr, int fq) const { epi_each(acc, u, wr, wc, fr, fq, f); } };
}

template <class F> __device__ __forceinline__ void conv_rows(bf16_t* dst, int nrows, int K, F f, size_t gtid, size_t gstride) {
    const size_t n_el = (size_t)nrows * K;
    for (size_t i = gtid; i < n_el; i += gstride) { const int n = (int)(i / K), k = (int)(i % K); dst[i] = f2bf(f(n, k)); }
}
__device__ __forceinline__ void ph_prologue(const P& p, int bid, int nblk, int tid_) {
    const size_t gtid = (size_t)bid * NTHR + tid_, gstride = (size_t)nblk * NTHR;
    { const f32x4* src = (const f32x4*)p.x; u32x2* dst = wsp<u32x2>(p, R_XBZ);
      for (size_t i = gtid; i < (size_t)T * D / 4; i += gstride) { const f32x4 v = src[i]; u32x2 o; o.x = pk_bf16(v[0], v[1]); o.y = pk_bf16(v[2], v[3]); dst[i] = o; } }
    { float* DT = wsp<float>(p, OFF_DT);
      for (size_t i = gtid; i < (size_t)T * 16; i += gstride) { const int t = (int)(i >> 4), h = (int)(i & 15); const float* xr = p.x + (size_t)t * D; const float* w = p.ev_w_in + 2560 + h;
        float a = 0.f; for (int k = 0; k < D; ++k) a += xr[k] * w[(size_t)k * EVEN_IN]; DT[i] = softplus_f(a + p.ev_dt_bias[h]); } }
    { const float* w = p.ev_w_in;
      conv_rows(wsp<bf16_t>(p, W0M), 3584, 1024, [=](int n, int k) { const int c = n < 2560 ? n : (n < 3072 ? 2576 + (n - 2560) : 3088 + (n - 3072)); return w[(size_t)k * EVEN_IN + c]; }, gtid, gstride);
      conv_rows(wsp<bf16_t>(p, W0V), 512, 1024, [=](int n, int k) { return w[(size_t)k * EVEN_IN + 3600 + n]; }, gtid, gstride); }
    { const float* w = p.ev_w_out; const float* g = p.ev_norm_g;
      conv_rows(wsp<bf16_t>(p, W0O), 1024, 1536, [=](int n, int k) { return w[(size_t)k * 1024 + n] * (k < 1024 ? g[k] : 1.f); }, gtid, gstride); }
    { const float* w = p.od_w_in;
      conv_rows(wsp<bf16_t>(p, W1M), 1536, 1024, [=](int n, int k) {
          int c;
          if (n < 384) c = n;
          else if (n < 416) { const int j = n - 384, i = j >> 1; c = 384 + ((j & 1) ? i + 16 : i); }
          else if (n < 512) return 0.f;
          else if (n < 1024) c = 416 + (n - 512);
          else c = 928 + (n - 1024);
          return w[(size_t)k * ODD_IN + c]; }, gtid, gstride);
      conv_rows(wsp<bf16_t>(p, W1V), 512, 1024, [=](int n, int k) { return w[(size_t)k * ODD_IN + 1440 + n]; }, gtid, gstride); }
    { const float* w = p.od_w_q_up; const float* g = p.od_q_norm_g;
      conv_rows(wsp<bf16_t>(p, W1Q), 768, 256, [=](int n, int k) { const int h = n / 96, j = n % 96; int c = n;
          if (j >= 64) { const int jj = j - 64, i = jj >> 1; c = 96 * h + 64 + ((jj & 1) ? i + 16 : i); }
          return w[(size_t)k * 768 + c] * g[k]; }, gtid, gstride); }
    { const float* w = p.od_w_kv_up; const float* g = p.od_kv_norm_g;
      conv_rows(wsp<bf16_t>(p, W1K), 512, 128, [=](int n, int k) { const int h = n >> 6, d = n & 63; return w[(size_t)k * 1024 + 128 * h + d] * g[k]; }, gtid, gstride);
      conv_rows(wsp<bf16_t>(p, W1VV), 512, 128, [=](int n, int k) { const int h = n >> 6, d = n & 63; return w[(size_t)k * 1024 + 128 * h + 64 + d] * g[k]; }, gtid, gstride); }
    { const float* w = p.od_w_out;
      conv_rows(wsp<bf16_t>(p, W1O), 1024, 1024, [=](int n, int k) { return w[(size_t)k * 1024 + n]; }, gtid, gstride); }
    { const float* wg = p.moe_w_gate; const float* wu = p.moe_w_up; const float* wd = p.moe_w_down;
      { bf16_t* dst = wsp<bf16_t>(p, WGU);
        for (size_t i = gtid; i < (size_t)32 * 256 * 1024; i += gstride) { const int k = (int)(i & 1023), n = (int)(i >> 10), le = n >> 8, c = n & 255, j = c >> 7, r = c & 127;
          const size_t row = (size_t)le * 512 + j * 256 + r, si = ((size_t)le * 1024 + k) * 256 + c;
          dst[row * 1024 + k] = f2bf(wg[si]); dst[(row + 128) * 1024 + k] = f2bf(wu[si]); } }
      conv_rows(wsp<bf16_t>(p, WDN), 32 * 1024, 256, [=](int n, int k) { const int le = n >> 10, c = n & 1023; return wd[((size_t)le * 256 + k) * 1024 + c]; }, gtid, gstride); }
    { float* tab = wsp<float>(p, OFF_TAB);
      for (size_t i = gtid; i < (size_t)S * 16; i += gstride) { const int s = (int)(i >> 4), f = (int)(i & 15);
        double inv = 1.0; for (int k = 0; k < f; ++k) inv *= 0.56234132519034908;
        const double rev = (double)s * inv * 0.15915494309189535; const double fr = rev - floor(rev);
        const double x = fr * 4.0; const double qd = floor(x + 0.5); const int qi = (int)qd & 3;
        const double y = (x - qd) * 1.5707963267948966, y2 = y * y;
        const double sy = y * (1.0 + y2 * (-1.0 / 6 + y2 * (1.0 / 120 + y2 * (-1.0 / 5040 + y2 * (1.0 / 362880 + y2 * (-1.0 / 39916800 + y2 * (1.0 / 6227020800.0)))))));
        const double cy = 1.0 + y2 * (-0.5 + y2 * (1.0 / 24 + y2 * (-1.0 / 720 + y2 * (1.0 / 40320 + y2 * (-1.0 / 3628800 + y2 * (1.0 / 479001600.0 + y2 * (-1.0 / 87178291200.0)))))));
        const double cv = (qi == 0) ? cy : (qi == 1) ? -sy : (qi == 2) ? -cy : sy;
        const double sv = (qi == 0) ? sy : (qi == 1) ? cy : (qi == 2) ? -sy : -cy;
        tab[i] = (float)cv; tab[S * 16 + i] = (float)sv; } }
}

struct EpiIn0 {
    bf16_t* Z; bf16_t* XBCR; bf16_t* Q; bf16_t* K;
    __device__ __forceinline__ void operator()(int row, int col, f32x4 v) const {
        if (col < 1024) st_bf16x4(Z + (size_t)row * 1024 + col, v);
        else if (col < 2560) st_bf16x4(XBCR + (size_t)row * 1536 + (col - 1024), v);
        else if (col < 3072) st_bf16x4(Q + (size_t)row * 512 + (col - 2560), v * C2_64);
        else st_bf16x4(K + (size_t)row * 512 + (col - 3072), v);
    }
};
struct EpiVt { bf16_t* Vt; __device__ __forceinline__ void operator()(int row, int col, f32x4 v) const { st_bf16x4(Vt + (size_t)row * T + col, v); } };

__device__ __forceinline__ void ph_inproj0(const P& p, float* lds, int bid, int nblk, int tid_) {
    const bf16_t* XB = wsp<bf16_t>(p, R_XBZ);
    EpiIn0 e{wsp<bf16_t>(p, R_XBZ + 64 * MiB), wsp<bf16_t>(p, R_A2), wsp<bf16_t>(p, R_XQ + 96 * MiB), wsp<bf16_t>(p, R_XQ + 128 * MiB)};
    gemm_naive<false>(XB, 1024, nullptr, wsp<bf16_t>(p, W0M), 1024, T, 3584, 1024, e, NoMid{}, lds, bid, nblk, tid_);
    EpiVt ev{wsp<bf16_t>(p, R_XQ + 160 * MiB)};
    gemm_naive<false>(wsp<bf16_t>(p, W0V), 1024, nullptr, XB, 1024, 512, T, 1024, ev, NoMid{}, lds, bid, nblk, tid_);
}
__device__ __forceinline__ void ph_conv(const P& p, int bid, int nblk, int tid_) {
    const bf16_t* XR = wsp<bf16_t>(p, R_A2); bf16_t* XC = wsp<bf16_t>(p, R_XQ);
    const size_t gtid = (size_t)bid * NTHR + tid_, gstride = (size_t)nblk * NTHR;
    for (size_t i = gtid; i < (size_t)T * 1536; i += gstride) {
        const int t = (int)(i / 1536), c = (int)(i % 1536), s = t & (S - 1);
        float a = p.ev_conv_b[c];
#pragma unroll
        for (int k = 0; k < 4; ++k) { const int ss = s - 3 + k; if (ss >= 0) a += p.ev_conv_w[k * 1536 + c] * bf2f(XR[(size_t)(t - 3 + k) * 1536 + c]); }
        XC[i] = f2bf(silu_f(a));
    }
}
__device__ __forceinline__ void ph_ssd_naive(const P& p, float* lds, int bid, int nblk, int tid_) {
    const bf16_t* XC = wsp<bf16_t>(p, R_XQ); const bf16_t* Z = wsp<bf16_t>(p, R_XBZ + 64 * MiB); const float* DT = wsp<float>(p, OFF_DT);
    bf16_t* A2 = wsp<bf16_t>(p, R_A2); float* SSQ = wsp<float>(p, OFF_SSQ);
    float* Bs = lds; float* Cs = Bs + 16 * 128; float* xs = Cs + 16 * 128; float* dts = xs + 16 * 64; float* yp = dts + 16;
    const int tid = tid_, pp = tid & 63, nq = tid >> 6, lane = tid & 63;
    for (int u = bid; u < NB * 16; u += nblk) {
        const int b = u >> 4, h = u & 15, g = h >> 3;
        const float a = -expf(p.ev_a_log[h]), dsk = p.ev_d_skip[h];
        float st[16];
#pragma unroll
        for (int n = 0; n < 16; ++n) st[n] = 0.f;
        for (int c0 = 0; c0 < S; c0 += 16) {
            const size_t r0 = (size_t)b * S + c0;
            for (int idx = tid; idx < 16 * 128; idx += NTHR) { const int i = idx >> 7, n = idx & 127; const bf16_t* r = XC + (r0 + i) * 1536;
                Bs[idx] = bf2f(r[1024 + g * 128 + n]); Cs[idx] = bf2f(r[1280 + g * 128 + n]); }
            for (int idx = tid; idx < 16 * 64; idx += NTHR) { const int i = idx >> 6, q = idx & 63; xs[idx] = bf2f(XC[(r0 + i) * 1536 + h * 64 + q]); }
            if (tid < 16) dts[tid] = DT[(r0 + tid) * 16 + h];
            __syncthreads();
            for (int i = 0; i < 16; ++i) {
                const float dt = dts[i], dA = expf(dt * a), dtx = dt * xs[i * 64 + pp];
                float y = 0.f;
#pragma unroll
                for (int n = 0; n < 16; ++n) { st[n] = st[n] * dA + dtx * Bs[i * 128 + nq * 16 + n]; y += Cs[i * 128 + nq * 16 + n] * st[n]; }
                yp[(nq * 16 + i) * 64 + pp] = y;
            }
            __syncthreads();
            for (int idx = tid; idx < 16 * 64; idx += NTHR) {
                const int i = idx >> 6, q = idx & 63; float y = 0.f;
#pragma unroll
                for (int w = 0; w < 8; ++w) y += yp[(w * 16 + i) * 64 + q];
                y += dsk * xs[idx];
                const float z = bf2f(Z[(r0 + i) * 1024 + h * 64 + q]);
                const float uu = y * silu_f(z);
                A2[(r0 + i) * 1536 + h * 64 + q] = f2bf(uu);
                const float ss = wave_sum(uu * uu);
                if (lane == 0) SSQ[(r0 + i) * 16 + h] = ss;
            }
            __syncthreads();
        }
    }
}
__device__ __forceinline__ void ph_sb_naive(const P& p, int bid, int nblk, int tid_) {
    const bf16_t* Q = wsp<bf16_t>(p, R_XQ + 96 * MiB); const bf16_t* K = wsp<bf16_t>(p, R_XQ + 128 * MiB); const bf16_t* Vt = wsp<bf16_t>(p, R_XQ + 160 * MiB);
    bf16_t* A2 = wsp<bf16_t>(p, R_A2);
    const int lane = tid_ & 63, wid = tid_ >> 6;
    const int nunits = NB * 8 * (S / 64);
    for (int u = bid * 8 + wid; u < nunits; u += nblk * 8) {
        const int tb = (S / 64 - 1) - (u % (S / 64)), bh = u / (S / 64), b = bh >> 3, h = bh & 7;
        const int t0 = tb * 64, t = t0 + lane; const size_t row = (size_t)b * S + t;
        unsigned qp[32]; float o[64];
#pragma unroll
        for (int d = 0; d < 64; d += 8) { const u32x4 v = *(const u32x4*)(Q + row * 512 + h * 64 + d);
#pragma unroll
            for (int j = 0; j < 4; ++j) qp[d / 2 + j] = v[j]; }
#pragma unroll
        for (int d = 0; d < 64; ++d) o[d] = 0.f;
        float csum = 0.f;
        for (int s = t0 + 62; s >= 0; --s) {
            const bf16_t* kr = K + ((size_t)b * S + s) * 512 + h * 64;
            float z = 0.f;
#pragma unroll
            for (int d = 0; d < 64; d += 8) { const u32x4 v = *(const u32x4*)(kr + d);
#pragma unroll
                for (int j = 0; j < 4; ++j) { z += bflo(qp[d / 2 + j]) * bflo(v[j]); z += bfhi(qp[d / 2 + j]) * bfhi(v[j]); } }
            float w = 0.f;
            if (s < t) { const float l = fmaxf(z, 0.f) + log2f(1.f + exp2f(-fabsf(z))); csum += l; w = exp2f(z - csum); }
            const bf16_t* vc = Vt + (size_t)(h * 64) * T + (size_t)b * S + s;
#pragma unroll
            for (int d = 0; d < 64; ++d) o[d] += w * bf2f(vc[(size_t)d * T]);
        }
#pragma unroll
        for (int d = 0; d < 64; d += 4) st_bf16x4(A2 + row * 1536 + 1024 + h * 64 + d, (f32x4){o[d], o[d + 1], o[d + 2], o[d + 3]});
    }
}
struct MidRms0 { static constexpr int ksplit = 1024; const float* SSQ;
    __device__ __forceinline__ float scale(int row) const { float s = 0.f;
#pragma unroll
        for (int h = 0; h < 16; ++h) s += SSQ[(size_t)row * 16 + h];
        return rsqrtf(s * (1.0f / 1024.0f) + 1e-6f); } };
struct EpiRes { const float* X; float* PRE; __device__ __forceinline__ void operator()(int row, int col, f32x4 v) const {
        const f32x4 xr = *(const f32x4*)(X + (size_t)row * 1024 + col); *(f32x4*)(PRE + (size_t)row * 1024 + col) = xr * ALPHA + v; } };
struct EpiMixMf { bf16_t* MIX; __device__ __forceinline__ void operator()(const f32x4 (&acc)[2][2][4][2], const pg8::Unit& u, int, int wr, int wc, int fr, int fq) const; };
__device__ __forceinline__ void ph_outproj0(const P& p, float* lds, int bid, int nblk, int tid_) {
    MidRms0 mid{wsp<float>(p, OFF_SSQ)}; EpiRes e{p.x, wsp<float>(p, R_XBZ)};
    gemm_naive<false>(wsp<bf16_t>(p, R_A2), 1536, nullptr, wsp<bf16_t>(p, W0O), 1536, T, 1024, 1536, e, mid, lds, bid, nblk, tid_);
}

__device__ __forceinline__ void ln_row(f32x4 (&v)[4], const float* g, const float* bta, int lane) {
    float s = 0.f;
#pragma unroll
    for (int j = 0; j < 4; ++j) s += (v[j][0] + v[j][1]) + (v[j][2] + v[j][3]);
    const float mu = wave_sum(s) * (1.0f / 1024.0f);
    float q = 0.f;
#pragma unroll
    for (int j = 0; j < 4; ++j) { const f32x4 d = v[j] - mu; q += (d[0] * d[0] + d[1] * d[1]) + (d[2] * d[2] + d[3] * d[3]); }
    const float rstd = rsqrtf(wave_sum(q) * (1.0f / 1024.0f) + 1e-5f);
#pragma unroll
    for (int j = 0; j < 4; ++j) { const f32x4 gg = *(const f32x4*)(g + j * 256 + lane * 4), bb = *(const f32x4*)(bta + j * 256 + lane * 4); v[j] = (v[j] - mu) * rstd * gg + bb; }
}
__device__ __forceinline__ void ph_ln1_router(const P& p, int l, int bid, int nblk, int tid_) {
    const float* PRE = wsp<float>(p, R_XBZ); float* X1F = wsp<float>(p, R_XQ); bf16_t* X1B = wsp<bf16_t>(p, R_XQ + 128 * MiB);
    int* TOKE = wsp<int>(p, OFF_ROUTE); float* TOKW = wsp<float>(p, OFF_ROUTE + 256 * 1024); int* LIST = wsp<int>(p, OFF_ROUTE + 512 * 1024);
    unsigned* CNT = wsp<unsigned>(p, OFF_CTRL) + 64 * l;
    const float* g = p.ln1_g + l * 1024; const float* bta = p.ln1_b + l * 1024;
    const float* wgp = p.moe_w_group + (size_t)l * 1024 * 4; const float* wep = p.moe_w_expert + (size_t)l * 1024 * 16;
    const int lane = tid_ & 63, wid = tid_ >> 6;
    for (int t = bid * 8 + wid; t < T; t += nblk * 8) {
        f32x4 v[4];
#pragma unroll
        for (int j = 0; j < 4; ++j) v[j] = *(const f32x4*)(PRE + (size_t)t * 1024 + j * 256 + lane * 4);
        ln_row(v, g, bta, lane);
#pragma unroll
        for (int j = 0; j < 4; ++j) { *(f32x4*)(X1F + (size_t)t * 1024 + j * 256 + lane * 4) = v[j]; st_bf16x4(X1B + (size_t)t * 1024 + j * 256 + lane * 4, v[j]); }
        float lg[20];
#pragma unroll
        for (int e = 0; e < 20; ++e) lg[e] = 0.f;
#pragma unroll
        for (int j = 0; j < 4; ++j)
#pragma unroll
            for (int i = 0; i < 4; ++i) { const int k = j * 256 + lane * 4 + i; const float xv = v[j][i];
                const f32x4 wg4 = *(const f32x4*)(wgp + (size_t)k * 4);
#pragma unroll
                for (int e = 0; e < 4; ++e) lg[e] += xv * wg4[e];
#pragma unroll
                for (int e4 = 0; e4 < 4; ++e4) { const f32x4 we4 = *(const f32x4*)(wep + (size_t)k * 16 + e4 * 4);
#pragma unroll
                    for (int e = 0; e < 4; ++e) lg[4 + e4 * 4 + e] += xv * we4[e]; } }
#pragma unroll
        for (int e = 0; e < 20; ++e) lg[e] = wave_sum(lg[e]);
        if (lane == 0) {
            float gl[4]; float gm = -INFINITY; int gs = 0;
#pragma unroll
            for (int e = 0; e < 4; ++e) { gl[e] = lg[e] + p.moe_b_group[l * 4 + e]; if (gl[e] > gm) { gm = gl[e]; gs = e; } }
            float gsum = 0.f;
#pragma unroll
            for (int e = 0; e < 4; ++e) gsum += expf(gl[e] - gm);
            const float gp = 1.0f / gsum;
            float el[4]; float em = -INFINITY;
#pragma unroll
            for (int e = 0; e < 4; ++e) { float vv = 0.f;
#pragma unroll
                for (int gg = 0; gg < 4; ++gg) vv = (gg == gs) ? lg[4 + gg * 4 + e] : vv;
                el[e] = vv + p.moe_b_expert[l * 16 + gs * 4 + e]; em = fmaxf(em, el[e]); }
            int i0 = 0; float b0 = el[0];
#pragma unroll
            for (int e = 1; e < 4; ++e) if (el[e] > b0) { b0 = el[e]; i0 = e; }
            int i1 = 0; float b1 = -INFINITY;
#pragma unroll
            for (int e = 0; e < 4; ++e) if (e != i0 && el[e] > b1) { b1 = el[e]; i1 = e; }
            const float p0 = expf(b0 - em), p1 = expf(b1 - em);
            const float w0 = gp * p0 / (p0 + p1), w1 = gp * p1 / (p0 + p1);
            const int e0 = gs * 4 + i0, e1 = gs * 4 + i1;
            TOKE[t * 2] = e0; TOKE[t * 2 + 1] = e1; TOKW[t * 2] = w0; TOKW[t * 2 + 1] = w1;
            const unsigned s0 = atomicAdd(&CNT[e0], 1u); LIST[(size_t)e0 * T + s0] = t * 2;
            const unsigned s1 = atomicAdd(&CNT[e1], 1u); LIST[(size_t)e1 * T + s1] = t * 2 + 1;
        }
    }
}
struct EpiHid { bf16_t* HID; __device__ __forceinline__ void operator()(int row, int col, f32x4 v) const { st_bf16x4(HID + (size_t)row * 256 + col, v); } };
struct EpiDown { bf16_t* Y; const int* gidx; const float* TOKW;
    __device__ __forceinline__ void operator()(int row, int col, f32x4 v) const { const int e = gidx[row]; if (e < 0) return; const float w = TOKW[e];
        st_bf16x4(Y + ((size_t)(e & 1) * T + (e >> 1)) * 1024 + col, v * w); } };
__device__ __forceinline__ void moe_range(const unsigned* CNT, int e, int& off_e, int& rows) {
    int o = 0; off_e = 0; rows = 0;
#pragma unroll
    for (int k = 0; k < 16; ++k) { const int r = ((int)CNT[k] + 255) & ~255; if (k == e) { off_e = o; rows = r; } o += r; }
}
__device__ __forceinline__ void ph_moe_index(const P& p, int l, int bid, int nblk, int tid_) {
    const unsigned* CNT = wsp<unsigned>(p, OFF_CTRL) + 64 * l; const int* LIST = wsp<int>(p, OFF_ROUTE + 512 * 1024); int* GIDX = wsp<int>(p, OFF_ROUTE + 512 * 1024 + 2 * MiB);
    int total = 0;
#pragma unroll
    for (int k = 0; k < 16; ++k) total += ((int)CNT[k] + 255) & ~255;
    const size_t gtid = (size_t)bid * NTHR + tid_, gstride = (size_t)nblk * NTHR;
    for (size_t i = gtid; i < (size_t)total; i += gstride) {
        int o = 0, e_off = 0, e_n = 0, e_id = 0;
#pragma unroll
        for (int k = 0; k < 16; ++k) { const int nk = (int)CNT[k], r = (nk + 255) & ~255; if ((int)i >= o && (int)i < o + r) { e_off = o; e_n = nk; e_id = k; } o += r; }
        const int r = (int)i - e_off; GIDX[i] = r < e_n ? LIST[(size_t)e_id * T + r] : -1;
    }
}
__device__ __forceinline__ void ph_moe1(const P& p, int l, float* lds, int bid, int nblk, int tid_) {
    const unsigned* CNT = wsp<unsigned>(p, OFF_CTRL) + 64 * l; const int* GIDX = wsp<int>(p, OFF_ROUTE + 512 * 1024 + 2 * MiB);
    const bf16_t* X1B = wsp<bf16_t>(p, R_XQ + 128 * MiB);
    for (int e = 0; e < 16; ++e) {
        int off_e, rows; moe_range(CNT, e, off_e, rows); if (rows == 0) continue;
        EpiHid ep{wsp<bf16_t>(p, R_A2) + (size_t)off_e * 256};
        gemm_naive<true>(X1B, 1024, GIDX + off_e, wsp<bf16_t>(p, WGU) + (size_t)(l * 16 + e) * 512 * 1024, 1024, rows, 256, 1024, ep, NoMid{}, lds, bid, nblk, tid_);
    }
}
__device__ __forceinline__ void ph_moe2(const P& p, int l, float* lds, int bid, int nblk, int tid_) {
    const unsigned* CNT = wsp<unsigned>(p, OFF_CTRL) + 64 * l; const int* GIDX = wsp<int>(p, OFF_ROUTE + 512 * 1024 + 2 * MiB);
    for (int e = 0; e < 16; ++e) {
        int off_e, rows; moe_range(CNT, e, off_e, rows); if (rows == 0) continue;
        EpiDown ep{wsp<bf16_t>(p, R_XBZ), GIDX + off_e, wsp<float>(p, OFF_ROUTE + 256 * 1024)};
        gemm_naive<false>(wsp<bf16_t>(p, R_A2) + (size_t)off_e * 256, 256, nullptr, wsp<bf16_t>(p, WDN) + (size_t)(l * 16 + e) * 1024 * 256, 256, rows, 1024, 256, ep, NoMid{}, lds, bid, nblk, tid_);
    }
}
__device__ __forceinline__ void ph_ln2(const P& p, int l, int bid, int nblk, int tid_) {
    float* X1F = wsp<float>(p, R_XQ); bf16_t* X1B = wsp<bf16_t>(p, R_XQ + 128 * MiB); const bf16_t* Y = wsp<bf16_t>(p, R_XBZ);
    float* LOGF = wsp<float>(p, OFF_DT);
    const float* g = p.ln2_g + l * 1024; const float* bta = p.ln2_b + l * 1024;
    const int lane = tid_ & 63, wid = tid_ >> 6;
    for (int t = bid * 8 + wid; t < T; t += nblk * 8) {
        f32x4 v[4];
#pragma unroll
        for (int j = 0; j < 4; ++j) { const size_t o = (size_t)t * 1024 + j * 256 + lane * 4; const f32x4 xv = *(const f32x4*)(X1F + o);
            const u32x2 a = *(const u32x2*)(Y + o), b = *(const u32x2*)(Y + (size_t)T * 1024 + o);
            v[j] = xv * ALPHA + (f32x4){bflo(a.x) + bflo(b.x), bfhi(a.x) + bfhi(b.x), bflo(a.y) + bflo(b.y), bfhi(a.y) + bfhi(b.y)}; }
        ln_row(v, g, bta, lane);
        if (l == 1) {
#pragma unroll
            for (int j = 0; j < 4; ++j) *(f32x4*)(p.out + (size_t)t * 1024 + j * 256 + lane * 4) = v[j];
        } else {
#pragma unroll
            for (int j = 0; j < 4; ++j) { *(f32x4*)(X1F + (size_t)t * 1024 + j * 256 + lane * 4) = v[j]; st_bf16x4(X1B + (size_t)t * 1024 + j * 256 + lane * 4, v[j]); }
            float f[8];
#pragma unroll
            for (int e = 0; e < 8; ++e) f[e] = 0.f;
#pragma unroll
            for (int j = 0; j < 4; ++j)
#pragma unroll
                for (int i = 0; i < 4; ++i) { const int k = j * 256 + lane * 4 + i; const float* w = p.od_w_in + (size_t)k * ODD_IN + 1952;
#pragma unroll
                    for (int e = 0; e < 8; ++e) f[e] += v[j][i] * w[e]; }
#pragma unroll
            for (int e = 0; e < 8; ++e) f[e] = wave_sum(f[e]);
            if (lane < 8) { float fv = 0.f;
#pragma unroll
                for (int e = 0; e < 8; ++e) fv = (e == lane) ? f[e] : fv;
                LOGF[(size_t)t * 8 + lane] = logsigmoid_f(fv + p.od_f_bias[lane]); }
        }
    }
}

struct EpiIn1 {
    bf16_t* CQ; bf16_t* CKV; bf16_t* Q; bf16_t* K; float* SSQQ; float* SSQK; const float* tab;
    __device__ __forceinline__ void operator()(int row, int col, f32x4 v) const {
        const int tx = lane_id() & 15;
        if (col < 512) {
            const bool isq = col < 256; const bool iskv = (col >= 256 && col < 384);
            float s = (isq || iskv) ? (v[0] * v[0] + v[1] * v[1]) + (v[2] * v[2] + v[3] * v[3]) : 0.f;
            s += __shfl_xor(s, 1); s += __shfl_xor(s, 2); s += __shfl_xor(s, 4); s += __shfl_xor(s, 8);
            if (tx == 0) { if (isq) SSQQ[(size_t)row * 4 + (col >> 6)] = s; else SSQK[(size_t)row * 4 + ((col - 256) >> 6)] = s; }
            if (isq) st_bf16x4(CQ + (size_t)row * 256 + col, v);
            else {
                if (col >= 384 && col < 416) { const int sp = row & (S - 1), i0 = (col - 384) >> 1;
                    const float c0 = tab[sp * 16 + i0], s0 = tab[S * 16 + sp * 16 + i0], c1 = tab[sp * 16 + i0 + 1], s1 = tab[S * 16 + sp * 16 + i0 + 1];
                    v = (f32x4){v[0] * c0 - v[1] * s0, v[1] * c0 + v[0] * s0, v[2] * c1 - v[3] * s1, v[3] * c1 + v[2] * s1}; }
                st_bf16x4(CKV + (size_t)row * 256 + (col - 256), v);
            }
        } else if (col < 1024) st_bf16x4(Q + (size_t)row * 512 + (col - 512), v * C2_64);
        else st_bf16x4(K + (size_t)row * 512 + (col - 1024), v);
    }
};
__device__ __forceinline__ void ph_inproj1(const P& p, float* lds, int bid, int nblk, int tid_) {
    const bf16_t* XB = wsp<bf16_t>(p, R_XQ + 128 * MiB);
    EpiIn1 e{wsp<bf16_t>(p, R_XBZ), wsp<bf16_t>(p, R_XBZ + 16 * MiB), wsp<bf16_t>(p, R_XBZ + 32 * MiB), wsp<bf16_t>(p, R_XBZ + 64 * MiB),
             wsp<float>(p, OFF_SSQ), wsp<float>(p, OFF_SSQ + 512 * 1024), wsp<float>(p, OFF_TAB)};
    gemm_naive<false>(XB, 1024, nullptr, wsp<bf16_t>(p, W1M), 1024, T, 1536, 1024, e, NoMid{}, lds, bid, nblk, tid_);
    EpiVt ev{wsp<bf16_t>(p, R_XBZ + 96 * MiB)};
    gemm_naive<false>(wsp<bf16_t>(p, W1V), 1024, nullptr, XB, 1024, 512, T, 1024, ev, NoMid{}, lds, bid, nblk, tid_);
}
__device__ __forceinline__ float rs4(const float* s, int row, float inv_n) { const f32x4 v = *(const f32x4*)(s + (size_t)row * 4); return rsqrtf(((v[0] + v[1]) + (v[2] + v[3])) * inv_n + 1e-6f); }
struct EpiQup { bf16_t* QM; const float* SSQQ; const float* tab;
    __device__ __forceinline__ void operator()(int row, int col, f32x4 v) const {
        v = v * rs4(SSQQ, row, 1.0f / 256.0f);
        const int j = col % 96;
        if (j >= 64) { const int sp = row & (S - 1), i0 = (j - 64) >> 1;
            const float c0 = tab[sp * 16 + i0], s0 = tab[S * 16 + sp * 16 + i0], c1 = tab[sp * 16 + i0 + 1], s1 = tab[S * 16 + sp * 16 + i0 + 1];
            v = (f32x4){v[0] * c0 - v[1] * s0, v[1] * c0 + v[0] * s0, v[2] * c1 - v[3] * s1, v[3] * c1 + v[2] * s1}; }
        st_bf16x4(QM + (size_t)row * 768 + col, v * C2_96);
    } };
struct EpiKup { bf16_t* KN; const float* SSQK; __device__ __forceinline__ void operator()(int row, int col, f32x4 v) const { st_bf16x4(KN + (size_t)row * 512 + col, v * rs4(SSQK, row, 1.0f / 128.0f)); } };
struct EpiVup { bf16_t* VtM; const float* SSQK; __device__ __forceinline__ void operator()(int row, int col, f32x4 v) const {
        v = (f32x4){v[0] * rs4(SSQK, col, 1.0f / 128.0f), v[1] * rs4(SSQK, col + 1, 1.0f / 128.0f), v[2] * rs4(SSQK, col + 2, 1.0f / 128.0f), v[3] * rs4(SSQK, col + 3, 1.0f / 128.0f)};
        st_bf16x4(VtM + (size_t)row * T + col, v); } };
__device__ __forceinline__ void ph_upproj(const P& p, float* lds, int bid, int nblk, int tid_) {
    const bf16_t* CQ = wsp<bf16_t>(p, R_XBZ); const bf16_t* CKV = wsp<bf16_t>(p, R_XBZ + 16 * MiB);
    const float* SSQQ = wsp<float>(p, OFF_SSQ); const float* SSQK = wsp<float>(p, OFF_SSQ + 512 * 1024);
    EpiQup eq{wsp<bf16_t>(p, R_A2), SSQQ, wsp<float>(p, OFF_TAB)};
    gemm_naive<false>(CQ, 256, nullptr, wsp<bf16_t>(p, W1Q), 256, T, 768, 256, eq, NoMid{}, lds, bid, nblk, tid_);
    EpiKup ek{wsp<bf16_t>(p, R_A2 + 48 * MiB), SSQK};
    gemm_naive<false>(CKV, 256, nullptr, wsp<bf16_t>(p, W1K), 128, T, 512, 128, ek, NoMid{}, lds, bid, nblk, tid_);
    EpiVup ev{wsp<bf16_t>(p, R_A2 + 80 * MiB), SSQK};
    gemm_naive<false>(wsp<bf16_t>(p, W1VV), 128, nullptr, CKV, 256, 512, T, 128, ev, NoMid{}, lds, bid, nblk, tid_);
    const float* LOGF = wsp<float>(p, OFF_DT); float* FH2 = wsp<float>(p, OFF_DT + 1 * MiB);
    const int lane = tid_ & 63, wid = tid_ >> 6;
    for (int u = bid * 8 + wid; u < NB * 8; u += nblk * 8) {
        const int b = u >> 3, h = u & 7;
        float loc[32]; float run = 0.f;
#pragma unroll
        for (int i = 0; i < 32; ++i) { run += LOGF[((size_t)b * S + lane * 32 + i) * 8 + h]; loc[i] = run; }
        float incl = run;
#pragma unroll
        for (int o = 1; o < 64; o <<= 1) { const float nb = __shfl_up(incl, o); if (lane >= o) incl += nb; }
        const float excl = incl - run;
#pragma unroll
        for (int i = 0; i < 32; ++i) FH2[(size_t)u * S + lane * 32 + i] = (excl + loc[i]) * LOG2E;
    }
}
__device__ __forceinline__ void ph_attn1_naive(const P& p, int bid, int nblk, int tid_) {
    const bf16_t* QM = wsp<bf16_t>(p, R_A2); const bf16_t* KN = wsp<bf16_t>(p, R_A2 + 48 * MiB); const bf16_t* VtM = wsp<bf16_t>(p, R_A2 + 80 * MiB);
    const bf16_t* CKV = wsp<bf16_t>(p, R_XBZ + 16 * MiB);
    const bf16_t* Qf = wsp<bf16_t>(p, R_XBZ + 32 * MiB); const bf16_t* Kf = wsp<bf16_t>(p, R_XBZ + 64 * MiB); const bf16_t* Vtf = wsp<bf16_t>(p, R_XBZ + 96 * MiB);
    const float* FH2 = wsp<float>(p, OFF_DT + 1 * MiB);
    bf16_t* A2 = wsp<bf16_t>(p, R_XQ + 128 * MiB);
    const int lane = tid_ & 63, wid = tid_ >> 6;
    const int nper = NB * 8 * (S / 64);
    for (int u = bid * 8 + wid; u < 2 * nper; u += nblk * 8) {
        const bool fox = u >= nper; const int uu = fox ? u - nper : u;
        const int tb = (S / 64 - 1) - (uu % (S / 64)), bh = uu / (S / 64), b = bh >> 3, h = bh & 7;
        const int t0 = tb * 64, t = t0 + lane; const size_t row = (size_t)b * S + t;
        float o[64];
#pragma unroll
        for (int d = 0; d < 64; ++d) o[d] = 0.f;
        float m = -INFINITY, lsum = 0.f;
        if (!fox) {
            unsigned qp[48];
#pragma unroll
            for (int d = 0; d < 96; d += 8) { const u32x4 v = *(const u32x4*)(QM + row * 768 + h * 96 + d);
#pragma unroll
                for (int j = 0; j < 4; ++j) qp[d / 2 + j] = v[j]; }
            for (int s = 0; s < t0 + 64; ++s) {
                const size_t kr = (size_t)b * S + s; float z = 0.f;
#pragma unroll
                for (int d = 0; d < 64; d += 8) { const u32x4 v = *(const u32x4*)(KN + kr * 512 + h * 64 + d);
#pragma unroll
                    for (int j = 0; j < 4; ++j) { z += bflo(qp[d / 2 + j]) * bflo(v[j]); z += bfhi(qp[d / 2 + j]) * bfhi(v[j]); } }
#pragma unroll
                for (int d = 0; d < 32; d += 8) { const u32x4 v = *(const u32x4*)(CKV + kr * 256 + 128 + d);
#pragma unroll
                    for (int j = 0; j < 4; ++j) { z += bflo(qp[32 + d / 2 + j]) * bflo(v[j]); z += bfhi(qp[32 + d / 2 + j]) * bfhi(v[j]); } }
                const float mn = fmaxf(m, z), corr = exp2f(m - mn), pw = exp2f(z - mn); m = mn; lsum = lsum * corr + pw;
                const bf16_t* vc = VtM + (size_t)(h * 64) * T + kr;
#pragma unroll
                for (int d = 0; d < 64; ++d) o[d] = o[d] * corr + pw * bf2f(vc[(size_t)d * T]);
            }
        } else {
            unsigned qp[32];
#pragma unroll
            for (int d = 0; d < 64; d += 8) { const u32x4 v = *(const u32x4*)(Qf + row * 512 + h * 64 + d);
#pragma unroll
                for (int j = 0; j < 4; ++j) qp[d / 2 + j] = v[j]; }
            const float fht = FH2[(size_t)bh * S + t];
            for (int s = 0; s < t0 + 64; ++s) {
                const size_t kr = (size_t)b * S + s; float z = 0.f;
#pragma unroll
                for (int d = 0; d < 64; d += 8) { const u32x4 v = *(const u32x4*)(Kf + kr * 512 + h * 64 + d);
#pragma unroll
                    for (int j = 0; j < 4; ++j) { z += bflo(qp[d / 2 + j]) * bflo(v[j]); z += bfhi(qp[d / 2 + j]) * bfhi(v[j]); } }
                z += fht - FH2[(size_t)bh * S + s];
                if (s <= t) {
                    const float mn = fmaxf(m, z), corr = exp2f(m - mn), pw = exp2f(z - mn); m = mn; lsum = lsum * corr + pw;
                    const bf16_t* vc = Vtf + (size_t)(h * 64) * T + kr;
#pragma unroll
                    for (int d = 0; d < 64; ++d) o[d] = o[d] * corr + pw * bf2f(vc[(size_t)d * T]);
                }
            }
        }
        const float inv = 1.0f / lsum;
#pragma unroll
        for (int d = 0; d < 64; d += 4) st_bf16x4(A2 + row * 1024 + (fox ? 512 : 0) + h * 64 + d, (f32x4){o[d] * inv, o[d + 1] * inv, o[d + 2] * inv, o[d + 3] * inv});
    }
}
__device__ __forceinline__ void ph_outproj1(const P& p, float* lds, int bid, int nblk, int tid_) {
    EpiRes e{wsp<float>(p, R_XQ), wsp<float>(p, R_XBZ)};
    gemm_naive<false>(wsp<bf16_t>(p, R_XQ + 128 * MiB), 1024, nullptr, wsp<bf16_t>(p, W1O), 1024, T, 1024, 1024, e, NoMid{}, lds, bid, nblk, tid_);
}

constexpr int LDS_STAGE = pg8::STAGE_BYTES;
constexpr int LDS_TAB_OFF = LDS_STAGE;
constexpr int LDS_TAB_BYTES = 16 * 1024;
#define LDSP(smem) ((PG8_LAS unsigned char*)(smem))

__device__ __forceinline__ void st_bf16x8(bf16_t* p, f32x4 a, f32x4 b) { u32x4 w; w[0] = pk_bf16(a[0], a[1]); w[1] = pk_bf16(a[2], a[3]); w[2] = pk_bf16(b[0], b[1]); w[3] = pk_bf16(b[2], b[3]); *(u32x4*)p = w; }
constexpr int PERM_SIMPLE = 2;
template <int PM = 1> __device__ __forceinline__ void epi_store_bf16p(const f32x4 (&acc)[2][2][4][2], const pg8::Unit& u, int wr, int wc, int fr, int fq, bf16_t* base, int ld, int c0, float sc) {
#pragma unroll
    for (int ai = 0; ai < 2; ++ai)
#pragma unroll
        for (int m = 0; m < 4; ++m) { bf16_t* rp = base + (size_t)(u.pm * 256 + ai * 128 + wr * 64 + m * 16 + fr) * ld + c0 + wc * (PM == 2 ? 64 : 32) + fq * 8;
#pragma unroll
            for (int bj = 0; bj < 2; ++bj) st_bf16x8(rp + bj * (PM == 2 ? 32 : 128), acc[ai][bj][m][0] * sc, acc[ai][bj][m][1] * sc); }
}
__device__ __forceinline__ void epi_store_bf16(const f32x4 (&acc)[2][2][4][2], const pg8::Unit& u, int wr, int wc, int fr, int fq, bf16_t* base, int ld, int c0, float sc) {
#pragma unroll
    for (int ai = 0; ai < 2; ++ai)
#pragma unroll
        for (int m = 0; m < 4; ++m) { bf16_t* rp = base + (size_t)(u.pm * 256 + ai * 128 + wr * 64 + m * 16 + fr) * ld + c0 + wc * 32 + fq * 4;
#pragma unroll
            for (int bj = 0; bj < 2; ++bj)
#pragma unroll
                for (int n = 0; n < 2; ++n) st_bf16x4(rp + bj * 128 + n * 16, acc[ai][bj][m][n] * sc); }
}
__device__ __forceinline__ void EpiMixMf::operator()(const f32x4 (&acc)[2][2][4][2], const pg8::Unit& u, int, int wr, int wc, int fr, int fq) const { epi_store_bf16p<PERM_SIMPLE>(acc, u, wr, wc, fr, fq, MIX, 1024, u.pn * 256, 1.f); }
struct EpiIn0Mf { bf16_t* Z; bf16_t* XBCR; bf16_t* Q; bf16_t* K;
    __device__ __forceinline__ void operator()(const f32x4 (&acc)[2][2][4][2], const pg8::Unit& u, int, int wr, int wc, int fr, int fq) const {
        bf16_t* base; int ld, c0; float sc = 1.f;
        if (u.pn < 4) { base = Z; ld = 1024; c0 = u.pn * 256; }
        else if (u.pn < 10) { base = XBCR; ld = 1536; c0 = (u.pn - 4) * 256; }
        else if (u.pn < 12) { base = Q; ld = 512; c0 = (u.pn - 10) * 256; sc = C2_64; }
        else { base = K; ld = 512; c0 = (u.pn - 12) * 256; }
        epi_store_bf16p<PERM_SIMPLE>(acc, u, wr, wc, fr, fq, base, ld, c0, sc); } };
template <int PM> struct EpiVtMf { bf16_t* Vt; __device__ __forceinline__ void operator()(const f32x4 (&acc)[2][2][4][2], const pg8::Unit& u, int, int wr, int wc, int fr, int fq) const {
        epi_store_bf16p<PM>(acc, u, wr, wc, fr, fq, Vt, T, u.pn * 256, 1.f); } };
template <class E1, class E2> struct EpiDual { E1 e1; E2 e2;
    __device__ __forceinline__ void operator()(const f32x4 (&acc)[2][2][4][2], const pg8::Unit& u, int ui, int wr, int wc, int fr, int fq) const {
        if (u.e == 0) e1(acc, u, ui, wr, wc, fr, fq); else e2(acc, u, ui, wr, wc, fr, fq); } };
template <class F> __device__ __forceinline__ void mf_dense(unsigned char* smem, const bf16_t* A, int lda, const bf16_t* Bt, int ldb, int M, int N, int K, const F& f, int bid, int nblk, int tid_) {
    pg8::Gemm g{A, Bt, lda, ldb, K, nullptr}; pg8::DenseOrder S; S.init(M, N, lda, ldb, nblk, bid);
    pg8::EpiWrap<F> E{f};
    pg8::gemm_phase<pg8::EpiWrap<F>, pg8::DenseOrder, pg8::NoMidK, false>(LDSP(smem), g, S, E, pg8::NoMidK{}, tid_);
}
template <int PERM, class E_> __device__ __forceinline__ void mf_dense_e(unsigned char* smem, const bf16_t* A, int lda, const bf16_t* Bt, int ldb, int M, int N, int K, const E_& E, int bid, int nblk, int tid_) {
    pg8::Gemm g{A, Bt, lda, ldb, K, nullptr}; pg8::DenseOrder S; S.init(M, N, lda, ldb, nblk, bid);
    pg8::gemm_phase<E_, pg8::DenseOrder, pg8::NoMidK, false, PERM>(LDSP(smem), g, S, E, pg8::NoMidK{}, tid_);
}
__device__ __forceinline__ void ph_inproj0_mf(const P& p, unsigned char* smem, int bid, int nblk, int tid_) {
    const bf16_t* XB = wsp<bf16_t>(p, R_XBZ);
    EpiIn0Mf e{wsp<bf16_t>(p, R_XBZ + 64 * MiB), wsp<bf16_t>(p, R_A2), wsp<bf16_t>(p, R_XQ + 96 * MiB), wsp<bf16_t>(p, R_XQ + 128 * MiB)};
    EpiVtMf<PERM_SIMPLE> ev{wsp<bf16_t>(p, R_XQ + 160 * MiB)};
    const bf16_t* W0Mp = wsp<bf16_t>(p, W0M); const bf16_t* W0Vp = wsp<bf16_t>(p, W0V);
    pg8::DualOrder S; S.s1.init(T, 3584, 1024, 1024, nblk, bid); S.s2.init(512, T, 1024, 1024, nblk, bid);
    S.a2off = (const char*)W0Vp - (const char*)XB; S.b2off = (const char*)XB - (const char*)W0Mp;
    EpiDual<EpiIn0Mf, EpiVtMf<PERM_SIMPLE>> E{e, ev};
    pg8::Gemm g{XB, W0Mp, 1024, 1024, 1024, nullptr};
    pg8::gemm_phase<EpiDual<EpiIn0Mf, EpiVtMf<PERM_SIMPLE>>, pg8::DualOrder, pg8::NoMidK, false, PERM_SIMPLE>(LDSP(smem), g, S, E, pg8::NoMidK{}, tid_);
}
struct MidRmsK { static constexpr int ktile = 16; const PG8_LAS float* rs;
    __device__ __forceinline__ void apply(f32x4 (&acc)[2][2][4][2], int ui, int wr, int fr) const {
#pragma unroll
        for (int ai = 0; ai < 2; ++ai)
#pragma unroll
            for (int m = 0; m < 4; ++m) { const float s = rs[ui * 256 + ai * 128 + wr * 64 + m * 16 + fr];
#pragma unroll
                for (int bj = 0; bj < 2; ++bj)
#pragma unroll
                    for (int n = 0; n < 2; ++n) acc[ai][bj][m][n] *= s; } } };
constexpr int NSSQ = USE_SSD ? 32 : 16;
__device__ __forceinline__ void ph_outproj0_mf(const P& p, unsigned char* smem, int bid, int nblk, int tid_) {
    const float* SSQ = wsp<float>(p, OFF_SSQ);
    PG8_LAS float* rs = (PG8_LAS float*)(LDSP(smem) + LDS_TAB_OFF);
    pg8::Gemm g{wsp<bf16_t>(p, R_A2), wsp<bf16_t>(p, W0O), 1536, 1536, 1536, nullptr}; pg8::DenseOrder S; S.init(T, 1024, 1536, 1536, nblk, bid);
    { const int ui = __builtin_amdgcn_readfirstlane(tid_ >> 6), ln = tid_ & 63; pg8::Unit u;
      if (S.next(ui, u)) {
#pragma unroll
          for (int k = 0; k < 4; ++k) { const int r = ln + 64 * k; const int row = u.pm * 256 + r; float s = 0.f;
#pragma unroll
              for (int h = 0; h < NSSQ; h += 4) { const f32x4 v = *(const f32x4*)(SSQ + (size_t)row * NSSQ + h); s += (v[0] + v[1]) + (v[2] + v[3]); }
              rs[ui * 256 + r] = rsqrtf(s * (1.0f / 1024.0f) + 1e-6f); } } }
    __syncthreads();
    EpiMixMf E{wsp<bf16_t>(p, R_XQ)}; MidRmsK mid{rs};
    pg8::gemm_phase<EpiMixMf, pg8::DenseOrder, MidRmsK, false, PERM_SIMPLE>(LDSP(smem), g, S, E, mid, tid_);
}
constexpr size_t OFF_DONE = OFF_CTRL + 4096;
constexpr size_t OFF_LIST = R_A2 + 100 * MiB;
constexpr int NLIST = 24;
__device__ __forceinline__ void pair_experts(int lid, int& elo, int& ehi) { const int gs = lid / 6, pid = lid % 6;
    const int lo = pid < 3 ? 0 : (pid < 5 ? 1 : 2), hi = pid < 3 ? pid + 1 : (pid < 5 ? pid - 1 : 3); elo = gs * 4 + lo; ehi = gs * 4 + hi; }
template <int PHASE> struct MoeOrder {
    static constexpr int NPN = 4;
    static constexpr bool HOOK = PHASE == 2;
    static constexpr int BSEAM = PHASE == 2 ? 4 : 0;
    int cnt[NLIST]; int G, c; unsigned* done; int nA, nB, qlo, NBtot, N2;
    __device__ __forceinline__ void init(const unsigned* CNT, unsigned* done_, int G_, int c_) {
        int tiles = 0;
#pragma unroll
        for (int k = 0; k < NLIST; ++k) { cnt[k] = (int)CNT[k]; tiles += (cnt[k] + 255) >> 8; }
        G = G_; c = c_; done = done_;
        const int n1 = tiles * 4; N2 = tiles * 4; nA = n1 % G; nB = G - nA;
        int q = (N2 + G - 1) / G;
        while (nB * q + nA * (q > 2 ? q - 2 : 0) < N2) ++q;
        qlo = q > 2 ? q - 2 : 0; NBtot = N2 - nA * qlo; if (NBtot < 0) NBtot = 0; }
    __device__ __forceinline__ bool next(int i, pg8::Unit& u) const {
        int L;
        if (PHASE == 1) L = i * G + c;
        else if (c >= nA) { L = i * nB + (c - nA); if (L >= NBtot) L = 1 << 30; }
        else { L = NBtot + i * nA + c; if (i >= qlo) L = 1 << 30; }
        int base = 0, off = 0; bool found = false;
        u.pm = 0; u.pn = 0; u.e = 0; u.g0 = 0;
#pragma unroll
        for (int k = 0; k < NLIST; ++k) { const int te = (cnt[k] + 255) >> 8, nu = te * NPN;
            if (!found && L < base + nu) { const int loc = L - base; u.e = k; u.pm = loc / NPN; u.pn = loc % NPN; u.g0 = off + u.pm * 256; found = true; }
            base += nu; off += te * 256; }
        int elo, ehi; pair_experts(u.e, elo, ehi);
        if (PHASE == 1) { u.aoff = 0; u.boff = ((size_t)((u.pn >> 1) ? ehi : elo) * 512 + (u.pn & 1) * 256) * 1024 * 2; u.boff2 = u.boff; }
        else { u.aoff = (size_t)u.g0 * 512 * 2; u.boff = ((size_t)elo * 1024 + u.pn * 256) * 256 * 2; u.boff2 = ((size_t)ehi * 1024 + u.pn * 256) * 256 * 2 - (size_t)BSEAM * 128; }
        return found; }
    __device__ __forceinline__ int count(int e) const { int r = 0;
#pragma unroll
        for (int k = 0; k < NLIST; ++k) r = (k == e) ? cnt[k] : r;
        return r; }
    __device__ __forceinline__ void a_ready(const pg8::Unit& u, int wid) const {
        if (wid == 0) { unsigned* w = done + (u.g0 >> 8); unsigned sp = 0;
            while (__hip_atomic_load(w, __ATOMIC_RELAXED, __HIP_MEMORY_SCOPE_AGENT) < 32u) { __builtin_amdgcn_s_sleep(2); if (++sp > (1u << 22)) break; }
            asm volatile("s_waitcnt vmcnt(0)" ::: "memory"); }
        __builtin_amdgcn_s_barrier(); asm volatile("" ::: "memory"); }
};
__device__ __forceinline__ void st16_sc1(void* p, u32x4 v) { asm volatile("global_store_dwordx4 %0, %1, off sc1" :: "v"(p), "v"(v) : "memory"); }
struct EpiHidMf { bf16_t* HID; unsigned* done; const PG8_LAS int* gl; const float* TOKW;
    __device__ __forceinline__ void operator()(const f32x4 (&acc)[2][2][4][2], const pg8::Unit& u, int ui, int wr, int wc, int fr, int fq) const {
        const int hi = u.pn >> 1;
#pragma unroll
        for (int ai = 0; ai < 2; ++ai)
#pragma unroll
            for (int m = 0; m < 4; ++m) { const int rl = ai * 128 + wr * 64 + m * 16 + fr; const size_t hrow = (size_t)u.g0 + rl; u32x4 w;
                const float tw = TOKW[gl[ui * 256 + rl] * 2 + hi];
#pragma unroll
                for (int n = 0; n < 2; ++n) { const f32x4 gt = acc[ai][0][m][n], up = acc[ai][1][m][n] * tw;
                    w[2 * n] = pk_bf16(silu_f(gt[0]) * up[0], silu_f(gt[1]) * up[1]); w[2 * n + 1] = pk_bf16(silu_f(gt[2]) * up[2], silu_f(gt[3]) * up[3]); }
                st16_sc1(HID + hrow * 512 + hi * 256 + (u.pn & 1) * 128 + wc * 32 + fq * 8, w); }
        asm volatile("s_waitcnt vmcnt(0)" ::: "memory");
        if (fr == 0 && fq == 0) __hip_atomic_fetch_add(done + (u.g0 >> 8), 1u, __ATOMIC_RELAXED, __HIP_MEMORY_SCOPE_AGENT); } };
__device__ __forceinline__ void ph_moe1_mf(const P& p, int l, unsigned char* smem, int bid, int nblk, int tid_) {
    const unsigned* CNT = wsp<unsigned>(p, OFF_CTRL) + 64 * l; const int* LIST = wsp<int>(p, OFF_LIST);
    PG8_LAS int* gl = (PG8_LAS int*)(LDSP(smem) + LDS_TAB_OFF);
    unsigned* done = wsp<unsigned>(p, OFF_DONE) + 512 * l;
    MoeOrder<1> S; S.init(CNT, done, nblk, bid);
    { const int ui = __builtin_amdgcn_readfirstlane(tid_ >> 6), ln = tid_ & 63; pg8::Unit u;
      if (S.next(ui, u)) { const int cnt = S.count(u.e); const int* lp = LIST + (size_t)u.e * T + u.pm * 256;
#pragma unroll
          for (int k = 0; k < 4; ++k) { const int r = ln + 64 * k; gl[ui * 256 + r] = (u.pm * 256 + r < cnt) ? lp[r] : 0; } } }
    __syncthreads();
    pg8::Gemm g{wsp<bf16_t>(p, R_XQ + 128 * MiB), wsp<bf16_t>(p, WGU) + (size_t)l * 16 * 512 * 1024, 1024, 1024, 1024, gl};
    EpiHidMf E{wsp<bf16_t>(p, R_A2), done, gl, wsp<float>(p, OFF_ROUTE + 256 * 1024)};
    pg8::gemm_phase<EpiHidMf, MoeOrder<1>, pg8::NoMidK, true, true>(LDSP(smem), g, S, E, pg8::NoMidK{}, tid_);
}
struct EpiDownMf { bf16_t* Y; const PG8_LAS int* ent;
    __device__ __forceinline__ void operator()(const f32x4 (&acc)[2][2][4][2], const pg8::Unit& u, int ui, int wr, int wc, int fr, int fq) const {
#pragma unroll
        for (int ai = 0; ai < 2; ++ai)
#pragma unroll
            for (int m = 0; m < 4; ++m) { const int r = ui * 256 + ai * 128 + wr * 64 + m * 16 + fr; const int en = ent[r];
                if (en >= 0) { bf16_t* yr = Y + (size_t)en * 1024 + u.pn * 256 + wc * 32 + fq * 8;
#pragma unroll
                    for (int bj = 0; bj < 2; ++bj) st_bf16x8(yr + bj * 128, acc[ai][bj][m][0], acc[ai][bj][m][1]); } } } };
__device__ __forceinline__ void ph_moe2_mf(const P& p, int l, unsigned char* smem, int bid, int nblk, int tid_) {
    const unsigned* CNT = wsp<unsigned>(p, OFF_CTRL) + 64 * l; const int* LIST = wsp<int>(p, OFF_LIST);
    PG8_LAS int* ent = (PG8_LAS int*)(LDSP(smem) + LDS_TAB_OFF);
    MoeOrder<2> S; S.init(CNT, wsp<unsigned>(p, OFF_DONE) + 512 * l, nblk, bid);
    { const int ui = __builtin_amdgcn_readfirstlane(tid_ >> 6), ln = tid_ & 63; pg8::Unit u;
      if (S.next(ui, u)) { const int cnt = S.count(u.e); const int* lp = LIST + (size_t)u.e * T + u.pm * 256;
#pragma unroll
          for (int k = 0; k < 4; ++k) { const int r = ln + 64 * k; ent[ui * 256 + r] = (u.pm * 256 + r < cnt) ? lp[r] : -1; } } }
    __syncthreads();
    pg8::Gemm g{wsp<bf16_t>(p, R_A2), wsp<bf16_t>(p, WDN) + (size_t)l * 16 * 1024 * 256, 512, 256, 512, nullptr};
    EpiDownMf E{wsp<bf16_t>(p, R_XBZ), ent};
    pg8::gemm_phase<EpiDownMf, MoeOrder<2>, pg8::NoMidK, false, true>(LDSP(smem), g, S, E, pg8::NoMidK{}, tid_);
}
struct EpiIn1Mf { bf16_t* CQ; bf16_t* CKV; bf16_t* Q; bf16_t* K; float* SSQQ; float* SSQK; const float* tab;
    __device__ __forceinline__ void operator()(const f32x4 (&acc)[2][2][4][2], const pg8::Unit& u, int, int wr, int wc, int fr, int fq) const {
        if (u.pn == 0) {
#pragma unroll
            for (int ai = 0; ai < 2; ++ai)
#pragma unroll
                for (int m = 0; m < 4; ++m) { const size_t row = (size_t)u.pm * 256 + ai * 128 + wr * 64 + m * 16 + fr; float s = 0.f;
#pragma unroll
                    for (int bj = 0; bj < 2; ++bj) {
#pragma unroll
                        for (int n = 0; n < 2; ++n) { const f32x4 v = acc[ai][bj][m][n]; s += (v[0] * v[0] + v[1] * v[1]) + (v[2] * v[2] + v[3] * v[3]); }
                        st_bf16x8(CQ + row * 256 + bj * 128 + wc * 32 + fq * 8, acc[ai][bj][m][0], acc[ai][bj][m][1]); }
                    s += __shfl_xor(s, 16); s += __shfl_xor(s, 32);
                    if (fq == 0) SSQQ[row * 4 + wc] = s; }
        } else if (u.pn == 1) {
#pragma unroll
            for (int ai = 0; ai < 2; ++ai)
#pragma unroll
                for (int m = 0; m < 4; ++m) { const size_t row = (size_t)u.pm * 256 + ai * 128 + wr * 64 + m * 16 + fr; float s = 0.f;
#pragma unroll
                    for (int n = 0; n < 2; ++n) { const f32x4 v = acc[ai][0][m][n]; s += (v[0] * v[0] + v[1] * v[1]) + (v[2] * v[2] + v[3] * v[3]); }
                    st_bf16x8(CKV + row * 256 + wc * 32 + fq * 8, acc[ai][0][m][0], acc[ai][0][m][1]);
                    s += __shfl_xor(s, 16); s += __shfl_xor(s, 32);
                    if (fq == 0) SSQK[row * 4 + wc] = s;
                    if (wc == 0) { const int sp = (int)(row & (S - 1)); f32x4 vv[2];
#pragma unroll
                        for (int n = 0; n < 2; ++n) { f32x4 v = acc[ai][1][m][n]; const int cp = fq * 8 + n * 4, i0 = cp >> 1;
                            const float c0 = tab[sp * 16 + i0], s0 = tab[S * 16 + sp * 16 + i0], c1 = tab[sp * 16 + i0 + 1], s1 = tab[S * 16 + sp * 16 + i0 + 1];
                            vv[n] = (f32x4){v[0] * c0 - v[1] * s0, v[1] * c0 + v[0] * s0, v[2] * c1 - v[3] * s1, v[3] * c1 + v[2] * s1}; }
                        st_bf16x8(CKV + row * 256 + 128 + fq * 8, vv[0], vv[1]); } }
        } else {
            const bool isq = u.pn < 4;
            epi_store_bf16p(acc, u, wr, wc, fr, fq, isq ? Q : K, 512, (isq ? u.pn - 2 : u.pn - 4) * 256, isq ? C2_64 : 1.f);
        } } };
__device__ __forceinline__ void ph_inproj1_mf(const P& p, unsigned char* smem, int bid, int nblk, int tid_) {
    const bf16_t* XB = wsp<bf16_t>(p, R_XQ + 128 * MiB);
    EpiIn1Mf E{wsp<bf16_t>(p, R_XBZ), wsp<bf16_t>(p, R_XBZ + 16 * MiB), wsp<bf16_t>(p, R_XBZ + 32 * MiB), wsp<bf16_t>(p, R_XBZ + 64 * MiB),
               wsp<float>(p, OFF_SSQ), wsp<float>(p, OFF_SSQ + 512 * 1024), wsp<float>(p, OFF_TAB)};
    EpiVtMf<1> ev{wsp<bf16_t>(p, R_XBZ + 96 * MiB)};
    const bf16_t* W1Mp = wsp<bf16_t>(p, W1M); const bf16_t* W1Vp = wsp<bf16_t>(p, W1V);
    pg8::DualOrder S; S.s1.init(T, 1536, 1024, 1024, nblk, bid); S.s2.init(512, T, 1024, 1024, nblk, bid);
    S.a2off = (const char*)W1Vp - (const char*)XB; S.b2off = (const char*)XB - (const char*)W1Mp;
    EpiDual<EpiIn1Mf, EpiVtMf<1>> E2{E, ev};
    pg8::Gemm g{XB, W1Mp, 1024, 1024, 1024, nullptr};
    pg8::gemm_phase<EpiDual<EpiIn1Mf, EpiVtMf<1>>, pg8::DualOrder, pg8::NoMidK, false, 1>(LDSP(smem), g, S, E2, pg8::NoMidK{}, tid_);
}
__device__ __forceinline__ void ph_fh_cumsum(const P& p, int bid, int nblk, int tid_) {
    const float* LOGF = wsp<float>(p, OFF_DT); float* FH2 = wsp<float>(p, OFF_DT + 1 * MiB);
    const int lane = tid_ & 63, wid = tid_ >> 6;
    for (int u = bid * 8 + wid; u < NB * 8; u += nblk * 8) {
        const int b = u >> 3, h = u & 7;
        float loc[32]; float run = 0.f;
#pragma unroll
        for (int i = 0; i < 32; ++i) { run += LOGF[((size_t)b * S + lane * 32 + i) * 8 + h]; loc[i] = run; }
        float incl = run;
#pragma unroll
        for (int o = 1; o < 64; o <<= 1) { const float nb = __shfl_up(incl, o); if (lane >= o) incl += nb; }
        const float excl = incl - run;
#pragma unroll
        for (int i = 0; i < 32; ++i) FH2[(size_t)u * S + lane * 32 + i] = (excl + loc[i]) * LOG2E;
    }
}
template <bool BYCOL> __device__ __forceinline__ void fill_scale(const pg8::DenseOrder& S, PG8_LAS float* tab, const float* SSQ, float inv_n, int tid_) {
    { const int ui = __builtin_amdgcn_readfirstlane(tid_ >> 6), ln = tid_ & 63; pg8::Unit u;
      if (S.next(ui, u)) {
#pragma unroll
          for (int k = 0; k < 4; ++k) { const int r = ln + 64 * k; tab[ui * 256 + r] = rs4(SSQ, (BYCOL ? u.pn : u.pm) * 256 + r, inv_n); } } }
    __syncthreads();
}
struct EpiQupMf { bf16_t* QM; const PG8_LAS float* rs; const float* tab;
    __device__ __forceinline__ void operator()(const f32x4 (&acc)[2][2][4][2], const pg8::Unit& u, int ui, int wr, int wc, int fr, int fq) const {
#pragma unroll
        for (int ai = 0; ai < 2; ++ai)
#pragma unroll
            for (int m = 0; m < 4; ++m) { const int r = ai * 128 + wr * 64 + m * 16 + fr; const size_t row = (size_t)u.pm * 256 + r; const float sc = rs[ui * 256 + r] * C2_96; const int sp = (int)(row & (S - 1));
#pragma unroll
                for (int bj = 0; bj < 2; ++bj) { f32x4 vv[2]; const int col8 = u.pn * 256 + bj * 128 + wc * 32 + fq * 8;
#pragma unroll
                    for (int n = 0; n < 2; ++n) { const int col = col8 + 4 * n; f32x4 v = acc[ai][bj][m][n] * sc; const int j = col % 96;
                        if (j >= 64) { const int i0 = (j - 64) >> 1;
                            const float c0 = tab[sp * 16 + i0], s0 = tab[S * 16 + sp * 16 + i0], c1 = tab[sp * 16 + i0 + 1], s1 = tab[S * 16 + sp * 16 + i0 + 1];
                            v = (f32x4){v[0] * c0 - v[1] * s0, v[1] * c0 + v[0] * s0, v[2] * c1 - v[3] * s1, v[3] * c1 + v[2] * s1}; }
                        vv[n] = v; }
                    st_bf16x8(QM + row * 768 + col8, vv[0], vv[1]); }
                asm volatile("" ::: "memory"); } } };
struct EpiKupMf { bf16_t* KN; const PG8_LAS float* rs;
    __device__ __forceinline__ void operator()(const f32x4 (&acc)[2][2][4][2], const pg8::Unit& u, int ui, int wr, int wc, int fr, int fq) const {
#pragma unroll
        for (int ai = 0; ai < 2; ++ai)
#pragma unroll
            for (int m = 0; m < 4; ++m) { const int r = ai * 128 + wr * 64 + m * 16 + fr; const size_t row = (size_t)u.pm * 256 + r; const float sc = rs[ui * 256 + r];
#pragma unroll
                for (int bj = 0; bj < 2; ++bj) st_bf16x8(KN + row * 512 + u.pn * 256 + bj * 128 + wc * 32 + fq * 8, acc[ai][bj][m][0] * sc, acc[ai][bj][m][1] * sc); } } };
struct EpiVupMf { bf16_t* VtM; const PG8_LAS float* cs;
    __device__ __forceinline__ void operator()(const f32x4 (&acc)[2][2][4][2], const pg8::Unit& u, int ui, int wr, int wc, int fr, int fq) const {
        f32x4 sc[2][2];
#pragma unroll
        for (int bj = 0; bj < 2; ++bj)
#pragma unroll
            for (int n = 0; n < 2; ++n) sc[bj][n] = *(const PG8_LAS f32x4*)(cs + ui * 256 + bj * 128 + wc * 32 + fq * 8 + n * 4);
#pragma unroll
        for (int ai = 0; ai < 2; ++ai)
#pragma unroll
            for (int m = 0; m < 4; ++m) { const size_t row = (size_t)u.pm * 256 + ai * 128 + wr * 64 + m * 16 + fr;
#pragma unroll
                for (int bj = 0; bj < 2; ++bj) st_bf16x8(VtM + row * T + u.pn * 256 + bj * 128 + wc * 32 + fq * 8, acc[ai][bj][m][0] * sc[bj][0], acc[ai][bj][m][1] * sc[bj][1]); } } };
__device__ __forceinline__ void ph_knorm(const P& p, int bid, int nblk, int tid_) {
    const bf16_t* Kf = wsp<bf16_t>(p, R_XBZ + 64 * MiB); float* KMAXT = wsp<float>(p, OFF_SSQ + 1 * MiB);
    const int lane = tid_ & 63, wid = tid_ >> 6;
    for (int it = bid * 8 + wid; it < 128 * 32; it += nblk * 8) {
        const int bh = it >> 5, tile = it & 31, b = bh >> 3, h = bh & 7;
        const bf16_t* kr = Kf + ((size_t)b * S + tile * 64 + lane) * 512 + h * 64; float s2 = 0.f;
#pragma unroll
        for (int c = 0; c < 8; ++c) { const u32x4 v = *(const u32x4*)(kr + c * 8);
#pragma unroll
            for (int j = 0; j < 4; ++j) { const float lo = bflo(v[j]), hi_ = bfhi(v[j]); s2 += lo * lo + hi_ * hi_; } }
        float m = sqrtf(s2);
#pragma unroll
        for (int o = 32; o >= 1; o >>= 1) m = fmaxf(m, __shfl_xor(m, o));
        if (lane == 0) KMAXT[it] = m;
    }
}
__device__ __forceinline__ void ph_upproj_mf(const P& p, unsigned char* smem, int bid, int nblk, int tid_) {
    const bf16_t* CQ = wsp<bf16_t>(p, R_XBZ); const bf16_t* CKV = wsp<bf16_t>(p, R_XBZ + 16 * MiB);
    const float* SSQQ = wsp<float>(p, OFF_SSQ); const float* SSQK = wsp<float>(p, OFF_SSQ + 512 * 1024);
    PG8_LAS float* tabl = (PG8_LAS float*)(LDSP(smem) + LDS_TAB_OFF);
    { pg8::Gemm g{CQ, wsp<bf16_t>(p, W1Q), 256, 256, 256, nullptr}; pg8::DenseOrder S; S.init(T, 768, 256, 256, nblk, bid);
      fill_scale<false>(S, tabl, SSQQ, 1.0f / 256.0f, tid_);
      EpiQupMf E{wsp<bf16_t>(p, R_A2), tabl, wsp<float>(p, OFF_TAB)};
      pg8::gemm_phase<EpiQupMf, pg8::DenseOrder, pg8::NoMidK, false, true>(LDSP(smem), g, S, E, pg8::NoMidK{}, tid_); }
    { pg8::Gemm g{CKV, wsp<bf16_t>(p, W1K), 256, 128, 128, nullptr}; pg8::DenseOrder S; S.init(T, 512, 256, 128, nblk, bid);
      fill_scale<false>(S, tabl, SSQK, 1.0f / 128.0f, tid_);
      EpiKupMf E{wsp<bf16_t>(p, R_A2 + 48 * MiB), tabl};
      pg8::gemm_phase<EpiKupMf, pg8::DenseOrder, pg8::NoMidK, false, true>(LDSP(smem), g, S, E, pg8::NoMidK{}, tid_); }
    { pg8::Gemm g{wsp<bf16_t>(p, W1VV), CKV, 128, 256, 128, nullptr}; pg8::DenseOrder S; S.init(512, T, 128, 256, nblk, bid);
      fill_scale<true>(S, tabl, SSQK, 1.0f / 128.0f, tid_);
      EpiVupMf E{wsp<bf16_t>(p, R_A2 + 80 * MiB), tabl};
      pg8::gemm_phase<EpiVupMf, pg8::DenseOrder, pg8::NoMidK, false, true>(LDSP(smem), g, S, E, pg8::NoMidK{}, tid_); }
    ph_fh_cumsum(p, bid, nblk, tid_);
    ph_knorm(p, bid, nblk, tid_);
}
__device__ __forceinline__ void ph_outproj1_mf(const P& p, unsigned char* smem, int bid, int nblk, int tid_) {
    EpiMixMf E{wsp<bf16_t>(p, R_XBZ)};
    mf_dense_e<PERM_SIMPLE>(smem, wsp<bf16_t>(p, R_XQ), 1024, wsp<bf16_t>(p, W1O), 1024, T, 1024, 1024, E, bid, nblk, tid_);
}

namespace att {
typedef short bf16x8 __attribute__((ext_vector_type(8)));
typedef float f32x16 __attribute__((ext_vector_type(16)));
struct Args { const bf16_t* Q; int ldq; const bf16_t* K; int ldk; const bf16_t* K2; const bf16_t* Vt; bf16_t* O; int ldo; const float* FH2; const float* KMAXT; };
template <int MODE> struct Cfg { static constexpr int DK = MODE == 2 ? 96 : 64, DKX = DK + (MODE == 1 ? 16 : 0), KROW = DKX * 2 + 16, VROW = 144, K_BYTES = 64 * KROW, V_BYTES = 64 * VROW, TILE = K_BYTES + V_BYTES + 256; };
__device__ __forceinline__ float swap_sum(float x) { auto rr = __builtin_amdgcn_permlane32_swap(__float_as_uint(x), __float_as_uint(x), false, false); return __uint_as_float(rr[0]) + __uint_as_float(rr[1]); }
__device__ __forceinline__ float swap_max(float x) { auto rr = __builtin_amdgcn_permlane32_swap(__float_as_uint(x), __float_as_uint(x), false, false); return fmaxf(__uint_as_float(rr[0]), __uint_as_float(rr[1])); }
__device__ __forceinline__ float swap_other(float x, int hi) { auto rr = __builtin_amdgcn_permlane32_swap(__float_as_uint(x), __float_as_uint(x), false, false); return __uint_as_float(hi ? rr[0] : rr[1]); }

template <int MODE, int HP = 1>
__device__ __forceinline__ void attn_unit(const Args& a, int b, int h0, int qb, unsigned char* smem, int tid_) {
    typedef Cfg<MODE> C;
    constexpr int BUF = HP * C::TILE, QROWS = 256 / HP;
    constexpr int NKS = C::DK / 16, NKX = C::DKX / 16;
    int tid = tid_; asm volatile("" : "+v"(tid));
    const int lane = tid & 63, wid = __builtin_amdgcn_readfirstlane(tid >> 6), r32 = lane & 31, hi = lane >> 5;
    PG8_LAS unsigned char* lds = (PG8_LAS unsigned char*)smem;
    const int hsw = (HP == 2) ? (wid >> 2) : 0, h = h0 + hsw, wq = (HP == 2) ? (wid & 3) : wid;
    const int q0 = qb * QROWS, qw = q0 + wq * 32;
    const size_t rowb = (size_t)b * S;
    const int jmax = q0 / 64 + QROWS / 64 - 1;
    const int hoff = hsw * C::TILE;
    const int jw = (MODE == 2) ? (qw >> 6) : ((qw + 31) >> 6);
    bf16x8 qf[NKX];
    { const bf16_t* qp = a.Q + (rowb + qw + r32) * a.ldq + h * C::DK + hi * 8;
#pragma unroll
      for (int ks = 0; ks < NKS; ++ks) qf[ks] = *(const bf16x8*)(qp + ks * 16);
      if (MODE == 1) { const u32x4 m1 = {hi ? 0u : 0xBF80BF80u, hi ? 0u : 0x0000BF80u, 0u, 0u}; qf[NKX - 1] = __builtin_bit_cast(bf16x8, m1); } }
    const u32x4 ones_u = {0x3F803F80u, 0x3F803F80u, 0x3F803F80u, 0x3F803F80u}; const bf16x8 ones8 = __builtin_bit_cast(bf16x8, ones_u);
    const int kkey = tid >> 3, kch = tid & 7;
    const bf16_t* kg = a.K + (rowb + kkey) * a.ldk + h0 * 64 + kch * 8;
    const bf16_t* k2g = a.K2 + (rowb + (tid >> 2)) * 256 + 128 + (tid & 3) * 8;
    const bf16_t* vg = a.Vt + (size_t)(h0 * 64 + kkey) * T + rowb + kch * 8;
    const float* fg0 = a.FH2 + (size_t)(b * 8 + h0) * S;
    const float* fg = fg0 + (size_t)hsw * S;
    const int k_l = kkey * C::KROW + kch * 16, k2_l = (tid >> 2) * C::KROW + 128 + (tid & 3) * 16, v_l = C::K_BYTES + kkey * C::VROW + (kch >> 1) * 32 + (kch & 1) * 8, f_l = C::K_BYTES + C::V_BYTES + tid * 4;
    u32x4 sk[HP], sv[HP], sk2; float sf[HP];
#pragma unroll
    for (int hs = 0; hs < HP; ++hs) sf[hs] = 0.f;
#define ATT_LOAD(j) do { _Pragma("unroll") for (int hs_ = 0; hs_ < HP; ++hs_) { sk[hs_] = *(const u32x4*)(kg + (size_t)(j) * 64 * a.ldk + hs_ * 64); sv[hs_] = *(const u32x4*)(vg + (size_t)hs_ * 64 * T + (j) * 64); \
            if (MODE == 1) { if (tid < 64) sf[hs_] = fg0[(size_t)hs_ * S + (j) * 64 + tid]; } } \
        if (MODE == 2) { if (tid < 256) sk2 = *(const u32x4*)(k2g + (size_t)(j) * 64 * 256); } } while (0)
#define ATT_STORE(bufo) do { _Pragma("unroll") for (int hs_ = 0; hs_ < HP; ++hs_) { const int bo_ = (bufo) + hs_ * C::TILE; *(PG8_LAS u32x4*)(lds + bo_ + k_l) = sk[hs_]; \
            *(PG8_LAS u32x2*)(lds + bo_ + v_l) = (u32x2){sv[hs_][0], sv[hs_][1]}; *(PG8_LAS u32x2*)(lds + bo_ + v_l + 16) = (u32x2){sv[hs_][2], sv[hs_][3]}; \
            if (MODE == 1) { if (tid < 64) { const float f_ = sf[hs_]; const unsigned h1_ = pk_bf16(f_, 0.f) & 0xffffu; const float r1_ = f_ - bflo(h1_); const unsigned h2_ = pk_bf16(r1_, 0.f) & 0xffffu; const float r2_ = r1_ - bflo(h2_); const unsigned h3_ = pk_bf16(r2_, 0.f) & 0xffffu; \
                *(PG8_LAS u32x4*)(lds + bo_ + tid * C::KROW + 128) = (u32x4){h1_ | (h2_ << 16), h3_, 0u, 0u}; *(PG8_LAS u32x4*)(lds + bo_ + tid * C::KROW + 144) = (u32x4){0u, 0u, 0u, 0u}; } } } \
        if (MODE == 2) { if (tid < 256) *(PG8_LAS u32x4*)(lds + (bufo) + k2_l) = sk2; } } while (0)
    { const int j0 = (MODE != 2) ? jmax : 0; ATT_LOAD(j0); }
    float qn = 0.f;
    if (MODE == 1) {
#pragma unroll
        for (int ks = 0; ks < NKS; ++ks)
#pragma unroll
            for (int e = 0; e < 8; ++e) { const float qv = __uint_as_float(((unsigned)(unsigned short)qf[ks][e]) << 16); qn += qv * qv; }
        qn = sqrtf(swap_sum(qn)) * 1.001f; }
    f32x16 o[2];
#pragma unroll
    for (int i = 0; i < 16; ++i) { o[0][i] = 0.f; o[1][i] = 0.f; }
    float R = 0.f; bool first = true;
    f32x16 lacc;
#pragma unroll
    for (int i = 0; i < 16; ++i) lacc[i] = 0.f;
    float fht = 0.f; if (MODE == 1) fht = fg[qw + r32];
    f32x16 negm;
#pragma unroll
    for (int i = 0; i < 16; ++i) negm[i] = (MODE == 0) ? 0.f : fht;
    const int qi = qw + r32;
    const int nt = jmax + 1;
    PG8_LAS int* dflag = (PG8_LAS int*)(lds + 2 * BUF);
    PG8_LAS float* kpm0 = (PG8_LAS float*)(lds + 2 * BUF + 64);
    PG8_LAS float* kpm = kpm0 + hsw * 64;
    PG8_LAS float* fedge = kpm + 32;
    if (MODE != 2) { if (tid < 8) dflag[tid] = 0; }
    if (MODE == 1) { if (tid < 32 * HP) { const int hs = tid >> 5, ti = tid & 31; float v = a.KMAXT[(b * 8 + h0 + hs) * 32 + ti];
#pragma unroll
            for (int o = 1; o < 32; o <<= 1) { const float u_ = __shfl_up(v, o, 32); if (ti >= o) v = fmaxf(v, u_); }
            kpm0[hs * 64 + ti] = v; kpm0[hs * 64 + 32 + ti] = fg0[(size_t)hs * S + 64 * (ti + 1) - 1]; } }
    ATT_STORE(0);
    __syncthreads();
    for (int it = 0; it < nt; ++it) {
        const int j = (MODE != 2) ? (jmax - it) : it;
        const int bufo = (it & 1) * BUF, nbufo = ((it + 1) & 1) * BUF;
        const bool more = (it + 1 < nt);
        if (more) { const int jn = (MODE != 2) ? (j - 1) : (j + 1); ATT_LOAD(jn); }
        if (j <= jw) {
            f32x16 p0 = negm, p1 = negm;
            { const PG8_LAS unsigned char* kb = lds + bufo + hoff + r32 * C::KROW + hi * 16;
              __builtin_amdgcn_s_setprio(1);
#pragma unroll
              for (int ks = 0; ks < NKX; ++ks) {
                  const bf16x8 a0 = *(const PG8_LAS bf16x8*)(kb + ks * 32), a1 = *(const PG8_LAS bf16x8*)(kb + 32 * C::KROW + ks * 32);
                  p0 = __builtin_amdgcn_mfma_f32_32x32x16_bf16(a0, qf[ks], p0, 0, 0, 0);
                  p1 = __builtin_amdgcn_mfma_f32_32x32x16_bf16(a1, qf[ks], p1, 0, 0, 0); }
              __builtin_amdgcn_s_setprio(0); }
            const int kbase = j * 64 + 4 * hi;
            if (MODE != 0) {
                if (MODE == 1 && j == jw) {
#pragma unroll
                    for (int i = 0; i < 16; ++i) { const int kp = kbase + 8 * (i >> 2) + (i & 3); if (kp > qi) p0[i] = -INFINITY; if (kp + 32 > qi) p1[i] = -INFINITY; }
                }
                float mx = __builtin_fmaxf(__builtin_fmaxf(p0[0], p0[1]), p1[0]), mx2 = __builtin_fmaxf(__builtin_fmaxf(p0[2], p0[3]), p1[1]);
                mx = __builtin_fmaxf(__builtin_fmaxf(mx, p1[2]), p1[3]);
#pragma unroll
                for (int i = 4; i < 16; i += 4) { mx = __builtin_fmaxf(__builtin_fmaxf(mx, p0[i]), p0[i + 1]); mx2 = __builtin_fmaxf(__builtin_fmaxf(mx2, p0[i + 2]), p0[i + 3]);
                    mx = __builtin_fmaxf(__builtin_fmaxf(mx, p1[i]), p1[i + 1]); mx2 = __builtin_fmaxf(__builtin_fmaxf(mx2, p1[i + 2]), p1[i + 3]); }
                mx = swap_max(__builtin_fmaxf(mx, mx2));
                if (first || __any(mx > 8.0f)) {
                    const float dl = first ? mx : __builtin_fmaxf(mx, 0.f);
                    const float alpha = first ? 0.f : __builtin_amdgcn_exp2f(-dl);
#pragma unroll
                    for (int i = 0; i < 16; ++i) { p0[i] -= dl; p1[i] -= dl; negm[i] -= dl; o[0][i] *= alpha; o[1][i] *= alpha; lacc[i] *= alpha; }
                    first = false;
                }
#pragma unroll
                for (int i = 0; i < 16; ++i) { p0[i] = __builtin_amdgcn_exp2f(p0[i]); p1[i] = __builtin_amdgcn_exp2f(p1[i]); }
            } else {
                const bool diag = (j == jw);
#pragma unroll
                for (int blk = 1; blk >= 0; --blk) {
                    f32x16& pz = blk ? p1 : p0;
                    float L[16];
#pragma unroll
                    for (int i = 0; i < 16; ++i) { const float z = pz[i]; float l = fmaxf(z, 0.f) + __builtin_amdgcn_logf(1.f + __builtin_amdgcn_exp2f(-fabsf(z)));
                        if (diag) { const int kp = kbase + 32 * blk + 8 * (i >> 2) + (i & 3); if (kp >= qi) l = 0.f; }
                        L[i] = l; }
                    float tail = R;
#pragma unroll
                    for (int g = 3; g >= 0; --g) {
                        const float s3 = L[4 * g + 3], s2 = s3 + L[4 * g + 2], s1 = s2 + L[4 * g + 1], s0 = s1 + L[4 * g];
                        const float gp = swap_other(s0, hi);
                        const float base = tail + (hi ? 0.f : gp);
                        tail += s0 + gp;
                        const float c0 = base + s0, c1 = base + s1, c2 = base + s2, c3 = base + s3;
                        pz[4 * g] = __builtin_amdgcn_exp2f(pz[4 * g] - c0); pz[4 * g + 1] = __builtin_amdgcn_exp2f(pz[4 * g + 1] - c1);
                        pz[4 * g + 2] = __builtin_amdgcn_exp2f(pz[4 * g + 2] - c2); pz[4 * g + 3] = __builtin_amdgcn_exp2f(pz[4 * g + 3] - c3);
                    }
                    R = tail;
                    if (diag) {
#pragma unroll
                        for (int i = 0; i < 16; ++i) { const int kp = kbase + 32 * blk + 8 * (i >> 2) + (i & 3); if (kp >= qi) pz[i] = 0.f; }
                    }
                }
            }
            bf16x8 pf[4];
#pragma unroll
            for (int s = 0; s < 4; ++s) { const f32x16& pp = (s < 2) ? p0 : p1; const int o8 = (s & 1) * 8; u32x4 w;
                w[0] = pk_bf16(pp[o8], pp[o8 + 1]); w[1] = pk_bf16(pp[o8 + 2], pp[o8 + 3]); w[2] = pk_bf16(pp[o8 + 4], pp[o8 + 5]); w[3] = pk_bf16(pp[o8 + 6], pp[o8 + 7]);
                pf[s] = __builtin_bit_cast(bf16x8, w); }
            __builtin_amdgcn_s_setprio(1);
            if (MODE != 0) {
#pragma unroll
                for (int s = 0; s < 4; ++s) lacc = __builtin_amdgcn_mfma_f32_32x32x16_bf16(ones8, pf[s], lacc, 0, 0, 0); }
            { const PG8_LAS unsigned char* vb = lds + bufo + hoff + C::K_BYTES + r32 * C::VROW + hi * 16;
#pragma unroll
              for (int db = 0; db < 2; ++db)
#pragma unroll
                  for (int s = 0; s < 4; ++s) o[db] = __builtin_amdgcn_mfma_f32_32x32x16_bf16(*(const PG8_LAS bf16x8*)(vb + db * 32 * C::VROW + s * 32), pf[s], o[db], 0, 0, 0); }
            __builtin_amdgcn_s_setprio(0);
        }
        if (more) ATT_STORE(nbufo);
        if (MODE == 0) {
            if (j <= jw) { const bool dn = __all(R >= 150.f) != 0; if (lane == 0) dflag[wid] = dn ? 1 : 0; }
        }
        if (MODE == 1) {
            if (j <= jw) { bool dn = true; if (j > 0) { const float bnd = qn * kpm[j - 1] + negm[0] - fedge[j - 1]; dn = __all(bnd < -150.f) != 0; } if (lane == 0) dflag[wid] = dn ? 1 : 0; }
        }
        LDS_BARRIER();
        if (MODE != 2) { const u32x4 f0 = *(const PG8_LAS u32x4*)dflag, f1 = *(const PG8_LAS u32x4*)(dflag + 4);
            if ((f0[0] & f0[1] & f0[2] & f0[3] & f1[0] & f1[1] & f1[2] & f1[3]) != 0u) break; }
    }
    if (MODE != 2) __syncthreads();
    float inv = 1.f;
    if (MODE != 0) inv = 1.0f / lacc[0];
    { bf16_t* op = a.O + (rowb + qw + r32) * a.ldo + h * 64 + 4 * hi;
#pragma unroll
      for (int db = 0; db < 2; ++db)
#pragma unroll
          for (int g = 0; g < 4; ++g) st_bf16x4(op + db * 32 + g * 8, (f32x4){o[db][4 * g] * inv, o[db][4 * g + 1] * inv, o[db][4 * g + 2] * inv, o[db][4 * g + 3] * inv}); }
#undef ATT_LOAD
#undef ATT_STORE
}
}

constexpr size_t O_XT = R_XQ, O_BN = R_XQ + 64 * MiB, O_CN = R_XQ + 80 * MiB, O_BT = R_A2 + 96 * MiB;
__device__ __forceinline__ void ph_conv2(const P& p, unsigned char* smem, int bid, int nblk, int tid_) {
    int tid = tid_; asm volatile("" : "+v"(tid));
    const bf16_t* XR = wsp<bf16_t>(p, R_A2);
    bf16_t* tile = (bf16_t*)smem;
    const int tg = tid >> 3, cg = tid & 7;
    constexpr int NH = 4;
    constexpr int NITEM = 24 * 16 * (32 / NH);
    const int hfw = tg >> 4, lw0 = 4 * (tg & 15);
    u32x4 rw[7]; f32x4 wv[4][2]; f32x4 bv[2];
#define CONV_LOAD(it_) do { const int cb_ = (it_) / (16 * (32 / NH)), bc_ = (it_) % (16 * (32 / NH)), b_ = bc_ / (32 / NH), c0_ = (bc_ % (32 / NH)) * NH, ch0_ = cb_ * 64 + cg * 8; \
        const int s0_ = c0_ * 64 + 4 * tg; const size_t t0_ = (size_t)b_ * S + s0_; \
        _Pragma("unroll") for (int r = 0; r < 7; ++r) { const bool ok_ = s0_ - 3 + r >= 0; rw[r] = *(const u32x4*)(XR + (ok_ ? (t0_ - 3 + r) : t0_) * 1536 + ch0_); }   \
        bv[0] = *(const f32x4*)(p.ev_conv_b + ch0_); bv[1] = *(const f32x4*)(p.ev_conv_b + ch0_ + 4); \
        _Pragma("unroll") for (int k = 0; k < 4; ++k) { wv[k][0] = *(const f32x4*)(p.ev_conv_w + k * 1536 + ch0_); wv[k][1] = *(const f32x4*)(p.ev_conv_w + k * 1536 + ch0_ + 4); } } while (0)
    if (bid < NITEM) CONV_LOAD(bid);
    for (int it = bid; it < NITEM; it += nblk) {
        const int cb = it / (16 * (32 / NH)), bc = it % (16 * (32 / NH)), b = bc / (32 / NH), c0 = (bc % (32 / NH)) * NH;
        const int s0 = c0 * 64 + 4 * tg;
        f32x2 ur[7][4];
#pragma unroll
        for (int r = 0; r < 7; ++r) { const bool ok = s0 - 3 + r >= 0;
#pragma unroll
            for (int j = 0; j < 4; ++j) ur[r][j] = ok ? (f32x2){bflo(rw[r][j]), bfhi(rw[r][j])} : (f32x2){0.f, 0.f}; }
        u32x4 ov[4];
#pragma unroll
        for (int i = 0; i < 4; ++i) {
            f32x2 acc2[4] = {{bv[0][0], bv[0][1]}, {bv[0][2], bv[0][3]}, {bv[1][0], bv[1][1]}, {bv[1][2], bv[1][3]}};
#pragma unroll
            for (int k = 0; k < 4; ++k)
#pragma unroll
                for (int j = 0; j < 4; ++j) acc2[j] = __builtin_elementwise_fma((f32x2){wv[k][j >> 1][(j & 1) * 2], wv[k][j >> 1][(j & 1) * 2 + 1]}, ur[i + k][j], acc2[j]);
#pragma unroll
            for (int j = 0; j < 4; ++j) ov[i][j] = pk_bf16(silu_f(acc2[j][0]), silu_f(acc2[j][1]));
        }
        { const int itn = it + nblk; if (itn < NITEM) CONV_LOAD(itn); }
        if (cb >= 16) { bf16_t* nat = wsp<bf16_t>(p, O_BN + (cb >= 20 ? 16 * MiB : 0));
#pragma unroll
            for (int i = 0; i < 4; ++i) *(u32x4*)(nat + ((size_t)b * S + s0 + i) * 256 + ((cb - 16) & 3) * 64 + cg * 8) = ov[i]; }
        if (cb < 20) {
#pragma unroll
            for (int i = 0; i < 4; ++i) *(u32x4*)(tile + hfw * 64 * 72 + (lw0 + i) * 72 + cg * 8) = ov[i];
            LDS_BARRIER();
            const int r = tid >> 3, lg = tid & 7;
#pragma unroll
            for (int hf = 0; hf < NH; ++hf) { u32x4 tv; const int c = c0 + hf;
#pragma unroll
                for (int j = 0; j < 4; ++j) tv[j] = (unsigned)tile[hf * 64 * 72 + (lg * 8 + 2 * j) * 72 + r] | ((unsigned)tile[hf * 64 * 72 + (lg * 8 + 2 * j + 1) * 72 + r] << 16);
                bf16_t* dst;
                if (cb < 16) dst = wsp<bf16_t>(p, O_XT) + ((((size_t)(b * 16 + cb)) * 32 + c) * 64 + r) * 64 + lg * 8;
                else { const int g = (cb - 16) >> 1, n = ((cb - 16) & 1) * 64 + r; dst = wsp<bf16_t>(p, O_BT) + ((((size_t)(b * 2 + g)) * 32 + c) * 128 + n) * 64 + lg * 8; }
                *(u32x4*)dst = tv; }
            LDS_BARRIER();
        }
    }
}
#undef CONV_LOAD
namespace ssd {
typedef short bf16x8 __attribute__((ext_vector_type(8)));
typedef float f32x16 __attribute__((ext_vector_type(16)));
constexpr int RC = 272, RS = 144;
constexpr int O_CM = 0, O_BM = O_CM + 64 * RC, O_BMT = O_BM + 64 * RC, O_XST = O_BMT + 128 * RS, O_XDT = O_XST + 2 * 64 * RS, O_M = O_XDT + 64 * RS, O_HB = O_M + 64 * RS, O_TAB = O_HB + 64 * RC, LDS_END = O_TAB + 2 * 1024;
static_assert(LDS_END <= 128 * 1024, "ssd lds");
#define SSD_FRAG(off) (*(const PG8_LAS bf16x8*)(lds + (off)))
__device__ __forceinline__ void ssd_unit(const P& p, int b, int h, unsigned char* smem, int tid_) {
    int tid = tid_; asm volatile("" : "+v"(tid));
    const int lane = tid & 63, wid = __builtin_amdgcn_readfirstlane(tid >> 6), r32 = lane & 31, hi = lane >> 5;
    PG8_LAS unsigned char* lds = (PG8_LAS unsigned char*)smem;
    const int g = h >> 3;
    const float a = -expf(p.ev_a_log[h]), dsk = p.ev_d_skip[h];
    const bf16_t* XTu = wsp<bf16_t>(p, O_XT) + ((size_t)(b * 16 + h) * 32) * 4096 + tid * 8;
    const bf16_t* BTu = wsp<bf16_t>(p, O_BT) + ((size_t)(b * 2 + g) * 32) * 8192 + tid * 8;
    const bf16_t* BNu = wsp<bf16_t>(p, O_BN) + ((size_t)b * S + (tid >> 4)) * 256 + g * 128 + (tid & 15) * 8;
    const bf16_t* CNu = wsp<bf16_t>(p, O_CN) + ((size_t)b * S + (tid >> 4)) * 256 + g * 128 + (tid & 15) * 8;
    const float* DTu = wsp<float>(p, OFF_DT) + ((size_t)b * S + lane) * 16 + h;
    const bf16_t* Zu = wsp<bf16_t>(p, R_XBZ + 64 * MiB) + ((size_t)b * S) * 1024 + h * 64;
    bf16_t* A2u = wsp<bf16_t>(p, R_A2) + ((size_t)b * S) * 1536 + h * 64;
    float* SSQu = wsp<float>(p, OFF_SSQ) + ((size_t)b * S) * 32 + h * 2;
    u32x4 rxA, rbA[2], rbtA[2], rcA[2], rxB, rbB[2], rbtB[2], rcB[2]; float rdtA = 0.f, rdtB = 0.f;
#define SSD_LOAD(c, P) do { rx##P = *(const u32x4*)(XTu + (size_t)(c) * 4096); \
        rbt##P[0] = *(const u32x4*)(BTu + (size_t)(c) * 8192); rbt##P[1] = *(const u32x4*)(BTu + (size_t)(c) * 8192 + 4096); \
        rb##P[0] = *(const u32x4*)(BNu + (size_t)(c) * 64 * 256); rb##P[1] = *(const u32x4*)(BNu + ((size_t)(c) * 64 + 32) * 256); \
        rc##P[0] = *(const u32x4*)(CNu + (size_t)(c) * 64 * 256); rc##P[1] = *(const u32x4*)(CNu + ((size_t)(c) * 64 + 32) * 256); \
        if (wid == 2) rdt##P = DTu[(size_t)(c) * 64 * 16]; } while (0)
#define SSD_TABLES(par, P) do { PG8_LAS float* tb_ = (PG8_LAS float*)(lds + O_TAB + (par) * 1024); float x_ = rdt##P * a; \
        _Pragma("unroll") for (int o_ = 1; o_ < 64; o_ <<= 1) { const float y_ = __shfl_up(x_, o_); if (lane >= o_) x_ += y_; } \
        const float a63_ = __shfl(x_, 63); tb_[lane] = x_; tb_[64 + lane] = rdt##P; tb_[128 + lane] = rdt##P * __expf(a63_ - x_); tb_[192 + lane] = __expf(x_); } while (0)
#define SSD_FILL(c, P) do { const int par_ = (c) & 1; const PG8_LAS float* tw = (const PG8_LAS float*)(lds + O_TAB + par_ * 1024 + 512) + (tid & 7) * 8; \
        *(PG8_LAS u32x4*)(lds + O_XST + par_ * 64 * RS + (tid >> 3) * RS + (tid & 7) * 16) = rx##P; \
        { const f32x4 w0_ = *(const PG8_LAS f32x4*)tw, w1_ = *(const PG8_LAS f32x4*)(tw + 4); u32x4 xd_; \
          xd_[0] = pk_bf16(bflo(rx##P[0]) * w0_[0], bfhi(rx##P[0]) * w0_[1]); xd_[1] = pk_bf16(bflo(rx##P[1]) * w0_[2], bfhi(rx##P[1]) * w0_[3]); \
          xd_[2] = pk_bf16(bflo(rx##P[2]) * w1_[0], bfhi(rx##P[2]) * w1_[1]); xd_[3] = pk_bf16(bflo(rx##P[3]) * w1_[2], bfhi(rx##P[3]) * w1_[3]); \
          *(PG8_LAS u32x4*)(lds + O_XDT + (tid >> 3) * RS + (tid & 7) * 16) = xd_; } \
        *(PG8_LAS u32x4*)(lds + O_BMT + (tid >> 3) * RS + (tid & 7) * 16) = rbt##P[0]; *(PG8_LAS u32x4*)(lds + O_BMT + (64 + (tid >> 3)) * RS + (tid & 7) * 16) = rbt##P[1]; \
        *(PG8_LAS u32x4*)(lds + O_BM + (tid >> 4) * RC + (tid & 15) * 16) = rb##P[0]; *(PG8_LAS u32x4*)(lds + O_BM + (32 + (tid >> 4)) * RC + (tid & 15) * 16) = rb##P[1]; \
        *(PG8_LAS u32x4*)(lds + O_CM + (tid >> 4) * RC + (tid & 15) * 16) = rc##P[0]; *(PG8_LAS u32x4*)(lds + O_CM + (32 + (tid >> 4)) * RC + (tid & 15) * 16) = rc##P[1]; } while (0)
    for (int i = tid; i < 64 * RC / 16; i += NTHR) *(PG8_LAS u32x4*)(lds + O_HB + i * 16) = (u32x4){0u, 0u, 0u, 0u};
    f32x16 acch, accy;
#pragma unroll
    for (int i = 0; i < 16; ++i) { acch[i] = 0.f; accy[i] = 0.f; }
    const int nb = wid >> 1, pbh = wid & 1;
    const int w4 = wid & 3, t_a = w4 >> 1, t_b = w4 & 1;
#define SSD_BODY(c, P, Q) do { \
        const int par = (c) & 1; \
        if ((c) + 2 < 32) SSD_LOAD((c) + 2, P); \
        u32x2 zz[4] = {}; \
        if (wid >= 4) { \
_Pragma("unroll") \
            for (int g_ = 0; g_ < 4; ++g_) zz[g_] = *(const u32x2*)(Zu + ((size_t)(c) * 64 + 32 * t_b + r32) * 1024 + 32 * t_a + 8 * g_ + 4 * hi); } \
        LDS_BARRIER(); \
        const PG8_LAS float* tb = (const PG8_LAS float*)(lds + O_TAB + par * 1024); \
        { const float d63 = tb[192 + 63]; \
_Pragma("unroll") \
          for (int i = 0; i < 16; ++i) acch[i] *= d63; } \
        if (wid < 4) { \
            f32x16 cbt; \
_Pragma("unroll") \
            for (int i = 0; i < 16; ++i) cbt[i] = 0.f; \
            if (t_a <= t_b) { \
_Pragma("unroll") \
                for (int ks = 0; ks < 8; ++ks) { cbt = __builtin_amdgcn_mfma_f32_32x32x16_bf16(SSD_FRAG(O_BM + (32 * t_a + r32) * RC + ks * 32 + hi * 16), SSD_FRAG(O_CM + (32 * t_b + r32) * RC + ks * 32 + hi * 16), cbt, 0, 0, 0); \
                    if (ks < 4) { acch = __builtin_amdgcn_mfma_f32_32x32x16_bf16(SSD_FRAG(O_BMT + (32 * nb + r32) * RS + ks * 32 + hi * 16), SSD_FRAG(O_XDT + (32 * pbh + r32) * RS + ks * 32 + hi * 16), acch, 0, 0, 0); } } \
            } else { \
_Pragma("unroll") \
                for (int ks = 0; ks < 4; ++ks) { acch = __builtin_amdgcn_mfma_f32_32x32x16_bf16(SSD_FRAG(O_BMT + (32 * nb + r32) * RS + ks * 32 + hi * 16), SSD_FRAG(O_XDT + (32 * pbh + r32) * RS + ks * 32 + hi * 16), acch, 0, 0, 0); } \
            } \
            const int l = 32 * t_b + r32; const float Al = tb[l]; \
_Pragma("unroll") \
            for (int g_ = 0; g_ < 4; ++g_) { const int s0 = 32 * t_a + 8 * g_ + 4 * hi; \
                const f32x4 As = *(const PG8_LAS f32x4*)(tb + s0), ds = *(const PG8_LAS f32x4*)(tb + 64 + s0); \
                float m[4]; \
_Pragma("unroll") \
                for (int j = 0; j < 4; ++j) m[j] = (s0 + j <= l) ? cbt[4 * g_ + j] * __expf(Al - As[j]) * ds[j] : 0.f; \
                *(PG8_LAS u32x2*)(lds + O_M + l * RS + s0 * 2) = (u32x2){pk_bf16(m[0], m[1]), pk_bf16(m[2], m[3])}; } \
            if (wid == 2 && (c) + 1 < 32) SSD_TABLES(((c) + 1) & 1, Q); \
        } else { \
_Pragma("unroll") \
            for (int i = 0; i < 16; ++i) accy[i] = 0.f; \
_Pragma("unroll") \
            for (int ks = 0; ks < 8; ++ks) { accy = __builtin_amdgcn_mfma_f32_32x32x16_bf16(SSD_FRAG(O_HB + (32 * t_a + r32) * RC + ks * 32 + hi * 16), SSD_FRAG(O_CM + (32 * t_b + r32) * RC + ks * 32 + hi * 16), accy, 0, 0, 0); \
                if (ks < 4) { acch = __builtin_amdgcn_mfma_f32_32x32x16_bf16(SSD_FRAG(O_BMT + (32 * nb + r32) * RS + ks * 32 + hi * 16), SSD_FRAG(O_XDT + (32 * pbh + r32) * RS + ks * 32 + hi * 16), acch, 0, 0, 0); } } \
            const float eAl = tb[192 + 32 * t_b + r32]; \
_Pragma("unroll") \
            for (int i = 0; i < 16; ++i) accy[i] *= eAl; \
        } \
        LDS_BARRIER(); \
_Pragma("unroll") \
        for (int g_ = 0; g_ < 4; ++g_) *(PG8_LAS u32x2*)(lds + O_HB + (32 * pbh + r32) * RC + (32 * nb + 8 * g_ + 4 * hi) * 2) = (u32x2){pk_bf16(acch[4 * g_], acch[4 * g_ + 1]), pk_bf16(acch[4 * g_ + 2], acch[4 * g_ + 3])}; \
        if (wid >= 4) { \
            const int l = 32 * t_b + r32; const size_t trow = (size_t)(c) * 64 + l; \
_Pragma("unroll") \
            for (int ks = 0; ks < 4; ++ks) accy = __builtin_amdgcn_mfma_f32_32x32x16_bf16(SSD_FRAG(O_XST + par * 64 * RS + (32 * t_a + r32) * RS + ks * 32 + hi * 16), SSD_FRAG(O_M + (32 * t_b + r32) * RS + ks * 32 + hi * 16), accy, 0, 0, 0); \
            float ss = 0.f; \
_Pragma("unroll") \
            for (int g_ = 0; g_ < 4; ++g_) { const int p0 = 32 * t_a + 8 * g_ + 4 * hi; float u[4]; \
                const float z4[4] = {bflo(zz[g_][0]), bfhi(zz[g_][0]), bflo(zz[g_][1]), bfhi(zz[g_][1])}; \
_Pragma("unroll") \
                for (int j = 0; j < 4; ++j) { const float xs = bf2f(*(const PG8_LAS bf16_t*)(lds + O_XST + par * 64 * RS + (p0 + j) * RS + l * 2)); \
                    u[j] = (accy[4 * g_ + j] + dsk * xs) * silu_f(z4[j]); ss += u[j] * u[j]; } \
                st_bf16x4(A2u + trow * 1536 + p0, (f32x4){u[0], u[1], u[2], u[3]}); } \
            ss = att::swap_sum(ss); \
            if (hi == 0) SSQu[trow * 32 + t_a] = ss; \
        } \
        if ((c) + 1 < 32) SSD_FILL((c) + 1, Q); \
    } while (0)
    SSD_LOAD(0, A); SSD_LOAD(1, B);
    if (wid == 2) SSD_TABLES(0, A);
    __syncthreads();
    SSD_FILL(0, A);
    for (int c2 = 0; c2 < 32; c2 += 2) { SSD_BODY(c2, A, B); SSD_BODY(c2 + 1, B, A); }
    __syncthreads();
#undef SSD_LOAD
#undef SSD_BODY
#undef SSD_TABLES
#undef SSD_FILL
}
#undef SSD_FRAG
}
__device__ __forceinline__ void ph_ssd_mf(const P& p, unsigned char* smem, int bid, int nblk, int tid_) {
    for (int u = bid; u < NB * 16; u += nblk) ssd::ssd_unit(p, u >> 4, u & 15, smem, tid_);
}

__device__ __forceinline__ void hp_unit(int bid, int nblk, int i, int& b, int& h0, int& blk) {
    int pairidx;
    if (nblk == 256) { pairidx = (bid >> 4) + 16 * i; blk = ((bid & 15) + 4 * i) & 15; } else { const int u = bid + nblk * i; pairidx = u >> 4; blk = u & 15; }
    b = pairidx >> 2; h0 = (pairidx & 3) * 2;
}
constexpr size_t OFF_WQ = OFF_CTRL + 1024;
template <int MODE> __device__ __forceinline__ void hp_dynamic(const att::Args& a, unsigned* ctr, unsigned char* smem, int bid, int nblk, int tid_) {
    PG8_LAS int* slot = (PG8_LAS int*)(LDSP(smem) + 140 * 1024);
    int u = bid;
    while (u < 1024) {
        unsigned nxt = 0u;
        if (tid_ == 0) nxt = __hip_atomic_fetch_add(ctr, 1u, __ATOMIC_RELAXED, __HIP_MEMORY_SCOPE_AGENT);
        const int blk = 15 - (u >> 6), pairidx = u & 63;
        att::attn_unit<MODE, 2>(a, pairidx >> 2, (pairidx & 3) * 2, blk, smem, tid_);
        if (tid_ == 0) *slot = nblk + (int)nxt;
        __syncthreads();
        u = *slot;
        __syncthreads();
    }
}
__device__ __forceinline__ void ph_sb_mf(const P& p, unsigned char* smem, int bid, int nblk, int tid_) {
    att::Args a{wsp<bf16_t>(p, R_XQ + 96 * MiB), 512, wsp<bf16_t>(p, R_XQ + 128 * MiB), 512, nullptr, wsp<bf16_t>(p, R_XQ + 160 * MiB), wsp<bf16_t>(p, R_A2) + 1024, 1536, nullptr, nullptr};
    hp_dynamic<0>(a, wsp<unsigned>(p, OFF_WQ), smem, bid, nblk, tid_);
}
__device__ __forceinline__ void ph_attn1_mf(const P& p, unsigned char* smem, int bid, int nblk, int tid_) {
    att::Args am{wsp<bf16_t>(p, R_A2), 768, wsp<bf16_t>(p, R_A2 + 48 * MiB), 512, wsp<bf16_t>(p, R_XBZ + 16 * MiB), wsp<bf16_t>(p, R_A2 + 80 * MiB), wsp<bf16_t>(p, R_XQ), 1024, nullptr, nullptr};
    att::Args af{wsp<bf16_t>(p, R_XBZ + 32 * MiB), 512, wsp<bf16_t>(p, R_XBZ + 64 * MiB), 512, nullptr, wsp<bf16_t>(p, R_XBZ + 96 * MiB), wsp<bf16_t>(p, R_XQ) + 512, 1024, wsp<float>(p, OFF_DT + 1 * MiB), wsp<float>(p, OFF_SSQ + 1 * MiB)};
    for (int pi = bid; pi < 512; pi += nblk) { const int bh = pi >> 2, pr = pi & 3;
        att::attn_unit<2>(am, bh >> 3, bh & 7, 7 - pr, smem, tid_); att::attn_unit<2>(am, bh >> 3, bh & 7, pr, smem, tid_); }
    hp_dynamic<1>(af, wsp<unsigned>(p, OFF_WQ) + 16, smem, bid, nblk, tid_);
}
template <int N, int OFF, int NTOT> __device__ __forceinline__ void tred_rec(float (&v)[NTOT], int lane) {
    if constexpr (N > 1) {
        const bool up = (lane & OFF) != 0;
#pragma unroll
        for (int i = 0; i < N / 2; ++i) { const float keep = up ? v[i + N / 2] : v[i], send = up ? v[i] : v[i + N / 2];
            float got;
            if constexpr (OFF == 32) got = other32(send, up); else if constexpr (OFF == 16) got = other16(send, up); else if constexpr (OFF == 8) got = dpp_f<0x128>(send); else got = __shfl_xor(send, OFF);
            v[i] = keep + got; }
        tred_rec<N / 2, OFF / 2, NTOT>(v, lane);
    }
}
template <int N> __device__ __forceinline__ float tred(float (&v)[N], int lane) {
    tred_rec<N, 32, N>(v, lane);
    return group_sum<64 / N>(v[0]);
}
template <int N> __device__ __forceinline__ int tred_idx(int lane) { return lane / (64 / N); }
__device__ __forceinline__ int kpos(int k) { return (k & 1) * 512 + (k >> 1); }

struct TBuf { float v[4][8]; float g[8]; bf16_t* d; int ro[4]; int zm, gf; };
__device__ __forceinline__ void tconv_finish(const TBuf& pd, float* tile, int tid) {
    const int cq = tid & 63, rk = tid >> 6;
    const int wr_ = tid >> 3, wk = (tid & 7) * 8;
#pragma unroll
    for (int c = 0; c < 4; ++c)
#pragma unroll
        for (int i = 0; i < 8; ++i) { const float gv = pd.gf ? pd.g[i] : 1.f; tile[(rk + 8 * i) * 257 + cq + 64 * c] = ((pd.zm >> c) & 1) ? 0.f : pd.v[c][i] * gv; }
    LDS_BARRIER();
#pragma unroll
    for (int c = 0; c < 4; ++c) { u32x4 w;
#pragma unroll
      for (int j = 0; j < 4; ++j) w[j] = pk_bf16(tile[(wk + 2 * j) * 257 + wr_ + 64 * c], tile[(wk + 2 * j + 1) * 257 + wr_ + 64 * c]);
      *(u32x4*)(pd.d + pd.ro[c]) = w; }
    LDS_BARRIER();
}
template <bool GAIN, class Map> __device__ __forceinline__ void tconv(bf16_t* dst, const float* src, int src_ld, int K, const Map& map, const float* gain, int gain_n,
                                                          int nbatch, size_t dst_bstride, size_t src_bstride, float* tile, int bid, int nblk, int tid, int& toff, TBuf& A, TBuf& B, int& pp) {
    const int nkt = K / 64, nqt = map.nq / 256, per = nkt * nqt, total = per * nbatch;
    const int first = (bid - toff % nblk + nblk) % nblk;
    toff += total;
    const int cq = tid & 63, rk = tid >> 6;
    const int wr_ = tid >> 3, wk = (tid & 7) * 8;
#define TCONV_LOAD(X) do { \
        X.zm = 0; \
        _Pragma("unroll") for (int c = 0; c < 4; ++c) { const int sc = map.scol(q0 + cq + 64 * c); const int scc = sc < 0 ? 0 : sc; X.zm |= (sc < 0 ? 1 : 0) << c; \
            _Pragma("unroll") for (int i = 0; i < 8; ++i) X.v[c][i] = s[(size_t)(k0 + rk + 8 * i) * src_ld + scc]; } \
        if constexpr (GAIN) { X.gf = k0 < gain_n;             \
            _Pragma("unroll") for (int i = 0; i < 8; ++i) { const int k = k0 + rk + 8 * i; X.g[i] = gain[k < gain_n ? k : 0]; } } \
        else { X.gf = 0; _Pragma("unroll") for (int i = 0; i < 8; ++i) X.g[i] = 1.f; } \
        _Pragma("unroll") for (int c = 0; c < 4; ++c) X.ro[c] = map.drow(q0 + wr_ + 64 * c) * K + k0 + wk; \
        X.d = dst + (size_t)bt * dst_bstride; } while (0)
    for (int tI = first; tI < total; tI += nblk) {
        const int bt = tI / per, rem = tI % per, kt = rem / nqt, qt = rem % nqt, k0 = kt * 64, q0 = qt * 256;
        const float* s = src + (size_t)bt * src_bstride;
        if (pp == 1) { TCONV_LOAD(B); tconv_finish(A, tile, tid); pp = 2; }
        else { TCONV_LOAD(A); if (pp == 2) tconv_finish(B, tile, tid); pp = 1; }
    }
#undef TCONV_LOAD
}
struct MapIn0 { static constexpr int nq = 3584; __device__ __forceinline__ int drow(int q) const { return q; } __device__ __forceinline__ int scol(int q) const { return q < 2560 ? q : (q < 3072 ? 2576 + (q - 2560) : 3088 + (q - 3072)); } };
struct MapOff { int nq, off; __device__ __forceinline__ int drow(int q) const { return q; } __device__ __forceinline__ int scol(int q) const { return off + q; } };
struct MapIn1 { static constexpr int nq = 1536; __device__ __forceinline__ int drow(int q) const { return q; }
    __device__ __forceinline__ int scol(int q) const { if (q < 384) return q; if (q < 416) { const int j = q - 384, i = j >> 1; return 384 + ((j & 1) ? i + 16 : i); } if (q < 512) return -1; if (q < 1024) return 416 + (q - 512); return 928 + (q - 1024); } };
struct MapQup { static constexpr int nq = 768; __device__ __forceinline__ int drow(int q) const { return q; }
    __device__ __forceinline__ int scol(int q) const { const int h = q / 96, j = q % 96; if (j < 64) return q; const int jj = j - 64, i = jj >> 1; return 96 * h + 64 + ((jj & 1) ? i + 16 : i); } };
struct MapKV { static constexpr int nq = 512; int off; __device__ __forceinline__ int drow(int q) const { return q; } __device__ __forceinline__ int scol(int q) const { return 128 * (q >> 6) + off + (q & 63); } };
struct MapGU { static constexpr int nq = 256; int up; __device__ __forceinline__ int drow(int q) const { return 256 * (q >> 7) + 128 * up + (q & 127); } __device__ __forceinline__ int scol(int q) const { return q; } };

__device__ __forceinline__ void ph_prologue2(const P& p, unsigned char* smem, int bid, int nblk, int tid_) {
    int tid = tid_; asm volatile("" : "+v"(tid));
    const int lane = tid & 63, wid = tid >> 6;
    float* wl = (float*)smem;
    { f32x4 w4[8];
#pragma unroll
      for (int j = 0; j < 8; ++j) { const int q = tid + NTHR * j; w4[j] = *(const f32x4*)(p.ev_w_in + (size_t)(q >> 2) * EVEN_IN + 2560 + 4 * (q & 3)); }
#pragma unroll
      for (int j = 0; j < 8; ++j) { const int q = tid + NTHR * j; *(f32x4*)(wl + kpos(q >> 2) * 20 + 4 * (q & 3)) = w4[j]; } }
    __syncthreads();
    { float* DT = wsp<float>(p, OFF_DT); unsigned* XB = wsp<unsigned>(p, R_XBZ);
      const int hsel = tred_idx<16>(lane); const float dtb = p.ev_dt_bias[hsel];
      f32x2 xnx[8];
      { const int t0 = bid * 8 + wid; if (t0 < T) {
#pragma unroll
          for (int i = 0; i < 8; ++i) xnx[i] = ((const f32x2*)(p.x + (size_t)t0 * D))[lane + 64 * i]; } }
      for (int t = bid * 8 + wid; t < T; t += nblk * 8) {
          asm volatile("" ::: "memory");
          f32x2 xv[8];
#pragma unroll
          for (int i = 0; i < 8; ++i) xv[i] = xnx[i];
          { const int tn = t + nblk * 8; if (tn < T) {
#pragma unroll
              for (int i = 0; i < 8; ++i) xnx[i] = ((const f32x2*)(p.x + (size_t)tn * D))[lane + 64 * i]; } }
#pragma unroll
          for (int i = 0; i < 8; ++i) XB[(size_t)t * 512 + lane + 64 * i] = pk_bf16(xv[i][0], xv[i][1]);
          f32x2 accv[8];
#pragma unroll
          for (int h = 0; h < 8; ++h) accv[h] = (f32x2){0.f, 0.f};
#pragma unroll
          for (int i = 0; i < 8; ++i)
#pragma unroll
              for (int c = 0; c < 2; ++c) { const float* wrow = wl + (c * 512 + 64 * i + lane) * 20; const f32x2 xx = {xv[i][c], xv[i][c]};
#pragma unroll
                  for (int h4 = 0; h4 < 4; ++h4) { const f32x4 w4 = *(const f32x4*)(wrow + 4 * h4);
                      accv[2 * h4] = __builtin_elementwise_fma(xx, (f32x2){w4[0], w4[1]}, accv[2 * h4]); accv[2 * h4 + 1] = __builtin_elementwise_fma(xx, (f32x2){w4[2], w4[3]}, accv[2 * h4 + 1]); } }
          float acc[16];
#pragma unroll
          for (int h = 0; h < 8; ++h) { acc[2 * h] = accv[h][0]; acc[2 * h + 1] = accv[h][1]; }
          const float r = tred<16>(acc, lane);
          if ((lane & 3) == 0) DT[(size_t)t * 16 + hsel] = softplus_f(r + dtb);
      } }
    __syncthreads();
    float* tile = (float*)smem;
    int toff = 0, pp = 0; TBuf tbA, tbB;
    tconv<false>(wsp<bf16_t>(p, W0M), p.ev_w_in, EVEN_IN, 1024, MapIn0{}, nullptr, 0, 1, 0, 0, tile, bid, nblk, tid, toff, tbA, tbB, pp);
    tconv<false>(wsp<bf16_t>(p, W0V), p.ev_w_in, EVEN_IN, 1024, MapOff{512, 3600}, nullptr, 0, 1, 0, 0, tile, bid, nblk, tid, toff, tbA, tbB, pp);
    tconv<true>(wsp<bf16_t>(p, W0O), p.ev_w_out, 1024, 1536, MapOff{1024, 0}, p.ev_norm_g, 1024, 1, 0, 0, tile, bid, nblk, tid, toff, tbA, tbB, pp);
    tconv<false>(wsp<bf16_t>(p, W1M), p.od_w_in, ODD_IN, 1024, MapIn1{}, nullptr, 0, 1, 0, 0, tile, bid, nblk, tid, toff, tbA, tbB, pp);
    tconv<false>(wsp<bf16_t>(p, W1V), p.od_w_in, ODD_IN, 1024, MapOff{512, 1440}, nullptr, 0, 1, 0, 0, tile, bid, nblk, tid, toff, tbA, tbB, pp);
    tconv<true>(wsp<bf16_t>(p, W1Q), p.od_w_q_up, 768, 256, MapQup{}, p.od_q_norm_g, 256, 1, 0, 0, tile, bid, nblk, tid, toff, tbA, tbB, pp);
    tconv<true>(wsp<bf16_t>(p, W1K), p.od_w_kv_up, 1024, 128, MapKV{0}, p.od_kv_norm_g, 128, 1, 0, 0, tile, bid, nblk, tid, toff, tbA, tbB, pp);
    tconv<true>(wsp<bf16_t>(p, W1VV), p.od_w_kv_up, 1024, 128, MapKV{64}, p.od_kv_norm_g, 128, 1, 0, 0, tile, bid, nblk, tid, toff, tbA, tbB, pp);
    tconv<false>(wsp<bf16_t>(p, W1O), p.od_w_out, 1024, 1024, MapOff{1024, 0}, nullptr, 0, 1, 0, 0, tile, bid, nblk, tid, toff, tbA, tbB, pp);
    tconv<false>(wsp<bf16_t>(p, WGU), p.moe_w_gate, 256, 1024, MapGU{0}, nullptr, 0, 32, (size_t)512 * 1024, (size_t)1024 * 256, tile, bid, nblk, tid, toff, tbA, tbB, pp);
    tconv<false>(wsp<bf16_t>(p, WGU), p.moe_w_up, 256, 1024, MapGU{1}, nullptr, 0, 32, (size_t)512 * 1024, (size_t)1024 * 256, tile, bid, nblk, tid, toff, tbA, tbB, pp);
    tconv<false>(wsp<bf16_t>(p, WDN), p.moe_w_down, 1024, 256, MapOff{1024, 0}, nullptr, 0, 32, (size_t)1024 * 256, (size_t)256 * 1024, tile, bid, nblk, tid, toff, tbA, tbB, pp);
    if (pp == 1) tconv_finish(tbA, tile, tid); else if (pp == 2) tconv_finish(tbB, tile, tid);
    { const size_t gtid = (size_t)bid * NTHR + tid, gstride = (size_t)nblk * NTHR; float* tab = wsp<float>(p, OFF_TAB);
      for (size_t i = gtid; i < (size_t)S * 16; i += gstride) { const int s = (int)(i >> 4), f = (int)(i & 15);
        double inv = 1.0; for (int k = 0; k < f; ++k) inv *= 0.56234132519034908;
        const double rev = (double)s * inv * 0.15915494309189535; const double fr = rev - floor(rev);
        const double x = fr * 4.0; const double qd = floor(x + 0.5); const int qi = (int)qd & 3;
        const double y = (x - qd) * 1.5707963267948966, y2 = y * y;
        const double sy = y * (1.0 + y2 * (-1.0 / 6 + y2 * (1.0 / 120 + y2 * (-1.0 / 5040 + y2 * (1.0 / 362880 + y2 * (-1.0 / 39916800 + y2 * (1.0 / 6227020800.0)))))));
        const double cy = 1.0 + y2 * (-0.5 + y2 * (1.0 / 24 + y2 * (-1.0 / 720 + y2 * (1.0 / 40320 + y2 * (-1.0 / 3628800 + y2 * (1.0 / 479001600.0 + y2 * (-1.0 / 87178291200.0)))))));
        const double cv = (qi == 0) ? cy : (qi == 1) ? -sy : (qi == 2) ? -cy : sy;
        const double sv = (qi == 0) ? sy : (qi == 1) ? cy : (qi == 2) ? -sy : -cy;
        tab[i] = (float)cv; tab[S * 16 + i] = (float)sv; } }
}

__device__ __forceinline__ void ln_row2(f32x2 (&v)[8], const f32x2 (&g)[8], const f32x2 (&bt)[8]) {
    float s = 0.f;
#pragma unroll
    for (int i = 0; i < 8; ++i) s += v[i][0] + v[i][1];
    const float mu = wave_sum(s) * (1.0f / 1024.0f);
    float q = 0.f;
#pragma unroll
    for (int i = 0; i < 8; ++i) { const f32x2 d = v[i] - mu; q += d[0] * d[0] + d[1] * d[1]; }
    const float rstd = rsqrtf(wave_sum(q) * (1.0f / 1024.0f) + 1e-5f);
#pragma unroll
    for (int i = 0; i < 8; ++i) v[i] = (v[i] - mu) * rstd * g[i] + bt[i];
}
__device__ __forceinline__ void ph_ln1_router2(const P& p, int l, unsigned char* smem, int bid, int nblk, int tid_) {
    int tid = tid_; asm volatile("" : "+v"(tid));
    const int lane = tid & 63, wid = tid >> 6;
    const unsigned* MIX = wsp<unsigned>(p, l == 0 ? R_XQ : R_XBZ); unsigned* X1B = wsp<unsigned>(p, R_XQ + 128 * MiB);
    const unsigned* RES = l == 0 ? wsp<unsigned>(p, R_XBZ) : X1B;
    float* TOKW = wsp<float>(p, OFF_ROUTE + 256 * 1024); int* LIST = wsp<int>(p, OFF_LIST);
    unsigned* CNT = wsp<unsigned>(p, OFF_CTRL) + 64 * l;
    float* wl = (float*)smem;
    float* lgs = wl + 1024 * 20;
    int* ent = (int*)(lgs + 8 * 256);
    int* lcnt = ent + 256;
    int* lbase = lcnt + 32;
    { const f32x4* wgp = (const f32x4*)(p.moe_w_group + (size_t)l * 1024 * 4); const f32x4* wep = (const f32x4*)(p.moe_w_expert + (size_t)l * 1024 * 16);
      f32x4 wg4[2], we4[8];
#pragma unroll
      for (int j = 0; j < 2; ++j) wg4[j] = wgp[tid + NTHR * j];
#pragma unroll
      for (int j = 0; j < 8; ++j) we4[j] = wep[tid + NTHR * j];
#pragma unroll
      for (int j = 0; j < 2; ++j) *(f32x4*)(wl + kpos(tid + NTHR * j) * 20) = wg4[j];
#pragma unroll
      for (int j = 0; j < 8; ++j) { const int q = tid + NTHR * j; *(f32x4*)(wl + kpos(q >> 2) * 20 + 4 + 4 * (q & 3)) = we4[j]; } }
    f32x2 g[8], bt[8];
#pragma unroll
    for (int i = 0; i < 8; ++i) { g[i] = ((const f32x2*)(p.ln1_g + l * 1024))[lane + 64 * i]; bt[i] = ((const f32x2*)(p.ln1_b + l * 1024))[lane + 64 * i]; }
    const int gsel = tred_idx<4>(lane);
    for (int ch = bid; ch < T / 128; ch += nblk) {
        if (tid < 32) lcnt[tid] = 0;
        __syncthreads();
        unsigned xn[8], mn[8];
#pragma unroll
        for (int i = 0; i < 8; ++i) { const size_t o = (size_t)(ch * 128 + wid * 16) * 512 + lane + 64 * i; mn[i] = MIX[o];
            xn[i] = RES[o]; }
        for (int r = 0; r < 16; ++r) {
            const int lr = wid * 16 + r, t = ch * 128 + lr;
            f32x2 v[8];
#pragma unroll
            for (int i = 0; i < 8; ++i) v[i] = (f32x2){bflo(xn[i]), bfhi(xn[i])} * ALPHA + (f32x2){bflo(mn[i]), bfhi(mn[i])};
            if (r + 1 < 16) {
#pragma unroll
                for (int i = 0; i < 8; ++i) { const size_t o = (size_t)(t + 1) * 512 + lane + 64 * i; mn[i] = MIX[o];
                    xn[i] = RES[o]; } }
            ln_row2(v, g, bt);
#pragma unroll
            for (int i = 0; i < 8; ++i) X1B[(size_t)t * 512 + lane + 64 * i] = pk_bf16(v[i][0], v[i][1]);
            f32x2 agv[2];
#pragma unroll
            for (int e = 0; e < 2; ++e) agv[e] = (f32x2){0.f, 0.f};
#pragma unroll
            for (int i = 0; i < 8; ++i)
#pragma unroll
                for (int c = 0; c < 2; ++c) { const float* wrow = wl + (c * 512 + 64 * i + lane) * 20; const f32x2 xx = {v[i][c], v[i][c]};
                    const f32x4 w0 = *(const f32x4*)wrow;
                    agv[0] = __builtin_elementwise_fma(xx, (f32x2){w0[0], w0[1]}, agv[0]); agv[1] = __builtin_elementwise_fma(xx, (f32x2){w0[2], w0[3]}, agv[1]); }
            float ag[4];
#pragma unroll
            for (int e = 0; e < 2; ++e) { ag[2 * e] = agv[e][0]; ag[2 * e + 1] = agv[e][1]; }
            const float rg = tred<4>(ag, lane);
            float gl[4]; float gm = -INFINITY; int gs = 0;
#pragma unroll
            for (int e = 0; e < 4; ++e) { gl[e] = __int_as_float(__builtin_amdgcn_readlane(__float_as_int(rg), 16 * e)) + p.moe_b_group[l * 4 + e]; if (gl[e] > gm) { gm = gl[e]; gs = e; } }
            f32x2 aev[2];
#pragma unroll
            for (int e = 0; e < 2; ++e) aev[e] = (f32x2){0.f, 0.f};
#pragma unroll
            for (int i = 0; i < 8; ++i)
#pragma unroll
                for (int c = 0; c < 2; ++c) { const float* wrow = wl + (c * 512 + 64 * i + lane) * 20 + 4 + 4 * gs; const f32x2 xx = {v[i][c], v[i][c]};
                    const f32x4 w4 = *(const f32x4*)wrow;
                    aev[0] = __builtin_elementwise_fma(xx, (f32x2){w4[0], w4[1]}, aev[0]); aev[1] = __builtin_elementwise_fma(xx, (f32x2){w4[2], w4[3]}, aev[1]); }
            float ae[4];
#pragma unroll
            for (int e = 0; e < 2; ++e) { ae[2 * e] = aev[e][0]; ae[2 * e + 1] = aev[e][1]; }
            const float re = tred<4>(ae, lane);
            float* lw = lgs + wid * 256 + r * 16;
            if ((lane & 15) == 0) { lw[gsel] = rg + p.moe_b_group[l * 4 + gsel]; lw[4 + gsel] = re; }
            if (lane == 0) lw[8] = __int_as_float(gs);
        }
        __builtin_amdgcn_wave_barrier();
        if (lane < 16) {
            const int lr = wid * 16 + lane, t = ch * 128 + lr; const float* lw = lgs + wid * 256 + lane * 16;
            float gl[4]; float gm = -INFINITY;
#pragma unroll
            for (int e = 0; e < 4; ++e) { gl[e] = lw[e]; gm = fmaxf(gm, gl[e]); }
            const int gs = __float_as_int(lw[8]);
            float gsum = 0.f;
#pragma unroll
            for (int e = 0; e < 4; ++e) gsum += expf(gl[e] - gm);
            const float gp = 1.0f / gsum;
            float el[4]; float em = -INFINITY;
#pragma unroll
            for (int e = 0; e < 4; ++e) { el[e] = lw[4 + e] + p.moe_b_expert[l * 16 + gs * 4 + e]; em = fmaxf(em, el[e]); }
            int i0 = 0; float b0 = el[0];
#pragma unroll
            for (int e = 1; e < 4; ++e) if (el[e] > b0) { b0 = el[e]; i0 = e; }
            int i1 = 0; float b1 = -INFINITY;
#pragma unroll
            for (int e = 0; e < 4; ++e) if (e != i0 && el[e] > b1) { b1 = el[e]; i1 = e; }
            const float p0 = expf(b0 - em), p1 = expf(b1 - em);
            const float w0 = gp * p0 / (p0 + p1), w1 = gp * p1 / (p0 + p1);
            if (i1 == i0) i1 = (i0 + 1) & 3;
            const int lo = i0 < i1 ? i0 : i1, hi = i0 < i1 ? i1 : i0;
            const int lid = gs * 6 + (lo == 0 ? hi - 1 : (lo == 1 ? hi + 1 : 5));
            TOKW[t * 2] = i0 < i1 ? w0 : w1; TOKW[t * 2 + 1] = i0 < i1 ? w1 : w0;
            const int s0 = atomicAdd(&lcnt[lid], 1);
            ent[lr] = (lid << 16) | s0;
        }
        __syncthreads();
        if (tid < NLIST) lbase[tid] = (int)atomicAdd(&CNT[tid], (unsigned)lcnt[tid]);
        __syncthreads();
        if (tid < 128) { const int pe = ent[tid], e = pe >> 16, sl = pe & 0xffff; LIST[(size_t)e * T + lbase[e] + sl] = ch * 128 + tid; }
        __syncthreads();
    }
}
__device__ __forceinline__ void ph_ln2_2(const P& p, int l, unsigned char* smem, int bid, int nblk, int tid_) {
    int tid = tid_; asm volatile("" : "+v"(tid));
    const int lane = tid & 63, wid = tid >> 6;
    unsigned* X1B = wsp<unsigned>(p, R_XQ + 128 * MiB); const unsigned* Y = wsp<unsigned>(p, R_XBZ);
    float* LOGF = wsp<float>(p, OFF_DT);
    float* wl = (float*)smem;
    if (l == 0) { f32x4 w4[4];
#pragma unroll
        for (int j = 0; j < 4; ++j) { const int q = tid + NTHR * j; w4[j] = *(const f32x4*)(p.od_w_in + (size_t)(q >> 1) * ODD_IN + 1952 + 4 * (q & 1)); }
#pragma unroll
        for (int j = 0; j < 4; ++j) { const int q = tid + NTHR * j; *(f32x4*)(wl + kpos(q >> 1) * 12 + 4 * (q & 1)) = w4[j]; }
        __syncthreads(); }
    f32x2 g[8], bt[8];
#pragma unroll
    for (int i = 0; i < 8; ++i) { g[i] = ((const f32x2*)(p.ln2_g + l * 1024))[lane + 64 * i]; bt[i] = ((const f32x2*)(p.ln2_b + l * 1024))[lane + 64 * i]; }
    const int fsel = tred_idx<8>(lane); const float fb = p.od_f_bias[fsel];
    unsigned xn[8], ya[8];
    { const int t0 = bid * 8 + wid; if (t0 < T) {
#pragma unroll
        for (int i = 0; i < 8; ++i) { const size_t o = (size_t)t0 * 512 + lane + 64 * i; xn[i] = X1B[o]; ya[i] = Y[o]; } } }
    for (int t = bid * 8 + wid; t < T; t += nblk * 8) {
        f32x2 v[8];
#pragma unroll
        for (int i = 0; i < 8; ++i) v[i] = (f32x2){bflo(xn[i]), bfhi(xn[i])} * ALPHA + (f32x2){bflo(ya[i]), bfhi(ya[i])};
        { const int tn = t + nblk * 8; if (tn < T) {
#pragma unroll
            for (int i = 0; i < 8; ++i) { const size_t o = (size_t)tn * 512 + lane + 64 * i; xn[i] = X1B[o]; ya[i] = Y[o]; } } }
        ln_row2(v, g, bt);
        if (l == 1) {
#pragma unroll
            for (int i = 0; i < 8; ++i) ((f32x2*)(p.out + (size_t)t * 1024))[lane + 64 * i] = v[i];
        } else {
#pragma unroll
            for (int i = 0; i < 8; ++i) X1B[(size_t)t * 512 + lane + 64 * i] = pk_bf16(v[i][0], v[i][1]);
            f32x2 afv[4];
#pragma unroll
            for (int e = 0; e < 4; ++e) afv[e] = (f32x2){0.f, 0.f};
#pragma unroll
            for (int i = 0; i < 8; ++i)
#pragma unroll
                for (int c = 0; c < 2; ++c) { const float* wrow = wl + (c * 512 + 64 * i + lane) * 12; const f32x2 xx = {v[i][c], v[i][c]};
                    const f32x4 w0 = *(const f32x4*)wrow, w1 = *(const f32x4*)(wrow + 4);
                    afv[0] = __builtin_elementwise_fma(xx, (f32x2){w0[0], w0[1]}, afv[0]); afv[1] = __builtin_elementwise_fma(xx, (f32x2){w0[2], w0[3]}, afv[1]);
                    afv[2] = __builtin_elementwise_fma(xx, (f32x2){w1[0], w1[1]}, afv[2]); afv[3] = __builtin_elementwise_fma(xx, (f32x2){w1[2], w1[3]}, afv[3]); }
            float af[8];
#pragma unroll
            for (int e = 0; e < 4; ++e) { af[2 * e] = afv[e][0]; af[2 * e + 1] = afv[e][1]; }
            const float r = tred<8>(af, lane);
            if ((lane & 7) == 0) LOGF[(size_t)t * 8 + fsel] = logsigmoid_f(r + fb);
        }
    }
}

#ifndef USE_MF
#define USE_MF 1
#endif
#ifndef USE_ATT
#define USE_ATT 3
#endif
#ifndef USE_THIN
#define USE_THIN 1
#endif
#ifndef USE_SSD
#define USE_SSD 1
#endif
#ifndef REP_MASK
#define REP_MASK 0
#endif
#ifndef REP_SSD
#define REP_SSD 0
#endif
#ifndef REP_SB
#define REP_SB 0
#endif
constexpr int LDS_BYTES = LDS_STAGE + LDS_TAB_BYTES;
constexpr int NPH = 17;
template <int PH> __device__ __forceinline__ void run_phase(const P& p, unsigned char* smem, int bid, int nblk, int tid_) {
    float* lds = (float*)smem;
    if constexpr (PH == 0) { if (USE_THIN) ph_prologue2(p, smem, bid, nblk, tid_); else ph_prologue(p, bid, nblk, tid_); }
    if constexpr (PH == 1) { if (USE_MF) ph_inproj0_mf(p, smem, bid, nblk, tid_); else ph_inproj0(p, lds, bid, nblk, tid_); }
    if constexpr (PH == 2) { if (USE_SSD) ph_conv2(p, smem, bid, nblk, tid_); else ph_conv(p, bid, nblk, tid_); }
    if constexpr (PH == 3) { if (USE_SSD) ph_ssd_mf(p, smem, bid, nblk, tid_); else ph_ssd_naive(p, lds, bid, nblk, tid_); if (REP_SSD) ph_ssd_mf(p, smem, bid, nblk, tid_);
        if (USE_ATT & 1) ph_sb_mf(p, smem, bid, nblk, tid_); else ph_sb_naive(p, bid, nblk, tid_);
        if (REP_SB) ph_sb_mf(p, smem, bid, nblk, tid_); }
    if constexpr (PH == 4) { if (USE_MF) ph_outproj0_mf(p, smem, bid, nblk, tid_); else ph_outproj0(p, lds, bid, nblk, tid_); }
    if constexpr (PH == 5) { if (USE_THIN) ph_ln1_router2(p, 0, smem, bid, nblk, tid_); else ph_ln1_router(p, 0, bid, nblk, tid_); }
    if constexpr (PH == 6) { ph_moe1_mf(p, 0, smem, bid, nblk, tid_); __syncthreads(); ph_moe2_mf(p, 0, smem, bid, nblk, tid_); }
    if constexpr (PH == 8) { if (USE_THIN) ph_ln2_2(p, 0, smem, bid, nblk, tid_); else ph_ln2(p, 0, bid, nblk, tid_); }
    if constexpr (PH == 9) { if (USE_MF) ph_inproj1_mf(p, smem, bid, nblk, tid_); else ph_inproj1(p, lds, bid, nblk, tid_); }
    if constexpr (PH == 10) { if (USE_MF) ph_upproj_mf(p, smem, bid, nblk, tid_); else ph_upproj(p, lds, bid, nblk, tid_); }
    if constexpr (PH == 11) { if (USE_ATT & 2) ph_attn1_mf(p, smem, bid, nblk, tid_); else ph_attn1_naive(p, bid, nblk, tid_); }
    if constexpr (PH == 12) { if (USE_MF) ph_outproj1_mf(p, smem, bid, nblk, tid_); else ph_outproj1(p, lds, bid, nblk, tid_); }
    if constexpr (PH == 13) { if (USE_THIN) ph_ln1_router2(p, 1, smem, bid, nblk, tid_); else ph_ln1_router(p, 1, bid, nblk, tid_); }
    if constexpr (PH == 14) { ph_moe1_mf(p, 1, smem, bid, nblk, tid_); __syncthreads(); ph_moe2_mf(p, 1, smem, bid, nblk, tid_); }
    if constexpr (PH == 16) { if (USE_THIN) ph_ln2_2(p, 1, smem, bid, nblk, tid_); else ph_ln2(p, 1, bid, nblk, tid_); }
}

__device__ __forceinline__ void load_kargs(P& pl) {
#if defined(__HIP_DEVICE_COMPILE__)
    typedef __attribute__((address_space(4))) const P* kargp_t;
    kargp_t kp = (kargp_t)__builtin_amdgcn_kernarg_segment_ptr(); asm volatile("" : "+s"(kp));
    pl.x = kp->x; pl.ev_w_in = kp->ev_w_in; pl.ev_conv_w = kp->ev_conv_w; pl.ev_conv_b = kp->ev_conv_b; pl.ev_dt_bias = kp->ev_dt_bias; pl.ev_a_log = kp->ev_a_log; pl.ev_d_skip = kp->ev_d_skip; pl.ev_norm_g = kp->ev_norm_g; pl.ev_w_out = kp->ev_w_out; pl.od_w_in = kp->od_w_in; pl.od_q_norm_g = kp->od_q_norm_g; pl.od_w_q_up = kp->od_w_q_up; pl.od_kv_norm_g = kp->od_kv_norm_g; pl.od_w_kv_up = kp->od_w_kv_up; pl.od_f_bias = kp->od_f_bias; pl.od_w_out = kp->od_w_out; pl.ln1_g = kp->ln1_g; pl.ln1_b = kp->ln1_b; pl.ln2_g = kp->ln2_g; pl.ln2_b = kp->ln2_b; pl.moe_w_group = kp->moe_w_group; pl.moe_b_group = kp->moe_b_group; pl.moe_w_expert = kp->moe_w_expert; pl.moe_b_expert = kp->moe_b_expert; pl.moe_w_gate = kp->moe_w_gate; pl.moe_w_up = kp->moe_w_up; pl.moe_w_down = kp->moe_w_down; pl.out = kp->out; pl.ws = kp->ws;
#else
    (void)pl;
#endif
}
#if MK_MULTI
template <int PH> __global__ void __launch_bounds__(NTHR, 2) k_phase(P p) {
    extern __shared__ __attribute__((aligned(16))) unsigned char smem[];
    run_phase<PH>(p, smem, blockIdx.x, gridDim.x, threadIdx.x);
}
template <int PH> static void launch_phases(const P& p, int grid, hipStream_t stream) {
    if constexpr (PH < NPH) {
        (void)hipFuncSetAttribute((const void*)k_phase<PH>, hipFuncAttributeMaxDynamicSharedMemorySize, LDS_BYTES);
        hipLaunchKernelGGL(k_phase<PH>, dim3(grid), dim3(NTHR), LDS_BYTES, stream, p);
        launch_phases<PH + 1>(p, grid, stream);
    }
}
#else
template <int PH> __device__ __forceinline__ void run_all(unsigned char* smem, const XcdBarrier& bar, int wave_s) {
    if constexpr (PH < NPH) {
        asm volatile("; PHASE_MARK %0" :: "n"(PH));
#define RUN_ONE_PHASE() do { int bid_ = blockIdx.x, nblk_ = gridDim.x, w_ = wave_s; asm volatile("" : "+s"(bid_), "+s"(nblk_), "+s"(w_)); \
        int tid_ = (w_ << 6) | lane_id(); asm volatile("" : "+v"(tid_)); P pl; load_kargs(pl); run_phase<PH>(pl, smem, bid_, nblk_, tid_); } while (0)
        RUN_ONE_PHASE();
        if constexpr ((REP_MASK >> PH) & 1) { xcd_barrier(bar); RUN_ONE_PHASE(); }
#undef RUN_ONE_PHASE
        if constexpr (PH < NPH - 1 && PH != 7 && PH != 15) xcd_barrier(bar);
        run_all<PH + 1>(smem, bar, wave_s);
    }
}
__global__ void __launch_bounds__(NTHR, 2) k_all(P p) {
    extern __shared__ __attribute__((aligned(16))) unsigned char smem[];
    volatile LAS unsigned* st = (volatile LAS unsigned*)(smem + LDS_BYTES);
    if (threadIdx.x == 0) { st[0] = 0u; st[1] = 0u; st[2] = 0u; st[3] = 0u; }
    __syncthreads();
    XcdBarrier bar = xcd_barrier_post((unsigned*)(p.ws + OFF_BAR), st);
    const int wave_s = __builtin_amdgcn_readfirstlane(threadIdx.x >> 6);
    run_all<0>(smem, bar, wave_s);
}
#endif

extern "C" void kernel_launch(void* const* d_in, const int* in_sizes, int n_in, void* d_out, int out_size, void* d_ws, size_t ws_size, hipStream_t stream) {
    (void)in_sizes; (void)n_in; (void)out_size;
    if (ws_size < WS_NEED) { fprintf(stderr, "workspace too small: %zu < %zu\n", ws_size, WS_NEED); return; }
    P p{};
    const float** f = (const float**)&p;
    for (int i = 0; i < 27; ++i) f[i] = (const float*)d_in[i];
    p.out = (float*)d_out; p.ws = (unsigned char*)d_ws;
    (void)hipMemsetAsync(d_ws, 0, OFF_CTRL + CTRL_BYTES, stream);
#if MK_MULTI
    launch_phases<0>(p, 256, stream);
#else
    static int grid = 0;
    if (!grid) {
        int dev = 0, cus = 0, per_cu = 0;
        hipGetDevice(&dev);
        hipDeviceGetAttribute(&cus, hipDeviceAttributeMultiprocessorCount, dev);
        (void)hipFuncSetAttribute((const void*)k_all, hipFuncAttributeMaxDynamicSharedMemorySize, LDS_BYTES + 16);
        (void)hipOccupancyMaxActiveBlocksPerMultiprocessor(&per_cu, k_all, NTHR, LDS_BYTES + 16);
        grid = cus * (per_cu < 1 ? per_cu : 1);
        if (grid <= 0) grid = cus;
    }
    hipLaunchKernelGGL(k_all, dim3(grid), dim3(NTHR), LDS_BYTES + 16, stream, p);
#endif
}
```
